# Optimizing an MI355X kernel written in HIP

```python
import math
import jax, jax.numpy as jnp
from jax import lax
import numpy as np

D_MODEL = 1024
BATCH = 8
SEQ = 2048
DEPTH = 4

GRID_W = 64
CTX_LEN = 256

ATT_HEADS = 8
QK_DIM = 64
V_DIM = 2 * QK_DIM
Q_W = ATT_HEADS * 2 * QK_DIM
ATT_W = ATT_HEADS * V_DIM
Q_BLOCK = 128
ROPE_FREQS = QK_DIM // 4
ROPE_BASE = 10000.0
FOURIER_GROUPS = 4
FOURIER_GC = 128
FOURIER_W = FOURIER_GROUPS * FOURIER_GC
POOL_WINDOWS = (2, 4, 8, 16)
POOL_GROUPS = len(POOL_WINDOWS)
POOL_GC = 128
POOL_W = POOL_GROUPS * POOL_GC
N_BRANCH = 3
GATE_W = N_BRANCH * D_MODEL
OFF_K = 0
OFF_V = OFF_K + Q_W
OFF_Q = OFF_V + ATT_W
OFF_F = OFF_Q + Q_W
OFF_P = OFF_F + FOURIER_W
OFF_G = OFF_P + POOL_W
N_IN = OFF_G + GATE_W
D_FF = -(-8 * D_MODEL // (3 * 256)) * 256
ALPHA = (2 * DEPTH) ** 0.25
BETA = (8 * DEPTH) ** -0.25
LN_EPS = 1e-5

kernel_name = "hybrid_diffattn_fourier_pool_dit"


def layer_norm(x, g=None, b=None):
    xf = x.astype(jnp.float32)
    mu = jnp.mean(xf, axis=-1, keepdims=True)
    var = jnp.mean(jnp.square(xf - mu), axis=-1, keepdims=True)
    y = (xf - mu) * lax.rsqrt(var + LN_EPS)
    if g is not None:
        y = y * g.astype(jnp.float32) + b.astype(jnp.float32)
    return y.astype(x.dtype)


def modulate(h, shift, scale):
    return h * (1 + scale) + shift


def axial_rope_tables(rows, dtype):
    row = jnp.repeat(jnp.arange(rows), GRID_W).astype(jnp.float32)
    col = jnp.tile(jnp.arange(GRID_W), rows).astype(jnp.float32)
    inv = ROPE_BASE ** (-jnp.arange(ROPE_FREQS, dtype=jnp.float32) / ROPE_FREQS)
    ar = row[:, None] * inv[None, :]
    ac = col[:, None] * inv[None, :]
    ang = jnp.concatenate([ar, ar, ac, ac], axis=-1)
    return jnp.cos(ang).astype(dtype), jnp.sin(ang).astype(dtype)


def apply_rope(x, cos, sin):
    xr = x.reshape(x.shape[:-1] + (2, 2, ROPE_FREQS))
    rot = jnp.stack([-xr[..., 1, :], xr[..., 0, :]], axis=-2).reshape(x.shape)
    return x * cos[:, None, :] + rot * sin[:, None, :]


def diff_attend(q1, q2, k1, k2, v, lam):
    scale = QK_DIM ** -0.5
    s1 = jnp.einsum('bqhd,bkhd->bhqk', q1, k1).astype(jnp.float32) * scale
    s2 = jnp.einsum('bqhd,bkhd->bhqk', q2, k2).astype(jnp.float32) * scale
    a = jax.nn.softmax(s1, axis=-1) - lam * jax.nn.softmax(s2, axis=-1)
    return jnp.einsum('bhqk,bkhv->bqhv', a.astype(v.dtype), v)


def blocked_diff_attention(q1, q2, k1, k2, v, lam):
    B, S, H, _ = q1.shape
    nb = S // Q_BLOCK

    def blocks(t):
        return jnp.moveaxis(t.reshape(B, nb, Q_BLOCK, H, t.shape[-1]), 1, 0)

    out = lax.map(lambda qs: diff_attend(qs[0], qs[1], k1, k2, v, lam), (blocks(q1), blocks(q2)))
    return jnp.moveaxis(out, 0, 1).reshape(B, S, H, v.shape[-1])


def diff_head_norm(o, g, lam_init):
    B, L = o.shape[:2]
    of = o.astype(jnp.float32)
    y = of * lax.rsqrt(jnp.mean(jnp.square(of), axis=-1, keepdims=True) + LN_EPS)
    y = y * g.astype(jnp.float32) * (1.0 - lam_init)
    return y.reshape(B, L, ATT_W).astype(o.dtype)


def fourier_mix(h):
    B, L, _ = h.shape
    hg = h.reshape(B, L, FOURIER_GROUPS, FOURIER_GC).astype(jnp.float32)
    y = jnp.fft.fft2(hg, axes=(1, 3), norm='ortho').real
    return y.reshape(B, L, FOURIER_W).astype(h.dtype)


def multiscale_pool(h, w_grp, scale):
    B, L, _ = h.shape
    hg = h.reshape(B, L, POOL_GROUPS, POOL_GC).astype(jnp.float32)
    cs = jnp.concatenate([jnp.zeros_like(hg[:, :1]), jnp.cumsum(hg, axis=1)], axis=1)
    t = jnp.arange(L)
    means = []
    for g, w in enumerate(POOL_WINDOWS):
        lo = w // 2
        hi = w - lo
        start = jnp.clip(t - lo, 0, L)
        end = jnp.clip(t + hi, 0, L)
        cnt = (end - start).astype(jnp.float32)
        means.append((cs[:, end, g] - cs[:, start, g]) / cnt[None, :, None])
    pooled = jnp.stack(means, axis=2)
    y = jnp.einsum('blgc,gcd->blgd', (pooled - hg).astype(h.dtype), w_grp)
    return y.reshape(B, L, POOL_W) * scale


def mixer_output(att, tail, lam_init, subln_g_l, w_att_br_l, w_four_br_l,
                 w_pool_grp_l, pool_scale_l, w_pool_br_l, w_out_l):
    B, L = att.shape[:2]
    f_in = tail[..., :FOURIER_W]
    p_in = tail[..., FOURIER_W:FOURIER_W + POOL_W]
    gates = tail[..., FOURIER_W + POOL_W:]
    b_att = diff_head_norm(att, subln_g_l, lam_init) @ w_att_br_l
    b_four = fourier_mix(f_in) @ w_four_br_l
    b_pool = multiscale_pool(p_in, w_pool_grp_l, pool_scale_l) @ w_pool_br_l
    g = jax.nn.sigmoid(gates.astype(jnp.float32)).astype(att.dtype).reshape(B, L, N_BRANCH, D_MODEL)
    m = g[..., 0, :] * b_att + g[..., 1, :] * b_four + g[..., 2, :] * b_pool
    return m @ w_out_l


def swiglu(h, wg, wu, wd):
    return (jax.nn.silu(h @ wg) * (h @ wu)) @ wd


def setup_inputs(seed: int = 0) -> dict:
    key = jax.random.key(seed)
    ks = jax.random.split(key, 24)

    def nrm(k, shape, s):
        return jax.random.normal(k, shape, jnp.float32) * s

    D = D_MODEL
    return {
        "x": nrm(ks[0], (BATCH, SEQ, D), 1.0),
        "c": nrm(ks[1], (BATCH, D), 1.0),
        "ctx": nrm(ks[2], (BATCH, CTX_LEN, D), 1.0),
        "c_ctx": nrm(ks[3], (D,), 1.0),
        "w_mod": nrm(ks[4], (DEPTH, D, 6 * D), 0.5 * D ** -0.5),
        "b_mod": nrm(ks[5], (DEPTH, 6 * D), 0.01),
        "w_in": nrm(ks[6], (DEPTH, D, N_IN), D ** -0.5),
        "lam_qk": nrm(ks[7], (DEPTH, 4, QK_DIM), 0.1),
        "subln_g": 1.0 + nrm(ks[8], (DEPTH, V_DIM), 0.02),
        "w_att_br": nrm(ks[9], (DEPTH, ATT_W, D), ATT_W ** -0.5),
        "w_four_br": nrm(ks[10], (DEPTH, FOURIER_W, D), FOURIER_W ** -0.5),
        "w_pool_grp": nrm(ks[11], (DEPTH, POOL_GROUPS, POOL_GC, POOL_GC), POOL_GC ** -0.5),
        "pool_scale": 1.0 + nrm(ks[12], (DEPTH, POOL_W), 0.02),
        "w_pool_br": nrm(ks[13], (DEPTH, POOL_W, D), POOL_W ** -0.5),
        "w_out": nrm(ks[14], (DEPTH, D, D), BETA * D ** -0.5),
        "ln1_g": 1.0 + nrm(ks[15], (DEPTH, D), 0.02),
        "ln1_b": nrm(ks[16], (DEPTH, D), 0.01),
        "w_ffn_gate": nrm(ks[17], (DEPTH, D, D_FF), D ** -0.5),
        "w_ffn_up": nrm(ks[18], (DEPTH, D, D_FF), D ** -0.5),
        "w_ffn_down": nrm(ks[19], (DEPTH, D_FF, D), BETA * D_FF ** -0.5),
        "ln2_g": 1.0 + nrm(ks[20], (DEPTH, D), 0.02),
        "ln2_b": nrm(ks[21], (DEPTH, D), 0.01),
    }


def reference(x, c, ctx, c_ctx, w_mod, b_mod, w_in, lam_qk, subln_g, w_att_br, w_four_br,
              w_pool_grp, pool_scale, w_pool_br, w_out, ln1_g, ln1_b, w_ffn_gate, w_ffn_up,
              w_ffn_down, ln2_g, ln2_b):
    B, S, _ = x.shape
    Lc = ctx.shape[1]
    H = ATT_HEADS
    ROWS = S // GRID_W
    cos, sin = axial_rope_tables(ROWS, x.dtype)
    xc = ctx
    silu_c = jax.nn.silu(c)
    silu_cc = jax.nn.silu(c_ctx)

    for l in range(DEPTH):
        last = l == DEPTH - 1
        lam_init = 0.8 - 0.6 * math.exp(-0.3 * l)
        lf = lam_qk[l].astype(jnp.float32)
        lam = jnp.exp(jnp.sum(lf[0] * lf[1])) - jnp.exp(jnp.sum(lf[2] * lf[3])) + lam_init

        mod = (silu_c @ w_mod[l] + b_mod[l])[:, None, :]
        modc = (silu_cc @ w_mod[l] + b_mod[l])[None, None, :]
        sh1, sc1, g1, sh2, sc2, g2 = jnp.split(mod, 6, axis=-1)
        csh1, csc1, cg1, csh2, csc2, cg2 = jnp.split(modc, 6, axis=-1)

        uc = modulate(layer_norm(xc), csh1, csc1)
        pc_kv = uc @ w_in[l][:, :OFF_Q]
        ck = pc_kv[..., OFF_K:OFF_V].reshape(B, Lc, H, 2, QK_DIM)
        cv = pc_kv[..., OFF_V:OFF_Q].reshape(B, Lc, H, V_DIM)

        u = modulate(layer_norm(x), sh1, sc1)
        p = u @ w_in[l]
        k = p[..., OFF_K:OFF_V].reshape(B, S, H, 2, QK_DIM)
        v = p[..., OFF_V:OFF_Q].reshape(B, S, H, V_DIM)
        q = p[..., OFF_Q:OFF_F].reshape(B, S, H, 2, QK_DIM)
        q1 = apply_rope(q[..., 0, :], cos, sin)
        q2 = apply_rope(q[..., 1, :], cos, sin)
        k1 = jnp.concatenate([apply_rope(k[..., 0, :], cos, sin), ck[..., 0, :]], axis=1)
        k2 = jnp.concatenate([apply_rope(k[..., 1, :], cos, sin), ck[..., 1, :]], axis=1)
        vv = jnp.concatenate([v, cv], axis=1)
        att = blocked_diff_attention(q1, q2, k1, k2, vv, lam)
        y = mixer_output(att, p[..., OFF_F:], lam_init, subln_g[l], w_att_br[l], w_four_br[l],
                         w_pool_grp[l], pool_scale[l], w_pool_br[l], w_out[l])
        x = layer_norm(ALPHA * x + g1 * y, ln1_g[l], ln1_b[l])

        if not last:
            pc = uc @ w_in[l][:, OFF_Q:]
            cq = pc[..., :Q_W].reshape(B, Lc, H, 2, QK_DIM)
            catt = diff_attend(cq[..., 0, :], cq[..., 1, :], ck[..., 0, :], ck[..., 1, :], cv, lam)
            yc = mixer_output(catt, pc[..., Q_W:], lam_init, subln_g[l], w_att_br[l], w_four_br[l],
                              w_pool_grp[l], pool_scale[l], w_pool_br[l], w_out[l])
            xc = layer_norm(ALPHA * xc + cg1 * yc, ln1_g[l], ln1_b[l])

        f = swiglu(modulate(layer_norm(x), sh2, sc2), w_ffn_gate[l], w_ffn_up[l], w_ffn_down[l])
        x = layer_norm(ALPHA * x + g2 * f, ln2_g[l], ln2_b[l])
        if not last:
            fc = swiglu(modulate(layer_norm(xc), csh2, csc2), w_ffn_gate[l], w_ffn_up[l], w_ffn_down[l])
            xc = layer_norm(ALPHA * xc + cg2 * fc, ln2_g[l], ln2_b[l])

    return x
```

```cpp
#include <hip/hip_runtime.h>
#include <hip/hip_cooperative_groups.h>
#include <cstdio>
#include <cstdint>
#include <cstring>
#include <cmath>
namespace cg = cooperative_groups;

#define DI __device__ __forceinline__
typedef unsigned short bf16_t;
typedef short bf16x8 __attribute__((ext_vector_type(8)));
typedef float f32x4 __attribute__((ext_vector_type(4)));
typedef float f32x2 __attribute__((ext_vector_type(2)));
typedef float f32x16 __attribute__((ext_vector_type(16)));
typedef unsigned u32x2 __attribute__((ext_vector_type(2)));
typedef unsigned u32x4 __attribute__((ext_vector_type(4)));
typedef __bf16 bf16x2_t __attribute__((ext_vector_type(2)));

constexpr int D = 1024, NB = 8, SEQ = 2048, LC = 256, NH = 8, DEPTH = 4;
constexpr int T_LAT = NB * SEQ, T_CTX = NB * LC, T_ALL = T_LAT + T_CTX;
constexpr int NKEY = SEQ + LC;
constexpr int N_IN = 7168, DFF = 2816;
constexpr int WIN_ROWS = 7680;
constexpr int ROW_Z1 = 3072, ROW_Z2 = 3584, ROW_R = 4096, ROW_G = 4608;
constexpr float ALPHA = 1.6817928305074290f;
constexpr float LN_EPS = 1e-5f;
constexpr float QSCALE = 0.125f * 1.4426950408889634f;

constexpr size_t WO_WIN = 0;
constexpr size_t WO_WA = WO_WIN + (size_t)WIN_ROWS * 1024;
constexpr size_t WO_WF = WO_WA + 1024 * 1024;
constexpr size_t WO_WP = WO_WF + 1024 * 512;
constexpr size_t WO_WO = WO_WP + 1024 * 512;
constexpr size_t WO_WGU = WO_WO + 1024 * 1024;
constexpr size_t WO_WD = WO_WGU + (size_t)5632 * 1024;
constexpr size_t W_ELEMS = WO_WD + (size_t)1024 * DFF;

constexpr size_t al256(size_t x) { return (x + 255) & ~(size_t)255; }
constexpr size_t OFF_W = 0;
constexpr size_t OFF_ATAB = al256(OFF_W + W_ELEMS * 2);
constexpr size_t OFF_ATABC = al256(OFF_ATAB + (size_t)2048 * 4096 * 2);
constexpr size_t OFF_ROPEC = al256(OFF_ATABC + (size_t)256 * 512 * 2);
constexpr size_t OFF_ROPES = al256(OFF_ROPEC + (size_t)2048 * 32 * 4);
constexpr size_t OFF_MODV = al256(OFF_ROPES + (size_t)2048 * 32 * 4);
constexpr size_t OFF_LAMV = al256(OFF_MODV + (size_t)DEPTH * 9 * 6144 * 4);
constexpr size_t OFF_X = al256(OFF_LAMV + 256);
constexpr size_t OFF_U = al256(OFF_X + (size_t)T_ALL * 1024 * 4);
constexpr size_t OFF_KB = al256(OFF_U + (size_t)T_ALL * 1024 * 2);
constexpr size_t OFF_VT = al256(OFF_KB + (size_t)NB * NH * 2 * NKEY * 64 * 2);
constexpr size_t OFF_QB = al256(OFF_VT + (size_t)NB * NH * 128 * NKEY * 2);
constexpr size_t OFF_CQ = al256(OFF_QB + (size_t)NB * NH * 2 * SEQ * 64 * 2);
constexpr size_t OFF_ZT = al256(OFF_CQ + (size_t)NB * NH * 2 * LC * 64 * 2);
constexpr size_t OFF_ZTC = al256(OFF_ZT + (size_t)NB * 512 * 4096 * 2);
constexpr size_t OFF_R = al256(OFF_ZTC + (size_t)NB * 512 * 512 * 2);
constexpr size_t OFF_ATT = al256(OFF_R + (size_t)T_ALL * 512 * 2);
constexpr size_t OFF_FM = al256(OFF_ATT + (size_t)T_ALL * 1024 * 2);
constexpr size_t OFF_PM = al256(OFF_FM + (size_t)T_ALL * 512 * 2);
constexpr size_t OFF_BAR = al256(OFF_PM + (size_t)T_ALL * 512 * 2);
constexpr size_t WS_NEED = al256(OFF_BAR + 3456 * 4);
constexpr size_t OFF_MOUT = OFF_KB;
constexpr size_t OFF_Y = OFF_VT;
constexpr size_t OFF_H = OFF_KB;
constexpr size_t OFF_FO = OFF_ATT;
static_assert((size_t)T_ALL * DFF * 2 <= OFF_CQ - OFF_KB, "H overlay too large");

struct Params {
  const float *x, *c, *ctx, *c_ctx, *w_mod, *b_mod, *w_in, *lam_qk, *subln_g, *w_att_br, *w_four_br, *w_pool_grp, *pool_scale,
      *w_pool_br, *w_out, *ln1_g, *ln1_b, *w_ffn_gate, *w_ffn_up, *w_ffn_down, *ln2_g, *ln2_b;
  float* out;
  char* ws;
  float lam_init[4];
  int ph_begin, ph_end;
};

DI int g_tid() { int t = __builtin_amdgcn_workitem_id_x(); asm volatile("" : "+v"(t)); return t; }
DI unsigned pk2(float a, float b) { f32x2 v = {a, b}; bf16x2_t r = __builtin_convertvector(v, bf16x2_t); return __builtin_bit_cast(unsigned, r); }
DI float bf_lo(unsigned u) { return __uint_as_float(u << 16); }
DI float bf_hi(unsigned u) { return __uint_as_float(u & 0xffff0000u); }
DI float hw_cos_rev(float r) { return __builtin_amdgcn_cosf(r); }
DI float hw_sin_rev(float r) { return __builtin_amdgcn_sinf(r); }
DI float sigmoidf_(float x) { return 1.0f / (1.0f + __expf(-x)); }
DI float xor32_sum(float v) { const auto r = __builtin_amdgcn_permlane32_swap(__float_as_uint(v), __float_as_uint(v), false, false); return __uint_as_float(r[0]) + __uint_as_float(r[1]); }
DI float xor32_max(float v) { const auto r = __builtin_amdgcn_permlane32_swap(__float_as_uint(v), __float_as_uint(v), false, false); return fmaxf(__uint_as_float(r[0]), __uint_as_float(r[1])); }
DI float dpp_add(float v, int) { return v; }
#define DPP_ADD(v, ctrl) ((v) + __uint_as_float(__builtin_amdgcn_update_dpp(0u, __float_as_uint(v), (ctrl), 0xF, 0xF, true)))
DI float wave_sum(float v) {
  v = DPP_ADD(v, 0xB1);
  v = DPP_ADD(v, 0x4E);
  v = DPP_ADD(v, 0x141);
  v = DPP_ADD(v, 0x140);
  { const auto r = __builtin_amdgcn_permlane16_swap(__float_as_uint(v), __float_as_uint(v), false, false); v = __uint_as_float(r[0]) + __uint_as_float(r[1]); }
  return xor32_sum(v);
}
#define MFMA16(a, b, c) __builtin_amdgcn_mfma_f32_16x16x32_bf16((a), (b), (c), 0, 0, 0)
#define MFMA32(a, b, c) __builtin_amdgcn_mfma_f32_32x32x16_bf16((a), (b), (c), 0, 0, 0)

constexpr int GSTAGE = 49152;
#define WAIT_VM(n) asm volatile("s_waitcnt vmcnt(" #n ")" ::: "memory")
typedef __attribute__((address_space(3))) void* lds_ptr_t;
template <bool SWAP, int MI = 4>
DI void gemm_kloop(const bf16_t* __restrict__ A, int lda, const bf16_t* __restrict__ B, int ldb, int K, f32x4 (&acc)[MI][4], char* smem, bool pre = false  ) {
  const int tid = g_tid(), lane = tid & 63, wid = __builtin_amdgcn_readfirstlane(tid >> 6), wm = wid >> 1, wn = wid & 1;
  const int lr = tid >> 3, lc = (tid & 7) ^ ((tid >> 4) & 7);
  const unsigned aoff = (unsigned)(lr * lda + lc * 8) * 2u, boff = (unsigned)(lr * ldb + lc * 8) * 2u;
  const char* Ac = (const char*)A; const char* Bc = (const char*)B;
  const int fr = lane & 15, fq = lane >> 4, sw = fr >> 1;
  const int a_base = (wm * 16 * MI + fr) * 128, b_base = 32768 + (wn * 64 + fr) * 128;
  const int nk = K >> 6;
  char* sdst = smem + tid * 16;
#define G_ISSUE(KT, ST) do { _Pragma("unroll") for (int i = 0; i < MI; ++i) \
      __builtin_amdgcn_global_load_lds((const void*)(Ac + ((size_t)(64 * i) * lda + (size_t)(KT) * 64) * 2 + aoff), (lds_ptr_t)(sdst + (ST) * GSTAGE + i * 8192), 16, 0, 0); \
    _Pragma("unroll") for (int i = 0; i < 2; ++i) \
      __builtin_amdgcn_global_load_lds((const void*)(Bc + ((size_t)(64 * i) * ldb + (size_t)(KT) * 64) * 2 + boff), (lds_ptr_t)(sdst + (ST) * GSTAGE + 32768 + i * 8192), 16, 0, 0); } while (0)
#define G_COMPUTE(ST) do { const char* st_ = smem + (ST) * GSTAGE; \
    _Pragma("unroll") for (int ks = 0; ks < 2; ++ks) { const int co = ((ks * 4 + fq) ^ sw) << 4; bf16x8 af[MI], bfr[4]; \
      _Pragma("unroll") for (int i = 0; i < 4; ++i) bfr[i] = *(const bf16x8*)(st_ + b_base + i * 2048 + co); \
      _Pragma("unroll") for (int i = 0; i < MI; ++i) af[i] = *(const bf16x8*)(st_ + a_base + i * 2048 + co); \
      _Pragma("unroll") for (int mi = 0; mi < MI; ++mi) _Pragma("unroll") for (int ni = 0; ni < 4; ++ni) { \
          if (SWAP) acc[mi][ni] = MFMA16(bfr[ni], af[mi], acc[mi][ni]); else acc[mi][ni] = MFMA16(af[mi], bfr[ni], acc[mi][ni]); } } } while (0)
  if (!pre) { G_ISSUE(0, 0); G_ISSUE(1, 1); }
  int st = 0;
  for (int t = 0; t < nk; ++t) {
    if (t == 0 || t + 1 >= nk) WAIT_VM(0);
    else if (MI == 4) WAIT_VM(6); else WAIT_VM(5);
    __builtin_amdgcn_s_barrier();
    asm volatile("" ::: "memory");
    const int st2 = (st == 0) ? 2 : st - 1;
    if (t + 2 < nk) G_ISSUE(t + 2, st2);
    __builtin_amdgcn_sched_barrier(0);
    G_COMPUTE(st);
    __builtin_amdgcn_sched_group_barrier(0x100, 6, 0);
#pragma unroll
    for (int i_ = 0; i_ < 2 * MI + 2; ++i_) { __builtin_amdgcn_sched_group_barrier(0x008, 2, 0); __builtin_amdgcn_sched_group_barrier(0x100, 1, 0); }
    __builtin_amdgcn_sched_group_barrier(0x008, 4 * MI - 4, 0);
    __builtin_amdgcn_sched_barrier(0);
    st = (st == 2) ? 0 : st + 1;
  }
  asm volatile("s_waitcnt lgkmcnt(0)" ::: "memory");
  __builtin_amdgcn_s_barrier();
  asm volatile("" ::: "memory");
#undef G_ISSUE
#undef G_COMPUTE
}
template <bool SWAP, int MI = 4>
DI void gemm_kloop_pp(const bf16_t* __restrict__ A, int lda, const bf16_t* __restrict__ B, int ldb, int K, f32x4 (&acc)[MI][4], char* smem) {
  const int tid = g_tid(), lane = tid & 63, wid = __builtin_amdgcn_readfirstlane(tid >> 6), wm = wid >> 1, wn = wid & 1, grp = wid >> 2;
  const int lr = tid >> 3, lc = (tid & 7) ^ ((tid >> 4) & 7);
  const unsigned aoff = (unsigned)(lr * lda + lc * 8) * 2u, boff = (unsigned)(lr * ldb + lc * 8) * 2u;
  const char* Ac = (const char*)A; const char* Bc = (const char*)B;
  const int fr = lane & 15, fq = lane >> 4, sw = fr >> 1;
  const int a_base = (wm * 16 * MI + fr) * 128, b_base = 32768 + (wn * 64 + fr) * 128;
  const int nk = K >> 6;
  char* sdst = smem + tid * 16;
#define P_ISSUE(KT, ST) do { _Pragma("unroll") for (int i = 0; i < MI; ++i) \
      __builtin_amdgcn_global_load_lds((const void*)(Ac + ((size_t)(64 * i) * lda + (size_t)(KT) * 64) * 2 + aoff), (lds_ptr_t)(sdst + (ST) * GSTAGE + i * 8192), 16, 0, 0); \
    _Pragma("unroll") for (int i = 0; i < 2; ++i) \
      __builtin_amdgcn_global_load_lds((const void*)(Bc + ((size_t)(64 * i) * ldb + (size_t)(KT) * 64) * 2 + boff), (lds_ptr_t)(sdst + (ST) * GSTAGE + 32768 + i * 8192), 16, 0, 0); } while (0)
  P_ISSUE(0, 0);
  P_ISSUE(1, 1);
  WAIT_VM(0);
  __builtin_amdgcn_s_barrier();
  asm volatile("" ::: "memory");
  if (grp == 1) { __builtin_amdgcn_s_barrier(); asm volatile("" ::: "memory"); }
  int st = 0;
  for (int t = 0; t < nk; ++t) {
    const int st2 = (st == 0) ? 2 : st - 1;
    if (t + 2 < nk) P_ISSUE(t + 2, st2);
    bf16x8 af[2][MI], bfr[2][4];
    const char* st_ = smem + st * GSTAGE;
#pragma unroll
    for (int ks = 0; ks < 2; ++ks) {
      const int co = ((ks * 4 + fq) ^ sw) << 4;
#pragma unroll
      for (int i = 0; i < 4; ++i) bfr[ks][i] = *(const bf16x8*)(st_ + b_base + i * 2048 + co);
#pragma unroll
      for (int i = 0; i < MI; ++i) af[ks][i] = *(const bf16x8*)(st_ + a_base + i * 2048 + co);
    }
    if (t + 2 < nk) { if (MI == 4) WAIT_VM(6); else WAIT_VM(5); } else WAIT_VM(0);
    asm volatile("s_waitcnt lgkmcnt(0)" ::: "memory");
    __builtin_amdgcn_sched_barrier(0);
    __builtin_amdgcn_s_barrier();
    asm volatile("" ::: "memory");
#pragma unroll
    for (int ks = 0; ks < 2; ++ks)
#pragma unroll
      for (int mi = 0; mi < MI; ++mi)
#pragma unroll
        for (int ni = 0; ni < 4; ++ni) {
          if (SWAP) acc[mi][ni] = MFMA16(bfr[ks][ni], af[ks][mi], acc[mi][ni]); else acc[mi][ni] = MFMA16(af[ks][mi], bfr[ks][ni], acc[mi][ni]);
        }
    __builtin_amdgcn_sched_barrier(0);
    __builtin_amdgcn_s_barrier();
    asm volatile("" ::: "memory");
    st = (st == 2) ? 0 : st + 1;
  }
  if (grp == 0) { __builtin_amdgcn_s_barrier(); asm volatile("" ::: "memory"); }
#undef P_ISSUE
}

template <int MI>
DI void gemm_prefetch(const bf16_t* __restrict__ A, int lda, const bf16_t* __restrict__ B, int ldb, char* smem) {
  const int tid = g_tid();
  const int lr = tid >> 3, lc = (tid & 7) ^ ((tid >> 4) & 7);
  const unsigned aoff = (unsigned)(lr * lda + lc * 8) * 2u, boff = (unsigned)(lr * ldb + lc * 8) * 2u;
  const char* Ac = (const char*)A; const char* Bc = (const char*)B;
  char* sdst = smem + tid * 16;
#pragma unroll
  for (int kt = 0; kt < 2; ++kt) {
#pragma unroll
    for (int i = 0; i < MI; ++i)
      __builtin_amdgcn_global_load_lds((const void*)(Ac + ((size_t)(64 * i) * lda + (size_t)kt * 64) * 2 + aoff), (lds_ptr_t)(sdst + kt * GSTAGE + i * 8192), 16, 0, 0);
#pragma unroll
    for (int i = 0; i < 2; ++i)
      __builtin_amdgcn_global_load_lds((const void*)(Bc + ((size_t)(64 * i) * ldb + (size_t)kt * 64) * 2 + boff), (lds_ptr_t)(sdst + kt * GSTAGE + 32768 + i * 8192), 16, 0, 0);
  }
}
template <int MI>
DI void zero_acc_t(f32x4 (&acc)[MI][4]) {
#pragma unroll
  for (int i = 0; i < MI; ++i)
#pragma unroll
    for (int j = 0; j < 4; ++j) acc[i][j] = (f32x4){0.f, 0.f, 0.f, 0.f};
}
DI void zero_acc(f32x4 (&acc)[4][4]) {
#pragma unroll
  for (int i = 0; i < 4; ++i)
#pragma unroll
    for (int j = 0; j < 4; ++j) acc[i][j] = (f32x4){0.f, 0.f, 0.f, 0.f};
}

template <bool SWAP>
DI void gemm_kloop_big(const bf16_t* __restrict__ A, int lda, const bf16_t* __restrict__ B, int ldb, int K, f32x4 (&acc)[8][4], char* smem, bool pre = false) {
  const int tid = g_tid(), lane = tid & 63, wid = __builtin_amdgcn_readfirstlane(tid >> 6), wm = wid >> 2, wn = wid & 3;
  const int lr = tid >> 3, lc = (tid & 7) ^ ((tid >> 4) & 7);
  const unsigned aoff = (unsigned)(lr * lda + lc * 8) * 2u, boff = (unsigned)(lr * ldb + lc * 8) * 2u;
  const char* Ac = (const char*)A; const char* Bc = (const char*)B;
  const int fr = lane & 15, fq = lane >> 4, sw = fr >> 1;
  const int a_base = (wm * 128 + fr) * 128, b_base = 32768 + (wn * 64 + fr) * 128;
  const int nk = K >> 6;
  char* sdst = smem + tid * 16;
#define GB_ISSUE(KT, ST) do { _Pragma("unroll") for (int i = 0; i < 4; ++i) { \
      __builtin_amdgcn_global_load_lds((const void*)(Ac + ((size_t)(64 * i) * lda + (size_t)(KT) * 64) * 2 + aoff), (lds_ptr_t)(sdst + (ST) * 65536 + i * 8192), 16, 0, 0); \
      __builtin_amdgcn_global_load_lds((const void*)(Bc + ((size_t)(64 * i) * ldb + (size_t)(KT) * 64) * 2 + boff), (lds_ptr_t)(sdst + (ST) * 65536 + 32768 + i * 8192), 16, 0, 0); } } while (0)
  if (!pre) GB_ISSUE(0, 0);
  for (int t = 0; t < nk; ++t) {
    WAIT_VM(0);
    __builtin_amdgcn_s_barrier();
    asm volatile("" ::: "memory");
    if (t + 1 < nk) GB_ISSUE(t + 1, (t + 1) & 1);
    __builtin_amdgcn_sched_barrier(0);
    const char* st_ = smem + (t & 1) * 65536;
#pragma unroll
    for (int ks = 0; ks < 2; ++ks) {
      const int co = ((ks * 4 + fq) ^ sw) << 4;
      bf16x8 af[8], bfr[4];
#pragma unroll
      for (int i = 0; i < 4; ++i) bfr[i] = *(const bf16x8*)(st_ + b_base + i * 2048 + co);
#pragma unroll
      for (int i = 0; i < 8; ++i) af[i] = *(const bf16x8*)(st_ + a_base + i * 2048 + co);
#pragma unroll
      for (int mi = 0; mi < 8; ++mi)
#pragma unroll
        for (int ni = 0; ni < 4; ++ni) {
          if (SWAP) acc[mi][ni] = MFMA16(bfr[ni], af[mi], acc[mi][ni]); else acc[mi][ni] = MFMA16(af[mi], bfr[ni], acc[mi][ni]);
        }
    }
    __builtin_amdgcn_sched_group_barrier(0x100, 8, 0);
#pragma unroll
    for (int i_ = 0; i_ < 16; ++i_) { __builtin_amdgcn_sched_group_barrier(0x008, 3, 0); __builtin_amdgcn_sched_group_barrier(0x100, 1, 0); }
    __builtin_amdgcn_sched_group_barrier(0x008, 16, 0);
    __builtin_amdgcn_sched_barrier(0);
  }
  asm volatile("s_waitcnt lgkmcnt(0)" ::: "memory");
  __builtin_amdgcn_s_barrier();
  asm volatile("" ::: "memory");
#undef GB_ISSUE
}

namespace pg8 {
#define PG8_LAS __attribute__((address_space(3)))
constexpr int BM = 256, BK = 64, HALF = 128, HTB = HALF * BK * 2;
DI int lds_byte(int r, int c) { const int st = (r >> 4) * 2 + (c >> 5), rr = r & 15, cc = c & 31, ob = rr * 64 + cc * 2; return st * 1024 + (ob ^ (((ob >> 9) & 1) << 5)); }
DI void stage_rc(int b, int& R, int& C) { const int st = b / 1024, sb = b % 1024, swz = sb ^ (((sb >> 9) & 1) << 5); R = (st >> 1) * 16 + swz / 64; C = (st & 1) * 32 + (swz % 64) / 2; }
struct Unit { int pm, pn; };
template <class Epi, class Sched>
DI void gemm_phase(PG8_LAS unsigned char* lds, int K, const Sched& S, const Epi& E) {
  const int tid = g_tid(), wid = __builtin_amdgcn_readfirstlane(tid >> 6), lane = tid & 63, wr = wid >> 2, wc = wid & 3, fr = lane & 15, fq = lane >> 4;
  const int nt = K / BK;
  unsigned voff[2];
#pragma unroll
  for (int i = 0; i < 2; ++i) { int R, C; stage_rc(tid * 16 + i * 8192, R, C); voff[i] = (unsigned)(R * K + C) * 2u; }
  const size_t kstep = (size_t)(BK * 2);
  const size_t hstep = (size_t)HALF * K * 2;
  const unsigned ldsw = (unsigned)wid * 1024u;
  const int aoff = lds_byte(wr * 64 + fr, fq * 8), boff = lds_byte(wc * 32 + fr, fq * 8);
#define PG8_SA(b, h) (((b) * 2 + (h)) * HTB)
#define PG8_SB(b, h) ((4 + (b) * 2 + (h)) * HTB)
#define PG8_STAGE(bufoff, gbase) do { _Pragma("unroll") for (int _i = 0; _i < 2; ++_i) \
    __builtin_amdgcn_global_load_lds((const void*)((const char*)(gbase) + voff[_i]), (PG8_LAS void*)(lds + (bufoff) + ldsw + _i * 8192), 16, 0, 0); } while (0)
#define PG8_LDA(dst, b, h) do { _Pragma("unroll") for (int m = 0; m < 4; ++m) _Pragma("unroll") for (int k = 0; k < 2; ++k) dst[m][k] = *(const PG8_LAS bf16x8*)(lds + PG8_SA(b, h) + aoff + m * 2048 + k * 1024); } while (0)
#define PG8_LDB(dst, b, h) do { _Pragma("unroll") for (int n = 0; n < 2; ++n) _Pragma("unroll") for (int k = 0; k < 2; ++k) dst[n][k] = *(const PG8_LAS bf16x8*)(lds + PG8_SB(b, h) + boff + n * 2048 + k * 1024); } while (0)
#define PG8_MMA(ai, bj, At, Bt) do { __builtin_amdgcn_s_setprio(1); _Pragma("unroll") for (int m = 0; m < 4; ++m) _Pragma("unroll") for (int n = 0; n < 2; ++n) _Pragma("unroll") for (int k = 0; k < 2; ++k) \
    acc[ai][bj][m][n] = __builtin_amdgcn_mfma_f32_16x16x32_bf16(Bt[n][k], At[m][k], acc[ai][bj][m][n], 0, 0, 0); __builtin_amdgcn_s_setprio(0); } while (0)
#define PG8_WAIT_V(n) asm volatile("s_waitcnt vmcnt(" #n ")" ::: "memory")
#define PG8_WAIT_L(n) asm volatile("s_waitcnt lgkmcnt(" #n ")" ::: "memory")
#define PG8_BAR __builtin_amdgcn_s_barrier()
#define PG8_SCHED __builtin_amdgcn_sched_barrier(0)
  Unit cur, nxt; int ui = 0;
  if (!S.next(0, cur)) return;
  f32x4 acc[2][2][4][2];
#pragma unroll
  for (int a = 0; a < 2; ++a)
#pragma unroll
    for (int b = 0; b < 2; ++b)
#pragma unroll
      for (int m = 0; m < 4; ++m)
#pragma unroll
        for (int n = 0; n < 2; ++n) acc[a][b][m][n] = (f32x4){0.f, 0.f, 0.f, 0.f};
  bf16x8 At[4][2], B0[2][2], B1[2][2];
  const char* cA = S.pa(cur); const char* cB = S.pb(cur);
  PG8_WAIT_V(0);
  PG8_STAGE(PG8_SB(0, 0), cB); PG8_STAGE(PG8_SA(0, 0), cA); PG8_STAGE(PG8_SB(0, 1), cB + hstep); PG8_STAGE(PG8_SA(0, 1), cA + hstep);
  if (wr == 1) PG8_BAR;
  PG8_WAIT_V(4); PG8_BAR;
  PG8_STAGE(PG8_SB(1, 0), cB + kstep); PG8_STAGE(PG8_SA(1, 0), cA + kstep); PG8_STAGE(PG8_SB(1, 1), cB + hstep + kstep);
  PG8_WAIT_V(6); PG8_BAR;
  for (;;) {
    const bool has_next = S.next(ui + 1, nxt);
    const char* nA = has_next ? S.pa(nxt) : cA; const char* nB = has_next ? S.pb(nxt) : cB;
    for (int t = 0; t < nt; t += 2) {
      const bool last = (t == nt - 2);
      const char* a1 = cA + (size_t)(t + 1) * kstep;
      const char* a2 = last ? nA : cA + (size_t)(t + 2) * kstep; const char* b2 = last ? nB : cB + (size_t)(t + 2) * kstep;
      const char* a3 = a2 + kstep; const char* b3 = b2 + kstep;
      PG8_LDB(B0, 0, 0); PG8_SCHED; PG8_LDA(At, 0, 0); PG8_STAGE(PG8_SA(1, 1), a1 + hstep);
      PG8_WAIT_L(8); PG8_BAR; PG8_WAIT_L(0); PG8_MMA(0, 0, At, B0); PG8_BAR; PG8_SCHED;
      PG8_LDB(B1, 0, 1); PG8_STAGE(PG8_SB(0, 0), b2);
      PG8_BAR; PG8_WAIT_L(0); PG8_MMA(0, 1, At, B1); PG8_BAR;
      PG8_LDA(At, 0, 1); PG8_STAGE(PG8_SA(0, 0), a2);
      PG8_BAR; PG8_WAIT_L(0); PG8_MMA(1, 0, At, B0); PG8_BAR; PG8_SCHED;
      PG8_STAGE(PG8_SB(0, 1), b2 + hstep);
      PG8_WAIT_V(6); PG8_BAR; PG8_MMA(1, 1, At, B1); PG8_BAR;
      PG8_LDB(B0, 1, 0); PG8_SCHED; PG8_LDA(At, 1, 0); PG8_STAGE(PG8_SA(0, 1), a2 + hstep);
      PG8_WAIT_L(8); PG8_BAR; PG8_WAIT_L(0); PG8_MMA(0, 0, At, B0); PG8_BAR; PG8_SCHED;
      PG8_LDB(B1, 1, 1); PG8_STAGE(PG8_SB(1, 0), b3);
      PG8_BAR; PG8_WAIT_L(0); PG8_MMA(0, 1, At, B1); PG8_BAR;
      PG8_LDA(At, 1, 1); PG8_STAGE(PG8_SA(1, 0), a3);
      PG8_BAR; PG8_WAIT_L(0); PG8_MMA(1, 0, At, B0); PG8_BAR; PG8_SCHED;
      PG8_STAGE(PG8_SB(1, 1), b3 + hstep);
      PG8_WAIT_V(6); PG8_BAR; PG8_MMA(1, 1, At, B1); PG8_BAR;
    }
    E(acc, cur, wr, wc, fr, fq);
    if (!has_next) break;
#pragma unroll
    for (int a = 0; a < 2; ++a)
#pragma unroll
      for (int b = 0; b < 2; ++b)
#pragma unroll
        for (int m = 0; m < 4; ++m)
#pragma unroll
          for (int n = 0; n < 2; ++n) acc[a][b][m][n] = (f32x4){0.f, 0.f, 0.f, 0.f};
    cur = nxt; cA = nA; cB = nB; ++ui;
  }
  PG8_WAIT_V(0);
  if (wr == 0) PG8_BAR;
  PG8_BAR;
#undef PG8_SA
#undef PG8_SB
#undef PG8_STAGE
#undef PG8_LDA
#undef PG8_LDB
#undef PG8_MMA
#undef PG8_WAIT_V
#undef PG8_WAIT_L
#undef PG8_BAR
#undef PG8_SCHED
}
}

DI void gemm_prefetch_big(const bf16_t* __restrict__ A, int lda, const bf16_t* __restrict__ B, int ldb, char* smem) {
  const int tid = g_tid();
  const int lr = tid >> 3, lc = (tid & 7) ^ ((tid >> 4) & 7);
  const unsigned aoff = (unsigned)(lr * lda + lc * 8) * 2u, boff = (unsigned)(lr * ldb + lc * 8) * 2u;
  const char* Ac = (const char*)A; const char* Bc = (const char*)B;
  char* sdst = smem + tid * 16;
#pragma unroll
  for (int i = 0; i < 4; ++i) {
    __builtin_amdgcn_global_load_lds((const void*)(Ac + ((size_t)(64 * i) * lda) * 2 + aoff), (lds_ptr_t)(sdst + i * 8192), 16, 0, 0);
    __builtin_amdgcn_global_load_lds((const void*)(Bc + ((size_t)(64 * i) * ldb) * 2 + boff), (lds_ptr_t)(sdst + 32768 + i * 8192), 16, 0, 0);
  }
}

DI void row_info(int r, int& b, int& pos, bool& isctx) {
  if (r < T_LAT) { b = r >> 11; pos = r & 2047; isctx = false; } else { const int q = r - T_LAT; b = q >> 8; pos = q & 255; isctx = true; }
}

constexpr int HALF_LDS = 65792;
DI void conv_tile(bool active, const float* __restrict__ src, int ld, int k0, int c0, bf16_t* __restrict__ dst, int dstld, int ilv  , int n0, char* smem) {
  float* s = (float*)smem;
  const int tid = g_tid() & 255;
  if (active) {
#pragma unroll
    for (int i = 0; i < 4; ++i) {
      const int k = (tid >> 4) + 16 * i, cc = (tid & 15) * 4;
      const f32x4 v = *(const f32x4*)(src + (size_t)(k0 + k) * ld + c0 + n0 + cc);
      s[k * 65 + cc] = v[0]; s[k * 65 + cc + 1] = v[1]; s[k * 65 + cc + 2] = v[2]; s[k * 65 + cc + 3] = v[3];
    }
  }
  __syncthreads();
  if (active) {
    const int n = tid >> 2, kq = (tid & 3) * 16;
    unsigned w[8];
#pragma unroll
    for (int j = 0; j < 8; ++j) w[j] = pk2(s[(kq + 2 * j) * 65 + n], s[(kq + 2 * j + 1) * 65 + n]);
    const int ng = n0 + n;
    size_t drow = ng;
    if (ilv) drow = (size_t)(ng >> 4) * 32 + (ng & 15) + (ilv == 2 ? 16 : 0);
    bf16_t* dp = dst + drow * dstld + k0 + kq;
    *(u32x4*)dp = (u32x4){w[0], w[1], w[2], w[3]};
    *(u32x4*)(dp + 8) = (u32x4){w[4], w[5], w[6], w[7]};
  }
  __syncthreads();
}
DI void fold_tile(bool active, const float* __restrict__ src  , int cbase, int k0, int np0  , int mode, const float* __restrict__ wgrp,
                  const float* __restrict__ pscale, bf16_t* __restrict__ dst  , char* smem) {
  float* sA = (float*)smem;
  float* sT = (float*)(smem + 33024);
  const int tid = g_tid() & 255;
  if (active) {
    for (int i = tid; i < 64 * 32; i += 256) {
      const int k = i >> 5, c4 = (i & 31) * 4;
      const f32x4 v = *(const f32x4*)(src + (size_t)(k0 + k) * N_IN + cbase + c4);
      sA[k * 129 + c4] = v[0]; sA[k * 129 + c4 + 1] = v[1]; sA[k * 129 + c4 + 2] = v[2]; sA[k * 129 + c4 + 3] = v[3];
    }
    for (int i = tid; i < 128 * 64; i += 256) {
      const int c = i >> 6, n = i & 63, np = np0 + n;
      float t;
      if (mode == 2) t = wgrp[c * 128 + np] * pscale[np];
      else { const float r = (float)((c * np) & 127) * (1.0f / 128.0f); t = (mode == 0) ? hw_cos_rev(r) : hw_sin_rev(r); }
      sT[c * 64 + n] = t;
    }
  }
  __syncthreads();
  if (active) {
    const int ty = tid >> 4, tx = tid & 15;
    float acc[4][4];
#pragma unroll
    for (int a = 0; a < 4; ++a)
#pragma unroll
      for (int b = 0; b < 4; ++b) acc[a][b] = 0.f;
    for (int c = 0; c < 128; ++c) {
      const f32x4 t4 = *(const f32x4*)(sT + c * 64 + tx * 4);
      float a4[4];
#pragma unroll
      for (int a = 0; a < 4; ++a) a4[a] = sA[(ty * 4 + a) * 129 + c];
#pragma unroll
      for (int a = 0; a < 4; ++a)
#pragma unroll
        for (int b = 0; b < 4; ++b) acc[a][b] += a4[a] * t4[b];
    }
#pragma unroll
    for (int b = 0; b < 4; ++b) {
      bf16_t* dp = dst + (size_t)(np0 + tx * 4 + b) * 1024 + k0 + ty * 4;
      *(u32x2*)dp = (u32x2){pk2(acc[0][b], acc[1][b]), pk2(acc[2][b], acc[3][b])};
    }
  }
  __syncthreads();
}

DI void convert_layer(const Params& p, int l, char* smem0) {
  bf16_t* W = (bf16_t*)(p.ws + OFF_W);
  const float* win = p.w_in + (size_t)l * 1024 * N_IN;
  const int half = g_tid() >> 8;
  char* smem = smem0 + half * HALF_LDS;
  constexpr int C0 = 16 * 48, C1 = C0 + 16 * 48, C2 = C1 + 16 * 16, C3 = C2 + 8 * 16, C4 = C3 + 8 * 16, C5 = C4 + 16 * 16, C6 = C5 + 16 * 44, C7 = C6 + 16 * 44,
                C8 = C7 + 44 * 16, C9 = C8 + 256, C10 = C9 + 128;
  static_assert((C0 | C1 | C2 | C3 | C4 | C5 | C6 | C7 | C8 | C9 | C10) % 2 == 0, "segment boundaries must be even");
  const int total = C10;
  for (int tb = blockIdx.x * 2; tb < total; tb += gridDim.x * 2) {
    const bool active = (tb + half) < total;
    const int t = active ? tb + half : tb;
    int seg, r;
    if (t < C0) { seg = 0; r = t; } else if (t < C1) { seg = 1; r = t - C0; } else if (t < C2) { seg = 2; r = t - C1; } else if (t < C3) { seg = 3; r = t - C2; }
    else if (t < C4) { seg = 4; r = t - C3; } else if (t < C5) { seg = 5; r = t - C4; } else if (t < C6) { seg = 6; r = t - C5; } else if (t < C7) { seg = 7; r = t - C6; }
    else if (t < C8) { seg = 8; r = t - C7; } else if (t < C9) { seg = 9; r = t - C8; } else { seg = 10; r = t - C9; }
    if (seg <= 8) {
      const float* src; int ld, kt, nt, c0 = 0, dstld, ilv = 0; bf16_t* dst;
      if (seg <= 1) { kt = r & 15; nt = r >> 4; src = win; ld = N_IN; c0 = seg == 0 ? 0 : 4096; dst = W + WO_WIN + (seg == 0 ? 0 : (size_t)ROW_G * 1024); dstld = 1024; }
      else if (seg == 2) { kt = r & 15; nt = r >> 4; src = p.w_att_br + (size_t)l * 1024 * 1024; ld = 1024; dst = W + WO_WA; dstld = 1024; }
      else if (seg == 3) { kt = r & 7; nt = r >> 3; src = p.w_four_br + (size_t)l * 512 * 1024; ld = 1024; dst = W + WO_WF; dstld = 512; }
      else if (seg == 4) { kt = r & 7; nt = r >> 3; src = p.w_pool_br + (size_t)l * 512 * 1024; ld = 1024; dst = W + WO_WP; dstld = 512; }
      else if (seg == 5) { kt = r & 15; nt = r >> 4; src = p.w_out + (size_t)l * 1024 * 1024; ld = 1024; dst = W + WO_WO; dstld = 1024; }
      else if (seg == 6) { kt = r & 15; nt = r >> 4; src = p.w_ffn_gate + (size_t)l * 1024 * DFF; ld = DFF; dst = W + WO_WGU; dstld = 1024; ilv = 1; }
      else if (seg == 7) { kt = r & 15; nt = r >> 4; src = p.w_ffn_up + (size_t)l * 1024 * DFF; ld = DFF; dst = W + WO_WGU; dstld = 1024; ilv = 2; }
      else { kt = r % 44; nt = r / 44; src = p.w_ffn_down + (size_t)l * DFF * 1024; ld = 1024; dst = W + WO_WD; dstld = DFF; }
      conv_tile(active, src, ld, kt * 64, c0, dst, dstld, ilv, nt * 64, smem);
    } else if (seg == 9) {
      const int kt = r & 15, q = r >> 4; const int g = q & 3, hf = (q >> 2) & 1, mode = q >> 3;
      fold_tile(active, win, 3072 + g * 128, kt * 64, hf * 64, mode, nullptr, nullptr, W + WO_WIN + (size_t)((mode ? ROW_Z2 : ROW_Z1) + g * 128) * 1024, smem);
    } else {
      const int kt = r & 15, q = r >> 4; const int g = q & 3, hf = q >> 2;
      fold_tile(active, win, 3584 + g * 128, kt * 64, hf * 64, 2, p.w_pool_grp + ((size_t)l * 4 + g) * 128 * 128, p.pool_scale + (size_t)l * 512 + g * 128,
                W + WO_WIN + (size_t)(ROW_R + g * 128) * 1024, smem);
    }
  }
}

DI void phase0a(const Params& p, char* smem) {
  const int tid = g_tid();
  const int gtid = blockIdx.x * 512 + tid, gsz = gridDim.x * 512;
  {
    const int half = tid >> 8, t8 = tid & 255;
    float* ssil = (float*)smem;
    float* sred = (float*)(smem + 36864 + half * 9216);
    bool filled = false;
    float* modv = (float*)(p.ws + OFF_MODV);
    for (int tb = blockIdx.x * 2; tb < DEPTH * 96; tb += gridDim.x * 2) {
      if (!filled) {
        for (int i = tid; i < 9 * 1024; i += 512) { const float v = (i < 8192) ? p.c[i] : p.c_ctx[i - 8192]; ssil[i] = v * sigmoidf_(v); }
        filled = true;
        __syncthreads();
      }
      const int t = tb + half;
      const int l = t / 96, cgp = t % 96;
      const int col = cgp * 64 + (t8 & 63), kq = t8 >> 6;
      const float* wp = p.w_mod + ((size_t)l * 1024 + kq * 256) * 6144 + col;
      float a[9];
#pragma unroll
      for (int r = 0; r < 9; ++r) a[r] = 0.f;
#pragma unroll 4
      for (int k = 0; k < 256; ++k) {
        const float w = wp[(size_t)k * 6144];
#pragma unroll
        for (int r = 0; r < 9; ++r) a[r] += ssil[r * 1024 + kq * 256 + k] * w;
      }
#pragma unroll
      for (int r = 0; r < 9; ++r) sred[(kq * 9 + r) * 64 + (t8 & 63)] = a[r];
      __syncthreads();
      for (int i = t8; i < 9 * 64; i += 256) {
        const int r = i >> 6, cc = i & 63;
        const float v = sred[(0 * 9 + r) * 64 + cc] + sred[(1 * 9 + r) * 64 + cc] + sred[(2 * 9 + r) * 64 + cc] + sred[(3 * 9 + r) * 64 + cc];
        modv[((size_t)l * 9 + r) * 6144 + cgp * 64 + cc] = v + p.b_mod[(size_t)l * 6144 + cgp * 64 + cc];
      }
      __syncthreads();
    }
    __syncthreads();
  }
  convert_layer(p, 0, smem);
  {
    bf16_t* at = (bf16_t*)(p.ws + OFF_ATAB);
    for (int i = gtid; i < 2048 * 512; i += gsz) {
      const int k = i >> 9, c8 = (i & 511) * 8;
      unsigned w[4];
#pragma unroll
      for (int j = 0; j < 4; ++j) {
        float v[2];
#pragma unroll
        for (int e = 0; e < 2; ++e) {
          const int tp = c8 + 2 * j + e; const int tt = tp & 2047;
          const float r = (float)((k * tt) & 2047) * (1.0f / 2048.0f);
          v[e] = (tp < 2048) ? hw_cos_rev(r) : -hw_sin_rev(r);
        }
        w[j] = pk2(v[0], v[1]);
      }
      *(u32x4*)(at + (size_t)k * 4096 + c8) = (u32x4){w[0], w[1], w[2], w[3]};
    }
    bf16_t* atc = (bf16_t*)(p.ws + OFF_ATABC);
    for (int i = gtid; i < 256 * 64; i += gsz) {
      const int k = i >> 6, c8 = (i & 63) * 8;
      unsigned w[4];
#pragma unroll
      for (int j = 0; j < 4; ++j) {
        float v[2];
#pragma unroll
        for (int e = 0; e < 2; ++e) {
          const int tp = c8 + 2 * j + e; const int tt = tp & 255;
          const float r = (float)((k * tt) & 255) * (1.0f / 256.0f);
          v[e] = (tp < 256) ? hw_cos_rev(r) : -hw_sin_rev(r);
        }
        w[j] = pk2(v[0], v[1]);
      }
      *(u32x4*)(atc + (size_t)k * 512 + c8) = (u32x4){w[0], w[1], w[2], w[3]};
    }
  }
  {
    float* rc = (float*)(p.ws + OFF_ROPEC); float* rs = (float*)(p.ws + OFF_ROPES);
    for (int i = gtid; i < 2048 * 32; i += gsz) {
      const int t = i >> 5, a = i & 31, f = a & 15;
      const float pos = (float)((a < 16) ? (t >> 6) : (t & 63));
      const float inv = exp2f(-(float)f * (13.287712379549449f / 16.0f));
      float r = pos * inv * 0.15915494309189535f;
      r -= floorf(r);
      rc[i] = hw_cos_rev(r); rs[i] = hw_sin_rev(r);
    }
  }
  if (gtid < DEPTH) {
    const float* lq = p.lam_qk + (size_t)gtid * 256;
    float s1 = 0.f, s2 = 0.f;
    for (int i = 0; i < 64; ++i) { s1 += lq[i] * lq[64 + i]; s2 += lq[128 + i] * lq[192 + i]; }
    ((float*)(p.ws + OFF_LAMV))[gtid] = expf(s1) - expf(s2) + p.lam_init[gtid];
  }
}

DI void ln_pass(const Params& p, int mode, int nrows, const bf16_t* __restrict__ Yb, const float* __restrict__ lng, const float* __restrict__ lnb,
                        int modl_gate, int gate_chunk, int modl_next, int sh_chunk) {
  const int lane = g_tid() & 63, wid = g_tid() >> 6;
  float* X = (float*)(p.ws + OFF_X);
  bf16_t* U = (bf16_t*)(p.ws + OFF_U);
  const float* modv = (const float*)(p.ws + OFF_MODV);
  f32x4 xv[4], xn[4]; u32x2 yv[4], yn[4];
  const int r0 = blockIdx.x * 8 + wid, rstride = gridDim.x * 8;
  if (mode != 0 && r0 < nrows) {
#pragma unroll
    for (int i = 0; i < 4; ++i) { xv[i] = *(const f32x4*)(X + (size_t)r0 * 1024 + lane * 4 + 256 * i); yv[i] = *(const u32x2*)(Yb + (size_t)r0 * 1024 + lane * 4 + 256 * i); }
  }
  for (int r = r0; r < nrows; r += rstride) {
    int b, pos; bool isctx; row_info(r, b, pos, isctx);
    const int mr = isctx ? 8 : b;
    f32x4 v[4];
    if (mode == 0) {
      const float* src = isctx ? (p.ctx + (size_t)(r - T_LAT) * 1024) : (p.x + (size_t)r * 1024);
#pragma unroll
      for (int i = 0; i < 4; ++i) v[i] = *(const f32x4*)(src + lane * 4 + 256 * i);
#pragma unroll
      for (int i = 0; i < 4; ++i) *(f32x4*)(X + (size_t)r * 1024 + lane * 4 + 256 * i) = v[i];
    } else {
      const int rn = r + rstride;
      if (rn < nrows) {
#pragma unroll
        for (int i = 0; i < 4; ++i) { xn[i] = *(const f32x4*)(X + (size_t)rn * 1024 + lane * 4 + 256 * i); yn[i] = *(const u32x2*)(Yb + (size_t)rn * 1024 + lane * 4 + 256 * i); }
      }
      const float* gv = modv + ((size_t)modl_gate * 9 + mr) * 6144 + gate_chunk * 1024;
      float s = 0.f;
#pragma unroll
      for (int i = 0; i < 4; ++i) {
        const int col = lane * 4 + 256 * i;
        const f32x4 g = *(const f32x4*)(gv + col);
        v[i][0] = ALPHA * xv[i][0] + g[0] * bf_lo(yv[i][0]); v[i][1] = ALPHA * xv[i][1] + g[1] * bf_hi(yv[i][0]);
        v[i][2] = ALPHA * xv[i][2] + g[2] * bf_lo(yv[i][1]); v[i][3] = ALPHA * xv[i][3] + g[3] * bf_hi(yv[i][1]);
        s += (v[i][0] + v[i][1]) + (v[i][2] + v[i][3]);
      }
#pragma unroll
      for (int i = 0; i < 4; ++i) { xv[i] = xn[i]; yv[i] = yn[i]; }
      const float mu = wave_sum(s) * (1.0f / 1024.0f);
      float q = 0.f;
#pragma unroll
      for (int i = 0; i < 4; ++i) { const f32x4 d = v[i] - mu; q += (d[0] * d[0] + d[1] * d[1]) + (d[2] * d[2] + d[3] * d[3]); }
      const float rstd = rsqrtf(wave_sum(q) * (1.0f / 1024.0f) + LN_EPS);
#pragma unroll
      for (int i = 0; i < 4; ++i) {
        const int col = lane * 4 + 256 * i;
        const f32x4 g = *(const f32x4*)(lng + col), bb = *(const f32x4*)(lnb + col);
        v[i] = (v[i] - mu) * rstd * g + bb;
        if (mode == 2) *(f32x4*)(p.out + (size_t)r * 1024 + col) = v[i];
        else *(f32x4*)(X + (size_t)r * 1024 + col) = v[i];
      }
    }
    if (mode != 2) {
      float s = 0.f;
#pragma unroll
      for (int i = 0; i < 4; ++i) s += (v[i][0] + v[i][1]) + (v[i][2] + v[i][3]);
      const float mu = wave_sum(s) * (1.0f / 1024.0f);
      float q = 0.f;
#pragma unroll
      for (int i = 0; i < 4; ++i) { const f32x4 d = v[i] - mu; q += (d[0] * d[0] + d[1] * d[1]) + (d[2] * d[2] + d[3] * d[3]); }
      const float rstd = rsqrtf(wave_sum(q) * (1.0f / 1024.0f) + LN_EPS);
      const float* shv = modv + ((size_t)modl_next * 9 + mr) * 6144 + sh_chunk * 1024;
      const float* scv = shv + 1024;
#pragma unroll
      for (int i = 0; i < 4; ++i) {
        const int col = lane * 4 + 256 * i;
        const f32x4 sh = *(const f32x4*)(shv + col), sc = *(const f32x4*)(scv + col);
        const f32x4 u = (v[i] - mu) * rstd * (sc + 1.0f) + sh;
        *(u32x2*)(U + (size_t)r * 1024 + col) = (u32x2){pk2(u[0], u[1]), pk2(u[2], u[3])};
      }
    }
  }
}

DI bool tile_map(int v, int nmt, int nnt, int& mt, int& nt) {
  const int c = v >> 8, w = v & 255, xcd = w & 7, local = w >> 3;
  const int spr = nnt >> 2, nsup = (nmt >> 3) * spr, sup = c * 8 + xcd;
  if (sup >= nsup) return false;
  mt = (sup / spr) * 8 + (local & 7); nt = (sup % spr) * 4 + (local >> 3);
  return true;
}
DI int tile_vmax(int nmt, int nnt) { const int nsup = (nmt >> 3) * (nnt >> 2); return ((nsup + 7) >> 3) << 8; }

DI void phase_inproj(const Params& p, int l, char* smem) {
  const bool last = (l == DEPTH - 1);
  const bf16_t* W = (const bf16_t*)(p.ws + OFF_W) + WO_WIN;
  const bf16_t* U = (const bf16_t*)(p.ws + OFF_U);
  bf16_t* KB = (bf16_t*)(p.ws + OFF_KB); bf16_t* VT = (bf16_t*)(p.ws + OFF_VT); bf16_t* QB = (bf16_t*)(p.ws + OFF_QB); bf16_t* CQ = (bf16_t*)(p.ws + OFF_CQ);
  bf16_t* ZT = (bf16_t*)(p.ws + OFF_ZT); bf16_t* ZTC = (bf16_t*)(p.ws + OFF_ZTC); bf16_t* R = (bf16_t*)(p.ws + OFF_R);
  const float* ropec = (const float*)(p.ws + OFF_ROPEC); const float* ropes = (const float*)(p.ws + OFF_ROPES);
  const int nsupA = last ? 72 : 81, nsup = last ? 76 : 81;
  const int vmax = ((nsup + 15) >> 4) << 8;
  auto map_tile = [&](int v, int& mt, int& nt) -> bool {
    if (v >= vmax) return false;
    const int c = v >> 8, w = v & 255, local = w >> 3, sup = (c * 8 + (w & 7)) * 2 + (local >> 4);
    if (sup >= nsup) return false;
    if (sup < nsupA) { mt = (sup / 9) * 8 + (local & 7); nt = (sup % 9) * 2 + ((local >> 3) & 1); }
    else { mt = 64 + (local & 7); nt = (sup - nsupA) * 2 + ((local >> 3) & 1); }
    return true;
  };
  int v = blockIdx.x, mt = 0, nt = 0;
  bool cur = map_tile(v, mt, nt);
  if (cur) gemm_prefetch_big(U + (size_t)mt * 256 * 1024, 1024, W + (size_t)nt * 256 * 1024, 1024, smem);
  while (cur) {
    const int m0 = mt * 256;
    int b, pos0; bool isctx; row_info(m0, b, pos0, isctx);
    f32x4 acc[8][4];
#pragma unroll
    for (int i = 0; i < 8; ++i)
#pragma unroll
      for (int j = 0; j < 4; ++j) acc[i][j] = (f32x4){0.f, 0.f, 0.f, 0.f};
    const bool swap = !((nt >= 4 && nt < 8) || (nt >= 12 && nt < 16));
    if (swap) gemm_kloop_big<true>(U + (size_t)m0 * 1024, 1024, W + (size_t)nt * 256 * 1024, 1024, 1024, acc, smem, true);
    else gemm_kloop_big<false>(U + (size_t)m0 * 1024, 1024, W + (size_t)nt * 256 * 1024, 1024, 1024, acc, smem, true);
    int v2 = v + gridDim.x, mt2 = 0, nt2 = 0;
    const bool nxt = map_tile(v2, mt2, nt2);
    if (nxt) gemm_prefetch_big(U + (size_t)mt2 * 256 * 1024, 1024, W + (size_t)nt2 * 256 * 1024, 1024, smem);
    const int tid = g_tid(), lane = tid & 63, wid = __builtin_amdgcn_readfirstlane(tid >> 6), wm = wid >> 2, wn = wid & 3;
    const int fq = lane >> 4, fr = lane & 15;
    const int ncol0 = nt * 256 + wn * 64;
    const int prow0 = pos0 + wm * 128;
    if (ncol0 < 1024 || (ncol0 >= 2048 && ncol0 < 3072)) {
      const bool isq = ncol0 >= 2048; const int h = (ncol0 >> 7) & 7, map = (ncol0 >> 6) & 1;
#pragma unroll
      for (int mi = 0; mi < 8; ++mi) {
        const int pos = prow0 + mi * 16 + fr;
        f32x4 o[4];
        if (!isctx) {
#pragma unroll
          for (int pr = 0; pr < 2; ++pr) {
            const f32x4 cs = *(const f32x4*)(ropec + pos * 32 + pr * 16 + fq * 4);
            const f32x4 sn = *(const f32x4*)(ropes + pos * 32 + pr * 16 + fq * 4);
            const f32x4 x0 = acc[mi][2 * pr], x1 = acc[mi][2 * pr + 1];
            o[2 * pr] = x0 * cs - x1 * sn;
            o[2 * pr + 1] = x1 * cs + x0 * sn;
          }
        } else {
#pragma unroll
          for (int ni = 0; ni < 4; ++ni) o[ni] = acc[mi][ni];
        }
        bf16_t* dst;
        if (!isq) dst = KB + ((size_t)((b * 8 + h) * 2 + map) * NKEY + (isctx ? SEQ + pos : pos)) * 64;
        else if (!isctx) dst = QB + ((size_t)((b * 8 + h) * 2 + map) * SEQ + pos) * 64;
        else dst = CQ + ((size_t)((b * 8 + h) * 2 + map) * LC + pos) * 64;
        const float sc = isq ? QSCALE : 1.0f;
#pragma unroll
        for (int ni = 0; ni < 4; ++ni) {
          const f32x4 vv = o[ni] * sc;
          *(u32x2*)(dst + ni * 16 + fq * 4) = (u32x2){pk2(vv[0], vv[1]), pk2(vv[2], vv[3])};
        }
      }
    } else if (ncol0 < 2048) {
      const int h = (ncol0 - 1024) >> 7, vc0 = ncol0 & 127;
#pragma unroll
      for (int mi = 0; mi < 8; ++mi) {
        const int key = (isctx ? SEQ : 0) + prow0 + mi * 16 + fq * 4;
        const int k15 = key & 15;
        const int pkey = (key & ~15) | (k15 & 3) | ((k15 & 4) << 1) | ((k15 & 8) >> 1);
#pragma unroll
        for (int ni = 0; ni < 4; ++ni) {
          const int vcol = vc0 + ni * 16 + fr;
          const f32x4 vv = acc[mi][ni];
          *(u32x2*)(VT + ((size_t)(b * 8 + h) * 128 + vcol) * NKEY + pkey) = (u32x2){pk2(vv[0], vv[1]), pk2(vv[2], vv[3])};
        }
      }
    } else if (ncol0 < 4096) {
#pragma unroll
      for (int mi = 0; mi < 8; ++mi) {
        const int pos = prow0 + mi * 16 + fq * 4;
#pragma unroll
        for (int ni = 0; ni < 4; ++ni) {
          const int zc = ncol0 - 3072 + ni * 16 + fr;
          const int np = zc & 511, second = zc >> 9;
          const f32x4 vv = acc[mi][ni];
          bf16_t* dst = isctx ? (ZTC + ((size_t)b * 512 + np) * 512 + second * 256 + pos) : (ZT + ((size_t)b * 512 + np) * 4096 + second * 2048 + pos);
          *(u32x2*)dst = (u32x2){pk2(vv[0], vv[1]), pk2(vv[2], vv[3])};
        }
      }
    } else {
#pragma unroll
      for (int mi = 0; mi < 8; ++mi) {
        const int row = m0 + wm * 128 + mi * 16 + fr;
#pragma unroll
        for (int ni = 0; ni < 4; ++ni) {
          const int col = ncol0 - 4096 + ni * 16 + fq * 4;
          const f32x4 vv = acc[mi][ni];
          *(u32x2*)(R + (size_t)row * 512 + col) = (u32x2){pk2(vv[0], vv[1]), pk2(vv[2], vv[3])};
        }
      }
    }
    v = v2; mt = mt2; nt = nt2; cur = nxt;
  }
}

DI void attn_unit(const bf16_t* __restrict__ Qb  , int nq, int q0, const bf16_t* __restrict__ Kb  ,
                  const bf16_t* __restrict__ VTb  , int key0, int ntiles  , bf16_t* __restrict__ outp  ,
                  const float* __restrict__ subg, float lam, float nscale, char* smem) {
  const int tid = g_tid(), lane = tid & 63, wid = __builtin_amdgcn_readfirstlane(tid >> 6), wq = wid & 3, map = wid >> 2;
  const int l31 = lane & 31, kh = lane >> 5;
  bf16x8 qf[4];
  {
    const bf16_t* qp = Qb + ((size_t)map * nq + q0 + wq * 32 + l31) * 64 + kh * 8;
#pragma unroll
    for (int s = 0; s < 4; ++s) qf[s] = *(const bf16x8*)(qp + s * 16);
  }
  const int srow = tid >> 3, sc = (tid & 7) ^ ((tid >> 4) & 7);
  const unsigned koff = (unsigned)((key0 + srow) * 64 + sc * 8) * 2u;
  const unsigned voff = (unsigned)(srow * NKEY + key0 + sc * 8) * 2u;
  const char* Kc = (const char*)Kb; const char* Vc = (const char*)VTb;
  char* sdst = smem + tid * 16;
#define A_ISSUE(T) do { char* d_ = sdst + ((T) & 3) * 32768; \
    __builtin_amdgcn_global_load_lds((const void*)(Kc + (size_t)(T) * 8192 + koff), (lds_ptr_t)(d_), 16, 0, 0); \
    __builtin_amdgcn_global_load_lds((const void*)(Kc + (size_t)NKEY * 128 + (size_t)(T) * 8192 + koff), (lds_ptr_t)(d_ + 8192), 16, 0, 0); \
    __builtin_amdgcn_global_load_lds((const void*)(Vc + (size_t)(T) * 128 + voff), (lds_ptr_t)(d_ + 16384), 16, 0, 0); \
    __builtin_amdgcn_global_load_lds((const void*)(Vc + (size_t)64 * NKEY * 2 + (size_t)(T) * 128 + voff), (lds_ptr_t)(d_ + 24576), 16, 0, 0); } while (0)
  f32x16 O[4];
#pragma unroll
  for (int vb = 0; vb < 4; ++vb)
#pragma unroll
    for (int i = 0; i < 16; ++i) O[vb][i] = 0.f;
  float m = 0.f, lsum = 0.f;
  float big_ = __builtin_inff(); asm volatile("" : "+v"(big_));
  const int sw = (lane >> 1) & 7;
  const int kfo = l31 * 128, cho = kh;
#define A_QK(SX, T) do { const char* st_ = smem + ((T) & 3) * 32768 + map * 8192 + kfo; \
    bf16x8 kf_[8]; \
    _Pragma("unroll") for (int s = 0; s < 4; ++s) _Pragma("unroll") for (int kb = 0; kb < 2; ++kb) \
        kf_[s * 2 + kb] = *(const bf16x8*)(st_ + kb * 4096 + (((2 * s + cho) ^ sw) << 4)); \
    _Pragma("unroll") for (int kb = 0; kb < 2; ++kb) _Pragma("unroll") for (int i = 0; i < 16; ++i) SX[kb][i] = -m; \
    __builtin_amdgcn_sched_barrier(0); \
    _Pragma("unroll") for (int s = 0; s < 4; ++s) _Pragma("unroll") for (int kb = 0; kb < 2; ++kb) \
        SX[kb] = MFMA32(kf_[s * 2 + kb], qf[s], SX[kb]); \
    __builtin_amdgcn_sched_barrier(0); } while (0)
  bf16x8 pf[4];
  auto pv = [&](int T) {
    const char* sv = smem + (T & 3) * 32768 + 16384 + kfo;
    __builtin_amdgcn_sched_barrier(0);
    bf16x8 va[4], vb_[4];
#pragma unroll
    for (int vb = 0; vb < 4; ++vb) va[vb] = *(const bf16x8*)(sv + vb * 4096 + (((0 + cho) ^ sw) << 4));
#pragma unroll
    for (int vb = 0; vb < 4; ++vb) vb_[vb] = *(const bf16x8*)(sv + vb * 4096 + (((2 + cho) ^ sw) << 4));
    __builtin_amdgcn_sched_barrier(0);
#pragma unroll
    for (int vb = 0; vb < 4; ++vb) O[vb] = MFMA32(va[vb], pf[0], O[vb]);
    __builtin_amdgcn_sched_barrier(0);
#pragma unroll
    for (int vb = 0; vb < 4; ++vb) va[vb] = *(const bf16x8*)(sv + vb * 4096 + (((4 + cho) ^ sw) << 4));
    __builtin_amdgcn_sched_barrier(0);
#pragma unroll
    for (int vb = 0; vb < 4; ++vb) O[vb] = MFMA32(vb_[vb], pf[1], O[vb]);
    __builtin_amdgcn_sched_barrier(0);
#pragma unroll
    for (int vb = 0; vb < 4; ++vb) vb_[vb] = *(const bf16x8*)(sv + vb * 4096 + (((6 + cho) ^ sw) << 4));
    __builtin_amdgcn_sched_barrier(0);
#pragma unroll
    for (int vb = 0; vb < 4; ++vb) O[vb] = MFMA32(va[vb], pf[2], O[vb]);
    __builtin_amdgcn_sched_barrier(0);
#pragma unroll
    for (int vb = 0; vb < 4; ++vb) O[vb] = MFMA32(vb_[vb], pf[3], O[vb]);
    __builtin_amdgcn_sched_barrier(0);
  };
  auto softmax = [&](f32x16 (&SC)[2], f32x16 (&SN)[2], bool has_next, bool first) {
#define MAXF(a, b) __builtin_amdgcn_fmed3f((a), (b), big_)
    float mx[16];
#pragma unroll
    for (int i = 0; i < 16; ++i) mx[i] = MAXF(SC[0][i], SC[1][i]);
#pragma unroll
    for (int w = 8; w >= 1; w >>= 1)
#pragma unroll
      for (int i = 0; i < w; ++i) mx[i] = MAXF(mx[i], mx[i + w]);
#undef MAXF
    float tmax = xor32_max(mx[0]);
    if (first || __any(tmax > 8.0f)) {
      const float delta = first ? tmax : fmaxf(tmax, 0.f);
      const float alpha = first ? 1.0f : __builtin_amdgcn_exp2f(-delta);
      m += delta; lsum *= alpha;
#pragma unroll
      for (int vb = 0; vb < 4; ++vb) O[vb] = O[vb] * alpha;
#pragma unroll
      for (int kb = 0; kb < 2; ++kb)
#pragma unroll
        for (int i = 0; i < 16; ++i) SC[kb][i] -= delta;
      if (has_next) {
#pragma unroll
        for (int kb = 0; kb < 2; ++kb)
#pragma unroll
          for (int i = 0; i < 16; ++i) SN[kb][i] -= delta;
      }
    }
    float sm[16];
#pragma unroll
    for (int i = 0; i < 16; ++i) { const float e0 = __builtin_amdgcn_exp2f(SC[0][i]), e1 = __builtin_amdgcn_exp2f(SC[1][i]); SC[0][i] = e0; SC[1][i] = e1; sm[i] = e0 + e1; }
#pragma unroll
    for (int w = 8; w >= 1; w >>= 1)
#pragma unroll
      for (int i = 0; i < w; ++i) sm[i] += sm[i + w];
    lsum += sm[0];
#pragma unroll
    for (int g = 0; g < 4; ++g) {
      const int kb = g >> 1, s2 = g & 1;
      u32x4 w;
      w[0] = pk2(SC[kb][8 * s2 + 0], SC[kb][8 * s2 + 1]); w[1] = pk2(SC[kb][8 * s2 + 2], SC[kb][8 * s2 + 3]);
      w[2] = pk2(SC[kb][8 * s2 + 4], SC[kb][8 * s2 + 5]); w[3] = pk2(SC[kb][8 * s2 + 6], SC[kb][8 * s2 + 7]);
      pf[g] = __builtin_bit_cast(bf16x8, w);
    }
  };
  f32x16 Sa[2], Sb[2];
  WAIT_VM(0);
  A_ISSUE(0); A_ISSUE(1); A_ISSUE(2);
  WAIT_VM(8);
  __builtin_amdgcn_s_barrier();
  asm volatile("" ::: "memory");
  A_QK(Sa, 0);
  for (int t = 0; t < ntiles; t += 2) {
    if (t + 2 < ntiles) WAIT_VM(4); else WAIT_VM(0);
    __builtin_amdgcn_s_barrier();
    asm volatile("" ::: "memory");
    if (t + 3 < ntiles) A_ISSUE(t + 3);
    A_QK(Sb, t + 1);
    softmax(Sa, Sb, true, t == 0);
    pv(t);
    const bool nx = (t + 2 < ntiles);
    if (nx) { if (t + 3 < ntiles) WAIT_VM(4); else WAIT_VM(0); }
    __builtin_amdgcn_s_barrier();
    asm volatile("" ::: "memory");
    if (t + 4 < ntiles) A_ISSUE(t + 4);
    if (nx) A_QK(Sa, t + 2);
    softmax(Sb, Sa, nx, false);
    pv(t + 1);
  }
  asm volatile("s_waitcnt lgkmcnt(0)" ::: "memory");
  __builtin_amdgcn_s_barrier();
  asm volatile("" ::: "memory");
#undef A_ISSUE
#undef A_QK
  const float ltot = xor32_sum(lsum);
  const float inv = 1.0f / ltot;
  float* ex = (float*)smem;
  if (map == 1) {
#pragma unroll
    for (int vb = 0; vb < 4; ++vb)
#pragma unroll
      for (int g4 = 0; g4 < 4; ++g4) {
        f32x4 v = {O[vb][4 * g4] * inv, O[vb][4 * g4 + 1] * inv, O[vb][4 * g4 + 2] * inv, O[vb][4 * g4 + 3] * inv};
        *(f32x4*)(ex + (wq * 32 + l31) * 132 + vb * 32 + 8 * g4 + 4 * kh) = v;
      }
  }
  __syncthreads();
  if (map == 0) {
    float ss = 0.f;
#pragma unroll
    for (int vb = 0; vb < 4; ++vb)
#pragma unroll
      for (int g4 = 0; g4 < 4; ++g4) {
        const f32x4 o2 = *(const f32x4*)(ex + (wq * 32 + l31) * 132 + vb * 32 + 8 * g4 + 4 * kh);
#pragma unroll
        for (int j = 0; j < 4; ++j) { const float o = O[vb][4 * g4 + j] * inv - lam * o2[j]; O[vb][4 * g4 + j] = o; ss += o * o; }
      }
    ss = xor32_sum(ss);
    const float rs = rsqrtf(ss * (1.0f / 128.0f) + LN_EPS) * nscale;
    bf16_t* op = outp + (size_t)(wq * 32 + l31) * 1024;
#pragma unroll
    for (int vb = 0; vb < 4; ++vb)
#pragma unroll
      for (int g4 = 0; g4 < 4; ++g4) {
        const int vc = vb * 32 + 8 * g4 + 4 * kh;
        const f32x4 g = *(const f32x4*)(subg + vc);
        *(u32x2*)(op + vc) = (u32x2){pk2(O[vb][4 * g4] * rs * g[0], O[vb][4 * g4 + 1] * rs * g[1]), pk2(O[vb][4 * g4 + 2] * rs * g[2], O[vb][4 * g4 + 3] * rs * g[3])};
      }
  }
  __syncthreads();
}

template <int MI>
DI void store_tile_bf16(const f32x4 (&acc)[MI][4], bf16_t* __restrict__ C, int ldc, float scale) {
  const int tid = g_tid(), lane = tid & 63, wid = __builtin_amdgcn_readfirstlane(tid >> 6), wm = wid >> 1, wn = wid & 1, fq = lane >> 4, fr = lane & 15;
#pragma unroll
  for (int mi = 0; mi < MI; ++mi)
#pragma unroll
    for (int ni = 0; ni < 4; ++ni) {
      const f32x4 v = acc[mi][ni] * scale;
      *(u32x2*)(C + (size_t)(wm * 16 * MI + mi * 16 + fr) * ldc + wn * 64 + ni * 16 + fq * 4) = (u32x2){pk2(v[0], v[1]), pk2(v[2], v[3])};
    }
}

template <int W>
DI void pool_rows(const bf16_t* __restrict__ R, bf16_t* __restrict__ PM, int m0, int g, int rhalf, int lane) {
  constexpr int LO = W / 2;
  const int col = g * 128 + (lane & 15) * 8;
#pragma unroll 2
  for (int ps = 0; ps < 8; ++ps) {
    const int row = m0 + ps * 8 + rhalf * 4 + (lane >> 4);
    int b, pos; bool isctx; row_info(row, b, pos, isctx);
    const int L = isctx ? LC : SEQ;
    const int rbase = row - pos;
    float s[8];
#pragma unroll
    for (int j = 0; j < 8; ++j) s[j] = 0.f;
    int cnt = 0;
    u32x4 self = {0u, 0u, 0u, 0u};
#pragma unroll
    for (int k = 0; k < W; ++k) {
      const int q = pos - LO + k;
      const bool ok = (q >= 0) && (q < L);
      const int qc = ok ? q : pos;
      const u32x4 v = *(const u32x4*)(R + (size_t)(rbase + qc) * 512 + col);
      const float f = ok ? 1.0f : 0.0f;
      cnt += ok ? 1 : 0;
#pragma unroll
      for (int j = 0; j < 4; ++j) { s[2 * j] += f * bf_lo(v[j]); s[2 * j + 1] += f * bf_hi(v[j]); }
      if (k == LO) self = v;
    }
    const float ic = 1.0f / (float)cnt;
    u32x4 o;
#pragma unroll
    for (int j = 0; j < 4; ++j) o[j] = pk2(s[2 * j] * ic - bf_lo(self[j]), s[2 * j + 1] * ic - bf_hi(self[j]));
    *(u32x4*)(PM + (size_t)row * 512 + col) = o;
  }
}
DI void pool_task(const bf16_t* __restrict__ R, bf16_t* __restrict__ PM, int m0) {
  const int tid = g_tid(), lane = tid & 63, wid = __builtin_amdgcn_readfirstlane(tid >> 6), g = wid & 3, rhalf = wid >> 2;
  if (g == 0) pool_rows<2>(R, PM, m0, 0, rhalf, lane);
  else if (g == 1) pool_rows<4>(R, PM, m0, 1, rhalf, lane);
  else if (g == 2) pool_rows<8>(R, PM, m0, 2, rhalf, lane);
  else pool_rows<16>(R, PM, m0, 3, rhalf, lane);
}

DI void phase_mix(const Params& p, int l, char* smem) {
  const bool last = (l == DEPTH - 1);
  const bf16_t* KB = (const bf16_t*)(p.ws + OFF_KB); const bf16_t* VT = (const bf16_t*)(p.ws + OFF_VT);
  const bf16_t* QB = (const bf16_t*)(p.ws + OFF_QB); const bf16_t* CQ = (const bf16_t*)(p.ws + OFF_CQ);
  const bf16_t* ZT = (const bf16_t*)(p.ws + OFF_ZT); const bf16_t* ZTC = (const bf16_t*)(p.ws + OFF_ZTC); const bf16_t* R = (const bf16_t*)(p.ws + OFF_R);
  bf16_t* ATT = (bf16_t*)(p.ws + OFF_ATT); bf16_t* FM = (bf16_t*)(p.ws + OFF_FM); bf16_t* PM = (bf16_t*)(p.ws + OFF_PM);
  const bf16_t* ATAB = (const bf16_t*)(p.ws + OFF_ATAB); const bf16_t* ATABC = (const bf16_t*)(p.ws + OFF_ATABC);
  const float lam = ((const float*)(p.ws + OFF_LAMV))[l];
  const float nscale = 1.0f - p.lam_init[l];
  const float* subg = p.subln_g + (size_t)l * 128;
  const int n_attn = 1024, n_dft = 256, n_cattn = last ? 0 : 128, n_cdft = last ? 0 : 32, n_pool = last ? 256 : 288;
  const int total = n_attn + n_dft + n_cattn + n_cdft + n_pool;
  for (int t = blockIdx.x; t < total; t += gridDim.x) {
    int r = t;
    if (r < n_attn) {
      const int c = r >> 8, w = r & 255, xcd = w & 7, local = w >> 3;
      const int bh = c * 16 + xcd * 2 + (local >> 4), qb = local & 15;
      const int b = bh >> 3, h = bh & 7;
      attn_unit(QB + (size_t)bh * 2 * SEQ * 64, SEQ, qb * 128, KB + (size_t)bh * 2 * NKEY * 64, VT + (size_t)bh * 128 * NKEY, 0, NKEY / 64,
                ATT + ((size_t)b * SEQ + qb * 128) * 1024 + h * 128, subg, lam, nscale, smem);
      continue;
    }
    r -= n_attn;
    if (r < n_dft) {
      const int b = r & 7, local = r >> 3, mt = local & 7, nt = local >> 3;
      f32x4 acc[4][4]; zero_acc(acc);
      gemm_kloop_pp<true>(ATAB + (size_t)mt * 256 * 4096, 4096, ZT + ((size_t)b * 512 + nt * 128) * 4096, 4096, 4096, acc, smem);
      store_tile_bf16<4>(acc, FM + ((size_t)b * SEQ + mt * 256) * 512 + nt * 128, 512, 1.0f / 512.0f);
      continue;
    }
    r -= n_dft;
    if (r < n_cattn) {
      const int bh = r >> 1, qb = r & 1, b = bh >> 3, h = bh & 7;
      attn_unit(CQ + (size_t)bh * 2 * LC * 64, LC, qb * 128, KB + (size_t)bh * 2 * NKEY * 64, VT + (size_t)bh * 128 * NKEY, SEQ, LC / 64,
                ATT + ((size_t)T_LAT + b * LC + qb * 128) * 1024 + h * 128, subg, lam, nscale, smem);
      continue;
    }
    r -= n_cattn;
    if (r < n_cdft) {
      const int b = r >> 2, nt = r & 3;
      f32x4 acc[4][4]; zero_acc(acc);
      gemm_kloop_pp<true>(ATABC, 512, ZTC + ((size_t)b * 512 + nt * 128) * 512, 512, 512, acc, smem);
      store_tile_bf16<4>(acc, FM + ((size_t)T_LAT + b * LC) * 512 + nt * 128, 512, 0.005524271728019903f  );
      continue;
    }
    r -= n_cdft;
    pool_task(R, PM, r * 64);
  }
}

template <int MI>
DI void phase_branch(const Params& p, int l, char* smem) {
  const bool last = (l == DEPTH - 1);
  const bf16_t* W = (const bf16_t*)(p.ws + OFF_W);
  const bf16_t* U = (const bf16_t*)(p.ws + OFF_U);
  const bf16_t* ATT = (const bf16_t*)(p.ws + OFF_ATT); const bf16_t* FM = (const bf16_t*)(p.ws + OFF_FM); const bf16_t* PM = (const bf16_t*)(p.ws + OFF_PM);
  bf16_t* MOUT = (bf16_t*)(p.ws + OFF_MOUT);
  const int nmt = (last ? T_LAT : T_ALL) / (64 * MI), vmax = tile_vmax(nmt, 8);
  for (int v = blockIdx.x; v < vmax; v += gridDim.x) {
    int mt, nt;
    if (!tile_map(v, nmt, 8, mt, nt)) continue;
    const int m0 = mt * 64 * MI, n0 = nt * 128;
    u32x2 tot[MI][4], gpk[MI][4];
#pragma unroll
    for (int mi = 0; mi < MI; ++mi)
#pragma unroll
      for (int ni = 0; ni < 4; ++ni) tot[mi][ni] = (u32x2){0u, 0u};
#pragma unroll 1
    for (int br = 0; br < 3; ++br) {
      __builtin_amdgcn_sched_barrier(0);
      f32x4 acc[MI][4]; zero_acc_t<MI>(acc);
      gemm_kloop_pp<true, MI>(U + (size_t)m0 * 1024, 1024, W + WO_WIN + (size_t)(ROW_G + br * 1024 + n0) * 1024, 1024, 1024, acc, smem);
      __builtin_amdgcn_sched_barrier(0);
#pragma unroll
      for (int mi = 0; mi < MI; ++mi)
#pragma unroll
        for (int ni = 0; ni < 4; ++ni) {
          const f32x4 a = acc[mi][ni];
          gpk[mi][ni] = (u32x2){pk2(sigmoidf_(a[0]), sigmoidf_(a[1])), pk2(sigmoidf_(a[2]), sigmoidf_(a[3]))};
        }
      __builtin_amdgcn_sched_barrier(0);
      zero_acc_t<MI>(acc);
      const int K2 = (br == 0) ? 1024 : 512;
      const bf16_t* A2 = (br == 0) ? (ATT + (size_t)m0 * 1024) : ((br == 1 ? FM : PM) + (size_t)m0 * 512);
      const bf16_t* B2 = (br == 0) ? (W + WO_WA + (size_t)n0 * 1024) : (W + (br == 1 ? WO_WF : WO_WP) + (size_t)n0 * 512);
      gemm_kloop_pp<true, MI>(A2, K2, B2, K2, K2, acc, smem);
      __builtin_amdgcn_sched_barrier(0);
#pragma unroll
      for (int mi = 0; mi < MI; ++mi)
#pragma unroll
        for (int ni = 0; ni < 4; ++ni) {
          const f32x4 a = acc[mi][ni]; const u32x2 g = gpk[mi][ni]; const u32x2 tp = tot[mi][ni];
          const float v0 = bf_lo(g[0]) * a[0] + bf_lo(tp[0]), v1 = bf_hi(g[0]) * a[1] + bf_hi(tp[0]);
          const float v2 = bf_lo(g[1]) * a[2] + bf_lo(tp[1]), v3 = bf_hi(g[1]) * a[3] + bf_hi(tp[1]);
          tot[mi][ni] = (u32x2){pk2(v0, v1), pk2(v2, v3)};
        }
    }
    const int tid = g_tid(), lane = tid & 63, wid = __builtin_amdgcn_readfirstlane(tid >> 6), wm = wid >> 1, wn = wid & 1, fq = lane >> 4, fr = lane & 15;
#pragma unroll
    for (int mi = 0; mi < MI; ++mi)
#pragma unroll
      for (int ni = 0; ni < 4; ++ni)
        *(u32x2*)(MOUT + (size_t)(m0 + wm * 16 * MI + mi * 16 + fr) * 1024 + n0 + wn * 64 + ni * 16 + fq * 4) = tot[mi][ni];
  }
}

template <int MI>
DI void phase_gemm_plain(const bf16_t* __restrict__ A, int K, const bf16_t* __restrict__ Bt, bf16_t* __restrict__ C, int nmt, int nnt, char* smem) {
  const int vmax = tile_vmax(nmt, nnt), N = nnt * 128;
  for (int v = blockIdx.x; v < vmax; v += gridDim.x) {
    int mt, nt;
    if (!tile_map(v, nmt, nnt, mt, nt)) continue;
    f32x4 acc[MI][4]; zero_acc_t<MI>(acc);
    gemm_kloop_pp<true, MI>(A + (size_t)mt * 64 * MI * K, K, Bt + (size_t)nt * 128 * K, K, K, acc, smem);
    store_tile_bf16<MI>(acc, C + (size_t)mt * 64 * MI * N + nt * 128, N, 1.0f);
  }
}
DI void phase_ffn1(const Params& p, int l, char* smem) {
  const bool last = (l == DEPTH - 1);
  const bf16_t* W = (const bf16_t*)(p.ws + OFF_W) + WO_WGU;
  const bf16_t* U = (const bf16_t*)(p.ws + OFF_U);
  bf16_t* H = (bf16_t*)(p.ws + OFF_H);
  const int nsup = (last ? 8 : 9) * 11;
  const int vmax = ((nsup + 15) >> 4) << 8;
  auto map_tile = [&](int v, int& mt, int& nt) -> bool {
    if (v >= vmax) return false;
    const int c = v >> 8, w = v & 255, local = w >> 3, sup = (c * 8 + (w & 7)) * 2 + (local >> 4);
    if (sup >= nsup) return false;
    mt = (sup / 11) * 8 + (local & 7); nt = (sup % 11) * 2 + ((local >> 3) & 1);
    return true;
  };
  int v = blockIdx.x, mt = 0, nt = 0;
  bool cur = map_tile(v, mt, nt);
  if (cur) gemm_prefetch_big(U + (size_t)mt * 256 * 1024, 1024, W + (size_t)nt * 256 * 1024, 1024, smem);
  while (cur) {
    f32x4 acc[8][4];
#pragma unroll
    for (int i = 0; i < 8; ++i)
#pragma unroll
      for (int j = 0; j < 4; ++j) acc[i][j] = (f32x4){0.f, 0.f, 0.f, 0.f};
    gemm_kloop_big<true>(U + (size_t)mt * 256 * 1024, 1024, W + (size_t)nt * 256 * 1024, 1024, 1024, acc, smem, true);
    int v2 = v + gridDim.x, mt2 = 0, nt2 = 0;
    const bool nxt = map_tile(v2, mt2, nt2);
    if (nxt) gemm_prefetch_big(U + (size_t)mt2 * 256 * 1024, 1024, W + (size_t)nt2 * 256 * 1024, 1024, smem);
    const int tid = g_tid(), lane = tid & 63, wid = __builtin_amdgcn_readfirstlane(tid >> 6), wm = wid >> 2, wn = wid & 3, fq = lane >> 4, fr = lane & 15;
#pragma unroll
    for (int mi = 0; mi < 8; ++mi) {
      float o[8];
#pragma unroll
      for (int h2 = 0; h2 < 2; ++h2) {
        const f32x4 g = acc[mi][h2], u = acc[mi][2 + h2];
#pragma unroll
        for (int j = 0; j < 4; ++j) o[4 * h2 + j] = g[j] * sigmoidf_(g[j]) * u[j];
      }
      *(u32x4*)(H + (size_t)(mt * 256 + wm * 128 + mi * 16 + fr) * DFF + (nt * 4 + wn) * 32 + 8 * fq) = (u32x4){pk2(o[0], o[1]), pk2(o[2], o[3]), pk2(o[4], o[5]), pk2(o[6], o[7])};
    }
    v = v2; mt = mt2; nt = nt2; cur = nxt;
  }
}

struct InprojSched {
  const char* U; const char* W; int nsupA, nsup, vmax, grid, bid;
  DI static bool transposed(int nt) { return (nt >= 4 && nt < 8) || (nt >= 12 && nt < 16); }
  DI bool next(int i, pg8::Unit& u) const {
    const int v = bid + i * grid;
    if (v >= vmax) return false;
    const int c = v >> 8, w = v & 255, local = w >> 3, sup = (c * 8 + (w & 7)) * 2 + (local >> 4);
    if (sup >= nsup) return false;
    if (sup < nsupA) { u.pm = (sup / 9) * 8 + (local & 7); u.pn = (sup % 9) * 2 + ((local >> 3) & 1); }
    else { u.pm = 64 + (local & 7); u.pn = (sup - nsupA) * 2 + ((local >> 3) & 1); }
    return true;
  }
  DI const char* pa(const pg8::Unit& u) const { return transposed(u.pn) ? W + (size_t)u.pn * 256 * 1024 * 2 : U + (size_t)u.pm * 256 * 1024 * 2; }
  DI const char* pb(const pg8::Unit& u) const { return transposed(u.pn) ? U + (size_t)u.pm * 256 * 1024 * 2 : W + (size_t)u.pn * 256 * 1024 * 2; }
};
struct InprojEpi {
  bf16_t *KB, *VT, *QB, *CQ, *ZT, *ZTC, *R; const float *ropec, *ropes;
  DI void operator()(const f32x4 (&acc)[2][2][4][2], const pg8::Unit& u, int wr, int wc, int fr, int fq) const {
    const int mt = u.pm, nt = u.pn, m0 = mt * 256;
    int b, pos0; bool isctx; row_info(m0, b, pos0, isctx);
    if (nt < 4 || (nt >= 8 && nt < 12)) {
      const bool isq = nt >= 8; const int map = wc >> 1, axis = wc & 1;
      const float sc = isq ? QSCALE : 1.0f;
#pragma unroll
      for (int ai = 0; ai < 2; ++ai)
#pragma unroll
        for (int m = 0; m < 4; ++m) {
          const int pos = pos0 + 128 * ai + 64 * wr + 16 * m + fr;
          f32x4 cs = {1.f, 1.f, 1.f, 1.f}, sn = {0.f, 0.f, 0.f, 0.f};
          if (!isctx) { cs = *(const f32x4*)(ropec + pos * 32 + axis * 16 + fq * 4); sn = *(const f32x4*)(ropes + pos * 32 + axis * 16 + fq * 4); }
#pragma unroll
          for (int bj = 0; bj < 2; ++bj) {
            const int h = (nt * 2 + bj) & 7;
            const f32x4 x0 = acc[ai][bj][m][0], x1 = acc[ai][bj][m][1];
            const f32x4 o0 = (x0 * cs - x1 * sn) * sc, o1 = (x1 * cs + x0 * sn) * sc;
            bf16_t* dst;
            if (!isq) dst = KB + ((size_t)((b * 8 + h) * 2 + map) * NKEY + (isctx ? SEQ + pos : pos)) * 64;
            else if (!isctx) dst = QB + ((size_t)((b * 8 + h) * 2 + map) * SEQ + pos) * 64;
            else dst = CQ + ((size_t)((b * 8 + h) * 2 + map) * LC + pos) * 64;
            *(u32x2*)(dst + axis * 32 + fq * 4) = (u32x2){pk2(o0[0], o0[1]), pk2(o0[2], o0[3])};
            *(u32x2*)(dst + axis * 32 + 16 + fq * 4) = (u32x2){pk2(o1[0], o1[1]), pk2(o1[2], o1[3])};
          }
        }
    } else if (nt < 8 || (nt >= 12 && nt < 16)) {
      const bool isv = nt < 8;
#pragma unroll
      for (int ai = 0; ai < 2; ++ai)
#pragma unroll
        for (int m = 0; m < 4; ++m) {
          const int ncol = nt * 256 + 128 * ai + 64 * wr + 16 * m + fr;
#pragma unroll
          for (int bj = 0; bj < 2; ++bj)
#pragma unroll
            for (int n = 0; n < 2; ++n) {
              const int pos = pos0 + 128 * bj + 32 * wc + 16 * n + 4 * fq;
              const f32x4 vv = acc[ai][bj][m][n];
              bf16_t* dst;
              if (isv) {
                const int vg = ncol - 1024, h = vg >> 7, vcol = vg & 127;
                const int key = (isctx ? SEQ : 0) + pos, k15 = key & 15;
                const int pkey = (key & ~15) | (k15 & 3) | ((k15 & 4) << 1) | ((k15 & 8) >> 1);
                dst = VT + ((size_t)(b * 8 + h) * 128 + vcol) * NKEY + pkey;
              } else {
                const int zc = ncol - 3072, np = zc & 511, second = zc >> 9;
                dst = isctx ? (ZTC + ((size_t)b * 512 + np) * 512 + second * 256 + pos) : (ZT + ((size_t)b * 512 + np) * 4096 + second * 2048 + pos);
              }
              *(u32x2*)dst = (u32x2){pk2(vv[0], vv[1]), pk2(vv[2], vv[3])};
            }
        }
    } else {
#pragma unroll
      for (int ai = 0; ai < 2; ++ai)
#pragma unroll
        for (int m = 0; m < 4; ++m) {
          const int row = m0 + 128 * ai + 64 * wr + 16 * m + fr;
#pragma unroll
          for (int bj = 0; bj < 2; ++bj)
#pragma unroll
            for (int n = 0; n < 2; ++n) {
              const int col = nt * 256 + 128 * bj + 32 * wc + 16 * n + 4 * fq - 4096;
              const f32x4 vv = acc[ai][bj][m][n];
              *(u32x2*)(R + (size_t)row * 512 + col) = (u32x2){pk2(vv[0], vv[1]), pk2(vv[2], vv[3])};
            }
        }
    }
  }
};
DI void phase_inproj8(const Params& p, int l, char* smem) {
  const bool last = (l == DEPTH - 1);
  InprojSched S;
  S.U = (const char*)(p.ws + OFF_U); S.W = (const char*)((const bf16_t*)(p.ws + OFF_W) + WO_WIN);
  S.nsupA = last ? 72 : 81; S.nsup = last ? 76 : 81; S.vmax = ((S.nsup + 15) >> 4) << 8; S.grid = gridDim.x; S.bid = blockIdx.x;
  InprojEpi E;
  E.KB = (bf16_t*)(p.ws + OFF_KB); E.VT = (bf16_t*)(p.ws + OFF_VT); E.QB = (bf16_t*)(p.ws + OFF_QB); E.CQ = (bf16_t*)(p.ws + OFF_CQ);
  E.ZT = (bf16_t*)(p.ws + OFF_ZT); E.ZTC = (bf16_t*)(p.ws + OFF_ZTC); E.R = (bf16_t*)(p.ws + OFF_R);
  E.ropec = (const float*)(p.ws + OFF_ROPEC); E.ropes = (const float*)(p.ws + OFF_ROPES);
  pg8::gemm_phase(( __attribute__((address_space(3))) unsigned char*)(lds_ptr_t)smem, 1024, S, E);
}
struct Ffn1Sched {
  const char* U; const char* W; int nsup, vmax, grid, bid;
  DI bool next(int i, pg8::Unit& u) const {
    const int v = bid + i * grid;
    if (v >= vmax) return false;
    const int c = v >> 8, w = v & 255, local = w >> 3, sup = (c * 8 + (w & 7)) * 2 + (local >> 4);
    if (sup >= nsup) return false;
    u.pm = (sup / 11) * 8 + (local & 7); u.pn = (sup % 11) * 2 + ((local >> 3) & 1);
    return true;
  }
  DI const char* pa(const pg8::Unit& u) const { return U + (size_t)u.pm * 256 * 1024 * 2; }
  DI const char* pb(const pg8::Unit& u) const { return W + (size_t)u.pn * 256 * 1024 * 2; }
};
struct Ffn1Epi {
  bf16_t* H;
  DI void operator()(const f32x4 (&acc)[2][2][4][2], const pg8::Unit& u, int wr, int wc, int fr, int fq) const {
#pragma unroll
    for (int ai = 0; ai < 2; ++ai)
#pragma unroll
      for (int m = 0; m < 4; ++m) {
        const int row = u.pm * 256 + 128 * ai + 64 * wr + 16 * m + fr;
#pragma unroll
        for (int bj = 0; bj < 2; ++bj) {
          const f32x4 g = acc[ai][bj][m][0], up = acc[ai][bj][m][1];
          float o[4];
#pragma unroll
          for (int j = 0; j < 4; ++j) o[j] = g[j] * sigmoidf_(g[j]) * up[j];
          *(u32x2*)(H + (size_t)row * DFF + u.pn * 128 + (bj * 4 + wc) * 16 + fq * 4) = (u32x2){pk2(o[0], o[1]), pk2(o[2], o[3])};
        }
      }
  }
};
DI void phase_ffn18(const Params& p, int l, char* smem) {
  const bool last = (l == DEPTH - 1);
  Ffn1Sched S;
  S.U = (const char*)(p.ws + OFF_U); S.W = (const char*)((const bf16_t*)(p.ws + OFF_W) + WO_WGU);
  S.nsup = (last ? 8 : 9) * 11; S.vmax = ((S.nsup + 15) >> 4) << 8; S.grid = gridDim.x; S.bid = blockIdx.x;
  Ffn1Epi E; E.H = (bf16_t*)(p.ws + OFF_H);
  pg8::gemm_phase((__attribute__((address_space(3))) unsigned char*)(lds_ptr_t)smem, 1024, S, E);
}

#define XB_TMO      128
#define XB_XCNT(j)  (256  + 64 * (j))
#define XB_XSUB(j)  (1280 + 64 * (j))
#define XB_XGEN(j)  (2304 + 64 * (j))
#define XB_TOP      3328
#define XB_TOPGEN   3392
#define XCD_BAR_WORDS 3456
#define XB_SPIN_CAP (1u << 20)
#define LAS __attribute__((address_space(3)))
DI unsigned xb_ld(unsigned* p) { return __hip_atomic_load(p, __ATOMIC_RELAXED, __HIP_MEMORY_SCOPE_AGENT); }
DI unsigned xb_add(unsigned* p, unsigned v) { return __hip_atomic_fetch_add(p, v, __ATOMIC_RELAXED, __HIP_MEMORY_SCOPE_AGENT); }
DI unsigned xb_xcc_id() { return (unsigned)__builtin_amdgcn_s_getreg((3 << 11) | 20) & 0xFu; }
#define XB_SPIN(cond, bar) do { unsigned _sp = 0; while (cond) { __builtin_amdgcn_s_sleep(1); \
    if ((++_sp & 255u) == 0u) { if (xb_ld(&(bar)[XB_TMO])) break; if (_sp > XB_SPIN_CAP) { atomicAdd(&(bar)[XB_TMO], 1u); break; } } } } while (0)
struct XcdBarrier { unsigned* bar; unsigned x; volatile LAS unsigned* st; };
DI XcdBarrier xcd_barrier_post(unsigned* bar, volatile LAS unsigned* st) {
  XcdBarrier b; b.bar = bar; b.x = xb_xcc_id(); b.st = st;
  if (__builtin_amdgcn_workitem_id_x() == 0) (void)xb_add(&bar[XB_XCNT(b.x)], 1u);
  return b;
}
DI void xcd_barrier_complete(unsigned* bar, unsigned x, unsigned& nloc, unsigned& nx) {
  const unsigned G = gridDim.x * gridDim.y * gridDim.z;
  unsigned sum, cnt, mine, sp = 0u;
  for (;;) {
    sum = 0u; cnt = 0u; mine = 0u;
#pragma unroll
    for (unsigned j = 0; j < 16; ++j) { const unsigned c = xb_ld(&bar[XB_XCNT(j)]); sum += c; cnt += (c > 0u) ? 1u : 0u; mine = (j == x) ? c : mine; }
    if (sum == G) break;
    __builtin_amdgcn_s_sleep(1);
    if ((++sp & 255u) == 0u) { if (xb_ld(&bar[XB_TMO])) break; if (sp > XB_SPIN_CAP) { atomicAdd(&bar[XB_TMO], 1u); break; } }
  }
  nloc = mine > 0u ? mine : 1u; nx = cnt > 0u ? cnt : 1u;
}
DI void xcd_barrier(const XcdBarrier& b) {
  asm volatile("s_waitcnt vmcnt(0)" ::: "memory");
  __syncthreads();
  if (__builtin_amdgcn_workitem_id_x() == 0) {
    unsigned* bar = b.bar;
    __builtin_amdgcn_s_waitcnt(0);
    unsigned nloc = b.st[0], nx = b.st[1];
    if (nloc == 0u) { xcd_barrier_complete(bar, b.x, nloc, nx); b.st[0] = nloc; b.st[1] = nx; }
    const unsigned old = xb_add(&bar[XB_XSUB(b.x)], 1u);
    const unsigned gen = old / nloc;
    if (old + 1u == (gen + 1u) * nloc) {
      __builtin_amdgcn_fence(__ATOMIC_RELEASE, "agent");
      asm volatile("s_waitcnt vmcnt(0)" ::: "memory");
      const unsigned og = xb_add(&bar[XB_TOP], 1u);
      const unsigned tg = og / nx;
      if (og + 1u == (tg + 1u) * nx) xb_add(&bar[XB_TOPGEN], 1u);
      else XB_SPIN(xb_ld(&bar[XB_TOPGEN]) == tg, bar);
      __builtin_amdgcn_fence(__ATOMIC_ACQUIRE, "agent");
      xb_add(&bar[XB_XGEN(b.x)], 1u);
      asm volatile("s_waitcnt vmcnt(0)" ::: "memory");
    } else {
      XB_SPIN(xb_ld(&bar[XB_XGEN(b.x)]) == gen, bar);
      __builtin_amdgcn_fence(__ATOMIC_ACQUIRE, "agent");
      asm volatile("s_waitcnt vmcnt(0)" ::: "memory");
    }
  }
  __syncthreads();
}

#define REP_MASK 0
#define REP_PRO 0
__global__ void __launch_bounds__(512) mega(Params p0) {
  extern __shared__ __attribute__((aligned(16))) char smem[];
  cg::grid_group grid = cg::this_grid();
  volatile LAS unsigned* xst = (volatile LAS unsigned*)(lds_ptr_t)(smem + 3 * GSTAGE);
  if (__builtin_amdgcn_workitem_id_x() < 4) xst[__builtin_amdgcn_workitem_id_x()] = 0u;
  __syncthreads();
  const XcdBarrier xb = xcd_barrier_post((unsigned*)(p0.ws + OFF_BAR), xst);
  for (int ph = p0.ph_begin; ph < p0.ph_end; ++ph) {
    const Params& p = p0;
    const bf16_t* Wl = (const bf16_t*)(p.ws + OFF_W);
    if (ph == 0) { phase0a(p, smem); if (REP_PRO & 1) { xcd_barrier(xb); phase0a(p, smem); } }
    else if (ph == 1) { ln_pass(p, 0, T_ALL, nullptr, nullptr, nullptr, 0, 0, 0, 0); if (REP_PRO & 2) { xcd_barrier(xb); ln_pass(p, 0, T_ALL, nullptr, nullptr, nullptr, 0, 0, 0, 0); } }
    else {
      const int l = (ph - 2) >> 3, s = (ph - 2) & 7;
      const bool last = (l == DEPTH - 1);
      const int nmt = last ? 64 : 72, nrows = last ? T_LAT : T_ALL;
      for (int rep = 0; rep < 1 + ((REP_MASK >> s) & 1); ++rep) {
      if (rep) xcd_barrier(xb);
      switch (s) {
        case 0: phase_inproj8(p, l, smem); break;
        case 1: phase_mix(p, l, smem); break;
        case 2: if (last) phase_branch<4>(p, l, smem); else phase_branch<3>(p, l, smem); break;
        case 3: if (last) phase_gemm_plain<4>((const bf16_t*)(p.ws + OFF_MOUT), 1024, Wl + WO_WO, (bf16_t*)(p.ws + OFF_Y), 64, 8, smem);
                else phase_gemm_plain<3>((const bf16_t*)(p.ws + OFF_MOUT), 1024, Wl + WO_WO, (bf16_t*)(p.ws + OFF_Y), 96, 8, smem);
                break;
        case 4: ln_pass(p, 1, nrows, (const bf16_t*)(p.ws + OFF_Y), p.ln1_g + (size_t)l * 1024, p.ln1_b + (size_t)l * 1024, l, 2, l, 3); break;
        case 5: phase_ffn18(p, l, smem); break;
        case 6: if (last) phase_gemm_plain<4>((const bf16_t*)(p.ws + OFF_H), DFF, Wl + WO_WD, (bf16_t*)(p.ws + OFF_FO), 64, 8, smem);
                else phase_gemm_plain<3>((const bf16_t*)(p.ws + OFF_H), DFF, Wl + WO_WD, (bf16_t*)(p.ws + OFF_FO), 96, 8, smem);
                break;
        default:
          ln_pass(p, last ? 2 : 1, nrows, (const bf16_t*)(p.ws + OFF_FO), p.ln2_g + (size_t)l * 1024, p.ln2_b + (size_t)l * 1024, l, 5, last ? l : l + 1, 0);
          if (!last) convert_layer(p, l + 1, smem);
          break;
      }
      }
    }
    if (ph + 1 < p0.ph_end) { if (ph == p0.ph_begin) grid.sync(); else xcd_barrier(xb); }
  }
}

extern "C" void kernel_launch(void* const* d_in, const int* in_sizes, int n_in, void* d_out, int out_size, void* d_ws, size_t ws_size, hipStream_t stream) {
  constexpr size_t kDynLds = 3 * GSTAGE + 16;
  static int grid_blocks = 0;
  if (!grid_blocks) {
    int dev = 0, cus = 0, per_cu = 0;
    (void)hipGetDevice(&dev);
    (void)hipDeviceGetAttribute(&cus, hipDeviceAttributeMultiprocessorCount, dev);
    (void)hipFuncSetAttribute((const void*)mega, hipFuncAttributeMaxDynamicSharedMemorySize, (int)kDynLds);
    (void)hipOccupancyMaxActiveBlocksPerMultiprocessor(&per_cu, mega, 512, kDynLds);
    if (per_cu > 1) per_cu = 1;
    if (per_cu < 1) per_cu = 1;
    grid_blocks = cus * per_cu;
  }
  if (ws_size < WS_NEED) { fprintf(stderr, "workspace too small: %zu < %zu\n", ws_size, (size_t)WS_NEED); return; }
  (void)hipMemsetAsync((char*)d_ws + OFF_BAR, 0, XCD_BAR_WORDS * 4, stream);
  Params p;
  memset(&p, 0, sizeof(p));
  const float** fp = (const float**)&p;
  for (int i = 0; i < 22; ++i) fp[i] = (const float*)d_in[i];
  p.out = (float*)d_out;
  p.ws = (char*)d_ws;
  for (int l = 0; l < 4; ++l) p.lam_init[l] = (float)(0.8 - 0.6 * exp(-0.3 * l));
  p.ph_begin = 0; p.ph_end = 2 + 8 * DEPTH;
  void* args[] = {&p};
  hipError_t e = hipLaunchCooperativeKernel((void*)mega, dim3(grid_blocks), dim3(512), args, kDynLds, stream);
  if (e != hipSuccess) fprintf(stderr, "cooperative launch failed: %s (grid %d)\n", hipGetErrorString(e), grid_blocks);
}
```

```cpp
#include <hip/hip_runtime.h>
#include <hip/hip_cooperative_groups.h>
#include <cstdio>
#include <cstdint>
#include <cstring>
#include <cmath>
namespace cg = cooperative_groups;

#define DI __device__ __forceinline__
typedef unsigned short bf16_t;
typedef short bf16x8 __attribute__((ext_vector_type(8)));
typedef float f32x4 __attribute__((ext_vector_type(4)));
typedef float f32x2 __attribute__((ext_vector_type(2)));
typedef float f32x16 __attribute__((ext_vector_type(16)));
typedef unsigned u32x2 __attribute__((ext_vector_type(2)));
typedef unsigned u32x4 __attribute__((ext_vector_type(4)));
typedef __bf16 bf16x2_t __attribute__((ext_vector_type(2)));

constexpr int D = 1024, NB = 8, SEQ = 2048, LC = 256, NH = 8, DEPTH = 4;
constexpr int T_LAT = NB * SEQ, T_CTX = NB * LC, T_ALL = T_LAT + T_CTX;
constexpr int NKEY = SEQ + LC;
constexpr int N_IN = 7168, DFF = 2816;
constexpr int WIN_ROWS = 7680;
constexpr int ROW_Z1 = 3072, ROW_Z2 = 3584, ROW_R = 4096, ROW_G = 4608;
constexpr float ALPHA = 1.6817928305074290f;
constexpr float LN_EPS = 1e-5f;
constexpr float QSCALE = 0.125f * 1.4426950408889634f;

constexpr size_t WO_WIN = 0;
constexpr size_t WO_WA = WO_WIN + (size_t)WIN_ROWS * 1024;
constexpr size_t WO_WF = WO_WA + 1024 * 1024;
constexpr size_t WO_WP = WO_WF + 1024 * 512;
constexpr size_t WO_WO = WO_WP + 1024 * 512;
constexpr size_t WO_WGU = WO_WO + 1024 * 1024;
constexpr size_t WO_WD = WO_WGU + (size_t)5632 * 1024;
constexpr size_t W_ELEMS = WO_WD + (size_t)1024 * DFF;

constexpr size_t al256(size_t x) { return (x + 255) & ~(size_t)255; }
constexpr size_t OFF_W = 0;
constexpr size_t OFF_ATAB = al256(OFF_W + W_ELEMS * 2);
constexpr size_t OFF_ATABC = al256(OFF_ATAB + (size_t)2048 * 4096 * 2);
constexpr size_t OFF_ROPEC = al256(OFF_ATABC + (size_t)256 * 512 * 2);
constexpr size_t OFF_ROPES = al256(OFF_ROPEC + (size_t)2048 * 32 * 4);
constexpr size_t OFF_MODV = al256(OFF_ROPES + (size_t)2048 * 32 * 4);
constexpr size_t OFF_LAMV = al256(OFF_MODV + (size_t)DEPTH * 9 * 6144 * 4);
constexpr size_t OFF_X = al256(OFF_LAMV + 256);
constexpr size_t OFF_U = al256(OFF_X + (size_t)T_ALL * 1024 * 4);
constexpr size_t OFF_KB = al256(OFF_U + (size_t)T_ALL * 1024 * 2);
constexpr size_t OFF_VT = al256(OFF_KB + (size_t)NB * NH * 2 * NKEY * 64 * 2);
constexpr size_t OFF_QB = al256(OFF_VT + (size_t)NB * NH * 128 * NKEY * 2);
constexpr size_t OFF_CQ = al256(OFF_QB + (size_t)NB * NH * 2 * SEQ * 64 * 2);
constexpr size_t OFF_ZT = al256(OFF_CQ + (size_t)NB * NH * 2 * LC * 64 * 2);
constexpr size_t OFF_ZTC = al256(OFF_ZT + (size_t)NB * 512 * 4096 * 2);
constexpr size_t OFF_R = al256(OFF_ZTC + (size_t)NB * 512 * 512 * 2);
constexpr size_t OFF_ATT = al256(OFF_R + (size_t)T_ALL * 512 * 2);
constexpr size_t OFF_FM = al256(OFF_ATT + (size_t)T_ALL * 1024 * 2);
constexpr size_t OFF_PM = al256(OFF_FM + (size_t)T_ALL * 512 * 2);
constexpr size_t OFF_BAR = al256(OFF_PM + (size_t)T_ALL * 512 * 2);
constexpr size_t OFF_CTR = OFF_BAR + 3456 * 4;
constexpr size_t OFF_W2 = al256(OFF_CTR + 64);
constexpr size_t WS_NEED = al256(OFF_W2 + W_ELEMS * 2);
constexpr size_t OFF_MOUT = OFF_KB;
constexpr size_t OFF_Y = OFF_VT;
constexpr size_t OFF_H = OFF_KB;
constexpr size_t OFF_FO = OFF_ATT;
static_assert((size_t)T_ALL * DFF * 2 <= OFF_CQ - OFF_KB, "H overlay too large");

struct Params {
  const float *x, *c, *ctx, *c_ctx, *w_mod, *b_mod, *w_in, *lam_qk, *subln_g, *w_att_br, *w_four_br, *w_pool_grp, *pool_scale,
      *w_pool_br, *w_out, *ln1_g, *ln1_b, *w_ffn_gate, *w_ffn_up, *w_ffn_down, *ln2_g, *ln2_b;
  float* out;
  char* ws;
  float lam_init[4];
  int ph_begin, ph_end;
};

DI size_t w_off(int l) { return (l & 1) ? OFF_W2 : OFF_W; }
DI int g_tid() { int t = __builtin_amdgcn_workitem_id_x(); asm volatile("" : "+v"(t)); return t; }
DI unsigned pk2(float a, float b) { f32x2 v = {a, b}; bf16x2_t r = __builtin_convertvector(v, bf16x2_t); return __builtin_bit_cast(unsigned, r); }
DI float bf_lo(unsigned u) { return __uint_as_float(u << 16); }
DI float bf_hi(unsigned u) { return __uint_as_float(u & 0xffff0000u); }
DI float hw_cos_rev(float r) { return __builtin_amdgcn_cosf(r); }
DI float hw_sin_rev(float r) { return __builtin_amdgcn_sinf(r); }
DI float sigmoidf_(float x) { return 1.0f / (1.0f + __expf(-x)); }
DI float xor32_sum(float v) { const auto r = __builtin_amdgcn_permlane32_swap(__float_as_uint(v), __float_as_uint(v), false, false); return __uint_as_float(r[0]) + __uint_as_float(r[1]); }
DI float xor32_max(float v) { const auto r = __builtin_amdgcn_permlane32_swap(__float_as_uint(v), __float_as_uint(v), false, false); return fmaxf(__uint_as_float(r[0]), __uint_as_float(r[1])); }
DI float dpp_add(float v, int) { return v; }
#define DPP_ADD(v, ctrl) ((v) + __uint_as_float(__builtin_amdgcn_update_dpp(0u, __float_as_uint(v), (ctrl), 0xF, 0xF, true)))
DI float wave_sum(float v) {
  v = DPP_ADD(v, 0xB1);
  v = DPP_ADD(v, 0x4E);
  v = DPP_ADD(v, 0x141);
  v = DPP_ADD(v, 0x140);
  { const auto r = __builtin_amdgcn_permlane16_swap(__float_as_uint(v), __float_as_uint(v), false, false); v = __uint_as_float(r[0]) + __uint_as_float(r[1]); }
  return xor32_sum(v);
}
#define MFMA16(a, b, c) __builtin_amdgcn_mfma_f32_16x16x32_bf16((a), (b), (c), 0, 0, 0)
#define MFMA32(a, b, c) __builtin_amdgcn_mfma_f32_32x32x16_bf16((a), (b), (c), 0, 0, 0)

constexpr int GSTAGE = 49152;
#define WAIT_VM(n) asm volatile("s_waitcnt vmcnt(" #n ")" ::: "memory")
typedef __attribute__((address_space(3))) void* lds_ptr_t;
template <bool SWAP, int MI = 4>
DI void gemm_kloop(const bf16_t* __restrict__ A, int lda, const bf16_t* __restrict__ B, int ldb, int K, f32x4 (&acc)[MI][4], char* smem, bool pre = false  ) {
  const int tid = g_tid(), lane = tid & 63, wid = __builtin_amdgcn_readfirstlane(tid >> 6), wm = wid >> 1, wn = wid & 1;
  const int lr = tid >> 3, lc = (tid & 7) ^ ((tid >> 4) & 7);
  const unsigned aoff = (unsigned)(lr * lda + lc * 8) * 2u, boff = (unsigned)(lr * ldb + lc * 8) * 2u;
  const char* Ac = (const char*)A; const char* Bc = (const char*)B;
  const int fr = lane & 15, fq = lane >> 4, sw = fr >> 1;
  const int a_base = (wm * 16 * MI + fr) * 128, b_base = 32768 + (wn * 64 + fr) * 128;
  const int nk = K >> 6;
  char* sdst = smem + tid * 16;
#define G_ISSUE(KT, ST) do { _Pragma("unroll") for (int i = 0; i < MI; ++i) \
      __builtin_amdgcn_global_load_lds((const void*)(Ac + ((size_t)(64 * i) * lda + (size_t)(KT) * 64) * 2 + aoff), (lds_ptr_t)(sdst + (ST) * GSTAGE + i * 8192), 16, 0, 0); \
    _Pragma("unroll") for (int i = 0; i < 2; ++i) \
      __builtin_amdgcn_global_load_lds((const void*)(Bc + ((size_t)(64 * i) * ldb + (size_t)(KT) * 64) * 2 + boff), (lds_ptr_t)(sdst + (ST) * GSTAGE + 32768 + i * 8192), 16, 0, 0); } while (0)
#define G_COMPUTE(ST) do { const char* st_ = smem + (ST) * GSTAGE; \
    _Pragma("unroll") for (int ks = 0; ks < 2; ++ks) { const int co = ((ks * 4 + fq) ^ sw) << 4; bf16x8 af[MI], bfr[4]; \
      _Pragma("unroll") for (int i = 0; i < 4; ++i) bfr[i] = *(const bf16x8*)(st_ + b_base + i * 2048 + co); \
      _Pragma("unroll") for (int i = 0; i < MI; ++i) af[i] = *(const bf16x8*)(st_ + a_base + i * 2048 + co); \
      _Pragma("unroll") for (int mi = 0; mi < MI; ++mi) _Pragma("unroll") for (int ni = 0; ni < 4; ++ni) { \
          if (SWAP) acc[mi][ni] = MFMA16(bfr[ni], af[mi], acc[mi][ni]); else acc[mi][ni] = MFMA16(af[mi], bfr[ni], acc[mi][ni]); } } } while (0)
  if (!pre) { G_ISSUE(0, 0); G_ISSUE(1, 1); }
  int st = 0;
  for (int t = 0; t < nk; ++t) {
    if (t == 0 || t + 1 >= nk) WAIT_VM(0);
    else if (MI == 4) WAIT_VM(6); else WAIT_VM(5);
    __builtin_amdgcn_s_barrier();
    asm volatile("" ::: "memory");
    const int st2 = (st == 0) ? 2 : st - 1;
    if (t + 2 < nk) G_ISSUE(t + 2, st2);
    __builtin_amdgcn_sched_barrier(0);
    G_COMPUTE(st);
    __builtin_amdgcn_sched_group_barrier(0x100, 6, 0);
#pragma unroll
    for (int i_ = 0; i_ < 2 * MI + 2; ++i_) { __builtin_amdgcn_sched_group_barrier(0x008, 2, 0); __builtin_amdgcn_sched_group_barrier(0x100, 1, 0); }
    __builtin_amdgcn_sched_group_barrier(0x008, 4 * MI - 4, 0);
    __builtin_amdgcn_sched_barrier(0);
    st = (st == 2) ? 0 : st + 1;
  }
  asm volatile("s_waitcnt lgkmcnt(0)" ::: "memory");
  __builtin_amdgcn_s_barrier();
  asm volatile("" ::: "memory");
#undef G_ISSUE
#undef G_COMPUTE
}
template <bool SWAP, int MI = 4>
DI void gemm_kloop_pp(const bf16_t* __restrict__ A, int lda, const bf16_t* __restrict__ B, int ldb, int K, f32x4 (&acc)[MI][4], char* smem) {
  const int tid = g_tid(), lane = tid & 63, wid = __builtin_amdgcn_readfirstlane(tid >> 6), wm = wid >> 1, wn = wid & 1, grp = wid >> 2;
  const int lr = tid >> 3, lc = (tid & 7) ^ ((tid >> 4) & 7);
  const unsigned aoff = (unsigned)(lr * lda + lc * 8) * 2u, boff = (unsigned)(lr * ldb + lc * 8) * 2u;
  const char* Ac = (const char*)A; const char* Bc = (const char*)B;
  const int fr = lane & 15, fq = lane >> 4, sw = fr >> 1;
  const int a_base = (wm * 16 * MI + fr) * 128, b_base = 32768 + (wn * 64 + fr) * 128;
  const int nk = K >> 6;
  char* sdst = smem + tid * 16;
#define P_ISSUE(KT, ST) do { _Pragma("unroll") for (int i = 0; i < MI; ++i) \
      __builtin_amdgcn_global_load_lds((const void*)(Ac + ((size_t)(64 * i) * lda + (size_t)(KT) * 64) * 2 + aoff), (lds_ptr_t)(sdst + (ST) * GSTAGE + i * 8192), 16, 0, 0); \
    _Pragma("unroll") for (int i = 0; i < 2; ++i) \
      __builtin_amdgcn_global_load_lds((const void*)(Bc + ((size_t)(64 * i) * ldb + (size_t)(KT) * 64) * 2 + boff), (lds_ptr_t)(sdst + (ST) * GSTAGE + 32768 + i * 8192), 16, 0, 0); } while (0)
  P_ISSUE(0, 0);
  P_ISSUE(1, 1);
  WAIT_VM(0);
  __builtin_amdgcn_s_barrier();
  asm volatile("" ::: "memory");
  if (grp == 1) { __builtin_amdgcn_s_barrier(); asm volatile("" ::: "memory"); }
  int st = 0;
  for (int t = 0; t < nk; ++t) {
    const int st2 = (st == 0) ? 2 : st - 1;
    if (t + 2 < nk) P_ISSUE(t + 2, st2);
    bf16x8 af[2][MI], bfr[2][4];
    const char* st_ = smem + st * GSTAGE;
#pragma unroll
    for (int ks = 0; ks < 2; ++ks) {
      const int co = ((ks * 4 + fq) ^ sw) << 4;
#pragma unroll
      for (int i = 0; i < 4; ++i) bfr[ks][i] = *(const bf16x8*)(st_ + b_base + i * 2048 + co);
#pragma unroll
      for (int i = 0; i < MI; ++i) af[ks][i] = *(const bf16x8*)(st_ + a_base + i * 2048 + co);
    }
    if (t + 2 < nk) { if (MI == 4) WAIT_VM(6); else WAIT_VM(5); } else WAIT_VM(0);
    asm volatile("s_waitcnt lgkmcnt(0)" ::: "memory");
    __builtin_amdgcn_sched_barrier(0);
    __builtin_amdgcn_s_barrier();
    asm volatile("" ::: "memory");
#pragma unroll
    for (int ks = 0; ks < 2; ++ks)
#pragma unroll
      for (int mi = 0; mi < MI; ++mi)
#pragma unroll
        for (int ni = 0; ni < 4; ++ni) {
          if (SWAP) acc[mi][ni] = MFMA16(bfr[ks][ni], af[ks][mi], acc[mi][ni]); else acc[mi][ni] = MFMA16(af[ks][mi], bfr[ks][ni], acc[mi][ni]);
        }
    __builtin_amdgcn_sched_barrier(0);
    __builtin_amdgcn_s_barrier();
    asm volatile("" ::: "memory");
    st = (st == 2) ? 0 : st + 1;
  }
  if (grp == 0) { __builtin_amdgcn_s_barrier(); asm volatile("" ::: "memory"); }
#undef P_ISSUE
}

template <int MI>
DI void gemm_prefetch(const bf16_t* __restrict__ A, int lda, const bf16_t* __restrict__ B, int ldb, char* smem) {
  const int tid = g_tid();
  const int lr = tid >> 3, lc = (tid & 7) ^ ((tid >> 4) & 7);
  const unsigned aoff = (unsigned)(lr * lda + lc * 8) * 2u, boff = (unsigned)(lr * ldb + lc * 8) * 2u;
  const char* Ac = (const char*)A; const char* Bc = (const char*)B;
  char* sdst = smem + tid * 16;
#pragma unroll
  for (int kt = 0; kt < 2; ++kt) {
#pragma unroll
    for (int i = 0; i < MI; ++i)
      __builtin_amdgcn_global_load_lds((const void*)(Ac + ((size_t)(64 * i) * lda + (size_t)kt * 64) * 2 + aoff), (lds_ptr_t)(sdst + kt * GSTAGE + i * 8192), 16, 0, 0);
#pragma unroll
    for (int i = 0; i < 2; ++i)
      __builtin_amdgcn_global_load_lds((const void*)(Bc + ((size_t)(64 * i) * ldb + (size_t)kt * 64) * 2 + boff), (lds_ptr_t)(sdst + kt * GSTAGE + 32768 + i * 8192), 16, 0, 0);
  }
}
template <int MI>
DI void zero_acc_t(f32x4 (&acc)[MI][4]) {
#pragma unroll
  for (int i = 0; i < MI; ++i)
#pragma unroll
    for (int j = 0; j < 4; ++j) acc[i][j] = (f32x4){0.f, 0.f, 0.f, 0.f};
}
DI void zero_acc(f32x4 (&acc)[4][4]) {
#pragma unroll
  for (int i = 0; i < 4; ++i)
#pragma unroll
    for (int j = 0; j < 4; ++j) acc[i][j] = (f32x4){0.f, 0.f, 0.f, 0.f};
}

template <bool SWAP>
DI void gemm_kloop_big(const bf16_t* __restrict__ A, int lda, const bf16_t* __restrict__ B, int ldb, int K, f32x4 (&acc)[8][4], char* smem, bool pre = false) {
  const int tid = g_tid(), lane = tid & 63, wid = __builtin_amdgcn_readfirstlane(tid >> 6), wm = wid >> 2, wn = wid & 3;
  const int lr = tid >> 3, lc = (tid & 7) ^ ((tid >> 4) & 7);
  const unsigned aoff = (unsigned)(lr * lda + lc * 8) * 2u, boff = (unsigned)(lr * ldb + lc * 8) * 2u;
  const char* Ac = (const char*)A; const char* Bc = (const char*)B;
  const int fr = lane & 15, fq = lane >> 4, sw = fr >> 1;
  const int a_base = (wm * 128 + fr) * 128, b_base = 32768 + (wn * 64 + fr) * 128;
  const int nk = K >> 6;
  char* sdst = smem + tid * 16;
#define GB_ISSUE(KT, ST) do { _Pragma("unroll") for (int i = 0; i < 4; ++i) { \
      __builtin_amdgcn_global_load_lds((const void*)(Ac + ((size_t)(64 * i) * lda + (size_t)(KT) * 64) * 2 + aoff), (lds_ptr_t)(sdst + (ST) * 65536 + i * 8192), 16, 0, 0); \
      __builtin_amdgcn_global_load_lds((const void*)(Bc + ((size_t)(64 * i) * ldb + (size_t)(KT) * 64) * 2 + boff), (lds_ptr_t)(sdst + (ST) * 65536 + 32768 + i * 8192), 16, 0, 0); } } while (0)
  if (!pre) GB_ISSUE(0, 0);
  for (int t = 0; t < nk; ++t) {
    WAIT_VM(0);
    __builtin_amdgcn_s_barrier();
    asm volatile("" ::: "memory");
    if (t + 1 < nk) GB_ISSUE(t + 1, (t + 1) & 1);
    __builtin_amdgcn_sched_barrier(0);
    const char* st_ = smem + (t & 1) * 65536;
#pragma unroll
    for (int ks = 0; ks < 2; ++ks) {
      const int co = ((ks * 4 + fq) ^ sw) << 4;
      bf16x8 af[8], bfr[4];
#pragma unroll
      for (int i = 0; i < 4; ++i) bfr[i] = *(const bf16x8*)(st_ + b_base + i * 2048 + co);
#pragma unroll
      for (int i = 0; i < 8; ++i) af[i] = *(const bf16x8*)(st_ + a_base + i * 2048 + co);
#pragma unroll
      for (int mi = 0; mi < 8; ++mi)
#pragma unroll
        for (int ni = 0; ni < 4; ++ni) {
          if (SWAP) acc[mi][ni] = MFMA16(bfr[ni], af[mi], acc[mi][ni]); else acc[mi][ni] = MFMA16(af[mi], bfr[ni], acc[mi][ni]);
        }
    }
    __builtin_amdgcn_sched_group_barrier(0x100, 8, 0);
#pragma unroll
    for (int i_ = 0; i_ < 16; ++i_) { __builtin_amdgcn_sched_group_barrier(0x008, 3, 0); __builtin_amdgcn_sched_group_barrier(0x100, 1, 0); }
    __builtin_amdgcn_sched_group_barrier(0x008, 16, 0);
    __builtin_amdgcn_sched_barrier(0);
  }
  asm volatile("s_waitcnt lgkmcnt(0)" ::: "memory");
  __builtin_amdgcn_s_barrier();
  asm volatile("" ::: "memory");
#undef GB_ISSUE
}

namespace pg8 {
#define PG8_LAS __attribute__((address_space(3)))
constexpr int BM = 256, BK = 64, HALF = 128, HTB = HALF * BK * 2;
DI int lds_byte(int r, int c) { const int st = (r >> 4) * 2 + (c >> 5), rr = r & 15, cc = c & 31, ob = rr * 64 + cc * 2; return st * 1024 + (ob ^ (((ob >> 9) & 1) << 5)); }
DI void stage_rc(int b, int& R, int& C) { const int st = b / 1024, sb = b % 1024, swz = sb ^ (((sb >> 9) & 1) << 5); R = (st >> 1) * 16 + swz / 64; C = (st & 1) * 32 + (swz % 64) / 2; }
struct Unit { int pm, pn; };
template <class Epi, class Sched>
DI void gemm_phase(PG8_LAS unsigned char* lds, int K, const Sched& S, const Epi& E) {
  const int tid = g_tid(), wid = __builtin_amdgcn_readfirstlane(tid >> 6), lane = tid & 63, wr = wid >> 2, wc = wid & 3, fr = lane & 15, fq = lane >> 4;
  const int nt = K / BK;
  unsigned voff[2];
#pragma unroll
  for (int i = 0; i < 2; ++i) { int R, C; stage_rc(tid * 16 + i * 8192, R, C); voff[i] = (unsigned)(R * K + C) * 2u; }
  const size_t kstep = (size_t)(BK * 2);
  const size_t hstep = (size_t)HALF * K * 2;
  const unsigned ldsw = (unsigned)wid * 1024u;
  const int aoff = lds_byte(wr * 64 + fr, fq * 8), boff = lds_byte(wc * 32 + fr, fq * 8);
#define PG8_SA(b, h) (((b) * 2 + (h)) * HTB)
#define PG8_SB(b, h) ((4 + (b) * 2 + (h)) * HTB)
#define PG8_STAGE(bufoff, gbase) do { _Pragma("unroll") for (int _i = 0; _i < 2; ++_i) \
    __builtin_amdgcn_global_load_lds((const void*)((const char*)(gbase) + voff[_i]), (PG8_LAS void*)(lds + (bufoff) + ldsw + _i * 8192), 16, 0, 0); } while (0)
#define PG8_LDA(dst, b, h) do { _Pragma("unroll") for (int m = 0; m < 4; ++m) _Pragma("unroll") for (int k = 0; k < 2; ++k) dst[m][k] = *(const PG8_LAS bf16x8*)(lds + PG8_SA(b, h) + aoff + m * 2048 + k * 1024); } while (0)
#define PG8_LDB(dst, b, h) do { _Pragma("unroll") for (int n = 0; n < 2; ++n) _Pragma("unroll") for (int k = 0; k < 2; ++k) dst[n][k] = *(const PG8_LAS bf16x8*)(lds + PG8_SB(b, h) + boff + n * 2048 + k * 1024); } while (0)
#define PG8_MMA(ai, bj, At, Bt) do { __builtin_amdgcn_s_setprio(1); _Pragma("unroll") for (int m = 0; m < 4; ++m) _Pragma("unroll") for (int n = 0; n < 2; ++n) _Pragma("unroll") for (int k = 0; k < 2; ++k) \
    acc[ai][bj][m][n] = __builtin_amdgcn_mfma_f32_16x16x32_bf16(Bt[n][k], At[m][k], acc[ai][bj][m][n], 0, 0, 0); __builtin_amdgcn_s_setprio(0); } while (0)
#define PG8_WAIT_V(n) asm volatile("s_waitcnt vmcnt(" #n ")" ::: "memory")
#define PG8_WAIT_L(n) asm volatile("s_waitcnt lgkmcnt(" #n ")" ::: "memory")
#define PG8_BAR __builtin_amdgcn_s_barrier()
#define PG8_SCHED __builtin_amdgcn_sched_barrier(0)
  Unit cur, nxt; int ui = 0;
  if (!S.next(0, cur)) return;
  f32x4 acc[2][2][4][2];
#pragma unroll
  for (int a = 0; a < 2; ++a)
#pragma unroll
    for (int b = 0; b < 2; ++b)
#pragma unroll
      for (int m = 0; m < 4; ++m)
#pragma unroll
        for (int n = 0; n < 2; ++n) acc[a][b][m][n] = (f32x4){0.f, 0.f, 0.f, 0.f};
  bf16x8 At[4][2], B0[2][2], B1[2][2];
  const char* cA = S.pa(cur); const char* cB = S.pb(cur);
  PG8_WAIT_V(0);
  PG8_STAGE(PG8_SB(0, 0), cB); PG8_STAGE(PG8_SA(0, 0), cA); PG8_STAGE(PG8_SB(0, 1), cB + hstep); PG8_STAGE(PG8_SA(0, 1), cA + hstep);
  if (wr == 1) PG8_BAR;
  PG8_WAIT_V(4); PG8_BAR;
  PG8_STAGE(PG8_SB(1, 0), cB + kstep); PG8_STAGE(PG8_SA(1, 0), cA + kstep); PG8_STAGE(PG8_SB(1, 1), cB + hstep + kstep);
  PG8_WAIT_V(6); PG8_BAR;
  for (;;) {
    const bool has_next = S.next(ui + 1, nxt);
    const char* nA = has_next ? S.pa(nxt) : cA; const char* nB = has_next ? S.pb(nxt) : cB;
    for (int t = 0; t < nt; t += 2) {
      const bool last = (t == nt - 2);
      const char* a1 = cA + (size_t)(t + 1) * kstep;
      const char* a2 = last ? nA : cA + (size_t)(t + 2) * kstep; const char* b2 = last ? nB : cB + (size_t)(t + 2) * kstep;
      const char* a3 = a2 + kstep; const char* b3 = b2 + kstep;
      PG8_LDB(B0, 0, 0); PG8_SCHED; PG8_LDA(At, 0, 0); PG8_STAGE(PG8_SA(1, 1), a1 + hstep);
      PG8_WAIT_L(8); PG8_BAR; PG8_WAIT_L(0); PG8_MMA(0, 0, At, B0); PG8_BAR; PG8_SCHED;
      PG8_LDB(B1, 0, 1); PG8_STAGE(PG8_SB(0, 0), b2);
      PG8_BAR; PG8_WAIT_L(0); PG8_MMA(0, 1, At, B1); PG8_BAR;
      PG8_LDA(At, 0, 1); PG8_STAGE(PG8_SA(0, 0), a2);
      PG8_BAR; PG8_WAIT_L(0); PG8_MMA(1, 0, At, B0); PG8_BAR; PG8_SCHED;
      PG8_STAGE(PG8_SB(0, 1), b2 + hstep);
      PG8_WAIT_V(6); PG8_BAR; PG8_MMA(1, 1, At, B1); PG8_BAR;
      PG8_LDB(B0, 1, 0); PG8_SCHED; PG8_LDA(At, 1, 0); PG8_STAGE(PG8_SA(0, 1), a2 + hstep);
      PG8_WAIT_L(8); PG8_BAR; PG8_WAIT_L(0); PG8_MMA(0, 0, At, B0); PG8_BAR; PG8_SCHED;
      PG8_LDB(B1, 1, 1); PG8_STAGE(PG8_SB(1, 0), b3);
      PG8_BAR; PG8_WAIT_L(0); PG8_MMA(0, 1, At, B1); PG8_BAR;
      PG8_LDA(At, 1, 1); PG8_STAGE(PG8_SA(1, 0), a3);
      PG8_BAR; PG8_WAIT_L(0); PG8_MMA(1, 0, At, B0); PG8_BAR; PG8_SCHED;
      PG8_STAGE(PG8_SB(1, 1), b3 + hstep);
      PG8_WAIT_V(6); PG8_BAR; PG8_MMA(1, 1, At, B1); PG8_BAR;
    }
    E(acc, cur, wr, wc, fr, fq);
    if (!has_next) break;
#pragma unroll
    for (int a = 0; a < 2; ++a)
#pragma unroll
      for (int b = 0; b < 2; ++b)
#pragma unroll
        for (int m = 0; m < 4; ++m)
#pragma unroll
          for (int n = 0; n < 2; ++n) acc[a][b][m][n] = (f32x4){0.f, 0.f, 0.f, 0.f};
    cur = nxt; cA = nA; cB = nB; ++ui;
  }
  PG8_WAIT_V(0);
  if (wr == 0) PG8_BAR;
  PG8_BAR;
#undef PG8_SA
#undef PG8_SB
#undef PG8_STAGE
#undef PG8_LDA
#undef PG8_LDB
#undef PG8_MMA
#undef PG8_WAIT_V
#undef PG8_WAIT_L
#undef PG8_BAR
#undef PG8_SCHED
}
}

DI void gemm_prefetch_big(const bf16_t* __restrict__ A, int lda, const bf16_t* __restrict__ B, int ldb, char* smem) {
  const int tid = g_tid();
  const int lr = tid >> 3, lc = (tid & 7) ^ ((tid >> 4) & 7);
  const unsigned aoff = (unsigned)(lr * lda + lc * 8) * 2u, boff = (unsigned)(lr * ldb + lc * 8) * 2u;
  const char* Ac = (const char*)A; const char* Bc = (const char*)B;
  char* sdst = smem + tid * 16;
#pragma unroll
  for (int i = 0; i < 4; ++i) {
    __builtin_amdgcn_global_load_lds((const void*)(Ac + ((size_t)(64 * i) * lda) * 2 + aoff), (lds_ptr_t)(sdst + i * 8192), 16, 0, 0);
    __builtin_amdgcn_global_load_lds((const void*)(Bc + ((size_t)(64 * i) * ldb) * 2 + boff), (lds_ptr_t)(sdst + 32768 + i * 8192), 16, 0, 0);
  }
}

DI void row_info(int r, int& b, int& pos, bool& isctx) {
  if (r < T_LAT) { b = r >> 11; pos = r & 2047; isctx = false; } else { const int q = r - T_LAT; b = q >> 8; pos = q & 255; isctx = true; }
}

constexpr int HALF_LDS = 65792;
DI void conv_tile(bool active, const float* __restrict__ src, int ld, int k0, int c0, bf16_t* __restrict__ dst, int dstld, int ilv  , int n0, char* smem) {
  float* s = (float*)smem;
  const int tid = g_tid() & 255;
  if (active) {
#pragma unroll
    for (int i = 0; i < 4; ++i) {
      const int k = (tid >> 4) + 16 * i, cc = (tid & 15) * 4;
      const f32x4 v = *(const f32x4*)(src + (size_t)(k0 + k) * ld + c0 + n0 + cc);
      s[k * 65 + cc] = v[0]; s[k * 65 + cc + 1] = v[1]; s[k * 65 + cc + 2] = v[2]; s[k * 65 + cc + 3] = v[3];
    }
  }
  __syncthreads();
  if (active) {
    const int n = tid >> 2, kq = (tid & 3) * 16;
    unsigned w[8];
#pragma unroll
    for (int j = 0; j < 8; ++j) w[j] = pk2(s[(kq + 2 * j) * 65 + n], s[(kq + 2 * j + 1) * 65 + n]);
    const int ng = n0 + n;
    size_t drow = ng;
    if (ilv) drow = (size_t)(ng >> 4) * 32 + (ng & 15) + (ilv == 2 ? 16 : 0);
    bf16_t* dp = dst + drow * dstld + k0 + kq;
    *(u32x4*)dp = (u32x4){w[0], w[1], w[2], w[3]};
    *(u32x4*)(dp + 8) = (u32x4){w[4], w[5], w[6], w[7]};
  }
  __syncthreads();
}
DI void fold_tile(bool active, const float* __restrict__ src  , int cbase, int k0, int np0  , int mode, const float* __restrict__ wgrp,
                  const float* __restrict__ pscale, bf16_t* __restrict__ dst  , char* smem) {
  float* sA = (float*)smem;
  float* sT = (float*)(smem + 33024);
  const int tid = g_tid() & 255;
  if (active) {
    for (int i = tid; i < 64 * 32; i += 256) {
      const int k = i >> 5, c4 = (i & 31) * 4;
      const f32x4 v = *(const f32x4*)(src + (size_t)(k0 + k) * N_IN + cbase + c4);
      sA[k * 129 + c4] = v[0]; sA[k * 129 + c4 + 1] = v[1]; sA[k * 129 + c4 + 2] = v[2]; sA[k * 129 + c4 + 3] = v[3];
    }
    for (int i = tid; i < 128 * 64; i += 256) {
      const int c = i >> 6, n = i & 63, np = np0 + n;
      float t;
      if (mode == 2) t = wgrp[c * 128 + np] * pscale[np];
      else { const float r = (float)((c * np) & 127) * (1.0f / 128.0f); t = (mode == 0) ? hw_cos_rev(r) : hw_sin_rev(r); }
      sT[c * 64 + n] = t;
    }
  }
  __syncthreads();
  if (active) {
    const int ty = tid >> 4, tx = tid & 15;
    float acc[4][4];
#pragma unroll
    for (int a = 0; a < 4; ++a)
#pragma unroll
      for (int b = 0; b < 4; ++b) acc[a][b] = 0.f;
    for (int c = 0; c < 128; ++c) {
      const f32x4 t4 = *(const f32x4*)(sT + c * 64 + tx * 4);
      float a4[4];
#pragma unroll
      for (int a = 0; a < 4; ++a) a4[a] = sA[(ty * 4 + a) * 129 + c];
#pragma unroll
      for (int a = 0; a < 4; ++a)
#pragma unroll
        for (int b = 0; b < 4; ++b) acc[a][b] += a4[a] * t4[b];
    }
#pragma unroll
    for (int b = 0; b < 4; ++b) {
      bf16_t* dp = dst + (size_t)(np0 + tx * 4 + b) * 1024 + k0 + ty * 4;
      *(u32x2*)dp = (u32x2){pk2(acc[0][b], acc[1][b]), pk2(acc[2][b], acc[3][b])};
    }
  }
  __syncthreads();
}

constexpr int CONV_TOTAL = 16 * 48 * 2 + 16 * 16 + 8 * 16 * 2 + 16 * 16 + 16 * 44 * 2 + 44 * 16 + 256 + 128;
DI void convert_iter(const Params& p, int l, int tb, char* smem0) {
  bf16_t* W = (bf16_t*)(p.ws + w_off(l));
  const float* win = p.w_in + (size_t)l * 1024 * N_IN;
  const int half = g_tid() >> 8;
  char* smem = smem0 + half * HALF_LDS;
  constexpr int C0 = 16 * 48, C1 = C0 + 16 * 48, C2 = C1 + 16 * 16, C3 = C2 + 8 * 16, C4 = C3 + 8 * 16, C5 = C4 + 16 * 16, C6 = C5 + 16 * 44, C7 = C6 + 16 * 44,
                C8 = C7 + 44 * 16, C9 = C8 + 256, C10 = C9 + 128;
  static_assert((C0 | C1 | C2 | C3 | C4 | C5 | C6 | C7 | C8 | C9 | C10) % 2 == 0, "segment boundaries must be even");
  const int total = C10;
  static_assert(C10 == CONV_TOTAL, "conversion tile count");
  {
    const bool active = (tb + half) < total;
    const int t = active ? tb + half : tb;
    int seg, r;
    if (t < C0) { seg = 0; r = t; } else if (t < C1) { seg = 1; r = t - C0; } else if (t < C2) { seg = 2; r = t - C1; } else if (t < C3) { seg = 3; r = t - C2; }
    else if (t < C4) { seg = 4; r = t - C3; } else if (t < C5) { seg = 5; r = t - C4; } else if (t < C6) { seg = 6; r = t - C5; } else if (t < C7) { seg = 7; r = t - C6; }
    else if (t < C8) { seg = 8; r = t - C7; } else if (t < C9) { seg = 9; r = t - C8; } else { seg = 10; r = t - C9; }
    if (seg <= 8) {
      const float* src; int ld, kt, nt, c0 = 0, dstld, ilv = 0; bf16_t* dst;
      if (seg <= 1) { kt = r & 15; nt = r >> 4; src = win; ld = N_IN; c0 = seg == 0 ? 0 : 4096; dst = W + WO_WIN + (seg == 0 ? 0 : (size_t)ROW_G * 1024); dstld = 1024; }
      else if (seg == 2) { kt = r & 15; nt = r >> 4; src = p.w_att_br + (size_t)l * 1024 * 1024; ld = 1024; dst = W + WO_WA; dstld = 1024; }
      else if (seg == 3) { kt = r & 7; nt = r >> 3; src = p.w_four_br + (size_t)l * 512 * 1024; ld = 1024; dst = W + WO_WF; dstld = 512; }
      else if (seg == 4) { kt = r & 7; nt = r >> 3; src = p.w_pool_br + (size_t)l * 512 * 1024; ld = 1024; dst = W + WO_WP; dstld = 512; }
      else if (seg == 5) { kt = r & 15; nt = r >> 4; src = p.w_out + (size_t)l * 1024 * 1024; ld = 1024; dst = W + WO_WO; dstld = 1024; }
      else if (seg == 6) { kt = r & 15; nt = r >> 4; src = p.w_ffn_gate + (size_t)l * 1024 * DFF; ld = DFF; dst = W + WO_WGU; dstld = 1024; ilv = 1; }
      else if (seg == 7) { kt = r & 15; nt = r >> 4; src = p.w_ffn_up + (size_t)l * 1024 * DFF; ld = DFF; dst = W + WO_WGU; dstld = 1024; ilv = 2; }
      else { kt = r % 44; nt = r / 44; src = p.w_ffn_down + (size_t)l * DFF * 1024; ld = 1024; dst = W + WO_WD; dstld = DFF; }
      conv_tile(active, src, ld, kt * 64, c0, dst, dstld, ilv, nt * 64, smem);
    } else if (seg == 9) {
      const int kt = r & 15, q = r >> 4; const int g = q & 3, hf = (q >> 2) & 1, mode = q >> 3;
      fold_tile(active, win, 3072 + g * 128, kt * 64, hf * 64, mode, nullptr, nullptr, W + WO_WIN + (size_t)((mode ? ROW_Z2 : ROW_Z1) + g * 128) * 1024, smem);
    } else {
      const int kt = r & 15, q = r >> 4; const int g = q & 3, hf = q >> 2;
      fold_tile(active, win, 3584 + g * 128, kt * 64, hf * 64, 2, p.w_pool_grp + ((size_t)l * 4 + g) * 128 * 128, p.pool_scale + (size_t)l * 512 + g * 128,
                W + WO_WIN + (size_t)(ROW_R + g * 128) * 1024, smem);
    }
  }
}

DI void convert_layer(const Params& p, int l, char* smem) {
  for (int tb = blockIdx.x * 2; tb < CONV_TOTAL; tb += gridDim.x * 2) convert_iter(p, l, tb, smem);
}

DI void convert_grab(const Params& p, int l, int which  , char* smem) {
  unsigned* ctr = (unsigned*)(p.ws + OFF_CTR) + l * 2 + which;
  volatile __attribute__((address_space(3))) unsigned* slot = (volatile __attribute__((address_space(3))) unsigned*)(lds_ptr_t)(smem + 3 * GSTAGE + 8);
  const int lo = which ? 2400 : 0, hi = which ? CONV_TOTAL : 2400;
  for (;;) {
    __syncthreads();
    if (__builtin_amdgcn_workitem_id_x() == 0) *slot = __hip_atomic_fetch_add(ctr, 2u, __ATOMIC_RELAXED, __HIP_MEMORY_SCOPE_AGENT);
    __syncthreads();
    const int tb = lo + (int)*slot;
    if (tb >= hi) break;
    convert_iter(p, l, tb, smem);
  }
  __syncthreads();
}

DI void phase0a(const Params& p, char* smem) {
  const int tid = g_tid();
  const int gtid = blockIdx.x * 512 + tid, gsz = gridDim.x * 512;
  {
    const int half = tid >> 8, t8 = tid & 255;
    float* ssil = (float*)smem;
    float* sred = (float*)(smem + 36864 + half * 9216);
    bool filled = false;
    float* modv = (float*)(p.ws + OFF_MODV);
    for (int tb = blockIdx.x * 2; tb < DEPTH * 96; tb += gridDim.x * 2) {
      if (!filled) {
        for (int i = tid; i < 9 * 1024; i += 512) { const float v = (i < 8192) ? p.c[i] : p.c_ctx[i - 8192]; ssil[i] = v * sigmoidf_(v); }
        filled = true;
        __syncthreads();
      }
      const int t = tb + half;
      const int l = t / 96, cgp = t % 96;
      const int col = cgp * 64 + (t8 & 63), kq = t8 >> 6;
      const float* wp = p.w_mod + ((size_t)l * 1024 + kq * 256) * 6144 + col;
      float a[9];
#pragma unroll
      for (int r = 0; r < 9; ++r) a[r] = 0.f;
#pragma unroll 4
      for (int k = 0; k < 256; ++k) {
        const float w = wp[(size_t)k * 6144];
#pragma unroll
        for (int r = 0; r < 9; ++r) a[r] += ssil[r * 1024 + kq * 256 + k] * w;
      }
#pragma unroll
      for (int r = 0; r < 9; ++r) sred[(kq * 9 + r) * 64 + (t8 & 63)] = a[r];
      __syncthreads();
      for (int i = t8; i < 9 * 64; i += 256) {
        const int r = i >> 6, cc = i & 63;
        const float v = sred[(0 * 9 + r) * 64 + cc] + sred[(1 * 9 + r) * 64 + cc] + sred[(2 * 9 + r) * 64 + cc] + sred[(3 * 9 + r) * 64 + cc];
        modv[((size_t)l * 9 + r) * 6144 + cgp * 64 + cc] = v + p.b_mod[(size_t)l * 6144 + cgp * 64 + cc];
      }
      __syncthreads();
    }
    __syncthreads();
  }
  convert_layer(p, 0, smem);
  {
    bf16_t* at = (bf16_t*)(p.ws + OFF_ATAB);
    for (int i = gtid; i < 2048 * 512; i += gsz) {
      const int k = i >> 9, c8 = (i & 511) * 8;
      unsigned w[4];
#pragma unroll
      for (int j = 0; j < 4; ++j) {
        float v[2];
#pragma unroll
        for (int e = 0; e < 2; ++e) {
          const int tp = c8 + 2 * j + e; const int tt = tp & 2047;
          const float r = (float)((k * tt) & 2047) * (1.0f / 2048.0f);
          v[e] = (tp < 2048) ? hw_cos_rev(r) : -hw_sin_rev(r);
        }
        w[j] = pk2(v[0], v[1]);
      }
      *(u32x4*)(at + (size_t)k * 4096 + c8) = (u32x4){w[0], w[1], w[2], w[3]};
    }
    bf16_t* atc = (bf16_t*)(p.ws + OFF_ATABC);
    for (int i = gtid; i < 256 * 64; i += gsz) {
      const int k = i >> 6, c8 = (i & 63) * 8;
      unsigned w[4];
#pragma unroll
      for (int j = 0; j < 4; ++j) {
        float v[2];
#pragma unroll
        for (int e = 0; e < 2; ++e) {
          const int tp = c8 + 2 * j + e; const int tt = tp & 255;
          const float r = (float)((k * tt) & 255) * (1.0f / 256.0f);
          v[e] = (tp < 256) ? hw_cos_rev(r) : -hw_sin_rev(r);
        }
        w[j] = pk2(v[0], v[1]);
      }
      *(u32x4*)(atc + (size_t)k * 512 + c8) = (u32x4){w[0], w[1], w[2], w[3]};
    }
  }
  {
    float* rc = (float*)(p.ws + OFF_ROPEC); float* rs = (float*)(p.ws + OFF_ROPES);
    for (int i = gtid; i < 2048 * 32; i += gsz) {
      const int t = i >> 5, a = i & 31, f = a & 15;
      const float pos = (float)((a < 16) ? (t >> 6) : (t & 63));
      const float inv = exp2f(-(float)f * (13.287712379549449f / 16.0f));
      float r = pos * inv * 0.15915494309189535f;
      r -= floorf(r);
      rc[i] = hw_cos_rev(r); rs[i] = hw_sin_rev(r);
    }
  }
  if (gtid < DEPTH) {
    const float* lq = p.lam_qk + (size_t)gtid * 256;
    float s1 = 0.f, s2 = 0.f;
    for (int i = 0; i < 64; ++i) { s1 += lq[i] * lq[64 + i]; s2 += lq[128 + i] * lq[192 + i]; }
    ((float*)(p.ws + OFF_LAMV))[gtid] = expf(s1) - expf(s2) + p.lam_init[gtid];
  }
}

DI void ln_pass(const Params& p, int mode, int nrows, const bf16_t* __restrict__ Yb, const float* __restrict__ lng, const float* __restrict__ lnb,
                        int modl_gate, int gate_chunk, int modl_next, int sh_chunk) {
  const int lane = g_tid() & 63, wid = g_tid() >> 6;
  float* X = (float*)(p.ws + OFF_X);
  bf16_t* U = (bf16_t*)(p.ws + OFF_U);
  const float* modv = (const float*)(p.ws + OFF_MODV);
  f32x4 xv[4], xn[4]; u32x2 yv[4], yn[4];
  const int r0 = blockIdx.x * 8 + wid, rstride = gridDim.x * 8;
  if (mode != 0 && r0 < nrows) {
#pragma unroll
    for (int i = 0; i < 4; ++i) { xv[i] = *(const f32x4*)(X + (size_t)r0 * 1024 + lane * 4 + 256 * i); yv[i] = *(const u32x2*)(Yb + (size_t)r0 * 1024 + lane * 4 + 256 * i); }
  }
  for (int r = r0; r < nrows; r += rstride) {
    int b, pos; bool isctx; row_info(r, b, pos, isctx);
    const int mr = isctx ? 8 : b;
    f32x4 v[4];
    if (mode == 0) {
      const float* src = isctx ? (p.ctx + (size_t)(r - T_LAT) * 1024) : (p.x + (size_t)r * 1024);
#pragma unroll
      for (int i = 0; i < 4; ++i) v[i] = *(const f32x4*)(src + lane * 4 + 256 * i);
#pragma unroll
      for (int i = 0; i < 4; ++i) *(f32x4*)(X + (size_t)r * 1024 + lane * 4 + 256 * i) = v[i];
    } else {
      const int rn = r + rstride;
      if (rn < nrows) {
#pragma unroll
        for (int i = 0; i < 4; ++i) { xn[i] = *(const f32x4*)(X + (size_t)rn * 1024 + lane * 4 + 256 * i); yn[i] = *(const u32x2*)(Yb + (size_t)rn * 1024 + lane * 4 + 256 * i); }
      }
      const float* gv = modv + ((size_t)modl_gate * 9 + mr) * 6144 + gate_chunk * 1024;
      float s = 0.f;
#pragma unroll
      for (int i = 0; i < 4; ++i) {
        const int col = lane * 4 + 256 * i;
        const f32x4 g = *(const f32x4*)(gv + col);
        v[i][0] = ALPHA * xv[i][0] + g[0] * bf_lo(yv[i][0]); v[i][1] = ALPHA * xv[i][1] + g[1] * bf_hi(yv[i][0]);
        v[i][2] = ALPHA * xv[i][2] + g[2] * bf_lo(yv[i][1]); v[i][3] = ALPHA * xv[i][3] + g[3] * bf_hi(yv[i][1]);
        s += (v[i][0] + v[i][1]) + (v[i][2] + v[i][3]);
      }
#pragma unroll
      for (int i = 0; i < 4; ++i) { xv[i] = xn[i]; yv[i] = yn[i]; }
      const float mu = wave_sum(s) * (1.0f / 1024.0f);
      float q = 0.f;
#pragma unroll
      for (int i = 0; i < 4; ++i) { const f32x4 d = v[i] - mu; q += (d[0] * d[0] + d[1] * d[1]) + (d[2] * d[2] + d[3] * d[3]); }
      const float rstd = rsqrtf(wave_sum(q) * (1.0f / 1024.0f) + LN_EPS);
#pragma unroll
      for (int i = 0; i < 4; ++i) {
        const int col = lane * 4 + 256 * i;
        const f32x4 g = *(const f32x4*)(lng + col), bb = *(const f32x4*)(lnb + col);
        v[i] = (v[i] - mu) * rstd * g + bb;
        if (mode == 2) *(f32x4*)(p.out + (size_t)r * 1024 + col) = v[i];
        else *(f32x4*)(X + (size_t)r * 1024 + col) = v[i];
      }
    }
    if (mode != 2) {
      float s = 0.f;
#pragma unroll
      for (int i = 0; i < 4; ++i) s += (v[i][0] + v[i][1]) + (v[i][2] + v[i][3]);
      const float mu = wave_sum(s) * (1.0f / 1024.0f);
      float q = 0.f;
#pragma unroll
      for (int i = 0; i < 4; ++i) { const f32x4 d = v[i] - mu; q += (d[0] * d[0] + d[1] * d[1]) + (d[2] * d[2] + d[3] * d[3]); }
      const float rstd = rsqrtf(wave_sum(q) * (1.0f / 1024.0f) + LN_EPS);
      const float* shv = modv + ((size_t)modl_next * 9 + mr) * 6144 + sh_chunk * 1024;
      const float* scv = shv + 1024;
#pragma unroll
      for (int i = 0; i < 4; ++i) {
        const int col = lane * 4 + 256 * i;
        const f32x4 sh = *(const f32x4*)(shv + col), sc = *(const f32x4*)(scv + col);
        const f32x4 u = (v[i] - mu) * rstd * (sc + 1.0f) + sh;
        *(u32x2*)(U + (size_t)r * 1024 + col) = (u32x2){pk2(u[0], u[1]), pk2(u[2], u[3])};
      }
    }
  }
}

DI bool tile_map(int v, int nmt, int nnt, int& mt, int& nt) {
  const int c = v >> 8, w = v & 255, xcd = w & 7, local = w >> 3;
  const int spr = nnt >> 2, nsup = (nmt >> 3) * spr, sup = c * 8 + xcd;
  if (sup >= nsup) return false;
  mt = (sup / spr) * 8 + (local & 7); nt = (sup % spr) * 4 + (local >> 3);
  return true;
}
DI int tile_vmax(int nmt, int nnt) { const int nsup = (nmt >> 3) * (nnt >> 2); return ((nsup + 7) >> 3) << 8; }

DI void phase_inproj(const Params& p, int l, char* smem) {
  const bool last = (l == DEPTH - 1);
  const bf16_t* W = (const bf16_t*)(p.ws + w_off(l)) + WO_WIN;
  const bf16_t* U = (const bf16_t*)(p.ws + OFF_U);
  bf16_t* KB = (bf16_t*)(p.ws + OFF_KB); bf16_t* VT = (bf16_t*)(p.ws + OFF_VT); bf16_t* QB = (bf16_t*)(p.ws + OFF_QB); bf16_t* CQ = (bf16_t*)(p.ws + OFF_CQ);
  bf16_t* ZT = (bf16_t*)(p.ws + OFF_ZT); bf16_t* ZTC = (bf16_t*)(p.ws + OFF_ZTC); bf16_t* R = (bf16_t*)(p.ws + OFF_R);
  const float* ropec = (const float*)(p.ws + OFF_ROPEC); const float* ropes = (const float*)(p.ws + OFF_ROPES);
  const int nsupA = last ? 72 : 81, nsup = last ? 76 : 81;
  const int vmax = ((nsup + 15) >> 4) << 8;
  auto map_tile = [&](int v, int& mt, int& nt) -> bool {
    if (v >= vmax) return false;
    const int c = v >> 8, w = v & 255, local = w >> 3, sup = (c * 8 + (w & 7)) * 2 + (local >> 4);
    if (sup >= nsup) return false;
    if (sup < nsupA) { mt = (sup / 9) * 8 + (local & 7); nt = (sup % 9) * 2 + ((local >> 3) & 1); }
    else { mt = 64 + (local & 7); nt = (sup - nsupA) * 2 + ((local >> 3) & 1); }
    return true;
  };
  int v = blockIdx.x, mt = 0, nt = 0;
  bool cur = map_tile(v, mt, nt);
  if (cur) gemm_prefetch_big(U + (size_t)mt * 256 * 1024, 1024, W + (size_t)nt * 256 * 1024, 1024, smem);
  while (cur) {
    const int m0 = mt * 256;
    int b, pos0; bool isctx; row_info(m0, b, pos0, isctx);
    f32x4 acc[8][4];
#pragma unroll
    for (int i = 0; i < 8; ++i)
#pragma unroll
      for (int j = 0; j < 4; ++j) acc[i][j] = (f32x4){0.f, 0.f, 0.f, 0.f};
    const bool swap = !((nt >= 4 && nt < 8) || (nt >= 12 && nt < 16));
    if (swap) gemm_kloop_big<true>(U + (size_t)m0 * 1024, 1024, W + (size_t)nt * 256 * 1024, 1024, 1024, acc, smem, true);
    else gemm_kloop_big<false>(U + (size_t)m0 * 1024, 1024, W + (size_t)nt * 256 * 1024, 1024, 1024, acc, smem, true);
    int v2 = v + gridDim.x, mt2 = 0, nt2 = 0;
    const bool nxt = map_tile(v2, mt2, nt2);
    if (nxt) gemm_prefetch_big(U + (size_t)mt2 * 256 * 1024, 1024, W + (size_t)nt2 * 256 * 1024, 1024, smem);
    const int tid = g_tid(), lane = tid & 63, wid = __builtin_amdgcn_readfirstlane(tid >> 6), wm = wid >> 2, wn = wid & 3;
    const int fq = lane >> 4, fr = lane & 15;
    const int ncol0 = nt * 256 + wn * 64;
    const int prow0 = pos0 + wm * 128;
    if (ncol0 < 1024 || (ncol0 >= 2048 && ncol0 < 3072)) {
      const bool isq = ncol0 >= 2048; const int h = (ncol0 >> 7) & 7, map = (ncol0 >> 6) & 1;
#pragma unroll
      for (int mi = 0; mi < 8; ++mi) {
        const int pos = prow0 + mi * 16 + fr;
        f32x4 o[4];
        if (!isctx) {
#pragma unroll
          for (int pr = 0; pr < 2; ++pr) {
            const f32x4 cs = *(const f32x4*)(ropec + pos * 32 + pr * 16 + fq * 4);
            const f32x4 sn = *(const f32x4*)(ropes + pos * 32 + pr * 16 + fq * 4);
            const f32x4 x0 = acc[mi][2 * pr], x1 = acc[mi][2 * pr + 1];
            o[2 * pr] = x0 * cs - x1 * sn;
            o[2 * pr + 1] = x1 * cs + x0 * sn;
          }
        } else {
#pragma unroll
          for (int ni = 0; ni < 4; ++ni) o[ni] = acc[mi][ni];
        }
        bf16_t* dst;
        if (!isq) dst = KB + ((size_t)((b * 8 + h) * 2 + map) * NKEY + (isctx ? SEQ + pos : pos)) * 64;
        else if (!isctx) dst = QB + ((size_t)((b * 8 + h) * 2 + map) * SEQ + pos) * 64;
        else dst = CQ + ((size_t)((b * 8 + h) * 2 + map) * LC + pos) * 64;
        const float sc = isq ? QSCALE : 1.0f;
#pragma unroll
        for (int ni = 0; ni < 4; ++ni) {
          const f32x4 vv = o[ni] * sc;
          *(u32x2*)(dst + ni * 16 + fq * 4) = (u32x2){pk2(vv[0], vv[1]), pk2(vv[2], vv[3])};
        }
      }
    } else if (ncol0 < 2048) {
      const int h = (ncol0 - 1024) >> 7, vc0 = ncol0 & 127;
#pragma unroll
      for (int mi = 0; mi < 8; ++mi) {
        const int key = (isctx ? SEQ : 0) + prow0 + mi * 16 + fq * 4;
        const int k15 = key & 15;
        const int pkey = (key & ~15) | (k15 & 3) | ((k15 & 4) << 1) | ((k15 & 8) >> 1);
#pragma unroll
        for (int ni = 0; ni < 4; ++ni) {
          const int vcol = vc0 + ni * 16 + fr;
          const f32x4 vv = acc[mi][ni];
          *(u32x2*)(VT + ((size_t)(b * 8 + h) * 128 + vcol) * NKEY + pkey) = (u32x2){pk2(vv[0], vv[1]), pk2(vv[2], vv[3])};
        }
      }
    } else if (ncol0 < 4096) {
#pragma unroll
      for (int mi = 0; mi < 8; ++mi) {
        const int pos = prow0 + mi * 16 + fq * 4;
#pragma unroll
        for (int ni = 0; ni < 4; ++ni) {
          const int zc = ncol0 - 3072 + ni * 16 + fr;
          const int np = zc & 511, second = zc >> 9;
          const f32x4 vv = acc[mi][ni];
          bf16_t* dst = isctx ? (ZTC + ((size_t)b * 512 + np) * 512 + second * 256 + pos) : (ZT + ((size_t)b * 512 + np) * 4096 + second * 2048 + pos);
          *(u32x2*)dst = (u32x2){pk2(vv[0], vv[1]), pk2(vv[2], vv[3])};
        }
      }
    } else {
#pragma unroll
      for (int mi = 0; mi < 8; ++mi) {
        const int row = m0 + wm * 128 + mi * 16 + fr;
#pragma unroll
        for (int ni = 0; ni < 4; ++ni) {
          const int col = ncol0 - 4096 + ni * 16 + fq * 4;
          const f32x4 vv = acc[mi][ni];
          *(u32x2*)(R + (size_t)row * 512 + col) = (u32x2){pk2(vv[0], vv[1]), pk2(vv[2], vv[3])};
        }
      }
    }
    v = v2; mt = mt2; nt = nt2; cur = nxt;
  }
}

DI void attn_unit(const bf16_t* __restrict__ Qb  , int nq, int q0, const bf16_t* __restrict__ Kb  ,
                  const bf16_t* __restrict__ VTb  , int key0, int ntiles  , bf16_t* __restrict__ outp  ,
                  const float* __restrict__ subg, float lam, float nscale, char* smem) {
  const int tid = g_tid(), lane = tid & 63, wid = __builtin_amdgcn_readfirstlane(tid >> 6), wq = wid & 3, map = wid >> 2;
  const int l31 = lane & 31, kh = lane >> 5;
  bf16x8 qf[4];
  {
    const bf16_t* qp = Qb + ((size_t)map * nq + q0 + wq * 32 + l31) * 64 + kh * 8;
#pragma unroll
    for (int s = 0; s < 4; ++s) qf[s] = *(const bf16x8*)(qp + s * 16);
  }
  const int srow = tid >> 3, sc = (tid & 7) ^ ((tid >> 4) & 7);
  const unsigned koff = (unsigned)((key0 + srow) * 64 + sc * 8) * 2u;
  const unsigned voff = (unsigned)(srow * NKEY + key0 + sc * 8) * 2u;
  const char* Kc = (const char*)Kb; const char* Vc = (const char*)VTb;
  char* sdst = smem + tid * 16;
#define A_ISSUE(T) do { char* d_ = sdst + ((T) & 3) * 32768; \
    __builtin_amdgcn_global_load_lds((const void*)(Kc + (size_t)(T) * 8192 + koff), (lds_ptr_t)(d_), 16, 0, 0); \
    __builtin_amdgcn_global_load_lds((const void*)(Kc + (size_t)NKEY * 128 + (size_t)(T) * 8192 + koff), (lds_ptr_t)(d_ + 8192), 16, 0, 0); \
    __builtin_amdgcn_global_load_lds((const void*)(Vc + (size_t)(T) * 128 + voff), (lds_ptr_t)(d_ + 16384), 16, 0, 0); \
    __builtin_amdgcn_global_load_lds((const void*)(Vc + (size_t)64 * NKEY * 2 + (size_t)(T) * 128 + voff), (lds_ptr_t)(d_ + 24576), 16, 0, 0); } while (0)
  f32x16 O[4];
#pragma unroll
  for (int vb = 0; vb < 4; ++vb)
#pragma unroll
    for (int i = 0; i < 16; ++i) O[vb][i] = 0.f;
  float m = 0.f, lsum = 0.f;
  const int sw = (lane >> 1) & 7;
  const int kfo = l31 * 128, cho = kh;
#define A_QK(SX, T) do { const char* st_ = smem + ((T) & 3) * 32768 + map * 8192 + kfo; \
    bf16x8 kf_[8]; \
    _Pragma("unroll") for (int s = 0; s < 4; ++s) _Pragma("unroll") for (int kb = 0; kb < 2; ++kb) \
        kf_[s * 2 + kb] = *(const bf16x8*)(st_ + kb * 4096 + (((2 * s + cho) ^ sw) << 4)); \
    _Pragma("unroll") for (int kb = 0; kb < 2; ++kb) _Pragma("unroll") for (int i = 0; i < 16; ++i) SX[kb][i] = -m; \
    __builtin_amdgcn_sched_barrier(0); \
    _Pragma("unroll") for (int s = 0; s < 4; ++s) _Pragma("unroll") for (int kb = 0; kb < 2; ++kb) \
        SX[kb] = MFMA32(kf_[s * 2 + kb], qf[s], SX[kb]); \
    __builtin_amdgcn_sched_barrier(0); } while (0)
  bf16x8 pf[4];
  auto pv = [&](int T) {
    const char* sv = smem + (T & 3) * 32768 + 16384 + kfo;
    __builtin_amdgcn_sched_barrier(0);
    bf16x8 va[4], vb_[4];
#pragma unroll
    for (int vb = 0; vb < 4; ++vb) va[vb] = *(const bf16x8*)(sv + vb * 4096 + (((0 + cho) ^ sw) << 4));
#pragma unroll
    for (int vb = 0; vb < 4; ++vb) vb_[vb] = *(const bf16x8*)(sv + vb * 4096 + (((2 + cho) ^ sw) << 4));
    __builtin_amdgcn_sched_barrier(0);
#pragma unroll
    for (int vb = 0; vb < 4; ++vb) O[vb] = MFMA32(va[vb], pf[0], O[vb]);
    __builtin_amdgcn_sched_barrier(0);
#pragma unroll
    for (int vb = 0; vb < 4; ++vb) va[vb] = *(const bf16x8*)(sv + vb * 4096 + (((4 + cho) ^ sw) << 4));
    __builtin_amdgcn_sched_barrier(0);
#pragma unroll
    for (int vb = 0; vb < 4; ++vb) O[vb] = MFMA32(vb_[vb], pf[1], O[vb]);
    __builtin_amdgcn_sched_barrier(0);
#pragma unroll
    for (int vb = 0; vb < 4; ++vb) vb_[vb] = *(const bf16x8*)(sv + vb * 4096 + (((6 + cho) ^ sw) << 4));
    __builtin_amdgcn_sched_barrier(0);
#pragma unroll
    for (int vb = 0; vb < 4; ++vb) O[vb] = MFMA32(va[vb], pf[2], O[vb]);
    __builtin_amdgcn_sched_barrier(0);
#pragma unroll
    for (int vb = 0; vb < 4; ++vb) O[vb] = MFMA32(vb_[vb], pf[3], O[vb]);
    __builtin_amdgcn_sched_barrier(0);
  };
  auto softmax = [&](f32x16 (&SC)[2], f32x16 (&SN)[2], bool has_next, bool first) {
    float mx[16];
#pragma unroll
    for (int i = 0; i < 16; ++i) mx[i] = fmaxf(SC[0][i], SC[1][i]);
#pragma unroll
    for (int w = 8; w >= 1; w >>= 1)
#pragma unroll
      for (int i = 0; i < w; ++i) mx[i] = fmaxf(mx[i], mx[i + w]);
    float tmax = xor32_max(mx[0]);
    if (first || __any(tmax > 8.0f)) {
      const float delta = first ? tmax : fmaxf(tmax, 0.f);
      const float alpha = first ? 1.0f : __builtin_amdgcn_exp2f(-delta);
      m += delta; lsum *= alpha;
#pragma unroll
      for (int vb = 0; vb < 4; ++vb) O[vb] = O[vb] * alpha;
#pragma unroll
      for (int kb = 0; kb < 2; ++kb)
#pragma unroll
        for (int i = 0; i < 16; ++i) SC[kb][i] -= delta;
      if (has_next) {
#pragma unroll
        for (int kb = 0; kb < 2; ++kb)
#pragma unroll
          for (int i = 0; i < 16; ++i) SN[kb][i] -= delta;
      }
    }
    float sm[16];
#pragma unroll
    for (int i = 0; i < 16; ++i) { const float e0 = __builtin_amdgcn_exp2f(SC[0][i]), e1 = __builtin_amdgcn_exp2f(SC[1][i]); SC[0][i] = e0; SC[1][i] = e1; sm[i] = e0 + e1; }
#pragma unroll
    for (int w = 8; w >= 1; w >>= 1)
#pragma unroll
      for (int i = 0; i < w; ++i) sm[i] += sm[i + w];
    lsum += sm[0];
#pragma unroll
    for (int g = 0; g < 4; ++g) {
      const int kb = g >> 1, s2 = g & 1;
      u32x4 w;
      w[0] = pk2(SC[kb][8 * s2 + 0], SC[kb][8 * s2 + 1]); w[1] = pk2(SC[kb][8 * s2 + 2], SC[kb][8 * s2 + 3]);
      w[2] = pk2(SC[kb][8 * s2 + 4], SC[kb][8 * s2 + 5]); w[3] = pk2(SC[kb][8 * s2 + 6], SC[kb][8 * s2 + 7]);
      pf[g] = __builtin_bit_cast(bf16x8, w);
    }
  };
  f32x16 Sa[2], Sb[2];
  WAIT_VM(0);
  A_ISSUE(0); A_ISSUE(1); A_ISSUE(2);
  WAIT_VM(8);
  __builtin_amdgcn_s_barrier();
  asm volatile("" ::: "memory");
  A_QK(Sa, 0);
  for (int t = 0; t < ntiles; t += 2) {
    if (t + 2 < ntiles) WAIT_VM(4); else WAIT_VM(0);
    __builtin_amdgcn_s_barrier();
    asm volatile("" ::: "memory");
    if (t + 3 < ntiles) A_ISSUE(t + 3);
    A_QK(Sb, t + 1);
    softmax(Sa, Sb, true, t == 0);
    pv(t);
    const bool nx = (t + 2 < ntiles);
    if (nx) { if (t + 3 < ntiles) WAIT_VM(4); else WAIT_VM(0); }
    __builtin_amdgcn_s_barrier();
    asm volatile("" ::: "memory");
    if (t + 4 < ntiles) A_ISSUE(t + 4);
    if (nx) A_QK(Sa, t + 2);
    softmax(Sb, Sa, nx, false);
    pv(t + 1);
  }
  asm volatile("s_waitcnt lgkmcnt(0)" ::: "memory");
  __builtin_amdgcn_s_barrier();
  asm volatile("" ::: "memory");
#undef A_ISSUE
#undef A_QK
  const float ltot = xor32_sum(lsum);
  const float inv = 1.0f / ltot;
  float* ex = (float*)smem;
  if (map == 1) {
#pragma unroll
    for (int vb = 0; vb < 4; ++vb)
#pragma unroll
      for (int g4 = 0; g4 < 4; ++g4) {
        f32x4 v = {O[vb][4 * g4] * inv, O[vb][4 * g4 + 1] * inv, O[vb][4 * g4 + 2] * inv, O[vb][4 * g4 + 3] * inv};
        *(f32x4*)(ex + (wq * 32 + l31) * 132 + vb * 32 + 8 * g4 + 4 * kh) = v;
      }
  }
  __syncthreads();
  if (map == 0) {
    float ss = 0.f;
#pragma unroll
    for (int vb = 0; vb < 4; ++vb)
#pragma unroll
      for (int g4 = 0; g4 < 4; ++g4) {
        const f32x4 o2 = *(const f32x4*)(ex + (wq * 32 + l31) * 132 + vb * 32 + 8 * g4 + 4 * kh);
#pragma unroll
        for (int j = 0; j < 4; ++j) { const float o = O[vb][4 * g4 + j] * inv - lam * o2[j]; O[vb][4 * g4 + j] = o; ss += o * o; }
      }
    ss = xor32_sum(ss);
    const float rs = rsqrtf(ss * (1.0f / 128.0f) + LN_EPS) * nscale;
    bf16_t* op = outp + (size_t)(wq * 32 + l31) * 1024;
#pragma unroll
    for (int vb = 0; vb < 4; ++vb)
#pragma unroll
      for (int g4 = 0; g4 < 4; ++g4) {
        const int vc = vb * 32 + 8 * g4 + 4 * kh;
        const f32x4 g = *(const f32x4*)(subg + vc);
        *(u32x2*)(op + vc) = (u32x2){pk2(O[vb][4 * g4] * rs * g[0], O[vb][4 * g4 + 1] * rs * g[1]), pk2(O[vb][4 * g4 + 2] * rs * g[2], O[vb][4 * g4 + 3] * rs * g[3])};
      }
  }
  __syncthreads();
}

template <int MI>
DI void store_tile_bf16(const f32x4 (&acc)[MI][4], bf16_t* __restrict__ C, int ldc, float scale) {
  const int tid = g_tid(), lane = tid & 63, wid = __builtin_amdgcn_readfirstlane(tid >> 6), wm = wid >> 1, wn = wid & 1, fq = lane >> 4, fr = lane & 15;
#pragma unroll
  for (int mi = 0; mi < MI; ++mi)
#pragma unroll
    for (int ni = 0; ni < 4; ++ni) {
      const f32x4 v = acc[mi][ni] * scale;
      *(u32x2*)(C + (size_t)(wm * 16 * MI + mi * 16 + fr) * ldc + wn * 64 + ni * 16 + fq * 4) = (u32x2){pk2(v[0], v[1]), pk2(v[2], v[3])};
    }
}

template <int W>
DI void pool_rows(const bf16_t* __restrict__ R, bf16_t* __restrict__ PM, int m0, int g, int rhalf, int lane) {
  constexpr int LO = W / 2;
  const int col = g * 128 + (lane & 15) * 8;
#pragma unroll 2
  for (int ps = 0; ps < 8; ++ps) {
    const int row = m0 + ps * 8 + rhalf * 4 + (lane >> 4);
    int b, pos; bool isctx; row_info(row, b, pos, isctx);
    const int L = isctx ? LC : SEQ;
    const int rbase = row - pos;
    float s[8];
#pragma unroll
    for (int j = 0; j < 8; ++j) s[j] = 0.f;
    int cnt = 0;
    u32x4 self = {0u, 0u, 0u, 0u};
#pragma unroll
    for (int k = 0; k < W; ++k) {
      const int q = pos - LO + k;
      const bool ok = (q >= 0) && (q < L);
      const int qc = ok ? q : pos;
      const u32x4 v = *(const u32x4*)(R + (size_t)(rbase + qc) * 512 + col);
      const float f = ok ? 1.0f : 0.0f;
      cnt += ok ? 1 : 0;
#pragma unroll
      for (int j = 0; j < 4; ++j) { s[2 * j] += f * bf_lo(v[j]); s[2 * j + 1] += f * bf_hi(v[j]); }
      if (k == LO) self = v;
    }
    const float ic = 1.0f / (float)cnt;
    u32x4 o;
#pragma unroll
    for (int j = 0; j < 4; ++j) o[j] = pk2(s[2 * j] * ic - bf_lo(self[j]), s[2 * j + 1] * ic - bf_hi(self[j]));
    *(u32x4*)(PM + (size_t)row * 512 + col) = o;
  }
}
DI void pool_task(const bf16_t* __restrict__ R, bf16_t* __restrict__ PM, int m0) {
  const int tid = g_tid(), lane = tid & 63, wid = __builtin_amdgcn_readfirstlane(tid >> 6), g = wid & 3, rhalf = wid >> 2;
  if (g == 0) pool_rows<2>(R, PM, m0, 0, rhalf, lane);
  else if (g == 1) pool_rows<4>(R, PM, m0, 1, rhalf, lane);
  else if (g == 2) pool_rows<8>(R, PM, m0, 2, rhalf, lane);
  else pool_rows<16>(R, PM, m0, 3, rhalf, lane);
}

DI void phase_mix(const Params& p, int l, char* smem) {
  const bool last = (l == DEPTH - 1);
  const bf16_t* KB = (const bf16_t*)(p.ws + OFF_KB); const bf16_t* VT = (const bf16_t*)(p.ws + OFF_VT);
  const bf16_t* QB = (const bf16_t*)(p.ws + OFF_QB); const bf16_t* CQ = (const bf16_t*)(p.ws + OFF_CQ);
  const bf16_t* ZT = (const bf16_t*)(p.ws + OFF_ZT); const bf16_t* ZTC = (const bf16_t*)(p.ws + OFF_ZTC); const bf16_t* R = (const bf16_t*)(p.ws + OFF_R);
  bf16_t* ATT = (bf16_t*)(p.ws + OFF_ATT); bf16_t* FM = (bf16_t*)(p.ws + OFF_FM); bf16_t* PM = (bf16_t*)(p.ws + OFF_PM);
  const bf16_t* ATAB = (const bf16_t*)(p.ws + OFF_ATAB); const bf16_t* ATABC = (const bf16_t*)(p.ws + OFF_ATABC);
  const float lam = ((const float*)(p.ws + OFF_LAMV))[l];
  const float nscale = 1.0f - p.lam_init[l];
  const float* subg = p.subln_g + (size_t)l * 128;
  const int n_attn = 1024, n_dft = 256, n_cattn = last ? 0 : 128, n_cdft = last ? 0 : 32, n_pool = last ? 256 : 288;
  const int total = n_attn + n_dft + n_cattn + n_cdft + n_pool;
  for (int t = blockIdx.x; t < total; t += gridDim.x) {
    int r = t;
    if (r < n_attn) {
      const int c = r >> 8, w = r & 255, xcd = w & 7, local = w >> 3;
      const int bh = c * 16 + xcd * 2 + (local >> 4), qb = local & 15;
      const int b = bh >> 3, h = bh & 7;
      attn_unit(QB + (size_t)bh * 2 * SEQ * 64, SEQ, qb * 128, KB + (size_t)bh * 2 * NKEY * 64, VT + (size_t)bh * 128 * NKEY, 0, NKEY / 64,
                ATT + ((size_t)b * SEQ + qb * 128) * 1024 + h * 128, subg, lam, nscale, smem);
      continue;
    }
    r -= n_attn;
    if (r < n_dft) {
      const int b = r & 7, local = r >> 3, mt = local & 7, nt = local >> 3;
      f32x4 acc[4][4]; zero_acc(acc);
      gemm_kloop_pp<true>(ATAB + (size_t)mt * 256 * 4096, 4096, ZT + ((size_t)b * 512 + nt * 128) * 4096, 4096, 4096, acc, smem);
      store_tile_bf16<4>(acc, FM + ((size_t)b * SEQ + mt * 256) * 512 + nt * 128, 512, 1.0f / 512.0f);
      continue;
    }
    r -= n_dft;
    if (r < n_cattn) {
      const int bh = r >> 1, qb = r & 1, b = bh >> 3, h = bh & 7;
      attn_unit(CQ + (size_t)bh * 2 * LC * 64, LC, qb * 128, KB + (size_t)bh * 2 * NKEY * 64, VT + (size_t)bh * 128 * NKEY, SEQ, LC / 64,
                ATT + ((size_t)T_LAT + b * LC + qb * 128) * 1024 + h * 128, subg, lam, nscale, smem);
      continue;
    }
    r -= n_cattn;
    if (r < n_cdft) {
      const int b = r >> 2, nt = r & 3;
      f32x4 acc[4][4]; zero_acc(acc);
      gemm_kloop_pp<true>(ATABC, 512, ZTC + ((size_t)b * 512 + nt * 128) * 512, 512, 512, acc, smem);
      store_tile_bf16<4>(acc, FM + ((size_t)T_LAT + b * LC) * 512 + nt * 128, 512, 0.005524271728019903f  );
      continue;
    }
    r -= n_cdft;
    pool_task(R, PM, r * 64);
  }
}

template <int MI>
DI void phase_branch(const Params& p, int l, char* smem) {
  const bool last = (l == DEPTH - 1);
  const bf16_t* W = (const bf16_t*)(p.ws + w_off(l));
  const bf16_t* U = (const bf16_t*)(p.ws + OFF_U);
  const bf16_t* ATT = (const bf16_t*)(p.ws + OFF_ATT); const bf16_t* FM = (const bf16_t*)(p.ws + OFF_FM); const bf16_t* PM = (const bf16_t*)(p.ws + OFF_PM);
  bf16_t* MOUT = (bf16_t*)(p.ws + OFF_MOUT);
  const int nmt = (last ? T_LAT : T_ALL) / (64 * MI), vmax = tile_vmax(nmt, 8);
  for (int v = blockIdx.x; v < vmax; v += gridDim.x) {
    int mt, nt;
    if (!tile_map(v, nmt, 8, mt, nt)) continue;
    const int m0 = mt * 64 * MI, n0 = nt * 128;
    u32x2 tot[MI][4], gpk[MI][4];
#pragma unroll
    for (int mi = 0; mi < MI; ++mi)
#pragma unroll
      for (int ni = 0; ni < 4; ++ni) tot[mi][ni] = (u32x2){0u, 0u};
#pragma unroll 1
    for (int br = 0; br < 3; ++br) {
      __builtin_amdgcn_sched_barrier(0);
      f32x4 acc[MI][4]; zero_acc_t<MI>(acc);
      gemm_kloop_pp<true, MI>(U + (size_t)m0 * 1024, 1024, W + WO_WIN + (size_t)(ROW_G + br * 1024 + n0) * 1024, 1024, 1024, acc, smem);
      __builtin_amdgcn_sched_barrier(0);
#pragma unroll
      for (int mi = 0; mi < MI; ++mi)
#pragma unroll
        for (int ni = 0; ni < 4; ++ni) {
          const f32x4 a = acc[mi][ni];
          gpk[mi][ni] = (u32x2){pk2(sigmoidf_(a[0]), sigmoidf_(a[1])), pk2(sigmoidf_(a[2]), sigmoidf_(a[3]))};
        }
      __builtin_amdgcn_sched_barrier(0);
      zero_acc_t<MI>(acc);
      const int K2 = (br == 0) ? 1024 : 512;
      const bf16_t* A2 = (br == 0) ? (ATT + (size_t)m0 * 1024) : ((br == 1 ? FM : PM) + (size_t)m0 * 512);
      const bf16_t* B2 = (br == 0) ? (W + WO_WA + (size_t)n0 * 1024) : (W + (br == 1 ? WO_WF : WO_WP) + (size_t)n0 * 512);
      gemm_kloop_pp<true, MI>(A2, K2, B2, K2, K2, acc, smem);
      __builtin_amdgcn_sched_barrier(0);
#pragma unroll
      for (int mi = 0; mi < MI; ++mi)
#pragma unroll
        for (int ni = 0; ni < 4; ++ni) {
          const f32x4 a = acc[mi][ni]; const u32x2 g = gpk[mi][ni]; const u32x2 tp = tot[mi][ni];
          const float v0 = bf_lo(g[0]) * a[0] + bf_lo(tp[0]), v1 = bf_hi(g[0]) * a[1] + bf_hi(tp[0]);
          const float v2 = bf_lo(g[1]) * a[2] + bf_lo(tp[1]), v3 = bf_hi(g[1]) * a[3] + bf_hi(tp[1]);
          tot[mi][ni] = (u32x2){pk2(v0, v1), pk2(v2, v3)};
        }
    }
    const int tid = g_tid(), lane = tid & 63, wid = __builtin_amdgcn_readfirstlane(tid >> 6), wm = wid >> 1, wn = wid & 1, fq = lane >> 4, fr = lane & 15;
#pragma unroll
    for (int mi = 0; mi < MI; ++mi)
#pragma unroll
      for (int ni = 0; ni < 4; ++ni)
        *(u32x2*)(MOUT + (size_t)(m0 + wm * 16 * MI + mi * 16 + fr) * 1024 + n0 + wn * 64 + ni * 16 + fq * 4) = tot[mi][ni];
  }
}

template <int MI>
DI void phase_gemm_plain(const bf16_t* __restrict__ A, int K, const bf16_t* __restrict__ Bt, bf16_t* __restrict__ C, int nmt, int nnt, char* smem) {
  const int vmax = tile_vmax(nmt, nnt), N = nnt * 128;
  for (int v = blockIdx.x; v < vmax; v += gridDim.x) {
    int mt, nt;
    if (!tile_map(v, nmt, nnt, mt, nt)) continue;
    f32x4 acc[MI][4]; zero_acc_t<MI>(acc);
    gemm_kloop_pp<true, MI>(A + (size_t)mt * 64 * MI * K, K, Bt + (size_t)nt * 128 * K, K, K, acc, smem);
    store_tile_bf16<MI>(acc, C + (size_t)mt * 64 * MI * N + nt * 128, N, 1.0f);
  }
}
DI void phase_ffn1(const Params& p, int l, char* smem) {
  const bool last = (l == DEPTH - 1);
  const bf16_t* W = (const bf16_t*)(p.ws + w_off(l)) + WO_WGU;
  const bf16_t* U = (const bf16_t*)(p.ws + OFF_U);
  bf16_t* H = (bf16_t*)(p.ws + OFF_H);
  const int nsup = (last ? 8 : 9) * 11;
  const int vmax = ((nsup + 15) >> 4) << 8;
  auto map_tile = [&](int v, int& mt, int& nt) -> bool {
    if (v >= vmax) return false;
    const int c = v >> 8, w = v & 255, local = w >> 3, sup = (c * 8 + (w & 7)) * 2 + (local >> 4);
    if (sup >= nsup) return false;
    mt = (sup / 11) * 8 + (local & 7); nt = (sup % 11) * 2 + ((local >> 3) & 1);
    return true;
  };
  int v = blockIdx.x, mt = 0, nt = 0;
  bool cur = map_tile(v, mt, nt);
  if (cur) gemm_prefetch_big(U + (size_t)mt * 256 * 1024, 1024, W + (size_t)nt * 256 * 1024, 1024, smem);
  while (cur) {
    f32x4 acc[8][4];
#pragma unroll
    for (int i = 0; i < 8; ++i)
#pragma unroll
      for (int j = 0; j < 4; ++j) acc[i][j] = (f32x4){0.f, 0.f, 0.f, 0.f};
    gemm_kloop_big<true>(U + (size_t)mt * 256 * 1024, 1024, W + (size_t)nt * 256 * 1024, 1024, 1024, acc, smem, true);
    int v2 = v + gridDim.x, mt2 = 0, nt2 = 0;
    const bool nxt = map_tile(v2, mt2, nt2);
    if (nxt) gemm_prefetch_big(U + (size_t)mt2 * 256 * 1024, 1024, W + (size_t)nt2 * 256 * 1024, 1024, smem);
    const int tid = g_tid(), lane = tid & 63, wid = __builtin_amdgcn_readfirstlane(tid >> 6), wm = wid >> 2, wn = wid & 3, fq = lane >> 4, fr = lane & 15;
#pragma unroll
    for (int mi = 0; mi < 8; ++mi) {
      float o[8];
#pragma unroll
      for (int h2 = 0; h2 < 2; ++h2) {
        const f32x4 g = acc[mi][h2], u = acc[mi][2 + h2];
#pragma unroll
        for (int j = 0; j < 4; ++j) o[4 * h2 + j] = g[j] * sigmoidf_(g[j]) * u[j];
      }
      *(u32x4*)(H + (size_t)(mt * 256 + wm * 128 + mi * 16 + fr) * DFF + (nt * 4 + wn) * 32 + 8 * fq) = (u32x4){pk2(o[0], o[1]), pk2(o[2], o[3]), pk2(o[4], o[5]), pk2(o[6], o[7])};
    }
    v = v2; mt = mt2; nt = nt2; cur = nxt;
  }
}

struct InprojSched {
  const char* U; const char* W; int nsupA, nsup, vmax, grid, bid;
  DI static bool transposed(int nt) { return (nt >= 4 && nt < 8) || (nt >= 12 && nt < 16); }
  DI bool next(int i, pg8::Unit& u) const {
    const int v = bid + i * grid;
    if (v >= vmax) return false;
    const int c = v >> 8, w = v & 255, local = w >> 3, sup = (c * 8 + (w & 7)) * 2 + (local >> 4);
    if (sup >= nsup) return false;
    if (sup < nsupA) { u.pm = (sup / 9) * 8 + (local & 7); u.pn = (sup % 9) * 2 + ((local >> 3) & 1); }
    else { u.pm = 64 + (local & 7); u.pn = (sup - nsupA) * 2 + ((local >> 3) & 1); }
    return true;
  }
  DI const char* pa(const pg8::Unit& u) const { return transposed(u.pn) ? W + (size_t)u.pn * 256 * 1024 * 2 : U + (size_t)u.pm * 256 * 1024 * 2; }
  DI const char* pb(const pg8::Unit& u) const { return transposed(u.pn) ? U + (size_t)u.pm * 256 * 1024 * 2 : W + (size_t)u.pn * 256 * 1024 * 2; }
};
struct InprojEpi {
  bf16_t *KB, *VT, *QB, *CQ, *ZT, *ZTC, *R; const float *ropec, *ropes;
  DI void operator()(const f32x4 (&acc)[2][2][4][2], const pg8::Unit& u, int wr, int wc, int fr, int fq) const {
    const int mt = u.pm, nt = u.pn, m0 = mt * 256;
    int b, pos0; bool isctx; row_info(m0, b, pos0, isctx);
    if (nt < 4 || (nt >= 8 && nt < 12)) {
      const bool isq = nt >= 8; const int map = wc >> 1, axis = wc & 1;
      const float sc = isq ? QSCALE : 1.0f;
#pragma unroll
      for (int ai = 0; ai < 2; ++ai)
#pragma unroll
        for (int m = 0; m < 4; ++m) {
          const int pos = pos0 + 128 * ai + 64 * wr + 16 * m + fr;
          f32x4 cs = {1.f, 1.f, 1.f, 1.f}, sn = {0.f, 0.f, 0.f, 0.f};
          if (!isctx) { cs = *(const f32x4*)(ropec + pos * 32 + axis * 16 + fq * 4); sn = *(const f32x4*)(ropes + pos * 32 + axis * 16 + fq * 4); }
#pragma unroll
          for (int bj = 0; bj < 2; ++bj) {
            const int h = (nt * 2 + bj) & 7;
            const f32x4 x0 = acc[ai][bj][m][0], x1 = acc[ai][bj][m][1];
            const f32x4 o0 = (x0 * cs - x1 * sn) * sc, o1 = (x1 * cs + x0 * sn) * sc;
            bf16_t* dst;
            if (!isq) dst = KB + ((size_t)((b * 8 + h) * 2 + map) * NKEY + (isctx ? SEQ + pos : pos)) * 64;
            else if (!isctx) dst = QB + ((size_t)((b * 8 + h) * 2 + map) * SEQ + pos) * 64;
            else dst = CQ + ((size_t)((b * 8 + h) * 2 + map) * LC + pos) * 64;
            *(u32x2*)(dst + axis * 32 + fq * 4) = (u32x2){pk2(o0[0], o0[1]), pk2(o0[2], o0[3])};
            *(u32x2*)(dst + axis * 32 + 16 + fq * 4) = (u32x2){pk2(o1[0], o1[1]), pk2(o1[2], o1[3])};
          }
        }
    } else if (nt < 8 || (nt >= 12 && nt < 16)) {
      const bool isv = nt < 8;
#pragma unroll
      for (int ai = 0; ai < 2; ++ai)
#pragma unroll
        for (int m = 0; m < 4; ++m) {
          const int ncol = nt * 256 + 128 * ai + 64 * wr + 16 * m + fr;
#pragma unroll
          for (int bj = 0; bj < 2; ++bj)
#pragma unroll
            for (int n = 0; n < 2; ++n) {
              const int pos = pos0 + 128 * bj + 32 * wc + 16 * n + 4 * fq;
              const f32x4 vv = acc[ai][bj][m][n];
              bf16_t* dst;
              if (isv) {
                const int vg = ncol - 1024, h = vg >> 7, vcol = vg & 127;
                const int key = (isctx ? SEQ : 0) + pos, k15 = key & 15;
                const int pkey = (key & ~15) | (k15 & 3) | ((k15 & 4) << 1) | ((k15 & 8) >> 1);
                dst = VT + ((size_t)(b * 8 + h) * 128 + vcol) * NKEY + pkey;
              } else {
                const int zc = ncol - 3072, np = zc & 511, second = zc >> 9;
                dst = isctx ? (ZTC + ((size_t)b * 512 + np) * 512 + second * 256 + pos) : (ZT + ((size_t)b * 512 + np) * 4096 + second * 2048 + pos);
              }
              *(u32x2*)dst = (u32x2){pk2(vv[0], vv[1]), pk2(vv[2], vv[3])};
            }
        }
    } else {
#pragma unroll
      for (int ai = 0; ai < 2; ++ai)
#pragma unroll
        for (int m = 0; m < 4; ++m) {
          const int row = m0 + 128 * ai + 64 * wr + 16 * m + fr;
#pragma unroll
          for (int bj = 0; bj < 2; ++bj)
#pragma unroll
            for (int n = 0; n < 2; ++n) {
              const int col = nt * 256 + 128 * bj + 32 * wc + 16 * n + 4 * fq - 4096;
              const f32x4 vv = acc[ai][bj][m][n];
              *(u32x2*)(R + (size_t)row * 512 + col) = (u32x2){pk2(vv[0], vv[1]), pk2(vv[2], vv[3])};
            }
        }
    }
  }
};
DI void phase_inproj8(const Params& p, int l, char* smem) {
  const bool last = (l == DEPTH - 1);
  InprojSched S;
  S.U = (const char*)(p.ws + OFF_U); S.W = (const char*)((const bf16_t*)(p.ws + w_off(l)) + WO_WIN);
  S.nsupA = last ? 72 : 81; S.nsup = last ? 76 : 81; S.vmax = ((S.nsup + 15) >> 4) << 8; S.grid = gridDim.x; S.bid = blockIdx.x;
  InprojEpi E;
  E.KB = (bf16_t*)(p.ws + OFF_KB); E.VT = (bf16_t*)(p.ws + OFF_VT); E.QB = (bf16_t*)(p.ws + OFF_QB); E.CQ = (bf16_t*)(p.ws + OFF_CQ);
  E.ZT = (bf16_t*)(p.ws + OFF_ZT); E.ZTC = (bf16_t*)(p.ws + OFF_ZTC); E.R = (bf16_t*)(p.ws + OFF_R);
  E.ropec = (const float*)(p.ws + OFF_ROPEC); E.ropes = (const float*)(p.ws + OFF_ROPES);
  pg8::gemm_phase(( __attribute__((address_space(3))) unsigned char*)(lds_ptr_t)smem, 1024, S, E);
  if (!last) convert_grab(p, l + 1, 0, smem);
}
struct Ffn1Sched {
  const char* U; const char* W; int nsup, vmax, grid, bid;
  DI bool next(int i, pg8::Unit& u) const {
    const int v = bid + i * grid;
    if (v >= vmax) return false;
    const int c = v >> 8, w = v & 255, local = w >> 3, sup = (c * 8 + (w & 7)) * 2 + (local >> 4);
    if (sup >= nsup) return false;
    u.pm = (sup / 11) * 8 + (local & 7); u.pn = (sup % 11) * 2 + ((local >> 3) & 1);
    return true;
  }
  DI const char* pa(const pg8::Unit& u) const { return U + (size_t)u.pm * 256 * 1024 * 2; }
  DI const char* pb(const pg8::Unit& u) const { return W + (size_t)u.pn * 256 * 1024 * 2; }
};
struct Ffn1Epi {
  bf16_t* H;
  DI void operator()(const f32x4 (&acc)[2][2][4][2], const pg8::Unit& u, int wr, int wc, int fr, int fq) const {
#pragma unroll
    for (int ai = 0; ai < 2; ++ai)
#pragma unroll
      for (int m = 0; m < 4; ++m) {
        const int row = u.pm * 256 + 128 * ai + 64 * wr + 16 * m + fr;
#pragma unroll
        for (int bj = 0; bj < 2; ++bj) {
          const f32x4 g = acc[ai][bj][m][0], up = acc[ai][bj][m][1];
          float o[4];
#pragma unroll
          for (int j = 0; j < 4; ++j) o[j] = g[j] * sigmoidf_(g[j]) * up[j];
          *(u32x2*)(H + (size_t)row * DFF + u.pn * 128 + (bj * 4 + wc) * 16 + fq * 4) = (u32x2){pk2(o[0], o[1]), pk2(o[2], o[3])};
        }
      }
  }
};
DI void phase_ffn18(const Params& p, int l, char* smem) {
  const bool last = (l == DEPTH - 1);
  Ffn1Sched S;
  S.U = (const char*)(p.ws + OFF_U); S.W = (const char*)((const bf16_t*)(p.ws + w_off(l)) + WO_WGU);
  S.nsup = (last ? 8 : 9) * 11; S.vmax = ((S.nsup + 15) >> 4) << 8; S.grid = gridDim.x; S.bid = blockIdx.x;
  Ffn1Epi E; E.H = (bf16_t*)(p.ws + OFF_H);
  pg8::gemm_phase((__attribute__((address_space(3))) unsigned char*)(lds_ptr_t)smem, 1024, S, E);
  if (!last) convert_grab(p, l + 1, 1, smem);
}

#define XB_TMO      128
#define XB_XCNT(j)  (256  + 64 * (j))
#define XB_XSUB(j)  (1280 + 64 * (j))
#define XB_XGEN(j)  (2304 + 64 * (j))
#define XB_TOP      3328
#define XB_TOPGEN   3392
#define XCD_BAR_WORDS 3456
#define XB_SPIN_CAP (1u << 20)
#define LAS __attribute__((address_space(3)))
DI unsigned xb_ld(unsigned* p) { return __hip_atomic_load(p, __ATOMIC_RELAXED, __HIP_MEMORY_SCOPE_AGENT); }
DI unsigned xb_add(unsigned* p, unsigned v) { return __hip_atomic_fetch_add(p, v, __ATOMIC_RELAXED, __HIP_MEMORY_SCOPE_AGENT); }
DI unsigned xb_xcc_id() { return (unsigned)__builtin_amdgcn_s_getreg((3 << 11) | 20) & 0xFu; }
#define XB_SPIN(cond, bar) do { unsigned _sp = 0; while (cond) { __builtin_amdgcn_s_sleep(1); \
    if ((++_sp & 255u) == 0u) { if (xb_ld(&(bar)[XB_TMO])) break; if (_sp > XB_SPIN_CAP) { atomicAdd(&(bar)[XB_TMO], 1u); break; } } } } while (0)
struct XcdBarrier { unsigned* bar; unsigned x; volatile LAS unsigned* st; };
DI XcdBarrier xcd_barrier_post(unsigned* bar, volatile LAS unsigned* st) {
  XcdBarrier b; b.bar = bar; b.x = xb_xcc_id(); b.st = st;
  if (__builtin_amdgcn_workitem_id_x() == 0) (void)xb_add(&bar[XB_XCNT(b.x)], 1u);
  return b;
}
DI void xcd_barrier_complete(unsigned* bar, unsigned x, unsigned& nloc, unsigned& nx) {
  const unsigned G = gridDim.x * gridDim.y * gridDim.z;
  unsigned sum, cnt, mine, sp = 0u;
  for (;;) {
    sum = 0u; cnt = 0u; mine = 0u;
#pragma unroll
    for (unsigned j = 0; j < 16; ++j) { const unsigned c = xb_ld(&bar[XB_XCNT(j)]); sum += c; cnt += (c > 0u) ? 1u : 0u; mine = (j == x) ? c : mine; }
    if (sum == G) break;
    __builtin_amdgcn_s_sleep(1);
    if ((++sp & 255u) == 0u) { if (xb_ld(&bar[XB_TMO])) break; if (sp > XB_SPIN_CAP) { atomicAdd(&bar[XB_TMO], 1u); break; } }
  }
  nloc = mine > 0u ? mine : 1u; nx = cnt > 0u ? cnt : 1u;
}
DI void xcd_barrier(const XcdBarrier& b) {
  asm volatile("s_waitcnt vmcnt(0)" ::: "memory");
  __syncthreads();
  if (__builtin_amdgcn_workitem_id_x() == 0) {
    unsigned* bar = b.bar;
    __builtin_amdgcn_s_waitcnt(0);
    unsigned nloc = b.st[0], nx = b.st[1];
    if (nloc == 0u) { xcd_barrier_complete(bar, b.x, nloc, nx); b.st[0] = nloc; b.st[1] = nx; }
    const unsigned old = xb_add(&bar[XB_XSUB(b.x)], 1u);
    const unsigned gen = old / nloc;
    if (old + 1u == (gen + 1u) * nloc) {
      __builtin_amdgcn_fence(__ATOMIC_RELEASE, "agent");
      asm volatile("s_waitcnt vmcnt(0)" ::: "memory");
      const unsigned og = xb_add(&bar[XB_TOP], 1u);
      const unsigned tg = og / nx;
      if (og + 1u == (tg + 1u) * nx) xb_add(&bar[XB_TOPGEN], 1u);
      else XB_SPIN(xb_ld(&bar[XB_TOPGEN]) == tg, bar);
      __builtin_amdgcn_fence(__ATOMIC_ACQUIRE, "agent");
      xb_add(&bar[XB_XGEN(b.x)], 1u);
      asm volatile("s_waitcnt vmcnt(0)" ::: "memory");
    } else {
      XB_SPIN(xb_ld(&bar[XB_XGEN(b.x)]) == gen, bar);
      __builtin_amdgcn_fence(__ATOMIC_ACQUIRE, "agent");
      asm volatile("s_waitcnt vmcnt(0)" ::: "memory");
    }
  }
  __syncthreads();
}

#define REP_MASK 0
#define REP_PRO 0
__global__ void __launch_bounds__(512) mega(Params p0) {
  extern __shared__ __attribute__((aligned(16))) char smem[];
  cg::grid_group grid = cg::this_grid();
  volatile LAS unsigned* xst = (volatile LAS unsigned*)(lds_ptr_t)(smem + 3 * GSTAGE);
  if (__builtin_amdgcn_workitem_id_x() < 4) xst[__builtin_amdgcn_workitem_id_x()] = 0u;
  __syncthreads();
  const XcdBarrier xb = xcd_barrier_post((unsigned*)(p0.ws + OFF_BAR), xst);
  for (int ph = p0.ph_begin; ph < p0.ph_end; ++ph) {
    const Params& p = p0;
    const bf16_t* Wl = (const bf16_t*)(p.ws + w_off(ph >= 2 ? (ph - 2) >> 3 : 0));
    if (ph == 0) { phase0a(p, smem); if (REP_PRO & 1) { xcd_barrier(xb); phase0a(p, smem); } }
    else if (ph == 1) { ln_pass(p, 0, T_ALL, nullptr, nullptr, nullptr, 0, 0, 0, 0); if (REP_PRO & 2) { xcd_barrier(xb); ln_pass(p, 0, T_ALL, nullptr, nullptr, nullptr, 0, 0, 0, 0); } }
    else {
      const int l = (ph - 2) >> 3, s = (ph - 2) & 7;
      const bool last = (l == DEPTH - 1);
      const int nmt = last ? 64 : 72, nrows = last ? T_LAT : T_ALL;
      for (int rep = 0; rep < 1 + ((REP_MASK >> s) & 1); ++rep) {
      if (rep) xcd_barrier(xb);
      switch (s) {
        case 0: phase_inproj8(p, l, smem); break;
        case 1: phase_mix(p, l, smem); break;
        case 2: if (last) phase_branch<4>(p, l, smem); else phase_branch<3>(p, l, smem); break;
        case 3: if (last) phase_gemm_plain<4>((const bf16_t*)(p.ws + OFF_MOUT), 1024, Wl + WO_WO, (bf16_t*)(p.ws + OFF_Y), 64, 8, smem);
                else phase_gemm_plain<3>((const bf16_t*)(p.ws + OFF_MOUT), 1024, Wl + WO_WO, (bf16_t*)(p.ws + OFF_Y), 96, 8, smem);
                break;
        case 4: ln_pass(p, 1, nrows, (const bf16_t*)(p.ws + OFF_Y), p.ln1_g + (size_t)l * 1024, p.ln1_b + (size_t)l * 1024, l, 2, l, 3); break;
        case 5: phase_ffn18(p, l, smem); break;
        case 6: if (last) phase_gemm_plain<4>((const bf16_t*)(p.ws + OFF_H), DFF, Wl + WO_WD, (bf16_t*)(p.ws + OFF_FO), 64, 8, smem);
                else phase_gemm_plain<3>((const bf16_t*)(p.ws + OFF_H), DFF, Wl + WO_WD, (bf16_t*)(p.ws + OFF_FO), 96, 8, smem);
                break;
        default:
          ln_pass(p, last ? 2 : 1, nrows, (const bf16_t*)(p.ws + OFF_FO), p.ln2_g + (size_t)l * 1024, p.ln2_b + (size_t)l * 1024, l, 5, last ? l : l + 1, 0);
          if (!last) { convert_grab(p, l + 1, 0, smem); convert_grab(p, l + 1, 1, smem); }
          break;
      }
      }
    }
    if (ph + 1 < p0.ph_end) { if (ph == p0.ph_begin) grid.sync(); else xcd_barrier(xb); }
  }
}

extern "C" void kernel_launch(void* const* d_in, const int* in_sizes, int n_in, void* d_out, int out_size, void* d_ws, size_t ws_size, hipStream_t stream) {
  constexpr size_t kDynLds = 3 * GSTAGE + 16;
  static int grid_blocks = 0;
  if (!grid_blocks) {
    int dev = 0, cus = 0, per_cu = 0;
    (void)hipGetDevice(&dev);
    (void)hipDeviceGetAttribute(&cus, hipDeviceAttributeMultiprocessorCount, dev);
    (void)hipFuncSetAttribute((const void*)mega, hipFuncAttributeMaxDynamicSharedMemorySize, (int)kDynLds);
    (void)hipOccupancyMaxActiveBlocksPerMultiprocessor(&per_cu, mega, 512, kDynLds);
    if (per_cu > 1) per_cu = 1;
    if (per_cu < 1) per_cu = 1;
    grid_blocks = cus * per_cu;
  }
  if (ws_size < WS_NEED) { fprintf(stderr, "workspace too small: %zu < %zu\n", ws_size, (size_t)WS_NEED); return; }
  (void)hipMemsetAsync((char*)d_ws + OFF_BAR, 0, XCD_BAR_WORDS * 4 + 64, stream);
  Params p;
  memset(&p, 0, sizeof(p));
  const float** fp = (const float**)&p;
  for (int i = 0; i < 22; ++i) fp[i] = (const float*)d_in[i];
  p.out = (float*)d_out;
  p.ws = (char*)d_ws;
  for (int l = 0; l < 4; ++l) p.lam_init[l] = (float)(0.8 - 0.6 * exp(-0.3 * l));
  p.ph_begin = 0; p.ph_end = 2 + 8 * DEPTH;
  void* args[] = {&p};
  hipError_t e = hipLaunchCooperativeKernel((void*)mega, dim3(grid_blocks), dim3(512), args, kDynLds, stream);
  if (e != hipSuccess) fprintf(stderr, "cooperative launch failed: %s (grid %d)\n", hipGetErrorString(e), grid_blocks);
}
```

```cpp
#include <hip/hip_runtime.h>
#include <hip/hip_cooperative_groups.h>
#include <cstdio>
#include <cstdint>
#include <cstring>
#include <cmath>
namespace cg = cooperative_groups;

#define DI __device__ __forceinline__
typedef unsigned short bf16_t;
typedef short bf16x8 __attribute__((ext_vector_type(8)));
typedef float f32x4 __attribute__((ext_vector_type(4)));
typedef float f32x2 __attribute__((ext_vector_type(2)));
typedef float f32x16 __attribute__((ext_vector_type(16)));
typedef unsigned u32x2 __attribute__((ext_vector_type(2)));
typedef unsigned u32x4 __attribute__((ext_vector_type(4)));
typedef __bf16 bf16x2_t __attribute__((ext_vector_type(2)));

constexpr int D = 1024, NB = 8, SEQ = 2048, LC = 256, NH = 8, DEPTH = 4;
constexpr int T_LAT = NB * SEQ, T_CTX = NB * LC, T_ALL = T_LAT + T_CTX;
constexpr int NKEY = SEQ + LC;
constexpr int N_IN = 7168, DFF = 2816;
constexpr int WIN_ROWS = 7680;
constexpr int ROW_Z1 = 3072, ROW_Z2 = 3584, ROW_R = 4096, ROW_G = 4608;
constexpr float ALPHA = 1.6817928305074290f;
constexpr float LN_EPS = 1e-5f;
constexpr float QSCALE = 0.125f * 1.4426950408889634f;

constexpr size_t WO_WIN = 0;
constexpr size_t WO_WA = WO_WIN + (size_t)WIN_ROWS * 1024;
constexpr size_t WO_WF = WO_WA + 1024 * 1024;
constexpr size_t WO_WP = WO_WF + 1024 * 512;
constexpr size_t WO_WO = WO_WP + 1024 * 512;
constexpr size_t WO_WGU = WO_WO + 1024 * 1024;
constexpr size_t WO_WD = WO_WGU + (size_t)5632 * 1024;
constexpr size_t W_ELEMS = WO_WD + (size_t)1024 * DFF;

constexpr size_t al256(size_t x) { return (x + 255) & ~(size_t)255; }
constexpr size_t OFF_W = 0;
constexpr size_t OFF_ATAB = al256(OFF_W + W_ELEMS * 2);
constexpr size_t OFF_ATABC = al256(OFF_ATAB + (size_t)2048 * 4096 * 2);
constexpr size_t OFF_ROPEC = al256(OFF_ATABC + (size_t)256 * 512 * 2);
constexpr size_t OFF_ROPES = al256(OFF_ROPEC + (size_t)2048 * 32 * 4);
constexpr size_t OFF_MODV = al256(OFF_ROPES + (size_t)2048 * 32 * 4);
constexpr size_t OFF_LAMV = al256(OFF_MODV + (size_t)DEPTH * 9 * 6144 * 4);
constexpr size_t OFF_X = al256(OFF_LAMV + 256);
constexpr size_t OFF_U = al256(OFF_X + (size_t)T_ALL * 1024 * 4);
constexpr size_t OFF_KB = al256(OFF_U + (size_t)T_ALL * 1024 * 2);
constexpr size_t OFF_VT = al256(OFF_KB + (size_t)NB * NH * 2 * NKEY * 64 * 2);
constexpr size_t OFF_QB = al256(OFF_VT + (size_t)NB * NH * 128 * NKEY * 2);
constexpr size_t OFF_CQ = al256(OFF_QB + (size_t)NB * NH * 2 * SEQ * 64 * 2);
constexpr size_t OFF_ZT = al256(OFF_CQ + (size_t)NB * NH * 2 * LC * 64 * 2);
constexpr size_t OFF_ZTC = al256(OFF_ZT + (size_t)NB * 512 * 4096 * 2);
constexpr size_t OFF_R = al256(OFF_ZTC + (size_t)NB * 512 * 512 * 2);
constexpr size_t OFF_ATT = al256(OFF_R + (size_t)T_ALL * 512 * 2);
constexpr size_t OFF_FM = al256(OFF_ATT + (size_t)T_ALL * 1024 * 2);
constexpr size_t OFF_PM = al256(OFF_FM + (size_t)T_ALL * 512 * 2);
constexpr size_t OFF_BAR = al256(OFF_PM + (size_t)T_ALL * 512 * 2);
constexpr size_t OFF_CTR = OFF_BAR + 3456 * 4;
constexpr size_t OFF_W2 = al256(OFF_CTR + 64);
constexpr size_t OFF_G8 = al256(OFF_W2 + W_ELEMS * 2);
constexpr int G8_ROWS = 15360;
constexpr size_t WS_NEED = al256(OFF_G8 + (size_t)G8_ROWS * 1024);
constexpr size_t OFF_MOUT = OFF_KB;
constexpr size_t OFF_Y = OFF_VT;
constexpr size_t OFF_H = OFF_KB;
constexpr size_t OFF_FO = OFF_ATT;
static_assert((size_t)T_ALL * DFF * 2 <= OFF_CQ - OFF_KB, "H overlay too large");

struct Params {
  const float *x, *c, *ctx, *c_ctx, *w_mod, *b_mod, *w_in, *lam_qk, *subln_g, *w_att_br, *w_four_br, *w_pool_grp, *pool_scale,
      *w_pool_br, *w_out, *ln1_g, *ln1_b, *w_ffn_gate, *w_ffn_up, *w_ffn_down, *ln2_g, *ln2_b;
  float* out;
  char* ws;
  float lam_init[4];
  int ph_begin, ph_end;
};

DI size_t w_off(int l) { return (l & 1) ? OFF_W2 : OFF_W; }
DI int g_tid() { int t = __builtin_amdgcn_workitem_id_x(); asm volatile("" : "+v"(t)); return t; }
DI unsigned pk2(float a, float b) { f32x2 v = {a, b}; bf16x2_t r = __builtin_convertvector(v, bf16x2_t); return __builtin_bit_cast(unsigned, r); }
DI float bf_lo(unsigned u) { return __uint_as_float(u << 16); }
DI float bf_hi(unsigned u) { return __uint_as_float(u & 0xffff0000u); }
DI float hw_cos_rev(float r) { return __builtin_amdgcn_cosf(r); }
DI float hw_sin_rev(float r) { return __builtin_amdgcn_sinf(r); }
DI float sigmoidf_(float x) { return 1.0f / (1.0f + __expf(-x)); }
DI float xor32_sum(float v) { const auto r = __builtin_amdgcn_permlane32_swap(__float_as_uint(v), __float_as_uint(v), false, false); return __uint_as_float(r[0]) + __uint_as_float(r[1]); }
DI float xor32_max(float v) { const auto r = __builtin_amdgcn_permlane32_swap(__float_as_uint(v), __float_as_uint(v), false, false); return fmaxf(__uint_as_float(r[0]), __uint_as_float(r[1])); }
DI float dpp_add(float v, int) { return v; }
#define DPP_ADD(v, ctrl) ((v) + __uint_as_float(__builtin_amdgcn_update_dpp(0u, __float_as_uint(v), (ctrl), 0xF, 0xF, true)))
DI float wave_sum(float v) {
  v = DPP_ADD(v, 0xB1);
  v = DPP_ADD(v, 0x4E);
  v = DPP_ADD(v, 0x141);
  v = DPP_ADD(v, 0x140);
  { const auto r = __builtin_amdgcn_permlane16_swap(__float_as_uint(v), __float_as_uint(v), false, false); v = __uint_as_float(r[0]) + __uint_as_float(r[1]); }
  return xor32_sum(v);
}
#define MFMA16(a, b, c) __builtin_amdgcn_mfma_f32_16x16x32_bf16((a), (b), (c), 0, 0, 0)
#define MFMA32(a, b, c) __builtin_amdgcn_mfma_f32_32x32x16_bf16((a), (b), (c), 0, 0, 0)

constexpr int GSTAGE = 49152;
#define WAIT_VM(n) asm volatile("s_waitcnt vmcnt(" #n ")" ::: "memory")
typedef __attribute__((address_space(3))) void* lds_ptr_t;
template <bool SWAP, int MI = 4>
DI void gemm_kloop(const bf16_t* __restrict__ A, int lda, const bf16_t* __restrict__ B, int ldb, int K, f32x4 (&acc)[MI][4], char* smem, bool pre = false  ) {
  const int tid = g_tid(), lane = tid & 63, wid = __builtin_amdgcn_readfirstlane(tid >> 6), wm = wid >> 1, wn = wid & 1;
  const int lr = tid >> 3, lc = (tid & 7) ^ ((tid >> 4) & 7);
  const unsigned aoff = (unsigned)(lr * lda + lc * 8) * 2u, boff = (unsigned)(lr * ldb + lc * 8) * 2u;
  const char* Ac = (const char*)A; const char* Bc = (const char*)B;
  const int fr = lane & 15, fq = lane >> 4, sw = fr >> 1;
  const int a_base = (wm * 16 * MI + fr) * 128, b_base = 32768 + (wn * 64 + fr) * 128;
  const int nk = K >> 6;
  char* sdst = smem + tid * 16;
#define G_ISSUE(KT, ST) do { _Pragma("unroll") for (int i = 0; i < MI; ++i) \
      __builtin_amdgcn_global_load_lds((const void*)(Ac + ((size_t)(64 * i) * lda + (size_t)(KT) * 64) * 2 + aoff), (lds_ptr_t)(sdst + (ST) * GSTAGE + i * 8192), 16, 0, 0); \
    _Pragma("unroll") for (int i = 0; i < 2; ++i) \
      __builtin_amdgcn_global_load_lds((const void*)(Bc + ((size_t)(64 * i) * ldb + (size_t)(KT) * 64) * 2 + boff), (lds_ptr_t)(sdst + (ST) * GSTAGE + 32768 + i * 8192), 16, 0, 0); } while (0)
#define G_COMPUTE(ST) do { const char* st_ = smem + (ST) * GSTAGE; \
    _Pragma("unroll") for (int ks = 0; ks < 2; ++ks) { const int co = ((ks * 4 + fq) ^ sw) << 4; bf16x8 af[MI], bfr[4]; \
      _Pragma("unroll") for (int i = 0; i < 4; ++i) bfr[i] = *(const bf16x8*)(st_ + b_base + i * 2048 + co); \
      _Pragma("unroll") for (int i = 0; i < MI; ++i) af[i] = *(const bf16x8*)(st_ + a_base + i * 2048 + co); \
      _Pragma("unroll") for (int mi = 0; mi < MI; ++mi) _Pragma("unroll") for (int ni = 0; ni < 4; ++ni) { \
          if (SWAP) acc[mi][ni] = MFMA16(bfr[ni], af[mi], acc[mi][ni]); else acc[mi][ni] = MFMA16(af[mi], bfr[ni], acc[mi][ni]); } } } while (0)
  if (!pre) { G_ISSUE(0, 0); G_ISSUE(1, 1); }
  int st = 0;
  for (int t = 0; t < nk; ++t) {
    if (t == 0 || t + 1 >= nk) WAIT_VM(0);
    else if (MI == 4) WAIT_VM(6); else WAIT_VM(5);
    __builtin_amdgcn_s_barrier();
    asm volatile("" ::: "memory");
    const int st2 = (st == 0) ? 2 : st - 1;
    if (t + 2 < nk) G_ISSUE(t + 2, st2);
    __builtin_amdgcn_sched_barrier(0);
    G_COMPUTE(st);
    __builtin_amdgcn_sched_group_barrier(0x100, 6, 0);
#pragma unroll
    for (int i_ = 0; i_ < 2 * MI + 2; ++i_) { __builtin_amdgcn_sched_group_barrier(0x008, 2, 0); __builtin_amdgcn_sched_group_barrier(0x100, 1, 0); }
    __builtin_amdgcn_sched_group_barrier(0x008, 4 * MI - 4, 0);
    __builtin_amdgcn_sched_barrier(0);
    st = (st == 2) ? 0 : st + 1;
  }
  asm volatile("s_waitcnt lgkmcnt(0)" ::: "memory");
  __builtin_amdgcn_s_barrier();
  asm volatile("" ::: "memory");
#undef G_ISSUE
#undef G_COMPUTE
}
template <bool SWAP, int MI = 4>
DI void gemm_kloop_pp(const bf16_t* __restrict__ A, int lda, const bf16_t* __restrict__ B, int ldb, int K, f32x4 (&acc)[MI][4], char* smem) {
  const int tid = g_tid(), lane = tid & 63, wid = __builtin_amdgcn_readfirstlane(tid >> 6), wm = wid >> 1, wn = wid & 1, grp = wid >> 2;
  const int lr = tid >> 3, lc = (tid & 7) ^ ((tid >> 4) & 7);
  const unsigned aoff = (unsigned)(lr * lda + lc * 8) * 2u, boff = (unsigned)(lr * ldb + lc * 8) * 2u;
  const char* Ac = (const char*)A; const char* Bc = (const char*)B;
  const int fr = lane & 15, fq = lane >> 4, sw = fr >> 1;
  const int a_base = (wm * 16 * MI + fr) * 128, b_base = 32768 + (wn * 64 + fr) * 128;
  const int nk = K >> 6;
  char* sdst = smem + tid * 16;
#define P_ISSUE(KT, ST) do { _Pragma("unroll") for (int i = 0; i < MI; ++i) \
      __builtin_amdgcn_global_load_lds((const void*)(Ac + ((size_t)(64 * i) * lda + (size_t)(KT) * 64) * 2 + aoff), (lds_ptr_t)(sdst + (ST) * GSTAGE + i * 8192), 16, 0, 0); \
    _Pragma("unroll") for (int i = 0; i < 2; ++i) \
      __builtin_amdgcn_global_load_lds((const void*)(Bc + ((size_t)(64 * i) * ldb + (size_t)(KT) * 64) * 2 + boff), (lds_ptr_t)(sdst + (ST) * GSTAGE + 32768 + i * 8192), 16, 0, 0); } while (0)
  P_ISSUE(0, 0);
  P_ISSUE(1, 1);
  WAIT_VM(0);
  __builtin_amdgcn_s_barrier();
  asm volatile("" ::: "memory");
  if (grp == 1) { __builtin_amdgcn_s_barrier(); asm volatile("" ::: "memory"); }
  int st = 0;
  for (int t = 0; t < nk; ++t) {
    const int st2 = (st == 0) ? 2 : st - 1;
    if (t + 2 < nk) P_ISSUE(t + 2, st2);
    bf16x8 af[2][MI], bfr[2][4];
    const char* st_ = smem + st * GSTAGE;
#pragma unroll
    for (int ks = 0; ks < 2; ++ks) {
      const int co = ((ks * 4 + fq) ^ sw) << 4;
#pragma unroll
      for (int i = 0; i < 4; ++i) bfr[ks][i] = *(const bf16x8*)(st_ + b_base + i * 2048 + co);
#pragma unroll
      for (int i = 0; i < MI; ++i) af[ks][i] = *(const bf16x8*)(st_ + a_base + i * 2048 + co);
    }
    if (t + 2 < nk) { if (MI == 4) WAIT_VM(6); else WAIT_VM(5); } else WAIT_VM(0);
    asm volatile("s_waitcnt lgkmcnt(0)" ::: "memory");
    __builtin_amdgcn_sched_barrier(0);
    __builtin_amdgcn_s_barrier();
    asm volatile("" ::: "memory");
#pragma unroll
    for (int ks = 0; ks < 2; ++ks)
#pragma unroll
      for (int mi = 0; mi < MI; ++mi)
#pragma unroll
        for (int ni = 0; ni < 4; ++ni) {
          if (SWAP) acc[mi][ni] = MFMA16(bfr[ks][ni], af[ks][mi], acc[mi][ni]); else acc[mi][ni] = MFMA16(af[ks][mi], bfr[ks][ni], acc[mi][ni]);
        }
    __builtin_amdgcn_sched_barrier(0);
    __builtin_amdgcn_s_barrier();
    asm volatile("" ::: "memory");
    st = (st == 2) ? 0 : st + 1;
  }
  if (grp == 0) { __builtin_amdgcn_s_barrier(); asm volatile("" ::: "memory"); }
#undef P_ISSUE
}

template <int MI>
DI void gemm_prefetch(const bf16_t* __restrict__ A, int lda, const bf16_t* __restrict__ B, int ldb, char* smem) {
  const int tid = g_tid();
  const int lr = tid >> 3, lc = (tid & 7) ^ ((tid >> 4) & 7);
  const unsigned aoff = (unsigned)(lr * lda + lc * 8) * 2u, boff = (unsigned)(lr * ldb + lc * 8) * 2u;
  const char* Ac = (const char*)A; const char* Bc = (const char*)B;
  char* sdst = smem + tid * 16;
#pragma unroll
  for (int kt = 0; kt < 2; ++kt) {
#pragma unroll
    for (int i = 0; i < MI; ++i)
      __builtin_amdgcn_global_load_lds((const void*)(Ac + ((size_t)(64 * i) * lda + (size_t)kt * 64) * 2 + aoff), (lds_ptr_t)(sdst + kt * GSTAGE + i * 8192), 16, 0, 0);
#pragma unroll
    for (int i = 0; i < 2; ++i)
      __builtin_amdgcn_global_load_lds((const void*)(Bc + ((size_t)(64 * i) * ldb + (size_t)kt * 64) * 2 + boff), (lds_ptr_t)(sdst + kt * GSTAGE + 32768 + i * 8192), 16, 0, 0);
  }
}
template <int MI>
DI void zero_acc_t(f32x4 (&acc)[MI][4]) {
#pragma unroll
  for (int i = 0; i < MI; ++i)
#pragma unroll
    for (int j = 0; j < 4; ++j) acc[i][j] = (f32x4){0.f, 0.f, 0.f, 0.f};
}
DI void zero_acc(f32x4 (&acc)[4][4]) {
#pragma unroll
  for (int i = 0; i < 4; ++i)
#pragma unroll
    for (int j = 0; j < 4; ++j) acc[i][j] = (f32x4){0.f, 0.f, 0.f, 0.f};
}

template <bool SWAP>
DI void gemm_kloop_big(const bf16_t* __restrict__ A, int lda, const bf16_t* __restrict__ B, int ldb, int K, f32x4 (&acc)[8][4], char* smem, bool pre = false) {
  const int tid = g_tid(), lane = tid & 63, wid = __builtin_amdgcn_readfirstlane(tid >> 6), wm = wid >> 2, wn = wid & 3;
  const int lr = tid >> 3, lc = (tid & 7) ^ ((tid >> 4) & 7);
  const unsigned aoff = (unsigned)(lr * lda + lc * 8) * 2u, boff = (unsigned)(lr * ldb + lc * 8) * 2u;
  const char* Ac = (const char*)A; const char* Bc = (const char*)B;
  const int fr = lane & 15, fq = lane >> 4, sw = fr >> 1;
  const int a_base = (wm * 128 + fr) * 128, b_base = 32768 + (wn * 64 + fr) * 128;
  const int nk = K >> 6;
  char* sdst = smem + tid * 16;
#define GB_ISSUE(KT, ST) do { _Pragma("unroll") for (int i = 0; i < 4; ++i) { \
      __builtin_amdgcn_global_load_lds((const void*)(Ac + ((size_t)(64 * i) * lda + (size_t)(KT) * 64) * 2 + aoff), (lds_ptr_t)(sdst + (ST) * 65536 + i * 8192), 16, 0, 0); \
      __builtin_amdgcn_global_load_lds((const void*)(Bc + ((size_t)(64 * i) * ldb + (size_t)(KT) * 64) * 2 + boff), (lds_ptr_t)(sdst + (ST) * 65536 + 32768 + i * 8192), 16, 0, 0); } } while (0)
  if (!pre) GB_ISSUE(0, 0);
  for (int t = 0; t < nk; ++t) {
    WAIT_VM(0);
    __builtin_amdgcn_s_barrier();
    asm volatile("" ::: "memory");
    if (t + 1 < nk) GB_ISSUE(t + 1, (t + 1) & 1);
    __builtin_amdgcn_sched_barrier(0);
    const char* st_ = smem + (t & 1) * 65536;
#pragma unroll
    for (int ks = 0; ks < 2; ++ks) {
      const int co = ((ks * 4 + fq) ^ sw) << 4;
      bf16x8 af[8], bfr[4];
#pragma unroll
      for (int i = 0; i < 4; ++i) bfr[i] = *(const bf16x8*)(st_ + b_base + i * 2048 + co);
#pragma unroll
      for (int i = 0; i < 8; ++i) af[i] = *(const bf16x8*)(st_ + a_base + i * 2048 + co);
#pragma unroll
      for (int mi = 0; mi < 8; ++mi)
#pragma unroll
        for (int ni = 0; ni < 4; ++ni) {
          if (SWAP) acc[mi][ni] = MFMA16(bfr[ni], af[mi], acc[mi][ni]); else acc[mi][ni] = MFMA16(af[mi], bfr[ni], acc[mi][ni]);
        }
    }
    __builtin_amdgcn_sched_group_barrier(0x100, 8, 0);
#pragma unroll
    for (int i_ = 0; i_ < 16; ++i_) { __builtin_amdgcn_sched_group_barrier(0x008, 3, 0); __builtin_amdgcn_sched_group_barrier(0x100, 1, 0); }
    __builtin_amdgcn_sched_group_barrier(0x008, 16, 0);
    __builtin_amdgcn_sched_barrier(0);
  }
  asm volatile("s_waitcnt lgkmcnt(0)" ::: "memory");
  __builtin_amdgcn_s_barrier();
  asm volatile("" ::: "memory");
#undef GB_ISSUE
}

namespace pg8 {
#define PG8_LAS __attribute__((address_space(3)))
constexpr int BM = 256, BK = 64, HALF = 128, HTB = HALF * BK * 2;
DI int lds_byte(int r, int c) { const int st = (r >> 4) * 2 + (c >> 5), rr = r & 15, cc = c & 31, ob = rr * 64 + cc * 2; return st * 1024 + (ob ^ (((ob >> 9) & 1) << 5)); }
DI void stage_rc(int b, int& R, int& C) { const int st = b / 1024, sb = b % 1024, swz = sb ^ (((sb >> 9) & 1) << 5); R = (st >> 1) * 16 + swz / 64; C = (st & 1) * 32 + (swz % 64) / 2; }
struct Unit { int pm, pn; };
template <class Epi, class Sched>
DI void gemm_phase(PG8_LAS unsigned char* lds, int K, const Sched& S, const Epi& E) {
  const int tid = g_tid(), wid = __builtin_amdgcn_readfirstlane(tid >> 6), lane = tid & 63, wr = wid >> 2, wc = wid & 3, fr = lane & 15, fq = lane >> 4;
  const int nt = K / BK;
  unsigned voff[2];
#pragma unroll
  for (int i = 0; i < 2; ++i) { int R, C; stage_rc(tid * 16 + i * 8192, R, C); voff[i] = (unsigned)(R * K + C) * 2u; }
  const size_t kstep = (size_t)(BK * 2);
  const size_t hstep = (size_t)HALF * K * 2;
  const unsigned ldsw = (unsigned)wid * 1024u;
  const int aoff = lds_byte(wr * 64 + fr, fq * 8), boff = lds_byte(wc * 32 + fr, fq * 8);
#define PG8_SA(b, h) (((b) * 2 + (h)) * HTB)
#define PG8_SB(b, h) ((4 + (b) * 2 + (h)) * HTB)
#define PG8_STAGE(bufoff, gbase) do { _Pragma("unroll") for (int _i = 0; _i < 2; ++_i) \
    __builtin_amdgcn_global_load_lds((const void*)((const char*)(gbase) + voff[_i]), (PG8_LAS void*)(lds + (bufoff) + ldsw + _i * 8192), 16, 0, 0); } while (0)
#define PG8_LDA(dst, b, h) do { _Pragma("unroll") for (int m = 0; m < 4; ++m) _Pragma("unroll") for (int k = 0; k < 2; ++k) dst[m][k] = *(const PG8_LAS bf16x8*)(lds + PG8_SA(b, h) + aoff + m * 2048 + k * 1024); } while (0)
#define PG8_LDB(dst, b, h) do { _Pragma("unroll") for (int n = 0; n < 2; ++n) _Pragma("unroll") for (int k = 0; k < 2; ++k) dst[n][k] = *(const PG8_LAS bf16x8*)(lds + PG8_SB(b, h) + boff + n * 2048 + k * 1024); } while (0)
#define PG8_MMA(ai, bj, At, Bt) do { __builtin_amdgcn_s_setprio(1); _Pragma("unroll") for (int m = 0; m < 4; ++m) _Pragma("unroll") for (int n = 0; n < 2; ++n) _Pragma("unroll") for (int k = 0; k < 2; ++k) \
    acc[ai][bj][m][n] = __builtin_amdgcn_mfma_f32_16x16x32_bf16(Bt[n][k], At[m][k], acc[ai][bj][m][n], 0, 0, 0); __builtin_amdgcn_s_setprio(0); } while (0)
#define PG8_WAIT_V(n) asm volatile("s_waitcnt vmcnt(" #n ")" ::: "memory")
#define PG8_WAIT_L(n) asm volatile("s_waitcnt lgkmcnt(" #n ")" ::: "memory")
#define PG8_BAR __builtin_amdgcn_s_barrier()
#define PG8_SCHED __builtin_amdgcn_sched_barrier(0)
  Unit cur, nxt; int ui = 0;
  if (!S.next(0, cur)) return;
  f32x4 acc[2][2][4][2];
#pragma unroll
  for (int a = 0; a < 2; ++a)
#pragma unroll
    for (int b = 0; b < 2; ++b)
#pragma unroll
      for (int m = 0; m < 4; ++m)
#pragma unroll
        for (int n = 0; n < 2; ++n) acc[a][b][m][n] = (f32x4){0.f, 0.f, 0.f, 0.f};
  bf16x8 At[4][2], B0[2][2], B1[2][2];
  const char* cA = S.pa(cur); const char* cB = S.pb(cur);
  PG8_WAIT_V(0);
  PG8_STAGE(PG8_SB(0, 0), cB); PG8_STAGE(PG8_SA(0, 0), cA); PG8_STAGE(PG8_SB(0, 1), cB + hstep); PG8_STAGE(PG8_SA(0, 1), cA + hstep);
  if (wr == 1) PG8_BAR;
  PG8_WAIT_V(4); PG8_BAR;
  PG8_STAGE(PG8_SB(1, 0), cB + kstep); PG8_STAGE(PG8_SA(1, 0), cA + kstep); PG8_STAGE(PG8_SB(1, 1), cB + hstep + kstep);
  PG8_WAIT_V(6); PG8_BAR;
  for (;;) {
    const bool has_next = S.next(ui + 1, nxt);
    const char* nA = has_next ? S.pa(nxt) : cA; const char* nB = has_next ? S.pb(nxt) : cB;
    for (int t = 0; t < nt; t += 2) {
      const bool last = (t == nt - 2);
      const char* a1 = cA + (size_t)(t + 1) * kstep;
      const char* a2 = last ? nA : cA + (size_t)(t + 2) * kstep; const char* b2 = last ? nB : cB + (size_t)(t + 2) * kstep;
      const char* a3 = a2 + kstep; const char* b3 = b2 + kstep;
      PG8_LDB(B0, 0, 0); PG8_SCHED; PG8_LDA(At, 0, 0); PG8_STAGE(PG8_SA(1, 1), a1 + hstep);
      PG8_WAIT_L(8); PG8_BAR; PG8_WAIT_L(0); PG8_MMA(0, 0, At, B0); PG8_BAR; PG8_SCHED;
      PG8_LDB(B1, 0, 1); PG8_STAGE(PG8_SB(0, 0), b2);
      PG8_BAR; PG8_WAIT_L(0); PG8_MMA(0, 1, At, B1); PG8_BAR;
      PG8_LDA(At, 0, 1); PG8_STAGE(PG8_SA(0, 0), a2);
      PG8_BAR; PG8_WAIT_L(0); PG8_MMA(1, 0, At, B0); PG8_BAR; PG8_SCHED;
      PG8_STAGE(PG8_SB(0, 1), b2 + hstep);
      PG8_WAIT_V(6); PG8_BAR; PG8_MMA(1, 1, At, B1); PG8_BAR;
      PG8_LDB(B0, 1, 0); PG8_SCHED; PG8_LDA(At, 1, 0); PG8_STAGE(PG8_SA(0, 1), a2 + hstep);
      PG8_WAIT_L(8); PG8_BAR; PG8_WAIT_L(0); PG8_MMA(0, 0, At, B0); PG8_BAR; PG8_SCHED;
      PG8_LDB(B1, 1, 1); PG8_STAGE(PG8_SB(1, 0), b3);
      PG8_BAR; PG8_WAIT_L(0); PG8_MMA(0, 1, At, B1); PG8_BAR;
      PG8_LDA(At, 1, 1); PG8_STAGE(PG8_SA(1, 0), a3);
      PG8_BAR; PG8_WAIT_L(0); PG8_MMA(1, 0, At, B0); PG8_BAR; PG8_SCHED;
      PG8_STAGE(PG8_SB(1, 1), b3 + hstep);
      PG8_WAIT_V(6); PG8_BAR; PG8_MMA(1, 1, At, B1); PG8_BAR;
    }
    E(acc, cur, wr, wc, fr, fq);
    if (!has_next) break;
#pragma unroll
    for (int a = 0; a < 2; ++a)
#pragma unroll
      for (int b = 0; b < 2; ++b)
#pragma unroll
        for (int m = 0; m < 4; ++m)
#pragma unroll
          for (int n = 0; n < 2; ++n) acc[a][b][m][n] = (f32x4){0.f, 0.f, 0.f, 0.f};
    cur = nxt; cA = nA; cB = nB; ++ui;
  }
  PG8_WAIT_V(0);
  if (wr == 0) PG8_BAR;
  PG8_BAR;
#undef PG8_SA
#undef PG8_SB
#undef PG8_STAGE
#undef PG8_LDA
#undef PG8_LDB
#undef PG8_MMA
#undef PG8_WAIT_V
#undef PG8_WAIT_L
#undef PG8_BAR
#undef PG8_SCHED
}
}

DI void gemm_prefetch_big(const bf16_t* __restrict__ A, int lda, const bf16_t* __restrict__ B, int ldb, char* smem) {
  const int tid = g_tid();
  const int lr = tid >> 3, lc = (tid & 7) ^ ((tid >> 4) & 7);
  const unsigned aoff = (unsigned)(lr * lda + lc * 8) * 2u, boff = (unsigned)(lr * ldb + lc * 8) * 2u;
  const char* Ac = (const char*)A; const char* Bc = (const char*)B;
  char* sdst = smem + tid * 16;
#pragma unroll
  for (int i = 0; i < 4; ++i) {
    __builtin_amdgcn_global_load_lds((const void*)(Ac + ((size_t)(64 * i) * lda) * 2 + aoff), (lds_ptr_t)(sdst + i * 8192), 16, 0, 0);
    __builtin_amdgcn_global_load_lds((const void*)(Bc + ((size_t)(64 * i) * ldb) * 2 + boff), (lds_ptr_t)(sdst + 32768 + i * 8192), 16, 0, 0);
  }
}

DI void row_info(int r, int& b, int& pos, bool& isctx) {
  if (r < T_LAT) { b = r >> 11; pos = r & 2047; isctx = false; } else { const int q = r - T_LAT; b = q >> 8; pos = q & 255; isctx = true; }
}

constexpr int HALF_LDS = 65792;
DI void conv_tile(bool active, const float* __restrict__ src, int ld, int k0, int c0, bf16_t* __restrict__ dst, int dstld, int ilv  , int n0, char* smem) {
  float* s = (float*)smem;
  const int tid = g_tid() & 255;
  if (active) {
#pragma unroll
    for (int i = 0; i < 4; ++i) {
      const int k = (tid >> 4) + 16 * i, cc = (tid & 15) * 4;
      const f32x4 v = *(const f32x4*)(src + (size_t)(k0 + k) * ld + c0 + n0 + cc);
      s[k * 65 + cc] = v[0]; s[k * 65 + cc + 1] = v[1]; s[k * 65 + cc + 2] = v[2]; s[k * 65 + cc + 3] = v[3];
    }
  }
  __syncthreads();
  if (active) {
    const int n = tid >> 2, kq = (tid & 3) * 16;
    unsigned w[8];
#pragma unroll
    for (int j = 0; j < 8; ++j) w[j] = pk2(s[(kq + 2 * j) * 65 + n], s[(kq + 2 * j + 1) * 65 + n]);
    const int ng = n0 + n;
    size_t drow = ng;
    if (ilv) drow = (size_t)(ng >> 4) * 32 + (ng & 15) + (ilv == 2 ? 16 : 0);
    bf16_t* dp = dst + drow * dstld + k0 + kq;
    *(u32x4*)dp = (u32x4){w[0], w[1], w[2], w[3]};
    *(u32x4*)(dp + 8) = (u32x4){w[4], w[5], w[6], w[7]};
  }
  __syncthreads();
}
DI void fold_tile(bool active, const float* __restrict__ src  , int cbase, int k0, int np0  , int mode, const float* __restrict__ wgrp,
                  const float* __restrict__ pscale, bf16_t* __restrict__ dst  , char* smem) {
  float* sA = (float*)smem;
  float* sT = (float*)(smem + 33024);
  const int tid = g_tid() & 255;
  if (active) {
    for (int i = tid; i < 64 * 32; i += 256) {
      const int k = i >> 5, c4 = (i & 31) * 4;
      const f32x4 v = *(const f32x4*)(src + (size_t)(k0 + k) * N_IN + cbase + c4);
      sA[k * 129 + c4] = v[0]; sA[k * 129 + c4 + 1] = v[1]; sA[k * 129 + c4 + 2] = v[2]; sA[k * 129 + c4 + 3] = v[3];
    }
    for (int i = tid; i < 128 * 64; i += 256) {
      const int c = i >> 6, n = i & 63, np = np0 + n;
      float t;
      if (mode == 2) t = wgrp[c * 128 + np] * pscale[np];
      else { const float r = (float)((c * np) & 127) * (1.0f / 128.0f); t = (mode == 0) ? hw_cos_rev(r) : hw_sin_rev(r); }
      sT[c * 64 + n] = t;
    }
  }
  __syncthreads();
  if (active) {
    const int ty = tid >> 4, tx = tid & 15;
    float acc[4][4];
#pragma unroll
    for (int a = 0; a < 4; ++a)
#pragma unroll
      for (int b = 0; b < 4; ++b) acc[a][b] = 0.f;
    for (int c = 0; c < 128; ++c) {
      const f32x4 t4 = *(const f32x4*)(sT + c * 64 + tx * 4);
      float a4[4];
#pragma unroll
      for (int a = 0; a < 4; ++a) a4[a] = sA[(ty * 4 + a) * 129 + c];
#pragma unroll
      for (int a = 0; a < 4; ++a)
#pragma unroll
        for (int b = 0; b < 4; ++b) acc[a][b] += a4[a] * t4[b];
    }
#pragma unroll
    for (int b = 0; b < 4; ++b) {
      bf16_t* dp = dst + (size_t)(np0 + tx * 4 + b) * 1024 + k0 + ty * 4;
      *(u32x2*)dp = (u32x2){pk2(acc[0][b], acc[1][b]), pk2(acc[2][b], acc[3][b])};
    }
  }
  __syncthreads();
}

constexpr int CONV_TOTAL = 16 * 48 * 2 + 16 * 16 + 8 * 16 * 2 + 16 * 16 + 16 * 44 * 2 + 44 * 16 + 256 + 128;
DI void convert_iter(const Params& p, int l, int tb, char* smem0) {
  bf16_t* W = (bf16_t*)(p.ws + w_off(l));
  const float* win = p.w_in + (size_t)l * 1024 * N_IN;
  const int half = g_tid() >> 8;
  char* smem = smem0 + half * HALF_LDS;
  constexpr int C0 = 16 * 48, C1 = C0 + 16 * 48, C2 = C1 + 16 * 16, C3 = C2 + 8 * 16, C4 = C3 + 8 * 16, C5 = C4 + 16 * 16, C6 = C5 + 16 * 44, C7 = C6 + 16 * 44,
                C8 = C7 + 44 * 16, C9 = C8 + 256, C10 = C9 + 128;
  static_assert((C0 | C1 | C2 | C3 | C4 | C5 | C6 | C7 | C8 | C9 | C10) % 2 == 0, "segment boundaries must be even");
  const int total = C10;
  static_assert(C10 == CONV_TOTAL, "conversion tile count");
  {
    const bool active = (tb + half) < total;
    const int t = active ? tb + half : tb;
    int seg, r;
    if (t < C0) { seg = 0; r = t; } else if (t < C1) { seg = 1; r = t - C0; } else if (t < C2) { seg = 2; r = t - C1; } else if (t < C3) { seg = 3; r = t - C2; }
    else if (t < C4) { seg = 4; r = t - C3; } else if (t < C5) { seg = 5; r = t - C4; } else if (t < C6) { seg = 6; r = t - C5; } else if (t < C7) { seg = 7; r = t - C6; }
    else if (t < C8) { seg = 8; r = t - C7; } else if (t < C9) { seg = 9; r = t - C8; } else { seg = 10; r = t - C9; }
    if (seg <= 8) {
      const float* src; int ld, kt, nt, c0 = 0, dstld, ilv = 0; bf16_t* dst;
      if (seg <= 1) { kt = r & 15; nt = r >> 4; src = win; ld = N_IN; c0 = seg == 0 ? 0 : 4096; dst = W + WO_WIN + (seg == 0 ? 0 : (size_t)ROW_G * 1024); dstld = 1024; }
      else if (seg == 2) { kt = r & 15; nt = r >> 4; src = p.w_att_br + (size_t)l * 1024 * 1024; ld = 1024; dst = W + WO_WA; dstld = 1024; }
      else if (seg == 3) { kt = r & 7; nt = r >> 3; src = p.w_four_br + (size_t)l * 512 * 1024; ld = 1024; dst = W + WO_WF; dstld = 512; }
      else if (seg == 4) { kt = r & 7; nt = r >> 3; src = p.w_pool_br + (size_t)l * 512 * 1024; ld = 1024; dst = W + WO_WP; dstld = 512; }
      else if (seg == 5) { kt = r & 15; nt = r >> 4; src = p.w_out + (size_t)l * 1024 * 1024; ld = 1024; dst = W + WO_WO; dstld = 1024; }
      else if (seg == 6) { kt = r & 15; nt = r >> 4; src = p.w_ffn_gate + (size_t)l * 1024 * DFF; ld = DFF; dst = W + WO_WGU; dstld = 1024; ilv = 1; }
      else if (seg == 7) { kt = r & 15; nt = r >> 4; src = p.w_ffn_up + (size_t)l * 1024 * DFF; ld = DFF; dst = W + WO_WGU; dstld = 1024; ilv = 2; }
      else { kt = r % 44; nt = r / 44; src = p.w_ffn_down + (size_t)l * DFF * 1024; ld = 1024; dst = W + WO_WD; dstld = DFF; }
      conv_tile(active, src, ld, kt * 64, c0, dst, dstld, ilv, nt * 64, smem);
    } else if (seg == 9) {
      const int kt = r & 15, q = r >> 4; const int g = q & 3, hf = (q >> 2) & 1, mode = q >> 3;
      fold_tile(active, win, 3072 + g * 128, kt * 64, hf * 64, mode, nullptr, nullptr, W + WO_WIN + (size_t)((mode ? ROW_Z2 : ROW_Z1) + g * 128) * 1024, smem);
    } else {
      const int kt = r & 15, q = r >> 4; const int g = q & 3, hf = q >> 2;
      fold_tile(active, win, 3584 + g * 128, kt * 64, hf * 64, 2, p.w_pool_grp + ((size_t)l * 4 + g) * 128 * 128, p.pool_scale + (size_t)l * 512 + g * 128,
                W + WO_WIN + (size_t)(ROW_R + g * 128) * 1024, smem);
    }
  }
}

DI void convert_layer(const Params& p, int l, char* smem) {
  for (int tb = blockIdx.x * 2; tb < CONV_TOTAL; tb += gridDim.x * 2) convert_iter(p, l, tb, smem);
}

DI void convert_grab(const Params& p, int l, int which  , char* smem) {
  unsigned* ctr = (unsigned*)(p.ws + OFF_CTR) + l * 2 + which;
  volatile __attribute__((address_space(3))) unsigned* slot = (volatile __attribute__((address_space(3))) unsigned*)(lds_ptr_t)(smem + 3 * GSTAGE + 8);
  const int lo = which ? 2400 : 0, hi = which ? CONV_TOTAL : 2400;
  for (;;) {
    __syncthreads();
    if (__builtin_amdgcn_workitem_id_x() == 0) *slot = __hip_atomic_fetch_add(ctr, 2u, __ATOMIC_RELAXED, __HIP_MEMORY_SCOPE_AGENT);
    __syncthreads();
    const int tb = lo + (int)*slot;
    if (tb >= hi) break;
    convert_iter(p, l, tb, smem);
  }
  __syncthreads();
}

DI void phase0a(const Params& p, char* smem) {
  const int tid = g_tid();
  const int gtid = blockIdx.x * 512 + tid, gsz = gridDim.x * 512;
  {
    const int half = tid >> 8, t8 = tid & 255;
    float* ssil = (float*)smem;
    float* sred = (float*)(smem + 36864 + half * 9216);
    bool filled = false;
    float* modv = (float*)(p.ws + OFF_MODV);
    for (int tb = blockIdx.x * 2; tb < DEPTH * 96; tb += gridDim.x * 2) {
      if (!filled) {
        for (int i = tid; i < 9 * 1024; i += 512) { const float v = (i < 8192) ? p.c[i] : p.c_ctx[i - 8192]; ssil[i] = v * sigmoidf_(v); }
        filled = true;
        __syncthreads();
      }
      const int t = tb + half;
      const int l = t / 96, cgp = t % 96;
      const int col = cgp * 64 + (t8 & 63), kq = t8 >> 6;
      const float* wp = p.w_mod + ((size_t)l * 1024 + kq * 256) * 6144 + col;
      float a[9];
#pragma unroll
      for (int r = 0; r < 9; ++r) a[r] = 0.f;
#pragma unroll 4
      for (int k = 0; k < 256; ++k) {
        const float w = wp[(size_t)k * 6144];
#pragma unroll
        for (int r = 0; r < 9; ++r) a[r] += ssil[r * 1024 + kq * 256 + k] * w;
      }
#pragma unroll
      for (int r = 0; r < 9; ++r) sred[(kq * 9 + r) * 64 + (t8 & 63)] = a[r];
      __syncthreads();
      for (int i = t8; i < 9 * 64; i += 256) {
        const int r = i >> 6, cc = i & 63;
        const float v = sred[(0 * 9 + r) * 64 + cc] + sred[(1 * 9 + r) * 64 + cc] + sred[(2 * 9 + r) * 64 + cc] + sred[(3 * 9 + r) * 64 + cc];
        modv[((size_t)l * 9 + r) * 6144 + cgp * 64 + cc] = v + p.b_mod[(size_t)l * 6144 + cgp * 64 + cc];
      }
      __syncthreads();
    }
    __syncthreads();
  }
  convert_layer(p, 0, smem);
  {
    bf16_t* at = (bf16_t*)(p.ws + OFF_ATAB);
    for (int i = gtid; i < 2048 * 512; i += gsz) {
      const int k = i >> 9, c8 = (i & 511) * 8;
      unsigned w[4];
#pragma unroll
      for (int j = 0; j < 4; ++j) {
        float v[2];
#pragma unroll
        for (int e = 0; e < 2; ++e) {
          const int tp = c8 + 2 * j + e; const int tt = tp & 2047;
          const float r = (float)((k * tt) & 2047) * (1.0f / 2048.0f);
          v[e] = (tp < 2048) ? hw_cos_rev(r) : -hw_sin_rev(r);
        }
        w[j] = pk2(v[0], v[1]);
      }
      *(u32x4*)(at + (size_t)k * 4096 + c8) = (u32x4){w[0], w[1], w[2], w[3]};
    }
    bf16_t* atc = (bf16_t*)(p.ws + OFF_ATABC);
    for (int i = gtid; i < 256 * 64; i += gsz) {
      const int k = i >> 6, c8 = (i & 63) * 8;
      unsigned w[4];
#pragma unroll
      for (int j = 0; j < 4; ++j) {
        float v[2];
#pragma unroll
        for (int e = 0; e < 2; ++e) {
          const int tp = c8 + 2 * j + e; const int tt = tp & 255;
          const float r = (float)((k * tt) & 255) * (1.0f / 256.0f);
          v[e] = (tp < 256) ? hw_cos_rev(r) : -hw_sin_rev(r);
        }
        w[j] = pk2(v[0], v[1]);
      }
      *(u32x4*)(atc + (size_t)k * 512 + c8) = (u32x4){w[0], w[1], w[2], w[3]};
    }
  }
  {
    float* rc = (float*)(p.ws + OFF_ROPEC); float* rs = (float*)(p.ws + OFF_ROPES);
    for (int i = gtid; i < 2048 * 32; i += gsz) {
      const int t = i >> 5, a = i & 31, f = a & 15;
      const float pos = (float)((a < 16) ? (t >> 6) : (t & 63));
      const float inv = exp2f(-(float)f * (13.287712379549449f / 16.0f));
      float r = pos * inv * 0.15915494309189535f;
      r -= floorf(r);
      rc[i] = hw_cos_rev(r); rs[i] = hw_sin_rev(r);
    }
  }
  if (gtid < DEPTH) {
    const float* lq = p.lam_qk + (size_t)gtid * 256;
    float s1 = 0.f, s2 = 0.f;
    for (int i = 0; i < 64; ++i) { s1 += lq[i] * lq[64 + i]; s2 += lq[128 + i] * lq[192 + i]; }
    ((float*)(p.ws + OFF_LAMV))[gtid] = expf(s1) - expf(s2) + p.lam_init[gtid];
  }
}

DI void ln_pass(const Params& p, int mode, int nrows, const bf16_t* __restrict__ Yb, const float* __restrict__ lng, const float* __restrict__ lnb,
                        int modl_gate, int gate_chunk, int modl_next, int sh_chunk) {
  const int lane = g_tid() & 63, wid = g_tid() >> 6;
  float* X = (float*)(p.ws + OFF_X);
  bf16_t* U = (bf16_t*)(p.ws + OFF_U);
  const float* modv = (const float*)(p.ws + OFF_MODV);
  f32x4 xv[4], xn[4]; u32x2 yv[4], yn[4];
  const int r0 = blockIdx.x * 8 + wid, rstride = gridDim.x * 8;
  if (mode != 0 && r0 < nrows) {
#pragma unroll
    for (int i = 0; i < 4; ++i) { xv[i] = *(const f32x4*)(X + (size_t)r0 * 1024 + lane * 4 + 256 * i); yv[i] = *(const u32x2*)(Yb + (size_t)r0 * 1024 + lane * 4 + 256 * i); }
  }
  for (int r = r0; r < nrows; r += rstride) {
    int b, pos; bool isctx; row_info(r, b, pos, isctx);
    const int mr = isctx ? 8 : b;
    f32x4 v[4];
    if (mode == 0) {
      const float* src = isctx ? (p.ctx + (size_t)(r - T_LAT) * 1024) : (p.x + (size_t)r * 1024);
#pragma unroll
      for (int i = 0; i < 4; ++i) v[i] = *(const f32x4*)(src + lane * 4 + 256 * i);
#pragma unroll
      for (int i = 0; i < 4; ++i) *(f32x4*)(X + (size_t)r * 1024 + lane * 4 + 256 * i) = v[i];
    } else {
      const int rn = r + rstride;
      if (rn < nrows) {
#pragma unroll
        for (int i = 0; i < 4; ++i) { xn[i] = *(const f32x4*)(X + (size_t)rn * 1024 + lane * 4 + 256 * i); yn[i] = *(const u32x2*)(Yb + (size_t)rn * 1024 + lane * 4 + 256 * i); }
      }
      const float* gv = modv + ((size_t)modl_gate * 9 + mr) * 6144 + gate_chunk * 1024;
      float s = 0.f;
#pragma unroll
      for (int i = 0; i < 4; ++i) {
        const int col = lane * 4 + 256 * i;
        const f32x4 g = *(const f32x4*)(gv + col);
        v[i][0] = ALPHA * xv[i][0] + g[0] * bf_lo(yv[i][0]); v[i][1] = ALPHA * xv[i][1] + g[1] * bf_hi(yv[i][0]);
        v[i][2] = ALPHA * xv[i][2] + g[2] * bf_lo(yv[i][1]); v[i][3] = ALPHA * xv[i][3] + g[3] * bf_hi(yv[i][1]);
        s += (v[i][0] + v[i][1]) + (v[i][2] + v[i][3]);
      }
#pragma unroll
      for (int i = 0; i < 4; ++i) { xv[i] = xn[i]; yv[i] = yn[i]; }
      const float mu = wave_sum(s) * (1.0f / 1024.0f);
      float q = 0.f;
#pragma unroll
      for (int i = 0; i < 4; ++i) { const f32x4 d = v[i] - mu; q += (d[0] * d[0] + d[1] * d[1]) + (d[2] * d[2] + d[3] * d[3]); }
      const float rstd = rsqrtf(wave_sum(q) * (1.0f / 1024.0f) + LN_EPS);
#pragma unroll
      for (int i = 0; i < 4; ++i) {
        const int col = lane * 4 + 256 * i;
        const f32x4 g = *(const f32x4*)(lng + col), bb = *(const f32x4*)(lnb + col);
        v[i] = (v[i] - mu) * rstd * g + bb;
        if (mode == 2) *(f32x4*)(p.out + (size_t)r * 1024 + col) = v[i];
        else *(f32x4*)(X + (size_t)r * 1024 + col) = v[i];
      }
    }
    if (mode != 2) {
      float s = 0.f;
#pragma unroll
      for (int i = 0; i < 4; ++i) s += (v[i][0] + v[i][1]) + (v[i][2] + v[i][3]);
      const float mu = wave_sum(s) * (1.0f / 1024.0f);
      float q = 0.f;
#pragma unroll
      for (int i = 0; i < 4; ++i) { const f32x4 d = v[i] - mu; q += (d[0] * d[0] + d[1] * d[1]) + (d[2] * d[2] + d[3] * d[3]); }
      const float rstd = rsqrtf(wave_sum(q) * (1.0f / 1024.0f) + LN_EPS);
      const float* shv = modv + ((size_t)modl_next * 9 + mr) * 6144 + sh_chunk * 1024;
      const float* scv = shv + 1024;
#pragma unroll
      for (int i = 0; i < 4; ++i) {
        const int col = lane * 4 + 256 * i;
        const f32x4 sh = *(const f32x4*)(shv + col), sc = *(const f32x4*)(scv + col);
        const f32x4 u = (v[i] - mu) * rstd * (sc + 1.0f) + sh;
        *(u32x2*)(U + (size_t)r * 1024 + col) = (u32x2){pk2(u[0], u[1]), pk2(u[2], u[3])};
      }
    }
  }
}

DI bool tile_map(int v, int nmt, int nnt, int& mt, int& nt) {
  const int c = v >> 8, w = v & 255, xcd = w & 7, local = w >> 3;
  const int spr = nnt >> 2, nsup = (nmt >> 3) * spr, sup = c * 8 + xcd;
  if (sup >= nsup) return false;
  mt = (sup / spr) * 8 + (local & 7); nt = (sup % spr) * 4 + (local >> 3);
  return true;
}
DI int tile_vmax(int nmt, int nnt) { const int nsup = (nmt >> 3) * (nnt >> 2); return ((nsup + 7) >> 3) << 8; }

DI void phase_inproj(const Params& p, int l, char* smem) {
  const bool last = (l == DEPTH - 1);
  const bf16_t* W = (const bf16_t*)(p.ws + w_off(l)) + WO_WIN;
  const bf16_t* U = (const bf16_t*)(p.ws + OFF_U);
  bf16_t* KB = (bf16_t*)(p.ws + OFF_KB); bf16_t* VT = (bf16_t*)(p.ws + OFF_VT); bf16_t* QB = (bf16_t*)(p.ws + OFF_QB); bf16_t* CQ = (bf16_t*)(p.ws + OFF_CQ);
  bf16_t* ZT = (bf16_t*)(p.ws + OFF_ZT); bf16_t* ZTC = (bf16_t*)(p.ws + OFF_ZTC); bf16_t* R = (bf16_t*)(p.ws + OFF_R);
  const float* ropec = (const float*)(p.ws + OFF_ROPEC); const float* ropes = (const float*)(p.ws + OFF_ROPES);
  const int nsupA = last ? 72 : 81, nsup = last ? 76 : 81;
  const int vmax = ((nsup + 15) >> 4) << 8;
  auto map_tile = [&](int v, int& mt, int& nt) -> bool {
    if (v >= vmax) return false;
    const int c = v >> 8, w = v & 255, local = w >> 3, sup = (c * 8 + (w & 7)) * 2 + (local >> 4);
    if (sup >= nsup) return false;
    if (sup < nsupA) { mt = (sup / 9) * 8 + (local & 7); nt = (sup % 9) * 2 + ((local >> 3) & 1); }
    else { mt = 64 + (local & 7); nt = (sup - nsupA) * 2 + ((local >> 3) & 1); }
    return true;
  };
  int v = blockIdx.x, mt = 0, nt = 0;
  bool cur = map_tile(v, mt, nt);
  if (cur) gemm_prefetch_big(U + (size_t)mt * 256 * 1024, 1024, W + (size_t)nt * 256 * 1024, 1024, smem);
  while (cur) {
    const int m0 = mt * 256;
    int b, pos0; bool isctx; row_info(m0, b, pos0, isctx);
    f32x4 acc[8][4];
#pragma unroll
    for (int i = 0; i < 8; ++i)
#pragma unroll
      for (int j = 0; j < 4; ++j) acc[i][j] = (f32x4){0.f, 0.f, 0.f, 0.f};
    const bool swap = !((nt >= 4 && nt < 8) || (nt >= 12 && nt < 16));
    if (swap) gemm_kloop_big<true>(U + (size_t)m0 * 1024, 1024, W + (size_t)nt * 256 * 1024, 1024, 1024, acc, smem, true);
    else gemm_kloop_big<false>(U + (size_t)m0 * 1024, 1024, W + (size_t)nt * 256 * 1024, 1024, 1024, acc, smem, true);
    int v2 = v + gridDim.x, mt2 = 0, nt2 = 0;
    const bool nxt = map_tile(v2, mt2, nt2);
    if (nxt) gemm_prefetch_big(U + (size_t)mt2 * 256 * 1024, 1024, W + (size_t)nt2 * 256 * 1024, 1024, smem);
    const int tid = g_tid(), lane = tid & 63, wid = __builtin_amdgcn_readfirstlane(tid >> 6), wm = wid >> 2, wn = wid & 3;
    const int fq = lane >> 4, fr = lane & 15;
    const int ncol0 = nt * 256 + wn * 64;
    const int prow0 = pos0 + wm * 128;
    if (ncol0 < 1024 || (ncol0 >= 2048 && ncol0 < 3072)) {
      const bool isq = ncol0 >= 2048; const int h = (ncol0 >> 7) & 7, map = (ncol0 >> 6) & 1;
#pragma unroll
      for (int mi = 0; mi < 8; ++mi) {
        const int pos = prow0 + mi * 16 + fr;
        f32x4 o[4];
        if (!isctx) {
#pragma unroll
          for (int pr = 0; pr < 2; ++pr) {
            const f32x4 cs = *(const f32x4*)(ropec + pos * 32 + pr * 16 + fq * 4);
            const f32x4 sn = *(const f32x4*)(ropes + pos * 32 + pr * 16 + fq * 4);
            const f32x4 x0 = acc[mi][2 * pr], x1 = acc[mi][2 * pr + 1];
            o[2 * pr] = x0 * cs - x1 * sn;
            o[2 * pr + 1] = x1 * cs + x0 * sn;
          }
        } else {
#pragma unroll
          for (int ni = 0; ni < 4; ++ni) o[ni] = acc[mi][ni];
        }
        bf16_t* dst;
        if (!isq) dst = KB + ((size_t)((b * 8 + h) * 2 + map) * NKEY + (isctx ? SEQ + pos : pos)) * 64;
        else if (!isctx) dst = QB + ((size_t)((b * 8 + h) * 2 + map) * SEQ + pos) * 64;
        else dst = CQ + ((size_t)((b * 8 + h) * 2 + map) * LC + pos) * 64;
        const float sc = isq ? QSCALE : 1.0f;
#pragma unroll
        for (int ni = 0; ni < 4; ++ni) {
          const f32x4 vv = o[ni] * sc;
          *(u32x2*)(dst + ni * 16 + fq * 4) = (u32x2){pk2(vv[0], vv[1]), pk2(vv[2], vv[3])};
        }
      }
    } else if (ncol0 < 2048) {
      const int h = (ncol0 - 1024) >> 7, vc0 = ncol0 & 127;
#pragma unroll
      for (int mi = 0; mi < 8; ++mi) {
        const int key = (isctx ? SEQ : 0) + prow0 + mi * 16 + fq * 4;
        const int k15 = key & 15;
        const int pkey = (key & ~15) | (k15 & 3) | ((k15 & 4) << 1) | ((k15 & 8) >> 1);
#pragma unroll
        for (int ni = 0; ni < 4; ++ni) {
          const int vcol = vc0 + ni * 16 + fr;
          const f32x4 vv = acc[mi][ni];
          *(u32x2*)(VT + ((size_t)(b * 8 + h) * 128 + vcol) * NKEY + pkey) = (u32x2){pk2(vv[0], vv[1]), pk2(vv[2], vv[3])};
        }
      }
    } else if (ncol0 < 4096) {
#pragma unroll
      for (int mi = 0; mi < 8; ++mi) {
        const int pos = prow0 + mi * 16 + fq * 4;
#pragma unroll
        for (int ni = 0; ni < 4; ++ni) {
          const int zc = ncol0 - 3072 + ni * 16 + fr;
          const int np = zc & 511, second = zc >> 9;
          const f32x4 vv = acc[mi][ni];
          bf16_t* dst = isctx ? (ZTC + ((size_t)b * 512 + np) * 512 + second * 256 + pos) : (ZT + ((size_t)b * 512 + np) * 4096 + second * 2048 + pos);
          *(u32x2*)dst = (u32x2){pk2(vv[0], vv[1]), pk2(vv[2], vv[3])};
        }
      }
    } else {
#pragma unroll
      for (int mi = 0; mi < 8; ++mi) {
        const int row = m0 + wm * 128 + mi * 16 + fr;
#pragma unroll
        for (int ni = 0; ni < 4; ++ni) {
          const int col = ncol0 - 4096 + ni * 16 + fq * 4;
          const f32x4 vv = acc[mi][ni];
          *(u32x2*)(R + (size_t)row * 512 + col) = (u32x2){pk2(vv[0], vv[1]), pk2(vv[2], vv[3])};
        }
      }
    }
    v = v2; mt = mt2; nt = nt2; cur = nxt;
  }
}

DI void attn_unit(const bf16_t* __restrict__ Qb  , int nq, int q0, const bf16_t* __restrict__ Kb  ,
                  const bf16_t* __restrict__ VTb  , int key0, int ntiles  , bf16_t* __restrict__ outp  ,
                  const float* __restrict__ subg, float lam, float nscale, char* smem) {
  const int tid = g_tid(), lane = tid & 63, wid = __builtin_amdgcn_readfirstlane(tid >> 6), wq = wid & 3, map = wid >> 2;
  const int l31 = lane & 31, kh = lane >> 5;
  bf16x8 qf[4];
  {
    const bf16_t* qp = Qb + ((size_t)map * nq + q0 + wq * 32 + l31) * 64 + kh * 8;
#pragma unroll
    for (int s = 0; s < 4; ++s) qf[s] = *(const bf16x8*)(qp + s * 16);
  }
  const int srow = tid >> 3, sc = (tid & 7) ^ ((tid >> 4) & 7);
  const unsigned koff = (unsigned)((key0 + srow) * 64 + sc * 8) * 2u;
  const unsigned voff = (unsigned)(srow * NKEY + key0 + sc * 8) * 2u;
  const char* Kc = (const char*)Kb; const char* Vc = (const char*)VTb;
  char* sdst = smem + tid * 16;
#define A_ISSUE(T) do { char* d_ = sdst + ((T) & 3) * 32768; \
    __builtin_amdgcn_global_load_lds((const void*)(Kc + (size_t)(T) * 8192 + koff), (lds_ptr_t)(d_), 16, 0, 0); \
    __builtin_amdgcn_global_load_lds((const void*)(Kc + (size_t)NKEY * 128 + (size_t)(T) * 8192 + koff), (lds_ptr_t)(d_ + 8192), 16, 0, 0); \
    __builtin_amdgcn_global_load_lds((const void*)(Vc + (size_t)(T) * 128 + voff), (lds_ptr_t)(d_ + 16384), 16, 0, 0); \
    __builtin_amdgcn_global_load_lds((const void*)(Vc + (size_t)64 * NKEY * 2 + (size_t)(T) * 128 + voff), (lds_ptr_t)(d_ + 24576), 16, 0, 0); } while (0)
  f32x16 O[4];
#pragma unroll
  for (int vb = 0; vb < 4; ++vb)
#pragma unroll
    for (int i = 0; i < 16; ++i) O[vb][i] = 0.f;
  float m = 0.f, lsum = 0.f;
  const int sw = (lane >> 1) & 7;
  const int kfo = l31 * 128, cho = kh;
#define A_QK(SX, T) do { const char* st_ = smem + ((T) & 3) * 32768 + map * 8192 + kfo; \
    bf16x8 kf_[8]; \
    _Pragma("unroll") for (int s = 0; s < 4; ++s) _Pragma("unroll") for (int kb = 0; kb < 2; ++kb) \
        kf_[s * 2 + kb] = *(const bf16x8*)(st_ + kb * 4096 + (((2 * s + cho) ^ sw) << 4)); \
    _Pragma("unroll") for (int kb = 0; kb < 2; ++kb) _Pragma("unroll") for (int i = 0; i < 16; ++i) SX[kb][i] = -m; \
    __builtin_amdgcn_sched_barrier(0); \
    _Pragma("unroll") for (int s = 0; s < 4; ++s) _Pragma("unroll") for (int kb = 0; kb < 2; ++kb) \
        SX[kb] = MFMA32(kf_[s * 2 + kb], qf[s], SX[kb]); \
    __builtin_amdgcn_sched_barrier(0); } while (0)
  bf16x8 pf[4];
  auto pv = [&](int T) {
    const char* sv = smem + (T & 3) * 32768 + 16384 + kfo;
    __builtin_amdgcn_sched_barrier(0);
    bf16x8 va[4], vb_[4];
#pragma unroll
    for (int vb = 0; vb < 4; ++vb) va[vb] = *(const bf16x8*)(sv + vb * 4096 + (((0 + cho) ^ sw) << 4));
#pragma unroll
    for (int vb = 0; vb < 4; ++vb) vb_[vb] = *(const bf16x8*)(sv + vb * 4096 + (((2 + cho) ^ sw) << 4));
    __builtin_amdgcn_sched_barrier(0);
#pragma unroll
    for (int vb = 0; vb < 4; ++vb) O[vb] = MFMA32(va[vb], pf[0], O[vb]);
    __builtin_amdgcn_sched_barrier(0);
#pragma unroll
    for (int vb = 0; vb < 4; ++vb) va[vb] = *(const bf16x8*)(sv + vb * 4096 + (((4 + cho) ^ sw) << 4));
    __builtin_amdgcn_sched_barrier(0);
#pragma unroll
    for (int vb = 0; vb < 4; ++vb) O[vb] = MFMA32(vb_[vb], pf[1], O[vb]);
    __builtin_amdgcn_sched_barrier(0);
#pragma unroll
    for (int vb = 0; vb < 4; ++vb) vb_[vb] = *(const bf16x8*)(sv + vb * 4096 + (((6 + cho) ^ sw) << 4));
    __builtin_amdgcn_sched_barrier(0);
#pragma unroll
    for (int vb = 0; vb < 4; ++vb) O[vb] = MFMA32(va[vb], pf[2], O[vb]);
    __builtin_amdgcn_sched_barrier(0);
#pragma unroll
    for (int vb = 0; vb < 4; ++vb) O[vb] = MFMA32(vb_[vb], pf[3], O[vb]);
    __builtin_amdgcn_sched_barrier(0);
  };
  auto softmax = [&](f32x16 (&SC)[2], f32x16 (&SN)[2], bool has_next, bool first) {
    float mx[16];
#pragma unroll
    for (int i = 0; i < 16; ++i) mx[i] = fmaxf(SC[0][i], SC[1][i]);
#pragma unroll
    for (int w = 8; w >= 1; w >>= 1)
#pragma unroll
      for (int i = 0; i < w; ++i) mx[i] = fmaxf(mx[i], mx[i + w]);
    float tmax = xor32_max(mx[0]);
    if (first || __any(tmax > 8.0f)) {
      const float delta = first ? tmax : fmaxf(tmax, 0.f);
      const float alpha = first ? 1.0f : __builtin_amdgcn_exp2f(-delta);
      m += delta; lsum *= alpha;
#pragma unroll
      for (int vb = 0; vb < 4; ++vb) O[vb] = O[vb] * alpha;
#pragma unroll
      for (int kb = 0; kb < 2; ++kb)
#pragma unroll
        for (int i = 0; i < 16; ++i) SC[kb][i] -= delta;
      if (has_next) {
#pragma unroll
        for (int kb = 0; kb < 2; ++kb)
#pragma unroll
          for (int i = 0; i < 16; ++i) SN[kb][i] -= delta;
      }
    }
    float sm[16];
#pragma unroll
    for (int i = 0; i < 16; ++i) { const float e0 = __builtin_amdgcn_exp2f(SC[0][i]), e1 = __builtin_amdgcn_exp2f(SC[1][i]); SC[0][i] = e0; SC[1][i] = e1; sm[i] = e0 + e1; }
#pragma unroll
    for (int w = 8; w >= 1; w >>= 1)
#pragma unroll
      for (int i = 0; i < w; ++i) sm[i] += sm[i + w];
    lsum += sm[0];
#pragma unroll
    for (int g = 0; g < 4; ++g) {
      const int kb = g >> 1, s2 = g & 1;
      u32x4 w;
      w[0] = pk2(SC[kb][8 * s2 + 0], SC[kb][8 * s2 + 1]); w[1] = pk2(SC[kb][8 * s2 + 2], SC[kb][8 * s2 + 3]);
      w[2] = pk2(SC[kb][8 * s2 + 4], SC[kb][8 * s2 + 5]); w[3] = pk2(SC[kb][8 * s2 + 6], SC[kb][8 * s2 + 7]);
      pf[g] = __builtin_bit_cast(bf16x8, w);
    }
  };
  f32x16 Sa[2], Sb[2];
  WAIT_VM(0);
  A_ISSUE(0); A_ISSUE(1); A_ISSUE(2);
  WAIT_VM(8);
  __builtin_amdgcn_s_barrier();
  asm volatile("" ::: "memory");
  A_QK(Sa, 0);
  for (int t = 0; t < ntiles; t += 2) {
    if (t + 2 < ntiles) WAIT_VM(4); else WAIT_VM(0);
    __builtin_amdgcn_s_barrier();
    asm volatile("" ::: "memory");
    if (t + 3 < ntiles) A_ISSUE(t + 3);
    A_QK(Sb, t + 1);
    softmax(Sa, Sb, true, t == 0);
    pv(t);
    const bool nx = (t + 2 < ntiles);
    if (nx) { if (t + 3 < ntiles) WAIT_VM(4); else WAIT_VM(0); }
    __builtin_amdgcn_s_barrier();
    asm volatile("" ::: "memory");
    if (t + 4 < ntiles) A_ISSUE(t + 4);
    if (nx) A_QK(Sa, t + 2);
    softmax(Sb, Sa, nx, false);
    pv(t + 1);
  }
  asm volatile("s_waitcnt lgkmcnt(0)" ::: "memory");
  __builtin_amdgcn_s_barrier();
  asm volatile("" ::: "memory");
#undef A_ISSUE
#undef A_QK
  const float ltot = xor32_sum(lsum);
  const float inv = 1.0f / ltot;
  float* ex = (float*)smem;
  if (map == 1) {
#pragma unroll
    for (int vb = 0; vb < 4; ++vb)
#pragma unroll
      for (int g4 = 0; g4 < 4; ++g4) {
        f32x4 v = {O[vb][4 * g4] * inv, O[vb][4 * g4 + 1] * inv, O[vb][4 * g4 + 2] * inv, O[vb][4 * g4 + 3] * inv};
        *(f32x4*)(ex + (wq * 32 + l31) * 132 + vb * 32 + 8 * g4 + 4 * kh) = v;
      }
  }
  __syncthreads();
  if (map == 0) {
    float ss = 0.f;
#pragma unroll
    for (int vb = 0; vb < 4; ++vb)
#pragma unroll
      for (int g4 = 0; g4 < 4; ++g4) {
        const f32x4 o2 = *(const f32x4*)(ex + (wq * 32 + l31) * 132 + vb * 32 + 8 * g4 + 4 * kh);
#pragma unroll
        for (int j = 0; j < 4; ++j) { const float o = O[vb][4 * g4 + j] * inv - lam * o2[j]; O[vb][4 * g4 + j] = o; ss += o * o; }
      }
    ss = xor32_sum(ss);
    const float rs = rsqrtf(ss * (1.0f / 128.0f) + LN_EPS) * nscale;
    bf16_t* op = outp + (size_t)(wq * 32 + l31) * 1024;
#pragma unroll
    for (int vb = 0; vb < 4; ++vb)
#pragma unroll
      for (int g4 = 0; g4 < 4; ++g4) {
        const int vc = vb * 32 + 8 * g4 + 4 * kh;
        const f32x4 g = *(const f32x4*)(subg + vc);
        *(u32x2*)(op + vc) = (u32x2){pk2(O[vb][4 * g4] * rs * g[0], O[vb][4 * g4 + 1] * rs * g[1]), pk2(O[vb][4 * g4 + 2] * rs * g[2], O[vb][4 * g4 + 3] * rs * g[3])};
      }
  }
  __syncthreads();
}

template <int MI>
DI void store_tile_bf16(const f32x4 (&acc)[MI][4], bf16_t* __restrict__ C, int ldc, float scale) {
  const int tid = g_tid(), lane = tid & 63, wid = __builtin_amdgcn_readfirstlane(tid >> 6), wm = wid >> 1, wn = wid & 1, fq = lane >> 4, fr = lane & 15;
#pragma unroll
  for (int mi = 0; mi < MI; ++mi)
#pragma unroll
    for (int ni = 0; ni < 4; ++ni) {
      const f32x4 v = acc[mi][ni] * scale;
      *(u32x2*)(C + (size_t)(wm * 16 * MI + mi * 16 + fr) * ldc + wn * 64 + ni * 16 + fq * 4) = (u32x2){pk2(v[0], v[1]), pk2(v[2], v[3])};
    }
}

template <int W>
DI void pool_rows(const bf16_t* __restrict__ R, bf16_t* __restrict__ PM, int m0, int g, int rhalf, int lane) {
  constexpr int LO = W / 2;
  const int col = g * 128 + (lane & 15) * 8;
#pragma unroll 2
  for (int ps = 0; ps < 8; ++ps) {
    const int row = m0 + ps * 8 + rhalf * 4 + (lane >> 4);
    int b, pos; bool isctx; row_info(row, b, pos, isctx);
    const int L = isctx ? LC : SEQ;
    const int rbase = row - pos;
    float s[8];
#pragma unroll
    for (int j = 0; j < 8; ++j) s[j] = 0.f;
    int cnt = 0;
    u32x4 self = {0u, 0u, 0u, 0u};
#pragma unroll
    for (int k = 0; k < W; ++k) {
      const int q = pos - LO + k;
      const bool ok = (q >= 0) && (q < L);
      const int qc = ok ? q : pos;
      const u32x4 v = *(const u32x4*)(R + (size_t)(rbase + qc) * 512 + col);
      const float f = ok ? 1.0f : 0.0f;
      cnt += ok ? 1 : 0;
#pragma unroll
      for (int j = 0; j < 4; ++j) { s[2 * j] += f * bf_lo(v[j]); s[2 * j + 1] += f * bf_hi(v[j]); }
      if (k == LO) self = v;
    }
    const float ic = 1.0f / (float)cnt;
    u32x4 o;
#pragma unroll
    for (int j = 0; j < 4; ++j) o[j] = pk2(s[2 * j] * ic - bf_lo(self[j]), s[2 * j + 1] * ic - bf_hi(self[j]));
    *(u32x4*)(PM + (size_t)row * 512 + col) = o;
  }
}
DI void pool_task(const bf16_t* __restrict__ R, bf16_t* __restrict__ PM, int m0) {
  const int tid = g_tid(), lane = tid & 63, wid = __builtin_amdgcn_readfirstlane(tid >> 6), g = wid & 3, rhalf = wid >> 2;
  if (g == 0) pool_rows<2>(R, PM, m0, 0, rhalf, lane);
  else if (g == 1) pool_rows<4>(R, PM, m0, 1, rhalf, lane);
  else if (g == 2) pool_rows<8>(R, PM, m0, 2, rhalf, lane);
  else pool_rows<16>(R, PM, m0, 3, rhalf, lane);
}

DI void phase_mix(const Params& p, int l, char* smem) {
  const bool last = (l == DEPTH - 1);
  const bf16_t* KB = (const bf16_t*)(p.ws + OFF_KB); const bf16_t* VT = (const bf16_t*)(p.ws + OFF_VT);
  const bf16_t* QB = (const bf16_t*)(p.ws + OFF_QB); const bf16_t* CQ = (const bf16_t*)(p.ws + OFF_CQ);
  const bf16_t* ZT = (const bf16_t*)(p.ws + OFF_ZT); const bf16_t* ZTC = (const bf16_t*)(p.ws + OFF_ZTC); const bf16_t* R = (const bf16_t*)(p.ws + OFF_R);
  bf16_t* ATT = (bf16_t*)(p.ws + OFF_ATT); bf16_t* FM = (bf16_t*)(p.ws + OFF_FM); bf16_t* PM = (bf16_t*)(p.ws + OFF_PM);
  const bf16_t* ATAB = (const bf16_t*)(p.ws + OFF_ATAB); const bf16_t* ATABC = (const bf16_t*)(p.ws + OFF_ATABC);
  const float lam = ((const float*)(p.ws + OFF_LAMV))[l];
  const float nscale = 1.0f - p.lam_init[l];
  const float* subg = p.subln_g + (size_t)l * 128;
  const int n_attn = 1024, n_dft = 256, n_cattn = last ? 0 : 128, n_cdft = last ? 0 : 32, n_pool = last ? 256 : 288;
  const int total = n_attn + n_dft + n_cattn + n_cdft + n_pool;
  for (int t = blockIdx.x; t < total; t += gridDim.x) {
    int r = t;
    if (r < n_attn) {
      const int c = r >> 8, w = r & 255, xcd = w & 7, local = w >> 3;
      const int bh = c * 16 + xcd * 2 + (local >> 4), qb = local & 15;
      const int b = bh >> 3, h = bh & 7;
      attn_unit(QB + (size_t)bh * 2 * SEQ * 64, SEQ, qb * 128, KB + (size_t)bh * 2 * NKEY * 64, VT + (size_t)bh * 128 * NKEY, 0, NKEY / 64,
                ATT + ((size_t)b * SEQ + qb * 128) * 1024 + h * 128, subg, lam, nscale, smem);
      continue;
    }
    r -= n_attn;
    if (r < n_dft) {
      const int b = r & 7, local = r >> 3, mt = local & 7, nt = local >> 3;
      f32x4 acc[4][4]; zero_acc(acc);
      gemm_kloop_pp<true>(ATAB + (size_t)mt * 256 * 4096, 4096, ZT + ((size_t)b * 512 + nt * 128) * 4096, 4096, 4096, acc, smem);
      store_tile_bf16<4>(acc, FM + ((size_t)b * SEQ + mt * 256) * 512 + nt * 128, 512, 1.0f / 512.0f);
      continue;
    }
    r -= n_dft;
    if (r < n_cattn) {
      const int bh = r >> 1, qb = r & 1, b = bh >> 3, h = bh & 7;
      attn_unit(CQ + (size_t)bh * 2 * LC * 64, LC, qb * 128, KB + (size_t)bh * 2 * NKEY * 64, VT + (size_t)bh * 128 * NKEY, SEQ, LC / 64,
                ATT + ((size_t)T_LAT + b * LC + qb * 128) * 1024 + h * 128, subg, lam, nscale, smem);
      continue;
    }
    r -= n_cattn;
    if (r < n_cdft) {
      const int b = r >> 2, nt = r & 3;
      f32x4 acc[4][4]; zero_acc(acc);
      gemm_kloop_pp<true>(ATABC, 512, ZTC + ((size_t)b * 512 + nt * 128) * 512, 512, 512, acc, smem);
      store_tile_bf16<4>(acc, FM + ((size_t)T_LAT + b * LC) * 512 + nt * 128, 512, 0.005524271728019903f  );
      continue;
    }
    r -= n_cdft;
    pool_task(R, PM, r * 64);
  }
}

template <int MI>
DI void phase_branch(const Params& p, int l, char* smem) {
  const bool last = (l == DEPTH - 1);
  const bf16_t* W = (const bf16_t*)(p.ws + w_off(l));
  const bf16_t* U = (const bf16_t*)(p.ws + OFF_U);
  const bf16_t* ATT = (const bf16_t*)(p.ws + OFF_ATT); const bf16_t* FM = (const bf16_t*)(p.ws + OFF_FM); const bf16_t* PM = (const bf16_t*)(p.ws + OFF_PM);
  bf16_t* MOUT = (bf16_t*)(p.ws + OFF_MOUT);
  const int nmt = (last ? T_LAT : T_ALL) / (64 * MI), vmax = tile_vmax(nmt, 8);
  for (int v = blockIdx.x; v < vmax; v += gridDim.x) {
    int mt, nt;
    if (!tile_map(v, nmt, 8, mt, nt)) continue;
    const int m0 = mt * 64 * MI, n0 = nt * 128;
    u32x2 tot[MI][4], gpk[MI][4];
#pragma unroll
    for (int mi = 0; mi < MI; ++mi)
#pragma unroll
      for (int ni = 0; ni < 4; ++ni) tot[mi][ni] = (u32x2){0u, 0u};
#pragma unroll 1
    for (int br = 0; br < 3; ++br) {
      __builtin_amdgcn_sched_barrier(0);
      f32x4 acc[MI][4]; zero_acc_t<MI>(acc);
      const bool pre = !last && br == 0 && (m0 + 64 * MI <= G8_ROWS);
      if (!pre) {
        gemm_kloop_pp<true, MI>(U + (size_t)m0 * 1024, 1024, W + WO_WIN + (size_t)(ROW_G + br * 1024 + n0) * 1024, 1024, 1024, acc, smem);
        __builtin_amdgcn_sched_barrier(0);
#pragma unroll
        for (int mi = 0; mi < MI; ++mi)
#pragma unroll
          for (int ni = 0; ni < 4; ++ni) {
            const f32x4 a = acc[mi][ni];
            gpk[mi][ni] = (u32x2){pk2(sigmoidf_(a[0]), sigmoidf_(a[1])), pk2(sigmoidf_(a[2]), sigmoidf_(a[3]))};
          }
      } else {
        const unsigned char* G8 = (const unsigned char*)(p.ws + OFF_G8);
        const int tid_ = g_tid(), lane_ = tid_ & 63, wid_ = __builtin_amdgcn_readfirstlane(tid_ >> 6), wm_ = wid_ >> 1, wn_ = wid_ & 1, fq_ = lane_ >> 4, fr_ = lane_ & 15;
#pragma unroll
        for (int mi = 0; mi < MI; ++mi)
#pragma unroll
          for (int ni = 0; ni < 4; ++ni) {
            const unsigned g = *(const unsigned*)(G8 + (size_t)(m0 + wm_ * 16 * MI + mi * 16 + fr_) * 1024 + n0 + wn_ * 64 + ni * 16 + fq_ * 4);
            gpk[mi][ni] = (u32x2){pk2((float)(g & 255u) * (1.0f / 255.0f), (float)((g >> 8) & 255u) * (1.0f / 255.0f)),
                                  pk2((float)((g >> 16) & 255u) * (1.0f / 255.0f), (float)(g >> 24) * (1.0f / 255.0f))};
          }
      }
      __builtin_amdgcn_sched_barrier(0);
      zero_acc_t<MI>(acc);
      const int K2 = (br == 0) ? 1024 : 512;
      const bf16_t* A2 = (br == 0) ? (ATT + (size_t)m0 * 1024) : ((br == 1 ? FM : PM) + (size_t)m0 * 512);
      const bf16_t* B2 = (br == 0) ? (W + WO_WA + (size_t)n0 * 1024) : (W + (br == 1 ? WO_WF : WO_WP) + (size_t)n0 * 512);
      gemm_kloop_pp<true, MI>(A2, K2, B2, K2, K2, acc, smem);
      __builtin_amdgcn_sched_barrier(0);
#pragma unroll
      for (int mi = 0; mi < MI; ++mi)
#pragma unroll
        for (int ni = 0; ni < 4; ++ni) {
          const f32x4 a = acc[mi][ni]; const u32x2 g = gpk[mi][ni]; const u32x2 tp = tot[mi][ni];
          const float v0 = bf_lo(g[0]) * a[0] + bf_lo(tp[0]), v1 = bf_hi(g[0]) * a[1] + bf_hi(tp[0]);
          const float v2 = bf_lo(g[1]) * a[2] + bf_lo(tp[1]), v3 = bf_hi(g[1]) * a[3] + bf_hi(tp[1]);
          tot[mi][ni] = (u32x2){pk2(v0, v1), pk2(v2, v3)};
        }
    }
    const int tid = g_tid(), lane = tid & 63, wid = __builtin_amdgcn_readfirstlane(tid >> 6), wm = wid >> 1, wn = wid & 1, fq = lane >> 4, fr = lane & 15;
#pragma unroll
    for (int mi = 0; mi < MI; ++mi)
#pragma unroll
      for (int ni = 0; ni < 4; ++ni)
        *(u32x2*)(MOUT + (size_t)(m0 + wm * 16 * MI + mi * 16 + fr) * 1024 + n0 + wn * 64 + ni * 16 + fq * 4) = tot[mi][ni];
  }
}

template <int MI>
DI void phase_gemm_plain(const bf16_t* __restrict__ A, int K, const bf16_t* __restrict__ Bt, bf16_t* __restrict__ C, int nmt, int nnt, char* smem) {
  const int vmax = tile_vmax(nmt, nnt), N = nnt * 128;
  for (int v = blockIdx.x; v < vmax; v += gridDim.x) {
    int mt, nt;
    if (!tile_map(v, nmt, nnt, mt, nt)) continue;
    f32x4 acc[MI][4]; zero_acc_t<MI>(acc);
    gemm_kloop_pp<true, MI>(A + (size_t)mt * 64 * MI * K, K, Bt + (size_t)nt * 128 * K, K, K, acc, smem);
    store_tile_bf16<MI>(acc, C + (size_t)mt * 64 * MI * N + nt * 128, N, 1.0f);
  }
}
DI void phase_ffn1(const Params& p, int l, char* smem) {
  const bool last = (l == DEPTH - 1);
  const bf16_t* W = (const bf16_t*)(p.ws + w_off(l)) + WO_WGU;
  const bf16_t* U = (const bf16_t*)(p.ws + OFF_U);
  bf16_t* H = (bf16_t*)(p.ws + OFF_H);
  const int nsup = (last ? 8 : 9) * 11;
  const int vmax = ((nsup + 15) >> 4) << 8;
  auto map_tile = [&](int v, int& mt, int& nt) -> bool {
    if (v >= vmax) return false;
    const int c = v >> 8, w = v & 255, local = w >> 3, sup = (c * 8 + (w & 7)) * 2 + (local >> 4);
    if (sup >= nsup) return false;
    mt = (sup / 11) * 8 + (local & 7); nt = (sup % 11) * 2 + ((local >> 3) & 1);
    return true;
  };
  int v = blockIdx.x, mt = 0, nt = 0;
  bool cur = map_tile(v, mt, nt);
  if (cur) gemm_prefetch_big(U + (size_t)mt * 256 * 1024, 1024, W + (size_t)nt * 256 * 1024, 1024, smem);
  while (cur) {
    f32x4 acc[8][4];
#pragma unroll
    for (int i = 0; i < 8; ++i)
#pragma unroll
      for (int j = 0; j < 4; ++j) acc[i][j] = (f32x4){0.f, 0.f, 0.f, 0.f};
    gemm_kloop_big<true>(U + (size_t)mt * 256 * 1024, 1024, W + (size_t)nt * 256 * 1024, 1024, 1024, acc, smem, true);
    int v2 = v + gridDim.x, mt2 = 0, nt2 = 0;
    const bool nxt = map_tile(v2, mt2, nt2);
    if (nxt) gemm_prefetch_big(U + (size_t)mt2 * 256 * 1024, 1024, W + (size_t)nt2 * 256 * 1024, 1024, smem);
    const int tid = g_tid(), lane = tid & 63, wid = __builtin_amdgcn_readfirstlane(tid >> 6), wm = wid >> 2, wn = wid & 3, fq = lane >> 4, fr = lane & 15;
#pragma unroll
    for (int mi = 0; mi < 8; ++mi) {
      float o[8];
#pragma unroll
      for (int h2 = 0; h2 < 2; ++h2) {
        const f32x4 g = acc[mi][h2], u = acc[mi][2 + h2];
#pragma unroll
        for (int j = 0; j < 4; ++j) o[4 * h2 + j] = g[j] * sigmoidf_(g[j]) * u[j];
      }
      *(u32x4*)(H + (size_t)(mt * 256 + wm * 128 + mi * 16 + fr) * DFF + (nt * 4 + wn) * 32 + 8 * fq) = (u32x4){pk2(o[0], o[1]), pk2(o[2], o[3]), pk2(o[4], o[5]), pk2(o[6], o[7])};
    }
    v = v2; mt = mt2; nt = nt2; cur = nxt;
  }
}

struct InprojSched {
  const char* U; const char* W; int nsupA, nsup, vmax, grid, bid; bool fill;
  DI static bool transposed(int nt) { return (nt >= 4 && nt < 8) || (nt >= 12 && nt < 16); }
  DI bool next(int i, pg8::Unit& u) const {
    const int v = bid + i * grid;
    if (v >= vmax) return false;
    const int c = v >> 8, w = v & 255, local = w >> 3, sup = (c * 8 + (w & 7)) * 2 + (local >> 4);
    if (sup >= nsup) return false;
    if (sup < nsupA) { u.pm = (sup / 9) * 8 + (local & 7); u.pn = (sup % 9) * 2 + ((local >> 3) & 1); }
    else if (fill) { const int q = (sup - nsupA) * 16 + (local & 15); u.pm = q >> 2; u.pn = 18 + (q & 3); }
    else { u.pm = 64 + (local & 7); u.pn = (sup - nsupA) * 2 + ((local >> 3) & 1); }
    return true;
  }
  DI const char* pa(const pg8::Unit& u) const { return transposed(u.pn) ? W + (size_t)u.pn * 256 * 1024 * 2 : U + (size_t)u.pm * 256 * 1024 * 2; }
  DI const char* pb(const pg8::Unit& u) const { return transposed(u.pn) ? U + (size_t)u.pm * 256 * 1024 * 2 : W + (size_t)u.pn * 256 * 1024 * 2; }
};
struct InprojEpi {
  bf16_t *KB, *VT, *QB, *CQ, *ZT, *ZTC, *R; unsigned char* G8; const float *ropec, *ropes;
  DI void operator()(const f32x4 (&acc)[2][2][4][2], const pg8::Unit& u, int wr, int wc, int fr, int fq) const {
    const int mt = u.pm, nt = u.pn, m0 = mt * 256;
    int b, pos0; bool isctx; row_info(m0, b, pos0, isctx);
    if (nt < 4 || (nt >= 8 && nt < 12)) {
      const bool isq = nt >= 8; const int map = wc >> 1, axis = wc & 1;
      const float sc = isq ? QSCALE : 1.0f;
#pragma unroll
      for (int ai = 0; ai < 2; ++ai)
#pragma unroll
        for (int m = 0; m < 4; ++m) {
          const int pos = pos0 + 128 * ai + 64 * wr + 16 * m + fr;
          f32x4 cs = {1.f, 1.f, 1.f, 1.f}, sn = {0.f, 0.f, 0.f, 0.f};
          if (!isctx) { cs = *(const f32x4*)(ropec + pos * 32 + axis * 16 + fq * 4); sn = *(const f32x4*)(ropes + pos * 32 + axis * 16 + fq * 4); }
#pragma unroll
          for (int bj = 0; bj < 2; ++bj) {
            const int h = (nt * 2 + bj) & 7;
            const f32x4 x0 = acc[ai][bj][m][0], x1 = acc[ai][bj][m][1];
            const f32x4 o0 = (x0 * cs - x1 * sn) * sc, o1 = (x1 * cs + x0 * sn) * sc;
            bf16_t* dst;
            if (!isq) dst = KB + ((size_t)((b * 8 + h) * 2 + map) * NKEY + (isctx ? SEQ + pos : pos)) * 64;
            else if (!isctx) dst = QB + ((size_t)((b * 8 + h) * 2 + map) * SEQ + pos) * 64;
            else dst = CQ + ((size_t)((b * 8 + h) * 2 + map) * LC + pos) * 64;
            *(u32x2*)(dst + axis * 32 + fq * 4) = (u32x2){pk2(o0[0], o0[1]), pk2(o0[2], o0[3])};
            *(u32x2*)(dst + axis * 32 + 16 + fq * 4) = (u32x2){pk2(o1[0], o1[1]), pk2(o1[2], o1[3])};
          }
        }
    } else if (nt < 8 || (nt >= 12 && nt < 16)) {
      const bool isv = nt < 8;
#pragma unroll
      for (int ai = 0; ai < 2; ++ai)
#pragma unroll
        for (int m = 0; m < 4; ++m) {
          const int ncol = nt * 256 + 128 * ai + 64 * wr + 16 * m + fr;
#pragma unroll
          for (int bj = 0; bj < 2; ++bj)
#pragma unroll
            for (int n = 0; n < 2; ++n) {
              const int pos = pos0 + 128 * bj + 32 * wc + 16 * n + 4 * fq;
              const f32x4 vv = acc[ai][bj][m][n];
              bf16_t* dst;
              if (isv) {
                const int vg = ncol - 1024, h = vg >> 7, vcol = vg & 127;
                const int key = (isctx ? SEQ : 0) + pos, k15 = key & 15;
                const int pkey = (key & ~15) | (k15 & 3) | ((k15 & 4) << 1) | ((k15 & 8) >> 1);
                dst = VT + ((size_t)(b * 8 + h) * 128 + vcol) * NKEY + pkey;
              } else {
                const int zc = ncol - 3072, np = zc & 511, second = zc >> 9;
                dst = isctx ? (ZTC + ((size_t)b * 512 + np) * 512 + second * 256 + pos) : (ZT + ((size_t)b * 512 + np) * 4096 + second * 2048 + pos);
              }
              *(u32x2*)dst = (u32x2){pk2(vv[0], vv[1]), pk2(vv[2], vv[3])};
            }
        }
    } else if (nt >= 18) {
#pragma unroll
      for (int ai = 0; ai < 2; ++ai)
#pragma unroll
        for (int m = 0; m < 4; ++m) {
          const int row = m0 + 128 * ai + 64 * wr + 16 * m + fr;
#pragma unroll
          for (int bj = 0; bj < 2; ++bj)
#pragma unroll
            for (int n = 0; n < 2; ++n) {
              const int col = nt * 256 + 128 * bj + 32 * wc + 16 * n + 4 * fq - 4608;
              const f32x4 vv = acc[ai][bj][m][n];
              unsigned w = 0;
#pragma unroll
              for (int j = 0; j < 4; ++j) w |= (unsigned)__builtin_rintf(sigmoidf_(vv[j]) * 255.0f) << (8 * j);
              *(unsigned*)(G8 + (size_t)row * 1024 + col) = w;
            }
        }
    } else {
#pragma unroll
      for (int ai = 0; ai < 2; ++ai)
#pragma unroll
        for (int m = 0; m < 4; ++m) {
          const int row = m0 + 128 * ai + 64 * wr + 16 * m + fr;
#pragma unroll
          for (int bj = 0; bj < 2; ++bj)
#pragma unroll
            for (int n = 0; n < 2; ++n) {
              const int col = nt * 256 + 128 * bj + 32 * wc + 16 * n + 4 * fq - 4096;
              const f32x4 vv = acc[ai][bj][m][n];
              *(u32x2*)(R + (size_t)row * 512 + col) = (u32x2){pk2(vv[0], vv[1]), pk2(vv[2], vv[3])};
            }
        }
    }
  }
};
DI void phase_inproj8(const Params& p, int l, char* smem) {
  const bool last = (l == DEPTH - 1);
  InprojSched S;
  S.U = (const char*)(p.ws + OFF_U); S.W = (const char*)((const bf16_t*)(p.ws + w_off(l)) + WO_WIN);
  S.nsupA = last ? 72 : 81; S.nsup = last ? 76 : 96; S.fill = !last;
  S.vmax = ((S.nsup + 15) >> 4) << 8; S.grid = gridDim.x; S.bid = blockIdx.x;
  InprojEpi E;
  E.KB = (bf16_t*)(p.ws + OFF_KB); E.VT = (bf16_t*)(p.ws + OFF_VT); E.QB = (bf16_t*)(p.ws + OFF_QB); E.CQ = (bf16_t*)(p.ws + OFF_CQ);
  E.ZT = (bf16_t*)(p.ws + OFF_ZT); E.ZTC = (bf16_t*)(p.ws + OFF_ZTC); E.R = (bf16_t*)(p.ws + OFF_R);
  E.ropec = (const float*)(p.ws + OFF_ROPEC); E.ropes = (const float*)(p.ws + OFF_ROPES); E.G8 = (unsigned char*)(p.ws + OFF_G8);
  pg8::gemm_phase(( __attribute__((address_space(3))) unsigned char*)(lds_ptr_t)smem, 1024, S, E);
}
struct Ffn1Sched {
  const char* U; const char* W; int nsup, vmax, grid, bid;
  DI bool next(int i, pg8::Unit& u) const {
    const int v = bid + i * grid;
    if (v >= vmax) return false;
    const int c = v >> 8, w = v & 255, local = w >> 3, sup = (c * 8 + (w & 7)) * 2 + (local >> 4);
    if (sup >= nsup) return false;
    u.pm = (sup / 11) * 8 + (local & 7); u.pn = (sup % 11) * 2 + ((local >> 3) & 1);
    return true;
  }
  DI const char* pa(const pg8::Unit& u) const { return U + (size_t)u.pm * 256 * 1024 * 2; }
  DI const char* pb(const pg8::Unit& u) const { return W + (size_t)u.pn * 256 * 1024 * 2; }
};
struct Ffn1Epi {
  bf16_t* H;
  DI void operator()(const f32x4 (&acc)[2][2][4][2], const pg8::Unit& u, int wr, int wc, int fr, int fq) const {
#pragma unroll
    for (int ai = 0; ai < 2; ++ai)
#pragma unroll
      for (int m = 0; m < 4; ++m) {
        const int row = u.pm * 256 + 128 * ai + 64 * wr + 16 * m + fr;
#pragma unroll
        for (int bj = 0; bj < 2; ++bj) {
          const f32x4 g = acc[ai][bj][m][0], up = acc[ai][bj][m][1];
          float o[4];
#pragma unroll
          for (int j = 0; j < 4; ++j) o[j] = g[j] * sigmoidf_(g[j]) * up[j];
          *(u32x2*)(H + (size_t)row * DFF + u.pn * 128 + (bj * 4 + wc) * 16 + fq * 4) = (u32x2){pk2(o[0], o[1]), pk2(o[2], o[3])};
        }
      }
  }
};
DI void phase_ffn18(const Params& p, int l, char* smem) {
  const bool last = (l == DEPTH - 1);
  Ffn1Sched S;
  S.U = (const char*)(p.ws + OFF_U); S.W = (const char*)((const bf16_t*)(p.ws + w_off(l)) + WO_WGU);
  S.nsup = (last ? 8 : 9) * 11; S.vmax = ((S.nsup + 15) >> 4) << 8; S.grid = gridDim.x; S.bid = blockIdx.x;
  Ffn1Epi E; E.H = (bf16_t*)(p.ws + OFF_H);
  pg8::gemm_phase((__attribute__((address_space(3))) unsigned char*)(lds_ptr_t)smem, 1024, S, E);
  if (!last) convert_grab(p, l + 1, 1, smem);
}

#define XB_TMO      128
#define XB_XCNT(j)  (256  + 64 * (j))
#define XB_XSUB(j)  (1280 + 64 * (j))
#define XB_XGEN(j)  (2304 + 64 * (j))
#define XB_TOP      3328
#define XB_TOPGEN   3392
#define XCD_BAR_WORDS 3456
#define XB_SPIN_CAP (1u << 20)
#define LAS __attribute__((address_space(3)))
DI unsigned xb_ld(unsigned* p) { return __hip_atomic_load(p, __ATOMIC_RELAXED, __HIP_MEMORY_SCOPE_AGENT); }
DI unsigned xb_add(unsigned* p, unsigned v) { return __hip_atomic_fetch_add(p, v, __ATOMIC_RELAXED, __HIP_MEMORY_SCOPE_AGENT); }
DI unsigned xb_xcc_id() { return (unsigned)__builtin_amdgcn_s_getreg((3 << 11) | 20) & 0xFu; }
#define XB_SPIN(cond, bar) do { unsigned _sp = 0; while (cond) { __builtin_amdgcn_s_sleep(1); \
    if ((++_sp & 255u) == 0u) { if (xb_ld(&(bar)[XB_TMO])) break; if (_sp > XB_SPIN_CAP) { atomicAdd(&(bar)[XB_TMO], 1u); break; } } } } while (0)
struct XcdBarrier { unsigned* bar; unsigned x; volatile LAS unsigned* st; };
DI XcdBarrier xcd_barrier_post(unsigned* bar, volatile LAS unsigned* st) {
  XcdBarrier b; b.bar = bar; b.x = xb_xcc_id(); b.st = st;
  if (__builtin_amdgcn_workitem_id_x() == 0) (void)xb_add(&bar[XB_XCNT(b.x)], 1u);
  return b;
}
DI void xcd_barrier_complete(unsigned* bar, unsigned x, unsigned& nloc, unsigned& nx) {
  const unsigned G = gridDim.x * gridDim.y * gridDim.z;
  unsigned sum, cnt, mine, sp = 0u;
  for (;;) {
    sum = 0u; cnt = 0u; mine = 0u;
#pragma unroll
    for (unsigned j = 0; j < 16; ++j) { const unsigned c = xb_ld(&bar[XB_XCNT(j)]); sum += c; cnt += (c > 0u) ? 1u : 0u; mine = (j == x) ? c : mine; }
    if (sum == G) break;
    __builtin_amdgcn_s_sleep(1);
    if ((++sp & 255u) == 0u) { if (xb_ld(&bar[XB_TMO])) break; if (sp > XB_SPIN_CAP) { atomicAdd(&bar[XB_TMO], 1u); break; } }
  }
  nloc = mine > 0u ? mine : 1u; nx = cnt > 0u ? cnt : 1u;
}
DI void xcd_barrier(const XcdBarrier& b) {
  asm volatile("s_waitcnt vmcnt(0)" ::: "memory");
  __syncthreads();
  if (__builtin_amdgcn_workitem_id_x() == 0) {
    unsigned* bar = b.bar;
    __builtin_amdgcn_s_waitcnt(0);
    unsigned nloc = b.st[0], nx = b.st[1];
    if (nloc == 0u) { xcd_barrier_complete(bar, b.x, nloc, nx); b.st[0] = nloc; b.st[1] = nx; }
    const unsigned old = xb_add(&bar[XB_XSUB(b.x)], 1u);
    const unsigned gen = old / nloc;
    if (old + 1u == (gen + 1u) * nloc) {
      __builtin_amdgcn_fence(__ATOMIC_RELEASE, "agent");
      asm volatile("s_waitcnt vmcnt(0)" ::: "memory");
      const unsigned og = xb_add(&bar[XB_TOP], 1u);
      const unsigned tg = og / nx;
      if (og + 1u == (tg + 1u) * nx) xb_add(&bar[XB_TOPGEN], 1u);
      else XB_SPIN(xb_ld(&bar[XB_TOPGEN]) == tg, bar);
      __builtin_amdgcn_fence(__ATOMIC_ACQUIRE, "agent");
      xb_add(&bar[XB_XGEN(b.x)], 1u);
      asm volatile("s_waitcnt vmcnt(0)" ::: "memory");
    } else {
      XB_SPIN(xb_ld(&bar[XB_XGEN(b.x)]) == gen, bar);
      __builtin_amdgcn_fence(__ATOMIC_ACQUIRE, "agent");
      asm volatile("s_waitcnt vmcnt(0)" ::: "memory");
    }
  }
  __syncthreads();
}

#define REP_MASK 0
#define REP_PRO 0
__global__ void __launch_bounds__(512) mega(Params p0) {
  extern __shared__ __attribute__((aligned(16))) char smem[];
  cg::grid_group grid = cg::this_grid();
  volatile LAS unsigned* xst = (volatile LAS unsigned*)(lds_ptr_t)(smem + 3 * GSTAGE);
  if (__builtin_amdgcn_workitem_id_x() < 4) xst[__builtin_amdgcn_workitem_id_x()] = 0u;
  __syncthreads();
  const XcdBarrier xb = xcd_barrier_post((unsigned*)(p0.ws + OFF_BAR), xst);
  for (int ph = p0.ph_begin; ph < p0.ph_end; ++ph) {
    const Params& p = p0;
    const bf16_t* Wl = (const bf16_t*)(p.ws + w_off(ph >= 2 ? (ph - 2) >> 3 : 0));
    if (ph == 0) { phase0a(p, smem); if (REP_PRO & 1) { xcd_barrier(xb); phase0a(p, smem); } }
    else if (ph == 1) { ln_pass(p, 0, T_ALL, nullptr, nullptr, nullptr, 0, 0, 0, 0); if (REP_PRO & 2) { xcd_barrier(xb); ln_pass(p, 0, T_ALL, nullptr, nullptr, nullptr, 0, 0, 0, 0); } }
    else {
      const int l = (ph - 2) >> 3, s = (ph - 2) & 7;
      const bool last = (l == DEPTH - 1);
      const int nmt = last ? 64 : 72, nrows = last ? T_LAT : T_ALL;
      for (int rep = 0; rep < 1 + ((REP_MASK >> s) & 1); ++rep) {
      if (rep) xcd_barrier(xb);
      switch (s) {
        case 0: phase_inproj8(p, l, smem); break;
        case 1: phase_mix(p, l, smem); if (!last) convert_grab(p, l + 1, 0, smem); break;
        case 2: if (last) phase_branch<4>(p, l, smem); else { phase_branch<3>(p, l, smem); convert_grab(p, l + 1, 0, smem); } break;
        case 3: if (last) phase_gemm_plain<4>((const bf16_t*)(p.ws + OFF_MOUT), 1024, Wl + WO_WO, (bf16_t*)(p.ws + OFF_Y), 64, 8, smem);
                else phase_gemm_plain<3>((const bf16_t*)(p.ws + OFF_MOUT), 1024, Wl + WO_WO, (bf16_t*)(p.ws + OFF_Y), 96, 8, smem);
                break;
        case 4: ln_pass(p, 1, nrows, (const bf16_t*)(p.ws + OFF_Y), p.ln1_g + (size_t)l * 1024, p.ln1_b + (size_t)l * 1024, l, 2, l, 3); break;
        case 5: phase_ffn18(p, l, smem); break;
        case 6: if (last) phase_gemm_plain<4>((const bf16_t*)(p.ws + OFF_H), DFF, Wl + WO_WD, (bf16_t*)(p.ws + OFF_FO), 64, 8, smem);
                else phase_gemm_plain<3>((const bf16_t*)(p.ws + OFF_H), DFF, Wl + WO_WD, (bf16_t*)(p.ws + OFF_FO), 96, 8, smem);
                break;
        default:
          ln_pass(p, last ? 2 : 1, nrows, (const bf16_t*)(p.ws + OFF_FO), p.ln2_g + (size_t)l * 1024, p.ln2_b + (size_t)l * 1024, l, 5, last ? l : l + 1, 0);
          if (!last) { convert_grab(p, l + 1, 0, smem); convert_grab(p, l + 1, 1, smem); }
          break;
      }
      }
    }
    if (ph + 1 < p0.ph_end) { if (ph == p0.ph_begin) grid.sync(); else xcd_barrier(xb); }
  }
}

extern "C" void kernel_launch(void* const* d_in, const int* in_sizes, int n_in, void* d_out, int out_size, void* d_ws, size_t ws_size, hipStream_t stream) {
  constexpr size_t kDynLds = 3 * GSTAGE + 16;
  static int grid_blocks = 0;
  if (!grid_blocks) {
    int dev = 0, cus = 0, per_cu = 0;
    (void)hipGetDevice(&dev);
    (void)hipDeviceGetAttribute(&cus, hipDeviceAttributeMultiprocessorCount, dev);
    (void)hipFuncSetAttribute((const void*)mega, hipFuncAttributeMaxDynamicSharedMemorySize, (int)kDynLds);
    (void)hipOccupancyMaxActiveBlocksPerMultiprocessor(&per_cu, mega, 512, kDynLds);
    if (per_cu > 1) per_cu = 1;
    if (per_cu < 1) per_cu = 1;
    grid_blocks = cus * per_cu;
  }
  if (ws_size < WS_NEED) { fprintf(stderr, "workspace too small: %zu < %zu\n", ws_size, (size_t)WS_NEED); return; }
  (void)hipMemsetAsync((char*)d_ws + OFF_BAR, 0, XCD_BAR_WORDS * 4 + 64, stream);
  Params p;
  memset(&p, 0, sizeof(p));
  const float** fp = (const float**)&p;
  for (int i = 0; i < 22; ++i) fp[i] = (const float*)d_in[i];
  p.out = (float*)d_out;
  p.ws = (char*)d_ws;
  for (int l = 0; l < 4; ++l) p.lam_init[l] = (float)(0.8 - 0.6 * exp(-0.3 * l));
  p.ph_begin = 0; p.ph_end = 2 + 8 * DEPTH;
  void* args[] = {&p};
  hipError_t e = hipLaunchCooperativeKernel((void*)mega, dim3(grid_blocks), dim3(512), args, kDynLds, stream);
  if (e != hipSuccess) fprintf(stderr, "cooperative launch failed: %s (grid %d)\n", hipGetErrorString(e), grid_blocks);
}
```

```cpp
#include <hip/hip_runtime.h>
#include <hip/hip_cooperative_groups.h>
#include <cstdio>
#include <cstdint>
#include <cstring>
#include <cmath>
namespace cg = cooperative_groups;

#define DI __device__ __forceinline__
typedef unsigned short bf16_t;
typedef short bf16x8 __attribute__((ext_vector_type(8)));
typedef float f32x4 __attribute__((ext_vector_type(4)));
typedef float f32x2 __attribute__((ext_vector_type(2)));
typedef float f32x16 __attribute__((ext_vector_type(16)));
typedef unsigned u32x2 __attribute__((ext_vector_type(2)));
typedef unsigned u32x4 __attribute__((ext_vector_type(4)));
typedef __bf16 bf16x2_t __attribute__((ext_vector_type(2)));

constexpr int D = 1024, NB = 8, SEQ = 2048, LC = 256, NH = 8, DEPTH = 4;
constexpr int T_LAT = NB * SEQ, T_CTX = NB * LC, T_ALL = T_LAT + T_CTX;
constexpr int NKEY = SEQ + LC;
constexpr int N_IN = 7168, DFF = 2816;
constexpr int WIN_ROWS = 7680;
constexpr int ROW_Z1 = 3072, ROW_Z2 = 3584, ROW_R = 4096, ROW_G = 4608;
constexpr float ALPHA = 1.6817928305074290f;
constexpr float LN_EPS = 1e-5f;
constexpr float QSCALE = 0.125f * 1.4426950408889634f;

constexpr size_t WO_WIN = 0;
constexpr size_t WO_WA = WO_WIN + (size_t)WIN_ROWS * 1024;
constexpr size_t WO_WF = WO_WA + 1024 * 1024;
constexpr size_t WO_WP = WO_WF + 1024 * 512;
constexpr size_t WO_WO = WO_WP + 1024 * 512;
constexpr size_t WO_WGU = WO_WO + 1024 * 1024;
constexpr size_t WO_WD = WO_WGU + (size_t)5632 * 1024;
constexpr size_t W_ELEMS = WO_WD + (size_t)1024 * DFF;

constexpr size_t al256(size_t x) { return (x + 255) & ~(size_t)255; }
constexpr size_t OFF_W = 0;
constexpr size_t OFF_ATAB = al256(OFF_W + W_ELEMS * 2);
constexpr size_t OFF_ATABC = al256(OFF_ATAB + (size_t)2048 * 4096 * 2);
constexpr size_t OFF_ROPEC = al256(OFF_ATABC + (size_t)256 * 512 * 2);
constexpr size_t OFF_ROPES = al256(OFF_ROPEC + (size_t)2048 * 32 * 4);
constexpr size_t OFF_MODV = al256(OFF_ROPES + (size_t)2048 * 32 * 4);
constexpr size_t OFF_LAMV = al256(OFF_MODV + (size_t)DEPTH * 9 * 6144 * 4);
constexpr size_t OFF_X = al256(OFF_LAMV + 256);
constexpr size_t OFF_U = al256(OFF_X + (size_t)T_ALL * 1024 * 4);
constexpr size_t OFF_KB = al256(OFF_U + (size_t)T_ALL * 1024 * 2);
constexpr size_t OFF_VT = al256(OFF_KB + (size_t)NB * NH * 2 * NKEY * 64 * 2);
constexpr size_t OFF_QB = al256(OFF_VT + (size_t)NB * NH * 128 * NKEY * 2);
constexpr size_t OFF_CQ = al256(OFF_QB + (size_t)NB * NH * 2 * SEQ * 64 * 2);
constexpr size_t OFF_ZT = al256(OFF_CQ + (size_t)NB * NH * 2 * LC * 64 * 2);
constexpr size_t OFF_ZTC = al256(OFF_ZT + (size_t)NB * 512 * 4096 * 2);
constexpr size_t OFF_R = al256(OFF_ZTC + (size_t)NB * 512 * 512 * 2);
constexpr size_t OFF_ATT = al256(OFF_R + (size_t)T_ALL * 512 * 2);
constexpr size_t OFF_FM = al256(OFF_ATT + (size_t)T_ALL * 1024 * 2);
constexpr size_t OFF_PM = al256(OFF_FM + (size_t)T_ALL * 512 * 2);
constexpr size_t OFF_BAR = al256(OFF_PM + (size_t)T_ALL * 512 * 2);
constexpr size_t OFF_CTR = OFF_BAR + 3456 * 4;
constexpr size_t OFF_W2 = al256(OFF_CTR + 64);
constexpr size_t OFF_G8 = al256(OFF_W2 + W_ELEMS * 2);
constexpr int G8_ROWS = 15360;
constexpr size_t WS_NEED = al256(OFF_G8 + (size_t)G8_ROWS * 1024);
constexpr size_t OFF_MOUT = OFF_KB;
constexpr size_t OFF_Y = OFF_VT;
constexpr size_t OFF_H = OFF_KB;
constexpr size_t OFF_FO = OFF_ATT;
static_assert((size_t)T_ALL * DFF * 2 <= OFF_CQ - OFF_KB, "H overlay too large");

struct Params {
  const float *x, *c, *ctx, *c_ctx, *w_mod, *b_mod, *w_in, *lam_qk, *subln_g, *w_att_br, *w_four_br, *w_pool_grp, *pool_scale,
      *w_pool_br, *w_out, *ln1_g, *ln1_b, *w_ffn_gate, *w_ffn_up, *w_ffn_down, *ln2_g, *ln2_b;
  float* out;
  char* ws;
  float lam_init[4];
  int ph_begin, ph_end;
};

DI size_t w_off(int l) { return (l & 1) ? OFF_W2 : OFF_W; }
DI int g_tid() { int t = __builtin_amdgcn_workitem_id_x(); asm volatile("" : "+v"(t)); return t; }
DI unsigned pk2(float a, float b) { f32x2 v = {a, b}; bf16x2_t r = __builtin_convertvector(v, bf16x2_t); return __builtin_bit_cast(unsigned, r); }
DI float bf_lo(unsigned u) { return __uint_as_float(u << 16); }
DI float bf_hi(unsigned u) { return __uint_as_float(u & 0xffff0000u); }
DI float hw_cos_rev(float r) { return __builtin_amdgcn_cosf(r); }
DI float hw_sin_rev(float r) { return __builtin_amdgcn_sinf(r); }
DI float sigmoidf_(float x) { return 1.0f / (1.0f + __expf(-x)); }
DI float xor32_sum(float v) { const auto r = __builtin_amdgcn_permlane32_swap(__float_as_uint(v), __float_as_uint(v), false, false); return __uint_as_float(r[0]) + __uint_as_float(r[1]); }
DI float xor32_max(float v) { const auto r = __builtin_amdgcn_permlane32_swap(__float_as_uint(v), __float_as_uint(v), false, false); return fmaxf(__uint_as_float(r[0]), __uint_as_float(r[1])); }
DI float dpp_add(float v, int) { return v; }
#define DPP_ADD(v, ctrl) ((v) + __uint_as_float(__builtin_amdgcn_update_dpp(0u, __float_as_uint(v), (ctrl), 0xF, 0xF, true)))
DI float wave_sum(float v) {
  v = DPP_ADD(v, 0xB1);
  v = DPP_ADD(v, 0x4E);
  v = DPP_ADD(v, 0x141);
  v = DPP_ADD(v, 0x140);
  { const auto r = __builtin_amdgcn_permlane16_swap(__float_as_uint(v), __float_as_uint(v), false, false); v = __uint_as_float(r[0]) + __uint_as_float(r[1]); }
  return xor32_sum(v);
}
#define MFMA16(a, b, c) __builtin_amdgcn_mfma_f32_16x16x32_bf16((a), (b), (c), 0, 0, 0)
#define MFMA32(a, b, c) __builtin_amdgcn_mfma_f32_32x32x16_bf16((a), (b), (c), 0, 0, 0)

constexpr int GSTAGE = 49152;
#define WAIT_VM(n) asm volatile("s_waitcnt vmcnt(" #n ")" ::: "memory")
typedef __attribute__((address_space(3))) void* lds_ptr_t;
template <bool SWAP, int MI = 4>
DI void gemm_kloop(const bf16_t* __restrict__ A, int lda, const bf16_t* __restrict__ B, int ldb, int K, f32x4 (&acc)[MI][4], char* smem, bool pre = false  ) {
  const int tid = g_tid(), lane = tid & 63, wid = __builtin_amdgcn_readfirstlane(tid >> 6), wm = wid >> 1, wn = wid & 1;
  const int lr = tid >> 3, lc = (tid & 7) ^ ((tid >> 4) & 7);
  const unsigned aoff = (unsigned)(lr * lda + lc * 8) * 2u, boff = (unsigned)(lr * ldb + lc * 8) * 2u;
  const char* Ac = (const char*)A; const char* Bc = (const char*)B;
  const int fr = lane & 15, fq = lane >> 4, sw = fr >> 1;
  const int a_base = (wm * 16 * MI + fr) * 128, b_base = 32768 + (wn * 64 + fr) * 128;
  const int nk = K >> 6;
  char* sdst = smem + tid * 16;
#define G_ISSUE(KT, ST) do { _Pragma("unroll") for (int i = 0; i < MI; ++i) \
      __builtin_amdgcn_global_load_lds((const void*)(Ac + ((size_t)(64 * i) * lda + (size_t)(KT) * 64) * 2 + aoff), (lds_ptr_t)(sdst + (ST) * GSTAGE + i * 8192), 16, 0, 0); \
    _Pragma("unroll") for (int i = 0; i < 2; ++i) \
      __builtin_amdgcn_global_load_lds((const void*)(Bc + ((size_t)(64 * i) * ldb + (size_t)(KT) * 64) * 2 + boff), (lds_ptr_t)(sdst + (ST) * GSTAGE + 32768 + i * 8192), 16, 0, 0); } while (0)
#define G_COMPUTE(ST) do { const char* st_ = smem + (ST) * GSTAGE; \
    _Pragma("unroll") for (int ks = 0; ks < 2; ++ks) { const int co = ((ks * 4 + fq) ^ sw) << 4; bf16x8 af[MI], bfr[4]; \
      _Pragma("unroll") for (int i = 0; i < 4; ++i) bfr[i] = *(const bf16x8*)(st_ + b_base + i * 2048 + co); \
      _Pragma("unroll") for (int i = 0; i < MI; ++i) af[i] = *(const bf16x8*)(st_ + a_base + i * 2048 + co); \
      _Pragma("unroll") for (int mi = 0; mi < MI; ++mi) _Pragma("unroll") for (int ni = 0; ni < 4; ++ni) { \
          if (SWAP) acc[mi][ni] = MFMA16(bfr[ni], af[mi], acc[mi][ni]); else acc[mi][ni] = MFMA16(af[mi], bfr[ni], acc[mi][ni]); } } } while (0)
  if (!pre) { G_ISSUE(0, 0); G_ISSUE(1, 1); }
  int st = 0;
  for (int t = 0; t < nk; ++t) {
    if (t == 0 || t + 1 >= nk) WAIT_VM(0);
    else if (MI == 4) WAIT_VM(6); else WAIT_VM(5);
    __builtin_amdgcn_s_barrier();
    asm volatile("" ::: "memory");
    const int st2 = (st == 0) ? 2 : st - 1;
    if (t + 2 < nk) G_ISSUE(t + 2, st2);
    __builtin_amdgcn_sched_barrier(0);
    G_COMPUTE(st);
    __builtin_amdgcn_sched_group_barrier(0x100, 6, 0);
#pragma unroll
    for (int i_ = 0; i_ < 2 * MI + 2; ++i_) { __builtin_amdgcn_sched_group_barrier(0x008, 2, 0); __builtin_amdgcn_sched_group_barrier(0x100, 1, 0); }
    __builtin_amdgcn_sched_group_barrier(0x008, 4 * MI - 4, 0);
    __builtin_amdgcn_sched_barrier(0);
    st = (st == 2) ? 0 : st + 1;
  }
  asm volatile("s_waitcnt lgkmcnt(0)" ::: "memory");
  __builtin_amdgcn_s_barrier();
  asm volatile("" ::: "memory");
#undef G_ISSUE
#undef G_COMPUTE
}
template <bool SWAP, int MI = 4>
DI void gemm_kloop_pp(const bf16_t* __restrict__ A, int lda, const bf16_t* __restrict__ B, int ldb, int K, f32x4 (&acc)[MI][4], char* smem) {
  const int tid = g_tid(), lane = tid & 63, wid = __builtin_amdgcn_readfirstlane(tid >> 6), wm = wid >> 1, wn = wid & 1, grp = wid >> 2;
  const int lr = tid >> 3, lc = (tid & 7) ^ ((tid >> 4) & 7);
  const unsigned aoff = (unsigned)(lr * lda + lc * 8) * 2u, boff = (unsigned)(lr * ldb + lc * 8) * 2u;
  const char* Ac = (const char*)A; const char* Bc = (const char*)B;
  const int fr = lane & 15, fq = lane >> 4, sw = fr >> 1;
  const int a_base = (wm * 16 * MI + fr) * 128, b_base = 32768 + (wn * 64 + fr) * 128;
  const int nk = K >> 6;
  char* sdst = smem + tid * 16;
#define P_ISSUE(KT, ST) do { _Pragma("unroll") for (int i = 0; i < MI; ++i) \
      __builtin_amdgcn_global_load_lds((const void*)(Ac + ((size_t)(64 * i) * lda + (size_t)(KT) * 64) * 2 + aoff), (lds_ptr_t)(sdst + (ST) * GSTAGE + i * 8192), 16, 0, 0); \
    _Pragma("unroll") for (int i = 0; i < 2; ++i) \
      __builtin_amdgcn_global_load_lds((const void*)(Bc + ((size_t)(64 * i) * ldb + (size_t)(KT) * 64) * 2 + boff), (lds_ptr_t)(sdst + (ST) * GSTAGE + 32768 + i * 8192), 16, 0, 0); } while (0)
  P_ISSUE(0, 0);
  P_ISSUE(1, 1);
  WAIT_VM(0);
  __builtin_amdgcn_s_barrier();
  asm volatile("" ::: "memory");
  if (grp == 1) { __builtin_amdgcn_s_barrier(); asm volatile("" ::: "memory"); }
  int st = 0;
  for (int t = 0; t < nk; ++t) {
    const int st2 = (st == 0) ? 2 : st - 1;
    if (t + 2 < nk) P_ISSUE(t + 2, st2);
    bf16x8 af[2][MI], bfr[2][4];
    const char* st_ = smem + st * GSTAGE;
#pragma unroll
    for (int ks = 0; ks < 2; ++ks) {
      const int co = ((ks * 4 + fq) ^ sw) << 4;
#pragma unroll
      for (int i = 0; i < 4; ++i) bfr[ks][i] = *(const bf16x8*)(st_ + b_base + i * 2048 + co);
#pragma unroll
      for (int i = 0; i < MI; ++i) af[ks][i] = *(const bf16x8*)(st_ + a_base + i * 2048 + co);
    }
    if (t + 2 < nk) { if (MI == 4) WAIT_VM(6); else WAIT_VM(5); } else WAIT_VM(0);
    asm volatile("s_waitcnt lgkmcnt(0)" ::: "memory");
    __builtin_amdgcn_sched_barrier(0);
    __builtin_amdgcn_s_barrier();
    asm volatile("" ::: "memory");
#pragma unroll
    for (int ks = 0; ks < 2; ++ks)
#pragma unroll
      for (int mi = 0; mi < MI; ++mi)
#pragma unroll
        for (int ni = 0; ni < 4; ++ni) {
          if (SWAP) acc[mi][ni] = MFMA16(bfr[ks][ni], af[ks][mi], acc[mi][ni]); else acc[mi][ni] = MFMA16(af[ks][mi], bfr[ks][ni], acc[mi][ni]);
        }
    __builtin_amdgcn_sched_barrier(0);
    __builtin_amdgcn_s_barrier();
    asm volatile("" ::: "memory");
    st = (st == 2) ? 0 : st + 1;
  }
  if (grp == 0) { __builtin_amdgcn_s_barrier(); asm volatile("" ::: "memory"); }
#undef P_ISSUE
}

template <int MI>
DI void gemm_prefetch(const bf16_t* __restrict__ A, int lda, const bf16_t* __restrict__ B, int ldb, char* smem) {
  const int tid = g_tid();
  const int lr = tid >> 3, lc = (tid & 7) ^ ((tid >> 4) & 7);
  const unsigned aoff = (unsigned)(lr * lda + lc * 8) * 2u, boff = (unsigned)(lr * ldb + lc * 8) * 2u;
  const char* Ac = (const char*)A; const char* Bc = (const char*)B;
  char* sdst = smem + tid * 16;
#pragma unroll
  for (int kt = 0; kt < 2; ++kt) {
#pragma unroll
    for (int i = 0; i < MI; ++i)
      __builtin_amdgcn_global_load_lds((const void*)(Ac + ((size_t)(64 * i) * lda + (size_t)kt * 64) * 2 + aoff), (lds_ptr_t)(sdst + kt * GSTAGE + i * 8192), 16, 0, 0);
#pragma unroll
    for (int i = 0; i < 2; ++i)
      __builtin_amdgcn_global_load_lds((const void*)(Bc + ((size_t)(64 * i) * ldb + (size_t)kt * 64) * 2 + boff), (lds_ptr_t)(sdst + kt * GSTAGE + 32768 + i * 8192), 16, 0, 0);
  }
}
template <int MI>
DI void zero_acc_t(f32x4 (&acc)[MI][4]) {
#pragma unroll
  for (int i = 0; i < MI; ++i)
#pragma unroll
    for (int j = 0; j < 4; ++j) acc[i][j] = (f32x4){0.f, 0.f, 0.f, 0.f};
}
DI void zero_acc(f32x4 (&acc)[4][4]) {
#pragma unroll
  for (int i = 0; i < 4; ++i)
#pragma unroll
    for (int j = 0; j < 4; ++j) acc[i][j] = (f32x4){0.f, 0.f, 0.f, 0.f};
}

template <bool SWAP>
DI void gemm_kloop_big(const bf16_t* __restrict__ A, int lda, const bf16_t* __restrict__ B, int ldb, int K, f32x4 (&acc)[8][4], char* smem, bool pre = false) {
  const int tid = g_tid(), lane = tid & 63, wid = __builtin_amdgcn_readfirstlane(tid >> 6), wm = wid >> 2, wn = wid & 3;
  const int lr = tid >> 3, lc = (tid & 7) ^ ((tid >> 4) & 7);
  const unsigned aoff = (unsigned)(lr * lda + lc * 8) * 2u, boff = (unsigned)(lr * ldb + lc * 8) * 2u;
  const char* Ac = (const char*)A; const char* Bc = (const char*)B;
  const int fr = lane & 15, fq = lane >> 4, sw = fr >> 1;
  const int a_base = (wm * 128 + fr) * 128, b_base = 32768 + (wn * 64 + fr) * 128;
  const int nk = K >> 6;
  char* sdst = smem + tid * 16;
#define GB_ISSUE(KT, ST) do { _Pragma("unroll") for (int i = 0; i < 4; ++i) { \
      __builtin_amdgcn_global_load_lds((const void*)(Ac + ((size_t)(64 * i) * lda + (size_t)(KT) * 64) * 2 + aoff), (lds_ptr_t)(sdst + (ST) * 65536 + i * 8192), 16, 0, 0); \
      __builtin_amdgcn_global_load_lds((const void*)(Bc + ((size_t)(64 * i) * ldb + (size_t)(KT) * 64) * 2 + boff), (lds_ptr_t)(sdst + (ST) * 65536 + 32768 + i * 8192), 16, 0, 0); } } while (0)
  if (!pre) GB_ISSUE(0, 0);
  for (int t = 0; t < nk; ++t) {
    WAIT_VM(0);
    __builtin_amdgcn_s_barrier();
    asm volatile("" ::: "memory");
    if (t + 1 < nk) GB_ISSUE(t + 1, (t + 1) & 1);
    __builtin_amdgcn_sched_barrier(0);
    const char* st_ = smem + (t & 1) * 65536;
#pragma unroll
    for (int ks = 0; ks < 2; ++ks) {
      const int co = ((ks * 4 + fq) ^ sw) << 4;
      bf16x8 af[8], bfr[4];
#pragma unroll
      for (int i = 0; i < 4; ++i) bfr[i] = *(const bf16x8*)(st_ + b_base + i * 2048 + co);
#pragma unroll
      for (int i = 0; i < 8; ++i) af[i] = *(const bf16x8*)(st_ + a_base + i * 2048 + co);
#pragma unroll
      for (int mi = 0; mi < 8; ++mi)
#pragma unroll
        for (int ni = 0; ni < 4; ++ni) {
          if (SWAP) acc[mi][ni] = MFMA16(bfr[ni], af[mi], acc[mi][ni]); else acc[mi][ni] = MFMA16(af[mi], bfr[ni], acc[mi][ni]);
        }
    }
    __builtin_amdgcn_sched_group_barrier(0x100, 8, 0);
#pragma unroll
    for (int i_ = 0; i_ < 16; ++i_) { __builtin_amdgcn_sched_group_barrier(0x008, 3, 0); __builtin_amdgcn_sched_group_barrier(0x100, 1, 0); }
    __builtin_amdgcn_sched_group_barrier(0x008, 16, 0);
    __builtin_amdgcn_sched_barrier(0);
  }
  asm volatile("s_waitcnt lgkmcnt(0)" ::: "memory");
  __builtin_amdgcn_s_barrier();
  asm volatile("" ::: "memory");
#undef GB_ISSUE
}

namespace pg8 {
#define PG8_LAS __attribute__((address_space(3)))
constexpr int BM = 256, BK = 64, HALF = 128, HTB = HALF * BK * 2;
DI int lds_byte(int r, int c) { const int st = (r >> 4) * 2 + (c >> 5), rr = r & 15, cc = c & 31, ob = rr * 64 + cc * 2; return st * 1024 + (ob ^ (((ob >> 9) & 1) << 5)); }
DI void stage_rc(int b, int& R, int& C) { const int st = b / 1024, sb = b % 1024, swz = sb ^ (((sb >> 9) & 1) << 5); R = (st >> 1) * 16 + swz / 64; C = (st & 1) * 32 + (swz % 64) / 2; }
struct Unit { int pm, pn; };
template <class Epi, class Sched>
DI void gemm_phase(PG8_LAS unsigned char* lds, int K, const Sched& S, const Epi& E) {
  const int tid = g_tid(), wid = __builtin_amdgcn_readfirstlane(tid >> 6), lane = tid & 63, wr = wid >> 2, wc = wid & 3, fr = lane & 15, fq = lane >> 4;
  const int nt = K / BK;
  unsigned voff[2];
#pragma unroll
  for (int i = 0; i < 2; ++i) { int R, C; stage_rc(tid * 16 + i * 8192, R, C); voff[i] = (unsigned)(R * K + C) * 2u; }
  const size_t kstep = (size_t)(BK * 2);
  const size_t hstep = (size_t)HALF * K * 2;
  const unsigned ldsw = (unsigned)wid * 1024u;
  const int aoff = lds_byte(wr * 64 + fr, fq * 8), boff = lds_byte(wc * 32 + fr, fq * 8);
#define PG8_SA(b, h) (((b) * 2 + (h)) * HTB)
#define PG8_SB(b, h) ((4 + (b) * 2 + (h)) * HTB)
#define PG8_STAGE(bufoff, gbase) do { _Pragma("unroll") for (int _i = 0; _i < 2; ++_i) \
    __builtin_amdgcn_global_load_lds((const void*)((const char*)(gbase) + voff[_i]), (PG8_LAS void*)(lds + (bufoff) + ldsw + _i * 8192), 16, 0, 0); } while (0)
#define PG8_LDA(dst, b, h) do { _Pragma("unroll") for (int m = 0; m < 4; ++m) _Pragma("unroll") for (int k = 0; k < 2; ++k) dst[m][k] = *(const PG8_LAS bf16x8*)(lds + PG8_SA(b, h) + aoff + m * 2048 + k * 1024); } while (0)
#define PG8_LDB(dst, b, h) do { _Pragma("unroll") for (int n = 0; n < 2; ++n) _Pragma("unroll") for (int k = 0; k < 2; ++k) dst[n][k] = *(const PG8_LAS bf16x8*)(lds + PG8_SB(b, h) + boff + n * 2048 + k * 1024); } while (0)
#define PG8_MMA(ai, bj, At, Bt) do { __builtin_amdgcn_s_setprio(1); _Pragma("unroll") for (int m = 0; m < 4; ++m) _Pragma("unroll") for (int n = 0; n < 2; ++n) _Pragma("unroll") for (int k = 0; k < 2; ++k) \
    acc[ai][bj][m][n] = __builtin_amdgcn_mfma_f32_16x16x32_bf16(Bt[n][k], At[m][k], acc[ai][bj][m][n], 0, 0, 0); __builtin_amdgcn_s_setprio(0); } while (0)
#define PG8_WAIT_V(n) asm volatile("s_waitcnt vmcnt(" #n ")" ::: "memory")
#define PG8_WAIT_L(n) asm volatile("s_waitcnt lgkmcnt(" #n ")" ::: "memory")
#define PG8_BAR __builtin_amdgcn_s_barrier()
#define PG8_SCHED __builtin_amdgcn_sched_barrier(0)
  Unit cur, nxt; int ui = 0;
  if (!S.next(0, cur)) return;
  f32x4 acc[2][2][4][2];
#pragma unroll
  for (int a = 0; a < 2; ++a)
#pragma unroll
    for (int b = 0; b < 2; ++b)
#pragma unroll
      for (int m = 0; m < 4; ++m)
#pragma unroll
        for (int n = 0; n < 2; ++n) acc[a][b][m][n] = (f32x4){0.f, 0.f, 0.f, 0.f};
  bf16x8 At[4][2], B0[2][2], B1[2][2];
  const char* cA = S.pa(cur); const char* cB = S.pb(cur);
  PG8_WAIT_V(0);
  PG8_STAGE(PG8_SB(0, 0), cB); PG8_STAGE(PG8_SA(0, 0), cA); PG8_STAGE(PG8_SB(0, 1), cB + hstep); PG8_STAGE(PG8_SA(0, 1), cA + hstep);
  if (wr == 1) PG8_BAR;
  PG8_WAIT_V(4); PG8_BAR;
  PG8_STAGE(PG8_SB(1, 0), cB + kstep); PG8_STAGE(PG8_SA(1, 0), cA + kstep); PG8_STAGE(PG8_SB(1, 1), cB + hstep + kstep);
  PG8_WAIT_V(6); PG8_BAR;
  for (;;) {
    const bool has_next = S.next(ui + 1, nxt);
    const char* nA = has_next ? S.pa(nxt) : cA; const char* nB = has_next ? S.pb(nxt) : cB;
    for (int t = 0; t < nt; t += 2) {
      const bool last = (t == nt - 2);
      const char* a1 = cA + (size_t)(t + 1) * kstep;
      const char* a2 = last ? nA : cA + (size_t)(t + 2) * kstep; const char* b2 = last ? nB : cB + (size_t)(t + 2) * kstep;
      const char* a3 = a2 + kstep; const char* b3 = b2 + kstep;
      PG8_LDB(B0, 0, 0); PG8_SCHED; PG8_LDA(At, 0, 0); PG8_STAGE(PG8_SA(1, 1), a1 + hstep);
      PG8_WAIT_L(8); PG8_BAR; PG8_WAIT_L(0); PG8_MMA(0, 0, At, B0); PG8_BAR; PG8_SCHED;
      PG8_LDB(B1, 0, 1); PG8_STAGE(PG8_SB(0, 0), b2);
      PG8_BAR; PG8_WAIT_L(0); PG8_MMA(0, 1, At, B1); PG8_BAR;
      PG8_LDA(At, 0, 1); PG8_STAGE(PG8_SA(0, 0), a2);
      PG8_BAR; PG8_WAIT_L(0); PG8_MMA(1, 0, At, B0); PG8_BAR; PG8_SCHED;
      PG8_STAGE(PG8_SB(0, 1), b2 + hstep);
      PG8_WAIT_V(6); PG8_BAR; PG8_MMA(1, 1, At, B1); PG8_BAR;
      PG8_LDB(B0, 1, 0); PG8_SCHED; PG8_LDA(At, 1, 0); PG8_STAGE(PG8_SA(0, 1), a2 + hstep);
      PG8_WAIT_L(8); PG8_BAR; PG8_WAIT_L(0); PG8_MMA(0, 0, At, B0); PG8_BAR; PG8_SCHED;
      PG8_LDB(B1, 1, 1); PG8_STAGE(PG8_SB(1, 0), b3);
      PG8_BAR; PG8_WAIT_L(0); PG8_MMA(0, 1, At, B1); PG8_BAR;
      PG8_LDA(At, 1, 1); PG8_STAGE(PG8_SA(1, 0), a3);
      PG8_BAR; PG8_WAIT_L(0); PG8_MMA(1, 0, At, B0); PG8_BAR; PG8_SCHED;
      PG8_STAGE(PG8_SB(1, 1), b3 + hstep);
      PG8_WAIT_V(6); PG8_BAR; PG8_MMA(1, 1, At, B1); PG8_BAR;
    }
    E(acc, cur, wr, wc, fr, fq);
    if (!has_next) break;
#pragma unroll
    for (int a = 0; a < 2; ++a)
#pragma unroll
      for (int b = 0; b < 2; ++b)
#pragma unroll
        for (int m = 0; m < 4; ++m)
#pragma unroll
          for (int n = 0; n < 2; ++n) acc[a][b][m][n] = (f32x4){0.f, 0.f, 0.f, 0.f};
    cur = nxt; cA = nA; cB = nB; ++ui;
  }
  PG8_WAIT_V(0);
  if (wr == 0) PG8_BAR;
  PG8_BAR;
#undef PG8_SA
#undef PG8_SB
#undef PG8_STAGE
#undef PG8_LDA
#undef PG8_LDB
#undef PG8_MMA
#undef PG8_WAIT_V
#undef PG8_WAIT_L
#undef PG8_BAR
#undef PG8_SCHED
}
}

DI void gemm_prefetch_big(const bf16_t* __restrict__ A, int lda, const bf16_t* __restrict__ B, int ldb, char* smem) {
  const int tid = g_tid();
  const int lr = tid >> 3, lc = (tid & 7) ^ ((tid >> 4) & 7);
  const unsigned aoff = (unsigned)(lr * lda + lc * 8) * 2u, boff = (unsigned)(lr * ldb + lc * 8) * 2u;
  const char* Ac = (const char*)A; const char* Bc = (const char*)B;
  char* sdst = smem + tid * 16;
#pragma unroll
  for (int i = 0; i < 4; ++i) {
    __builtin_amdgcn_global_load_lds((const void*)(Ac + ((size_t)(64 * i) * lda) * 2 + aoff), (lds_ptr_t)(sdst + i * 8192), 16, 0, 0);
    __builtin_amdgcn_global_load_lds((const void*)(Bc + ((size_t)(64 * i) * ldb) * 2 + boff), (lds_ptr_t)(sdst + 32768 + i * 8192), 16, 0, 0);
  }
}

DI void row_info(int r, int& b, int& pos, bool& isctx) {
  if (r < T_LAT) { b = r >> 11; pos = r & 2047; isctx = false; } else { const int q = r - T_LAT; b = q >> 8; pos = q & 255; isctx = true; }
}

constexpr int HALF_LDS = 65792;
DI void conv_tile(bool active, const float* __restrict__ src, int ld, int k0, int c0, bf16_t* __restrict__ dst, int dstld, int ilv  , int n0, char* smem) {
  float* s = (float*)smem;
  const int tid = g_tid() & 255;
  if (active) {
#pragma unroll
    for (int i = 0; i < 4; ++i) {
      const int k = (tid >> 4) + 16 * i, cc = (tid & 15) * 4;
      const f32x4 v = *(const f32x4*)(src + (size_t)(k0 + k) * ld + c0 + n0 + cc);
      s[k * 65 + cc] = v[0]; s[k * 65 + cc + 1] = v[1]; s[k * 65 + cc + 2] = v[2]; s[k * 65 + cc + 3] = v[3];
    }
  }
  __syncthreads();
  if (active) {
    const int n = tid >> 2, kq = (tid & 3) * 16;
    unsigned w[8];
#pragma unroll
    for (int j = 0; j < 8; ++j) w[j] = pk2(s[(kq + 2 * j) * 65 + n], s[(kq + 2 * j + 1) * 65 + n]);
    const int ng = n0 + n;
    size_t drow = ng;
    if (ilv) drow = (size_t)(ng >> 4) * 32 + (ng & 15) + (ilv == 2 ? 16 : 0);
    bf16_t* dp = dst + drow * dstld + k0 + kq;
    *(u32x4*)dp = (u32x4){w[0], w[1], w[2], w[3]};
    *(u32x4*)(dp + 8) = (u32x4){w[4], w[5], w[6], w[7]};
  }
  __syncthreads();
}
DI void fold_tile(bool active, const float* __restrict__ src  , int cbase, int k0, int np0  , int mode, const float* __restrict__ wgrp,
                  const float* __restrict__ pscale, bf16_t* __restrict__ dst  , char* smem) {
  float* sA = (float*)smem;
  float* sT = (float*)(smem + 33024);
  const int tid = g_tid() & 255;
  if (active) {
    for (int i = tid; i < 64 * 32; i += 256) {
      const int k = i >> 5, c4 = (i & 31) * 4;
      const f32x4 v = *(const f32x4*)(src + (size_t)(k0 + k) * N_IN + cbase + c4);
      sA[k * 129 + c4] = v[0]; sA[k * 129 + c4 + 1] = v[1]; sA[k * 129 + c4 + 2] = v[2]; sA[k * 129 + c4 + 3] = v[3];
    }
    for (int i = tid; i < 128 * 64; i += 256) {
      const int c = i >> 6, n = i & 63, np = np0 + n;
      float t;
      if (mode == 2) t = wgrp[c * 128 + np] * pscale[np];
      else { const float r = (float)((c * np) & 127) * (1.0f / 128.0f); t = (mode == 0) ? hw_cos_rev(r) : hw_sin_rev(r); }
      sT[c * 64 + n] = t;
    }
  }
  __syncthreads();
  if (active) {
    const int ty = tid >> 4, tx = tid & 15;
    float acc[4][4];
#pragma unroll
    for (int a = 0; a < 4; ++a)
#pragma unroll
      for (int b = 0; b < 4; ++b) acc[a][b] = 0.f;
    for (int c = 0; c < 128; ++c) {
      const f32x4 t4 = *(const f32x4*)(sT + c * 64 + tx * 4);
      float a4[4];
#pragma unroll
      for (int a = 0; a < 4; ++a) a4[a] = sA[(ty * 4 + a) * 129 + c];
#pragma unroll
      for (int a = 0; a < 4; ++a)
#pragma unroll
        for (int b = 0; b < 4; ++b) acc[a][b] += a4[a] * t4[b];
    }
#pragma unroll
    for (int b = 0; b < 4; ++b) {
      bf16_t* dp = dst + (size_t)(np0 + tx * 4 + b) * 1024 + k0 + ty * 4;
      *(u32x2*)dp = (u32x2){pk2(acc[0][b], acc[1][b]), pk2(acc[2][b], acc[3][b])};
    }
  }
  __syncthreads();
}

constexpr int CONV_TOTAL = 16 * 48 * 2 + 16 * 16 + 8 * 16 * 2 + 16 * 16 + 16 * 44 * 2 + 44 * 16 + 256 + 128;
DI void convert_iter(const Params& p, int l, int tb, char* smem0) {
  bf16_t* W = (bf16_t*)(p.ws + w_off(l));
  const float* win = p.w_in + (size_t)l * 1024 * N_IN;
  const int half = g_tid() >> 8;
  char* smem = smem0 + half * HALF_LDS;
  constexpr int C0 = 16 * 48, C1 = C0 + 16 * 48, C2 = C1 + 16 * 16, C3 = C2 + 8 * 16, C4 = C3 + 8 * 16, C5 = C4 + 16 * 16, C6 = C5 + 16 * 44, C7 = C6 + 16 * 44,
                C8 = C7 + 44 * 16, C9 = C8 + 256, C10 = C9 + 128;
  static_assert((C0 | C1 | C2 | C3 | C4 | C5 | C6 | C7 | C8 | C9 | C10) % 2 == 0, "segment boundaries must be even");
  const int total = C10;
  static_assert(C10 == CONV_TOTAL, "conversion tile count");
  {
    const bool active = (tb + half) < total;
    const int t = active ? tb + half : tb;
    int seg, r;
    if (t < C0) { seg = 0; r = t; } else if (t < C1) { seg = 1; r = t - C0; } else if (t < C2) { seg = 2; r = t - C1; } else if (t < C3) { seg = 3; r = t - C2; }
    else if (t < C4) { seg = 4; r = t - C3; } else if (t < C5) { seg = 5; r = t - C4; } else if (t < C6) { seg = 6; r = t - C5; } else if (t < C7) { seg = 7; r = t - C6; }
    else if (t < C8) { seg = 8; r = t - C7; } else if (t < C9) { seg = 9; r = t - C8; } else { seg = 10; r = t - C9; }
    if (seg <= 8) {
      const float* src; int ld, kt, nt, c0 = 0, dstld, ilv = 0; bf16_t* dst;
      if (seg <= 1) { kt = r & 15; nt = r >> 4; src = win; ld = N_IN; c0 = seg == 0 ? 0 : 4096; dst = W + WO_WIN + (seg == 0 ? 0 : (size_t)ROW_G * 1024); dstld = 1024; }
      else if (seg == 2) { kt = r & 15; nt = r >> 4; src = p.w_att_br + (size_t)l * 1024 * 1024; ld = 1024; dst = W + WO_WA; dstld = 1024; }
      else if (seg == 3) { kt = r & 7; nt = r >> 3; src = p.w_four_br + (size_t)l * 512 * 1024; ld = 1024; dst = W + WO_WF; dstld = 512; }
      else if (seg == 4) { kt = r & 7; nt = r >> 3; src = p.w_pool_br + (size_t)l * 512 * 1024; ld = 1024; dst = W + WO_WP; dstld = 512; }
      else if (seg == 5) { kt = r & 15; nt = r >> 4; src = p.w_out + (size_t)l * 1024 * 1024; ld = 1024; dst = W + WO_WO; dstld = 1024; }
      else if (seg == 6) { kt = r & 15; nt = r >> 4; src = p.w_ffn_gate + (size_t)l * 1024 * DFF; ld = DFF; dst = W + WO_WGU; dstld = 1024; ilv = 1; }
      else if (seg == 7) { kt = r & 15; nt = r >> 4; src = p.w_ffn_up + (size_t)l * 1024 * DFF; ld = DFF; dst = W + WO_WGU; dstld = 1024; ilv = 2; }
      else { kt = r % 44; nt = r / 44; src = p.w_ffn_down + (size_t)l * DFF * 1024; ld = 1024; dst = W + WO_WD; dstld = DFF; }
      conv_tile(active, src, ld, kt * 64, c0, dst, dstld, ilv, nt * 64, smem);
    } else if (seg == 9) {
      const int kt = r & 15, q = r >> 4; const int g = q & 3, hf = (q >> 2) & 1, mode = q >> 3;
      fold_tile(active, win, 3072 + g * 128, kt * 64, hf * 64, mode, nullptr, nullptr, W + WO_WIN + (size_t)((mode ? ROW_Z2 : ROW_Z1) + g * 128) * 1024, smem);
    } else {
      const int kt = r & 15, q = r >> 4; const int g = q & 3, hf = q >> 2;
      fold_tile(active, win, 3584 + g * 128, kt * 64, hf * 64, 2, p.w_pool_grp + ((size_t)l * 4 + g) * 128 * 128, p.pool_scale + (size_t)l * 512 + g * 128,
                W + WO_WIN + (size_t)(ROW_R + g * 128) * 1024, smem);
    }
  }
}

DI void convert_layer(const Params& p, int l, char* smem) {
  for (int tb = blockIdx.x * 2; tb < CONV_TOTAL; tb += gridDim.x * 2) convert_iter(p, l, tb, smem);
}

DI void convert_grab(const Params& p, int l, int which  , char* smem) {
  unsigned* ctr = (unsigned*)(p.ws + OFF_CTR) + l * 2 + which;
  volatile __attribute__((address_space(3))) unsigned* slot = (volatile __attribute__((address_space(3))) unsigned*)(lds_ptr_t)(smem + 3 * GSTAGE + 8);
  const int lo = which ? 2400 : 0, hi = which ? CONV_TOTAL : 2400;
  for (;;) {
    __syncthreads();
    if (__builtin_amdgcn_workitem_id_x() == 0) *slot = __hip_atomic_fetch_add(ctr, 2u, __ATOMIC_RELAXED, __HIP_MEMORY_SCOPE_AGENT);
    __syncthreads();
    const int tb = lo + (int)*slot;
    if (tb >= hi) break;
    convert_iter(p, l, tb, smem);
  }
  __syncthreads();
}

DI void phase0a(const Params& p, char* smem) {
  const int tid = g_tid();
  const int gtid = blockIdx.x * 512 + tid, gsz = gridDim.x * 512;
  {
    const int half = tid >> 8, t8 = tid & 255;
    float* ssil = (float*)smem;
    float* sred = (float*)(smem + 36864 + half * 9216);
    bool filled = false;
    float* modv = (float*)(p.ws + OFF_MODV);
    for (int tb = blockIdx.x * 2; tb < DEPTH * 96; tb += gridDim.x * 2) {
      if (!filled) {
        for (int i = tid; i < 9 * 1024; i += 512) { const float v = (i < 8192) ? p.c[i] : p.c_ctx[i - 8192]; ssil[i] = v * sigmoidf_(v); }
        filled = true;
        __syncthreads();
      }
      const int t = tb + half;
      const int l = t / 96, cgp = t % 96;
      const int col = cgp * 64 + (t8 & 63), kq = t8 >> 6;
      const float* wp = p.w_mod + ((size_t)l * 1024 + kq * 256) * 6144 + col;
      float a[9];
#pragma unroll
      for (int r = 0; r < 9; ++r) a[r] = 0.f;
#pragma unroll 4
      for (int k = 0; k < 256; ++k) {
        const float w = wp[(size_t)k * 6144];
#pragma unroll
        for (int r = 0; r < 9; ++r) a[r] += ssil[r * 1024 + kq * 256 + k] * w;
      }
#pragma unroll
      for (int r = 0; r < 9; ++r) sred[(kq * 9 + r) * 64 + (t8 & 63)] = a[r];
      __syncthreads();
      for (int i = t8; i < 9 * 64; i += 256) {
        const int r = i >> 6, cc = i & 63;
        const float v = sred[(0 * 9 + r) * 64 + cc] + sred[(1 * 9 + r) * 64 + cc] + sred[(2 * 9 + r) * 64 + cc] + sred[(3 * 9 + r) * 64 + cc];
        modv[((size_t)l * 9 + r) * 6144 + cgp * 64 + cc] = v + p.b_mod[(size_t)l * 6144 + cgp * 64 + cc];
      }
      __syncthreads();
    }
    __syncthreads();
  }
  convert_layer(p, 0, smem);
  {
    bf16_t* at = (bf16_t*)(p.ws + OFF_ATAB);
    for (int i = gtid; i < 2048 * 512; i += gsz) {
      const int k = i >> 9, c8 = (i & 511) * 8;
      unsigned w[4];
#pragma unroll
      for (int j = 0; j < 4; ++j) {
        float v[2];
#pragma unroll
        for (int e = 0; e < 2; ++e) {
          const int tp = c8 + 2 * j + e; const int tt = tp & 2047;
          const float r = (float)((k * tt) & 2047) * (1.0f / 2048.0f);
          v[e] = (tp < 2048) ? hw_cos_rev(r) : -hw_sin_rev(r);
        }
        w[j] = pk2(v[0], v[1]);
      }
      *(u32x4*)(at + (size_t)k * 4096 + c8) = (u32x4){w[0], w[1], w[2], w[3]};
    }
    bf16_t* atc = (bf16_t*)(p.ws + OFF_ATABC);
    for (int i = gtid; i < 256 * 64; i += gsz) {
      const int k = i >> 6, c8 = (i & 63) * 8;
      unsigned w[4];
#pragma unroll
      for (int j = 0; j < 4; ++j) {
        float v[2];
#pragma unroll
        for (int e = 0; e < 2; ++e) {
          const int tp = c8 + 2 * j + e; const int tt = tp & 255;
          const float r = (float)((k * tt) & 255) * (1.0f / 256.0f);
          v[e] = (tp < 256) ? hw_cos_rev(r) : -hw_sin_rev(r);
        }
        w[j] = pk2(v[0], v[1]);
      }
      *(u32x4*)(atc + (size_t)k * 512 + c8) = (u32x4){w[0], w[1], w[2], w[3]};
    }
  }
  {
    float* rc = (float*)(p.ws + OFF_ROPEC); float* rs = (float*)(p.ws + OFF_ROPES);
    for (int i = gtid; i < 2048 * 32; i += gsz) {
      const int t = i >> 5, a = i & 31, f = a & 15;
      const float pos = (float)((a < 16) ? (t >> 6) : (t & 63));
      const float inv = exp2f(-(float)f * (13.287712379549449f / 16.0f));
      float r = pos * inv * 0.15915494309189535f;
      r -= floorf(r);
      rc[i] = hw_cos_rev(r); rs[i] = hw_sin_rev(r);
    }
  }
  if (gtid < DEPTH) {
    const float* lq = p.lam_qk + (size_t)gtid * 256;
    float s1 = 0.f, s2 = 0.f;
    for (int i = 0; i < 64; ++i) { s1 += lq[i] * lq[64 + i]; s2 += lq[128 + i] * lq[192 + i]; }
    ((float*)(p.ws + OFF_LAMV))[gtid] = expf(s1) - expf(s2) + p.lam_init[gtid];
  }
}

DI void ln_pass(const Params& p, int mode, int nrows, const bf16_t* __restrict__ Yb, const float* __restrict__ lng, const float* __restrict__ lnb,
                        int modl_gate, int gate_chunk, int modl_next, int sh_chunk) {
  const int lane = g_tid() & 63, wid = g_tid() >> 6;
  float* X = (float*)(p.ws + OFF_X);
  bf16_t* U = (bf16_t*)(p.ws + OFF_U);
  const float* modv = (const float*)(p.ws + OFF_MODV);
  f32x4 xv[4], xn[4]; u32x2 yv[4], yn[4];
  const int r0 = blockIdx.x * 8 + wid, rstride = gridDim.x * 8;
  if (mode != 0 && r0 < nrows) {
#pragma unroll
    for (int i = 0; i < 4; ++i) { xv[i] = *(const f32x4*)(X + (size_t)r0 * 1024 + lane * 4 + 256 * i); yv[i] = *(const u32x2*)(Yb + (size_t)r0 * 1024 + lane * 4 + 256 * i); }
  }
  for (int r = r0; r < nrows; r += rstride) {
    int b, pos; bool isctx; row_info(r, b, pos, isctx);
    const int mr = isctx ? 8 : b;
    f32x4 v[4];
    if (mode == 0) {
      const float* src = isctx ? (p.ctx + (size_t)(r - T_LAT) * 1024) : (p.x + (size_t)r * 1024);
#pragma unroll
      for (int i = 0; i < 4; ++i) v[i] = *(const f32x4*)(src + lane * 4 + 256 * i);
#pragma unroll
      for (int i = 0; i < 4; ++i) *(f32x4*)(X + (size_t)r * 1024 + lane * 4 + 256 * i) = v[i];
    } else {
      const int rn = r + rstride;
      if (rn < nrows) {
#pragma unroll
        for (int i = 0; i < 4; ++i) { xn[i] = *(const f32x4*)(X + (size_t)rn * 1024 + lane * 4 + 256 * i); yn[i] = *(const u32x2*)(Yb + (size_t)rn * 1024 + lane * 4 + 256 * i); }
      }
      const float* gv = modv + ((size_t)modl_gate * 9 + mr) * 6144 + gate_chunk * 1024;
      float s = 0.f;
#pragma unroll
      for (int i = 0; i < 4; ++i) {
        const int col = lane * 4 + 256 * i;
        const f32x4 g = *(const f32x4*)(gv + col);
        v[i][0] = ALPHA * xv[i][0] + g[0] * bf_lo(yv[i][0]); v[i][1] = ALPHA * xv[i][1] + g[1] * bf_hi(yv[i][0]);
        v[i][2] = ALPHA * xv[i][2] + g[2] * bf_lo(yv[i][1]); v[i][3] = ALPHA * xv[i][3] + g[3] * bf_hi(yv[i][1]);
        s += (v[i][0] + v[i][1]) + (v[i][2] + v[i][3]);
      }
#pragma unroll
      for (int i = 0; i < 4; ++i) { xv[i] = xn[i]; yv[i] = yn[i]; }
      const float mu = wave_sum(s) * (1.0f / 1024.0f);
      float q = 0.f;
#pragma unroll
      for (int i = 0; i < 4; ++i) { const f32x4 d = v[i] - mu; q += (d[0] * d[0] + d[1] * d[1]) + (d[2] * d[2] + d[3] * d[3]); }
      const float rstd = rsqrtf(wave_sum(q) * (1.0f / 1024.0f) + LN_EPS);
#pragma unroll
      for (int i = 0; i < 4; ++i) {
        const int col = lane * 4 + 256 * i;
        const f32x4 g = *(const f32x4*)(lng + col), bb = *(const f32x4*)(lnb + col);
        v[i] = (v[i] - mu) * rstd * g + bb;
        if (mode == 2) *(f32x4*)(p.out + (size_t)r * 1024 + col) = v[i];
        else *(f32x4*)(X + (size_t)r * 1024 + col) = v[i];
      }
    }
    if (mode != 2) {
      float s = 0.f;
#pragma unroll
      for (int i = 0; i < 4; ++i) s += (v[i][0] + v[i][1]) + (v[i][2] + v[i][3]);
      const float mu = wave_sum(s) * (1.0f / 1024.0f);
      float q = 0.f;
#pragma unroll
      for (int i = 0; i < 4; ++i) { const f32x4 d = v[i] - mu; q += (d[0] * d[0] + d[1] * d[1]) + (d[2] * d[2] + d[3] * d[3]); }
      const float rstd = rsqrtf(wave_sum(q) * (1.0f / 1024.0f) + LN_EPS);
      const float* shv = modv + ((size_t)modl_next * 9 + mr) * 6144 + sh_chunk * 1024;
      const float* scv = shv + 1024;
#pragma unroll
      for (int i = 0; i < 4; ++i) {
        const int col = lane * 4 + 256 * i;
        const f32x4 sh = *(const f32x4*)(shv + col), sc = *(const f32x4*)(scv + col);
        const f32x4 u = (v[i] - mu) * rstd * (sc + 1.0f) + sh;
        *(u32x2*)(U + (size_t)r * 1024 + col) = (u32x2){pk2(u[0], u[1]), pk2(u[2], u[3])};
      }
    }
  }
}

DI bool tile_map(int v, int nmt, int nnt, int& mt, int& nt) {
  const int c = v >> 8, w = v & 255, xcd = w & 7, local = w >> 3;
  const int spr = nnt >> 2, nsup = (nmt >> 3) * spr, sup = c * 8 + xcd;
  if (sup >= nsup) return false;
  mt = (sup / spr) * 8 + (local & 7); nt = (sup % spr) * 4 + (local >> 3);
  return true;
}
DI int tile_vmax(int nmt, int nnt) { const int nsup = (nmt >> 3) * (nnt >> 2); return ((nsup + 7) >> 3) << 8; }

DI void phase_inproj(const Params& p, int l, char* smem) {
  const bool last = (l == DEPTH - 1);
  const bf16_t* W = (const bf16_t*)(p.ws + w_off(l)) + WO_WIN;
  const bf16_t* U = (const bf16_t*)(p.ws + OFF_U);
  bf16_t* KB = (bf16_t*)(p.ws + OFF_KB); bf16_t* VT = (bf16_t*)(p.ws + OFF_VT); bf16_t* QB = (bf16_t*)(p.ws + OFF_QB); bf16_t* CQ = (bf16_t*)(p.ws + OFF_CQ);
  bf16_t* ZT = (bf16_t*)(p.ws + OFF_ZT); bf16_t* ZTC = (bf16_t*)(p.ws + OFF_ZTC); bf16_t* R = (bf16_t*)(p.ws + OFF_R);
  const float* ropec = (const float*)(p.ws + OFF_ROPEC); const float* ropes = (const float*)(p.ws + OFF_ROPES);
  const int nsupA = last ? 72 : 81, nsup = last ? 76 : 81;
  const int vmax = ((nsup + 15) >> 4) << 8;
  auto map_tile = [&](int v, int& mt, int& nt) -> bool {
    if (v >= vmax) return false;
    const int c = v >> 8, w = v & 255, local = w >> 3, sup = (c * 8 + (w & 7)) * 2 + (local >> 4);
    if (sup >= nsup) return false;
    if (sup < nsupA) { mt = (sup / 9) * 8 + (local & 7); nt = (sup % 9) * 2 + ((local >> 3) & 1); }
    else { mt = 64 + (local & 7); nt = (sup - nsupA) * 2 + ((local >> 3) & 1); }
    return true;
  };
  int v = blockIdx.x, mt = 0, nt = 0;
  bool cur = map_tile(v, mt, nt);
  if (cur) gemm_prefetch_big(U + (size_t)mt * 256 * 1024, 1024, W + (size_t)nt * 256 * 1024, 1024, smem);
  while (cur) {
    const int m0 = mt * 256;
    int b, pos0; bool isctx; row_info(m0, b, pos0, isctx);
    f32x4 acc[8][4];
#pragma unroll
    for (int i = 0; i < 8; ++i)
#pragma unroll
      for (int j = 0; j < 4; ++j) acc[i][j] = (f32x4){0.f, 0.f, 0.f, 0.f};
    const bool swap = !((nt >= 4 && nt < 8) || (nt >= 12 && nt < 16));
    if (swap) gemm_kloop_big<true>(U + (size_t)m0 * 1024, 1024, W + (size_t)nt * 256 * 1024, 1024, 1024, acc, smem, true);
    else gemm_kloop_big<false>(U + (size_t)m0 * 1024, 1024, W + (size_t)nt * 256 * 1024, 1024, 1024, acc, smem, true);
    int v2 = v + gridDim.x, mt2 = 0, nt2 = 0;
    const bool nxt = map_tile(v2, mt2, nt2);
    if (nxt) gemm_prefetch_big(U + (size_t)mt2 * 256 * 1024, 1024, W + (size_t)nt2 * 256 * 1024, 1024, smem);
    const int tid = g_tid(), lane = tid & 63, wid = __builtin_amdgcn_readfirstlane(tid >> 6), wm = wid >> 2, wn = wid & 3;
    const int fq = lane >> 4, fr = lane & 15;
    const int ncol0 = nt * 256 + wn * 64;
    const int prow0 = pos0 + wm * 128;
    if (ncol0 < 1024 || (ncol0 >= 2048 && ncol0 < 3072)) {
      const bool isq = ncol0 >= 2048; const int h = (ncol0 >> 7) & 7, map = (ncol0 >> 6) & 1;
#pragma unroll
      for (int mi = 0; mi < 8; ++mi) {
        const int pos = prow0 + mi * 16 + fr;
        f32x4 o[4];
        if (!isctx) {
#pragma unroll
          for (int pr = 0; pr < 2; ++pr) {
            const f32x4 cs = *(const f32x4*)(ropec + pos * 32 + pr * 16 + fq * 4);
            const f32x4 sn = *(const f32x4*)(ropes + pos * 32 + pr * 16 + fq * 4);
            const f32x4 x0 = acc[mi][2 * pr], x1 = acc[mi][2 * pr + 1];
            o[2 * pr] = x0 * cs - x1 * sn;
            o[2 * pr + 1] = x1 * cs + x0 * sn;
          }
        } else {
#pragma unroll
          for (int ni = 0; ni < 4; ++ni) o[ni] = acc[mi][ni];
        }
        bf16_t* dst;
        if (!isq) dst = KB + ((size_t)((b * 8 + h) * 2 + map) * NKEY + (isctx ? SEQ + pos : pos)) * 64;
        else if (!isctx) dst = QB + ((size_t)((b * 8 + h) * 2 + map) * SEQ + pos) * 64;
        else dst = CQ + ((size_t)((b * 8 + h) * 2 + map) * LC + pos) * 64;
        const float sc = isq ? QSCALE : 1.0f;
#pragma unroll
        for (int ni = 0; ni < 4; ++ni) {
          const f32x4 vv = o[ni] * sc;
          *(u32x2*)(dst + ni * 16 + fq * 4) = (u32x2){pk2(vv[0], vv[1]), pk2(vv[2], vv[3])};
        }
      }
    } else if (ncol0 < 2048) {
      const int h = (ncol0 - 1024) >> 7, vc0 = ncol0 & 127;
#pragma unroll
      for (int mi = 0; mi < 8; ++mi) {
        const int key = (isctx ? SEQ : 0) + prow0 + mi * 16 + fq * 4;
        const int k15 = key & 15;
        const int pkey = (key & ~15) | (k15 & 3) | ((k15 & 4) << 1) | ((k15 & 8) >> 1);
#pragma unroll
        for (int ni = 0; ni < 4; ++ni) {
          const int vcol = vc0 + ni * 16 + fr;
          const f32x4 vv = acc[mi][ni];
          *(u32x2*)(VT + ((size_t)(b * 8 + h) * 128 + vcol) * NKEY + pkey) = (u32x2){pk2(vv[0], vv[1]), pk2(vv[2], vv[3])};
        }
      }
    } else if (ncol0 < 4096) {
#pragma unroll
      for (int mi = 0; mi < 8; ++mi) {
        const int pos = prow0 + mi * 16 + fq * 4;
#pragma unroll
        for (int ni = 0; ni < 4; ++ni) {
          const int zc = ncol0 - 3072 + ni * 16 + fr;
          const int np = zc & 511, second = zc >> 9;
          const f32x4 vv = acc[mi][ni];
          bf16_t* dst = isctx ? (ZTC + ((size_t)b * 512 + np) * 512 + second * 256 + pos) : (ZT + ((size_t)b * 512 + np) * 4096 + second * 2048 + pos);
          *(u32x2*)dst = (u32x2){pk2(vv[0], vv[1]), pk2(vv[2], vv[3])};
        }
      }
    } else {
#pragma unroll
      for (int mi = 0; mi < 8; ++mi) {
        const int row = m0 + wm * 128 + mi * 16 + fr;
#pragma unroll
        for (int ni = 0; ni < 4; ++ni) {
          const int col = ncol0 - 4096 + ni * 16 + fq * 4;
          const f32x4 vv = acc[mi][ni];
          *(u32x2*)(R + (size_t)row * 512 + col) = (u32x2){pk2(vv[0], vv[1]), pk2(vv[2], vv[3])};
        }
      }
    }
    v = v2; mt = mt2; nt = nt2; cur = nxt;
  }
}

DI void attn_unit(const bf16_t* __restrict__ Qb  , int nq, int q0, const bf16_t* __restrict__ Kb  ,
                  const bf16_t* __restrict__ VTb  , int key0, int ntiles  , bf16_t* __restrict__ outp  ,
                  const float* __restrict__ subg, float lam, float nscale, char* smem) {
  const int tid = g_tid(), lane = tid & 63, wid = __builtin_amdgcn_readfirstlane(tid >> 6), wq = wid & 3, map = wid >> 2;
  const int l31 = lane & 31, kh = lane >> 5;
  bf16x8 qf[4];
  {
    const bf16_t* qp = Qb + ((size_t)map * nq + q0 + wq * 32 + l31) * 64 + kh * 8;
#pragma unroll
    for (int s = 0; s < 4; ++s) qf[s] = *(const bf16x8*)(qp + s * 16);
  }
  const int srow = tid >> 3, sc = (tid & 7) ^ ((tid >> 4) & 7);
  const unsigned koff = (unsigned)((key0 + srow) * 64 + sc * 8) * 2u;
  const unsigned voff = (unsigned)(srow * NKEY + key0 + sc * 8) * 2u;
  const char* Kc = (const char*)Kb; const char* Vc = (const char*)VTb;
  char* sdst = smem + tid * 16;
#define A_ISSUE(T) do { char* d_ = sdst + ((T) & 3) * 32768; \
    __builtin_amdgcn_global_load_lds((const void*)(Kc + (size_t)(T) * 8192 + koff), (lds_ptr_t)(d_), 16, 0, 0); \
    __builtin_amdgcn_global_load_lds((const void*)(Kc + (size_t)NKEY * 128 + (size_t)(T) * 8192 + koff), (lds_ptr_t)(d_ + 8192), 16, 0, 0); \
    __builtin_amdgcn_global_load_lds((const void*)(Vc + (size_t)(T) * 128 + voff), (lds_ptr_t)(d_ + 16384), 16, 0, 0); \
    __builtin_amdgcn_global_load_lds((const void*)(Vc + (size_t)64 * NKEY * 2 + (size_t)(T) * 128 + voff), (lds_ptr_t)(d_ + 24576), 16, 0, 0); } while (0)
  f32x16 O[4];
#pragma unroll
  for (int vb = 0; vb < 4; ++vb)
#pragma unroll
    for (int i = 0; i < 16; ++i) O[vb][i] = 0.f;
  float m = 0.f, lsum = 0.f;
  const int sw = (lane >> 1) & 7;
  const int kfo = l31 * 128, cho = kh;
#define A_QK(SX, T) do { const char* st_ = smem + ((T) & 3) * 32768 + map * 8192 + kfo; \
    bf16x8 kf_[8]; \
    _Pragma("unroll") for (int s = 0; s < 4; ++s) _Pragma("unroll") for (int kb = 0; kb < 2; ++kb) \
        kf_[s * 2 + kb] = *(const bf16x8*)(st_ + kb * 4096 + (((2 * s + cho) ^ sw) << 4)); \
    _Pragma("unroll") for (int kb = 0; kb < 2; ++kb) _Pragma("unroll") for (int i = 0; i < 16; ++i) SX[kb][i] = -m; \
    __builtin_amdgcn_sched_barrier(0); \
    _Pragma("unroll") for (int s = 0; s < 4; ++s) _Pragma("unroll") for (int kb = 0; kb < 2; ++kb) \
        SX[kb] = MFMA32(kf_[s * 2 + kb], qf[s], SX[kb]); \
    __builtin_amdgcn_sched_barrier(0); } while (0)
  bf16x8 pf[4];
  auto pv = [&](int T) {
    const char* sv = smem + (T & 3) * 32768 + 16384 + kfo;
    __builtin_amdgcn_sched_barrier(0);
    bf16x8 va[4], vb_[4];
#pragma unroll
    for (int vb = 0; vb < 4; ++vb) va[vb] = *(const bf16x8*)(sv + vb * 4096 + (((0 + cho) ^ sw) << 4));
#pragma unroll
    for (int vb = 0; vb < 4; ++vb) vb_[vb] = *(const bf16x8*)(sv + vb * 4096 + (((2 + cho) ^ sw) << 4));
    __builtin_amdgcn_sched_barrier(0);
#pragma unroll
    for (int vb = 0; vb < 4; ++vb) O[vb] = MFMA32(va[vb], pf[0], O[vb]);
    __builtin_amdgcn_sched_barrier(0);
#pragma unroll
    for (int vb = 0; vb < 4; ++vb) va[vb] = *(const bf16x8*)(sv + vb * 4096 + (((4 + cho) ^ sw) << 4));
    __builtin_amdgcn_sched_barrier(0);
#pragma unroll
    for (int vb = 0; vb < 4; ++vb) O[vb] = MFMA32(vb_[vb], pf[1], O[vb]);
    __builtin_amdgcn_sched_barrier(0);
#pragma unroll
    for (int vb = 0; vb < 4; ++vb) vb_[vb] = *(const bf16x8*)(sv + vb * 4096 + (((6 + cho) ^ sw) << 4));
    __builtin_amdgcn_sched_barrier(0);
#pragma unroll
    for (int vb = 0; vb < 4; ++vb) O[vb] = MFMA32(va[vb], pf[2], O[vb]);
    __builtin_amdgcn_sched_barrier(0);
#pragma unroll
    for (int vb = 0; vb < 4; ++vb) O[vb] = MFMA32(vb_[vb], pf[3], O[vb]);
    __builtin_amdgcn_sched_barrier(0);
  };
  auto softmax = [&](f32x16 (&SC)[2], f32x16 (&SN)[2], bool has_next, bool first) {
    float mx[16];
#pragma unroll
    for (int i = 0; i < 16; ++i) mx[i] = fmaxf(SC[0][i], SC[1][i]);
#pragma unroll
    for (int w = 8; w >= 1; w >>= 1)
#pragma unroll
      for (int i = 0; i < w; ++i) mx[i] = fmaxf(mx[i], mx[i + w]);
    float tmax = xor32_max(mx[0]);
    if (first || __any(tmax > 8.0f)) {
      const float delta = first ? tmax : fmaxf(tmax, 0.f);
      const float alpha = first ? 1.0f : __builtin_amdgcn_exp2f(-delta);
      m += delta; lsum *= alpha;
#pragma unroll
      for (int vb = 0; vb < 4; ++vb) O[vb] = O[vb] * alpha;
#pragma unroll
      for (int kb = 0; kb < 2; ++kb)
#pragma unroll
        for (int i = 0; i < 16; ++i) SC[kb][i] -= delta;
      if (has_next) {
#pragma unroll
        for (int kb = 0; kb < 2; ++kb)
#pragma unroll
          for (int i = 0; i < 16; ++i) SN[kb][i] -= delta;
      }
    }
    float sm[16];
#pragma unroll
    for (int i = 0; i < 16; ++i) { const float e0 = __builtin_amdgcn_exp2f(SC[0][i]), e1 = __builtin_amdgcn_exp2f(SC[1][i]); SC[0][i] = e0; SC[1][i] = e1; sm[i] = e0 + e1; }
#pragma unroll
    for (int w = 8; w >= 1; w >>= 1)
#pragma unroll
      for (int i = 0; i < w; ++i) sm[i] += sm[i + w];
    lsum += sm[0];
#pragma unroll
    for (int g = 0; g < 4; ++g) {
      const int kb = g >> 1, s2 = g & 1;
      u32x4 w;
      w[0] = pk2(SC[kb][8 * s2 + 0], SC[kb][8 * s2 + 1]); w[1] = pk2(SC[kb][8 * s2 + 2], SC[kb][8 * s2 + 3]);
      w[2] = pk2(SC[kb][8 * s2 + 4], SC[kb][8 * s2 + 5]); w[3] = pk2(SC[kb][8 * s2 + 6], SC[kb][8 * s2 + 7]);
      pf[g] = __builtin_bit_cast(bf16x8, w);
    }
  };
  f32x16 Sa[2], Sb[2];
  if (wid >= 4) __builtin_amdgcn_s_setprio(1);
  WAIT_VM(0);
  A_ISSUE(0); A_ISSUE(1); A_ISSUE(2);
  WAIT_VM(8);
  __builtin_amdgcn_s_barrier();
  asm volatile("" ::: "memory");
  A_QK(Sa, 0);
  for (int t = 0; t < ntiles; t += 2) {
    if (t + 2 < ntiles) WAIT_VM(4); else WAIT_VM(0);
    __builtin_amdgcn_s_barrier();
    asm volatile("" ::: "memory");
    if (t + 3 < ntiles) A_ISSUE(t + 3);
    A_QK(Sb, t + 1);
    softmax(Sa, Sb, true, t == 0);
    pv(t);
    const bool nx = (t + 2 < ntiles);
    if (nx) { if (t + 3 < ntiles) WAIT_VM(4); else WAIT_VM(0); }
    __builtin_amdgcn_s_barrier();
    asm volatile("" ::: "memory");
    if (t + 4 < ntiles) A_ISSUE(t + 4);
    if (nx) A_QK(Sa, t + 2);
    softmax(Sb, Sa, nx, false);
    pv(t + 1);
  }
  __builtin_amdgcn_s_setprio(0);
  asm volatile("s_waitcnt lgkmcnt(0)" ::: "memory");
  __builtin_amdgcn_s_barrier();
  asm volatile("" ::: "memory");
#undef A_ISSUE
#undef A_QK
  const float ltot = xor32_sum(lsum);
  const float inv = 1.0f / ltot;
  float* ex = (float*)smem;
  if (map == 1) {
#pragma unroll
    for (int vb = 0; vb < 4; ++vb)
#pragma unroll
      for (int g4 = 0; g4 < 4; ++g4) {
        f32x4 v = {O[vb][4 * g4] * inv, O[vb][4 * g4 + 1] * inv, O[vb][4 * g4 + 2] * inv, O[vb][4 * g4 + 3] * inv};
        *(f32x4*)(ex + (wq * 32 + l31) * 132 + vb * 32 + 8 * g4 + 4 * kh) = v;
      }
  }
  __syncthreads();
  if (map == 0) {
    float ss = 0.f;
#pragma unroll
    for (int vb = 0; vb < 4; ++vb)
#pragma unroll
      for (int g4 = 0; g4 < 4; ++g4) {
        const f32x4 o2 = *(const f32x4*)(ex + (wq * 32 + l31) * 132 + vb * 32 + 8 * g4 + 4 * kh);
#pragma unroll
        for (int j = 0; j < 4; ++j) { const float o = O[vb][4 * g4 + j] * inv - lam * o2[j]; O[vb][4 * g4 + j] = o; ss += o * o; }
      }
    ss = xor32_sum(ss);
    const float rs = rsqrtf(ss * (1.0f / 128.0f) + LN_EPS) * nscale;
    bf16_t* op = outp + (size_t)(wq * 32 + l31) * 1024;
#pragma unroll
    for (int vb = 0; vb < 4; ++vb)
#pragma unroll
      for (int g4 = 0; g4 < 4; ++g4) {
        const int vc = vb * 32 + 8 * g4 + 4 * kh;
        const f32x4 g = *(const f32x4*)(subg + vc);
        *(u32x2*)(op + vc) = (u32x2){pk2(O[vb][4 * g4] * rs * g[0], O[vb][4 * g4 + 1] * rs * g[1]), pk2(O[vb][4 * g4 + 2] * rs * g[2], O[vb][4 * g4 + 3] * rs * g[3])};
      }
  }
  __syncthreads();
}

template <int MI>
DI void store_tile_bf16(const f32x4 (&acc)[MI][4], bf16_t* __restrict__ C, int ldc, float scale) {
  const int tid = g_tid(), lane = tid & 63, wid = __builtin_amdgcn_readfirstlane(tid >> 6), wm = wid >> 1, wn = wid & 1, fq = lane >> 4, fr = lane & 15;
#pragma unroll
  for (int mi = 0; mi < MI; ++mi)
#pragma unroll
    for (int ni = 0; ni < 4; ++ni) {
      const f32x4 v = acc[mi][ni] * scale;
      *(u32x2*)(C + (size_t)(wm * 16 * MI + mi * 16 + fr) * ldc + wn * 64 + ni * 16 + fq * 4) = (u32x2){pk2(v[0], v[1]), pk2(v[2], v[3])};
    }
}

template <int W>
DI void pool_rows(const bf16_t* __restrict__ R, bf16_t* __restrict__ PM, int m0, int g, int rhalf, int lane) {
  constexpr int LO = W / 2;
  const int col = g * 128 + (lane & 15) * 8;
#pragma unroll 2
  for (int ps = 0; ps < 8; ++ps) {
    const int row = m0 + ps * 8 + rhalf * 4 + (lane >> 4);
    int b, pos; bool isctx; row_info(row, b, pos, isctx);
    const int L = isctx ? LC : SEQ;
    const int rbase = row - pos;
    float s[8];
#pragma unroll
    for (int j = 0; j < 8; ++j) s[j] = 0.f;
    int cnt = 0;
    u32x4 self = {0u, 0u, 0u, 0u};
#pragma unroll
    for (int k = 0; k < W; ++k) {
      const int q = pos - LO + k;
      const bool ok = (q >= 0) && (q < L);
      const int qc = ok ? q : pos;
      const u32x4 v = *(const u32x4*)(R + (size_t)(rbase + qc) * 512 + col);
      const float f = ok ? 1.0f : 0.0f;
      cnt += ok ? 1 : 0;
#pragma unroll
      for (int j = 0; j < 4; ++j) { s[2 * j] += f * bf_lo(v[j]); s[2 * j + 1] += f * bf_hi(v[j]); }
      if (k == LO) self = v;
    }
    const float ic = 1.0f / (float)cnt;
    u32x4 o;
#pragma unroll
    for (int j = 0; j < 4; ++j) o[j] = pk2(s[2 * j] * ic - bf_lo(self[j]), s[2 * j + 1] * ic - bf_hi(self[j]));
    *(u32x4*)(PM + (size_t)row * 512 + col) = o;
  }
}
DI void pool_task(const bf16_t* __restrict__ R, bf16_t* __restrict__ PM, int m0) {
  const int tid = g_tid(), lane = tid & 63, wid = __builtin_amdgcn_readfirstlane(tid >> 6), g = wid & 3, rhalf = wid >> 2;
  if (g == 0) pool_rows<2>(R, PM, m0, 0, rhalf, lane);
  else if (g == 1) pool_rows<4>(R, PM, m0, 1, rhalf, lane);
  else if (g == 2) pool_rows<8>(R, PM, m0, 2, rhalf, lane);
  else pool_rows<16>(R, PM, m0, 3, rhalf, lane);
}

DI void phase_mix(const Params& p, int l, char* smem) {
  const bool last = (l == DEPTH - 1);
  const bf16_t* KB = (const bf16_t*)(p.ws + OFF_KB); const bf16_t* VT = (const bf16_t*)(p.ws + OFF_VT);
  const bf16_t* QB = (const bf16_t*)(p.ws + OFF_QB); const bf16_t* CQ = (const bf16_t*)(p.ws + OFF_CQ);
  const bf16_t* ZT = (const bf16_t*)(p.ws + OFF_ZT); const bf16_t* ZTC = (const bf16_t*)(p.ws + OFF_ZTC); const bf16_t* R = (const bf16_t*)(p.ws + OFF_R);
  bf16_t* ATT = (bf16_t*)(p.ws + OFF_ATT); bf16_t* FM = (bf16_t*)(p.ws + OFF_FM); bf16_t* PM = (bf16_t*)(p.ws + OFF_PM);
  const bf16_t* ATAB = (const bf16_t*)(p.ws + OFF_ATAB); const bf16_t* ATABC = (const bf16_t*)(p.ws + OFF_ATABC);
  const float lam = ((const float*)(p.ws + OFF_LAMV))[l];
  const float nscale = 1.0f - p.lam_init[l];
  const float* subg = p.subln_g + (size_t)l * 128;
  const int n_attn = 1024, n_dft = 256, n_cattn = last ? 0 : 128, n_cdft = last ? 0 : 32, n_pool = last ? 256 : 288;
  const int total = n_attn + n_dft + n_cattn + n_cdft + n_pool;
  for (int t = blockIdx.x; t < total; t += gridDim.x) {
    int r = t;
    if (r < n_attn) {
      const int c = r >> 8, w = r & 255, xcd = w & 7, local = w >> 3;
      const int bh = c * 16 + xcd * 2 + (local >> 4), qb = local & 15;
      const int b = bh >> 3, h = bh & 7;
      attn_unit(QB + (size_t)bh * 2 * SEQ * 64, SEQ, qb * 128, KB + (size_t)bh * 2 * NKEY * 64, VT + (size_t)bh * 128 * NKEY, 0, NKEY / 64,
                ATT + ((size_t)b * SEQ + qb * 128) * 1024 + h * 128, subg, lam, nscale, smem);
      continue;
    }
    r -= n_attn;
    if (r < n_dft) {
      const int b = r & 7, local = r >> 3, mt = local & 7, nt = local >> 3;
      f32x4 acc[4][4]; zero_acc(acc);
      gemm_kloop_pp<true>(ATAB + (size_t)mt * 256 * 4096, 4096, ZT + ((size_t)b * 512 + nt * 128) * 4096, 4096, 4096, acc, smem);
      store_tile_bf16<4>(acc, FM + ((size_t)b * SEQ + mt * 256) * 512 + nt * 128, 512, 1.0f / 512.0f);
      continue;
    }
    r -= n_dft;
    if (r < n_cattn) {
      const int bh = r >> 1, qb = r & 1, b = bh >> 3, h = bh & 7;
      attn_unit(CQ + (size_t)bh * 2 * LC * 64, LC, qb * 128, KB + (size_t)bh * 2 * NKEY * 64, VT + (size_t)bh * 128 * NKEY, SEQ, LC / 64,
                ATT + ((size_t)T_LAT + b * LC + qb * 128) * 1024 + h * 128, subg, lam, nscale, smem);
      continue;
    }
    r -= n_cattn;
    if (r < n_cdft) {
      const int b = r >> 2, nt = r & 3;
      f32x4 acc[4][4]; zero_acc(acc);
      gemm_kloop_pp<true>(ATABC, 512, ZTC + ((size_t)b * 512 + nt * 128) * 512, 512, 512, acc, smem);
      store_tile_bf16<4>(acc, FM + ((size_t)T_LAT + b * LC) * 512 + nt * 128, 512, 0.005524271728019903f  );
      continue;
    }
    r -= n_cdft;
    pool_task(R, PM, r * 64);
  }
}

template <int MI>
DI void phase_branch(const Params& p, int l, char* smem) {
  const bool last = (l == DEPTH - 1);
  const bf16_t* W = (const bf16_t*)(p.ws + w_off(l));
  const bf16_t* U = (const bf16_t*)(p.ws + OFF_U);
  const bf16_t* ATT = (const bf16_t*)(p.ws + OFF_ATT); const bf16_t* FM = (const bf16_t*)(p.ws + OFF_FM); const bf16_t* PM = (const bf16_t*)(p.ws + OFF_PM);
  bf16_t* MOUT = (bf16_t*)(p.ws + OFF_MOUT);
  const int nmt = (last ? T_LAT : T_ALL) / (64 * MI), vmax = tile_vmax(nmt, 8);
  for (int v = blockIdx.x; v < vmax; v += gridDim.x) {
    int mt, nt;
    if (!tile_map(v, nmt, 8, mt, nt)) continue;
    const int m0 = mt * 64 * MI, n0 = nt * 128;
    u32x2 tot[MI][4], gpk[MI][4];
#pragma unroll
    for (int mi = 0; mi < MI; ++mi)
#pragma unroll
      for (int ni = 0; ni < 4; ++ni) tot[mi][ni] = (u32x2){0u, 0u};
#pragma unroll 1
    for (int br = 0; br < 3; ++br) {
      __builtin_amdgcn_sched_barrier(0);
      f32x4 acc[MI][4]; zero_acc_t<MI>(acc);
      const bool pre = !last && br == 0 && (m0 + 64 * MI <= G8_ROWS);
      if (!pre) {
        gemm_kloop_pp<true, MI>(U + (size_t)m0 * 1024, 1024, W + WO_WIN + (size_t)(ROW_G + br * 1024 + n0) * 1024, 1024, 1024, acc, smem);
        __builtin_amdgcn_sched_barrier(0);
#pragma unroll
        for (int mi = 0; mi < MI; ++mi)
#pragma unroll
          for (int ni = 0; ni < 4; ++ni) {
            const f32x4 a = acc[mi][ni];
            gpk[mi][ni] = (u32x2){pk2(sigmoidf_(a[0]), sigmoidf_(a[1])), pk2(sigmoidf_(a[2]), sigmoidf_(a[3]))};
          }
      } else {
        const unsigned char* G8 = (const unsigned char*)(p.ws + OFF_G8);
        const int tid_ = g_tid(), lane_ = tid_ & 63, wid_ = __builtin_amdgcn_readfirstlane(tid_ >> 6), wm_ = wid_ >> 1, wn_ = wid_ & 1, fq_ = lane_ >> 4, fr_ = lane_ & 15;
#pragma unroll
        for (int mi = 0; mi < MI; ++mi)
#pragma unroll
          for (int ni = 0; ni < 4; ++ni) {
            const unsigned g = *(const unsigned*)(G8 + (size_t)(m0 + wm_ * 16 * MI + mi * 16 + fr_) * 1024 + n0 + wn_ * 64 + ni * 16 + fq_ * 4);
            gpk[mi][ni] = (u32x2){pk2((float)(g & 255u) * (1.0f / 255.0f), (float)((g >> 8) & 255u) * (1.0f / 255.0f)),
                                  pk2((float)((g >> 16) & 255u) * (1.0f / 255.0f), (float)(g >> 24) * (1.0f / 255.0f))};
          }
      }
      __builtin_amdgcn_sched_barrier(0);
      zero_acc_t<MI>(acc);
      const int K2 = (br == 0) ? 1024 : 512;
      const bf16_t* A2 = (br == 0) ? (ATT + (size_t)m0 * 1024) : ((br == 1 ? FM : PM) + (size_t)m0 * 512);
      const bf16_t* B2 = (br == 0) ? (W + WO_WA + (size_t)n0 * 1024) : (W + (br == 1 ? WO_WF : WO_WP) + (size_t)n0 * 512);
      gemm_kloop_pp<true, MI>(A2, K2, B2, K2, K2, acc, smem);
      __builtin_amdgcn_sched_barrier(0);
#pragma unroll
      for (int mi = 0; mi < MI; ++mi)
#pragma unroll
        for (int ni = 0; ni < 4; ++ni) {
          const f32x4 a = acc[mi][ni]; const u32x2 g = gpk[mi][ni]; const u32x2 tp = tot[mi][ni];
          const float v0 = bf_lo(g[0]) * a[0] + bf_lo(tp[0]), v1 = bf_hi(g[0]) * a[1] + bf_hi(tp[0]);
          const float v2 = bf_lo(g[1]) * a[2] + bf_lo(tp[1]), v3 = bf_hi(g[1]) * a[3] + bf_hi(tp[1]);
          tot[mi][ni] = (u32x2){pk2(v0, v1), pk2(v2, v3)};
        }
    }
    const int tid = g_tid(), lane = tid & 63, wid = __builtin_amdgcn_readfirstlane(tid >> 6), wm = wid >> 1, wn = wid & 1, fq = lane >> 4, fr = lane & 15;
#pragma unroll
    for (int mi = 0; mi < MI; ++mi)
#pragma unroll
      for (int ni = 0; ni < 4; ++ni)
        *(u32x2*)(MOUT + (size_t)(m0 + wm * 16 * MI + mi * 16 + fr) * 1024 + n0 + wn * 64 + ni * 16 + fq * 4) = tot[mi][ni];
  }
}

template <int MI>
DI void phase_gemm_plain(const bf16_t* __restrict__ A, int K, const bf16_t* __restrict__ Bt, bf16_t* __restrict__ C, int nmt, int nnt, char* smem) {
  const int vmax = tile_vmax(nmt, nnt), N = nnt * 128;
  for (int v = blockIdx.x; v < vmax; v += gridDim.x) {
    int mt, nt;
    if (!tile_map(v, nmt, nnt, mt, nt)) continue;
    f32x4 acc[MI][4]; zero_acc_t<MI>(acc);
    gemm_kloop_pp<true, MI>(A + (size_t)mt * 64 * MI * K, K, Bt + (size_t)nt * 128 * K, K, K, acc, smem);
    store_tile_bf16<MI>(acc, C + (size_t)mt * 64 * MI * N + nt * 128, N, 1.0f);
  }
}
DI void phase_ffn1(const Params& p, int l, char* smem) {
  const bool last = (l == DEPTH - 1);
  const bf16_t* W = (const bf16_t*)(p.ws + w_off(l)) + WO_WGU;
  const bf16_t* U = (const bf16_t*)(p.ws + OFF_U);
  bf16_t* H = (bf16_t*)(p.ws + OFF_H);
  const int nsup = (last ? 8 : 9) * 11;
  const int vmax = ((nsup + 15) >> 4) << 8;
  auto map_tile = [&](int v, int& mt, int& nt) -> bool {
    if (v >= vmax) return false;
    const int c = v >> 8, w = v & 255, local = w >> 3, sup = (c * 8 + (w & 7)) * 2 + (local >> 4);
    if (sup >= nsup) return false;
    mt = (sup / 11) * 8 + (local & 7); nt = (sup % 11) * 2 + ((local >> 3) & 1);
    return true;
  };
  int v = blockIdx.x, mt = 0, nt = 0;
  bool cur = map_tile(v, mt, nt);
  if (cur) gemm_prefetch_big(U + (size_t)mt * 256 * 1024, 1024, W + (size_t)nt * 256 * 1024, 1024, smem);
  while (cur) {
    f32x4 acc[8][4];
#pragma unroll
    for (int i = 0; i < 8; ++i)
#pragma unroll
      for (int j = 0; j < 4; ++j) acc[i][j] = (f32x4){0.f, 0.f, 0.f, 0.f};
    gemm_kloop_big<true>(U + (size_t)mt * 256 * 1024, 1024, W + (size_t)nt * 256 * 1024, 1024, 1024, acc, smem, true);
    int v2 = v + gridDim.x, mt2 = 0, nt2 = 0;
    const bool nxt = map_tile(v2, mt2, nt2);
    if (nxt) gemm_prefetch_big(U + (size_t)mt2 * 256 * 1024, 1024, W + (size_t)nt2 * 256 * 1024, 1024, smem);
    const int tid = g_tid(), lane = tid & 63, wid = __builtin_amdgcn_readfirstlane(tid >> 6), wm = wid >> 2, wn = wid & 3, fq = lane >> 4, fr = lane & 15;
#pragma unroll
    for (int mi = 0; mi < 8; ++mi) {
      float o[8];
#pragma unroll
      for (int h2 = 0; h2 < 2; ++h2) {
        const f32x4 g = acc[mi][h2], u = acc[mi][2 + h2];
#pragma unroll
        for (int j = 0; j < 4; ++j) o[4 * h2 + j] = g[j] * sigmoidf_(g[j]) * u[j];
      }
      *(u32x4*)(H + (size_t)(mt * 256 + wm * 128 + mi * 16 + fr) * DFF + (nt * 4 + wn) * 32 + 8 * fq) = (u32x4){pk2(o[0], o[1]), pk2(o[2], o[3]), pk2(o[4], o[5]), pk2(o[6], o[7])};
    }
    v = v2; mt = mt2; nt = nt2; cur = nxt;
  }
}

struct InprojSched {
  const char* U; const char* W; int nsupA, nsup, vmax, grid, bid; bool fill;
  DI static bool transposed(int nt) { return (nt >= 4 && nt < 8) || (nt >= 12 && nt < 16); }
  DI bool next(int i, pg8::Unit& u) const {
    const int v = bid + i * grid;
    if (v >= vmax) return false;
    const int c = v >> 8, w = v & 255, local = w >> 3, sup = (c * 8 + (w & 7)) * 2 + (local >> 4);
    if (sup >= nsup) return false;
    if (sup < nsupA) { u.pm = (sup / 9) * 8 + (local & 7); u.pn = (sup % 9) * 2 + ((local >> 3) & 1); }
    else if (fill) { const int q = (sup - nsupA) * 16 + (local & 15); u.pm = q >> 2; u.pn = 18 + (q & 3); }
    else { u.pm = 64 + (local & 7); u.pn = (sup - nsupA) * 2 + ((local >> 3) & 1); }
    return true;
  }
  DI const char* pa(const pg8::Unit& u) const { return transposed(u.pn) ? W + (size_t)u.pn * 256 * 1024 * 2 : U + (size_t)u.pm * 256 * 1024 * 2; }
  DI const char* pb(const pg8::Unit& u) const { return transposed(u.pn) ? U + (size_t)u.pm * 256 * 1024 * 2 : W + (size_t)u.pn * 256 * 1024 * 2; }
};
struct InprojEpi {
  bf16_t *KB, *VT, *QB, *CQ, *ZT, *ZTC, *R; unsigned char* G8; const float *ropec, *ropes;
  DI void operator()(const f32x4 (&acc)[2][2][4][2], const pg8::Unit& u, int wr, int wc, int fr, int fq) const {
    const int mt = u.pm, nt = u.pn, m0 = mt * 256;
    int b, pos0; bool isctx; row_info(m0, b, pos0, isctx);
    if (nt < 4 || (nt >= 8 && nt < 12)) {
      const bool isq = nt >= 8; const int map = wc >> 1, axis = wc & 1;
      const float sc = isq ? QSCALE : 1.0f;
#pragma unroll
      for (int ai = 0; ai < 2; ++ai)
#pragma unroll
        for (int m = 0; m < 4; ++m) {
          const int pos = pos0 + 128 * ai + 64 * wr + 16 * m + fr;
          f32x4 cs = {1.f, 1.f, 1.f, 1.f}, sn = {0.f, 0.f, 0.f, 0.f};
          if (!isctx) { cs = *(const f32x4*)(ropec + pos * 32 + axis * 16 + fq * 4); sn = *(const f32x4*)(ropes + pos * 32 + axis * 16 + fq * 4); }
#pragma unroll
          for (int bj = 0; bj < 2; ++bj) {
            const int h = (nt * 2 + bj) & 7;
            const f32x4 x0 = acc[ai][bj][m][0], x1 = acc[ai][bj][m][1];
            const f32x4 o0 = (x0 * cs - x1 * sn) * sc, o1 = (x1 * cs + x0 * sn) * sc;
            bf16_t* dst;
            if (!isq) dst = KB + ((size_t)((b * 8 + h) * 2 + map) * NKEY + (isctx ? SEQ + pos : pos)) * 64;
            else if (!isctx) dst = QB + ((size_t)((b * 8 + h) * 2 + map) * SEQ + pos) * 64;
            else dst = CQ + ((size_t)((b * 8 + h) * 2 + map) * LC + pos) * 64;
            *(u32x2*)(dst + axis * 32 + fq * 4) = (u32x2){pk2(o0[0], o0[1]), pk2(o0[2], o0[3])};
            *(u32x2*)(dst + axis * 32 + 16 + fq * 4) = (u32x2){pk2(o1[0], o1[1]), pk2(o1[2], o1[3])};
          }
        }
    } else if (nt < 8 || (nt >= 12 && nt < 16)) {
      const bool isv = nt < 8;
#pragma unroll
      for (int ai = 0; ai < 2; ++ai)
#pragma unroll
        for (int m = 0; m < 4; ++m) {
          const int ncol = nt * 256 + 128 * ai + 64 * wr + 16 * m + fr;
#pragma unroll
          for (int bj = 0; bj < 2; ++bj)
#pragma unroll
            for (int n = 0; n < 2; ++n) {
              const int pos = pos0 + 128 * bj + 32 * wc + 16 * n + 4 * fq;
              const f32x4 vv = acc[ai][bj][m][n];
              bf16_t* dst;
              if (isv) {
                const int vg = ncol - 1024, h = vg >> 7, vcol = vg & 127;
                const int key = (isctx ? SEQ : 0) + pos, k15 = key & 15;
                const int pkey = (key & ~15) | (k15 & 3) | ((k15 & 4) << 1) | ((k15 & 8) >> 1);
                dst = VT + ((size_t)(b * 8 + h) * 128 + vcol) * NKEY + pkey;
              } else {
                const int zc = ncol - 3072, np = zc & 511, second = zc >> 9;
                dst = isctx ? (ZTC + ((size_t)b * 512 + np) * 512 + second * 256 + pos) : (ZT + ((size_t)b * 512 + np) * 4096 + second * 2048 + pos);
              }
              *(u32x2*)dst = (u32x2){pk2(vv[0], vv[1]), pk2(vv[2], vv[3])};
            }
        }
    } else if (nt >= 18) {
#pragma unroll
      for (int ai = 0; ai < 2; ++ai)
#pragma unroll
        for (int m = 0; m < 4; ++m) {
          const int row = m0 + 128 * ai + 64 * wr + 16 * m + fr;
#pragma unroll
          for (int bj = 0; bj < 2; ++bj)
#pragma unroll
            for (int n = 0; n < 2; ++n) {
              const int col = nt * 256 + 128 * bj + 32 * wc + 16 * n + 4 * fq - 4608;
              const f32x4 vv = acc[ai][bj][m][n];
              unsigned w = 0;
#pragma unroll
              for (int j = 0; j < 4; ++j) w |= (unsigned)__builtin_rintf(sigmoidf_(vv[j]) * 255.0f) << (8 * j);
              *(unsigned*)(G8 + (size_t)row * 1024 + col) = w;
            }
        }
    } else {
#pragma unroll
      for (int ai = 0; ai < 2; ++ai)
#pragma unroll
        for (int m = 0; m < 4; ++m) {
          const int row = m0 + 128 * ai + 64 * wr + 16 * m + fr;
#pragma unroll
          for (int bj = 0; bj < 2; ++bj)
#pragma unroll
            for (int n = 0; n < 2; ++n) {
              const int col = nt * 256 + 128 * bj + 32 * wc + 16 * n + 4 * fq - 4096;
              const f32x4 vv = acc[ai][bj][m][n];
              *(u32x2*)(R + (size_t)row * 512 + col) = (u32x2){pk2(vv[0], vv[1]), pk2(vv[2], vv[3])};
            }
        }
    }
  }
};
DI void phase_inproj8(const Params& p, int l, char* smem) {
  const bool last = (l == DEPTH - 1);
  InprojSched S;
  S.U = (const char*)(p.ws + OFF_U); S.W = (const char*)((const bf16_t*)(p.ws + w_off(l)) + WO_WIN);
  S.nsupA = last ? 72 : 81; S.nsup = last ? 76 : 96; S.fill = !last;
  S.vmax = ((S.nsup + 15) >> 4) << 8; S.grid = gridDim.x; S.bid = blockIdx.x;
  InprojEpi E;
  E.KB = (bf16_t*)(p.ws + OFF_KB); E.VT = (bf16_t*)(p.ws + OFF_VT); E.QB = (bf16_t*)(p.ws + OFF_QB); E.CQ = (bf16_t*)(p.ws + OFF_CQ);
  E.ZT = (bf16_t*)(p.ws + OFF_ZT); E.ZTC = (bf16_t*)(p.ws + OFF_ZTC); E.R = (bf16_t*)(p.ws + OFF_R);
  E.ropec = (const float*)(p.ws + OFF_ROPEC); E.ropes = (const float*)(p.ws + OFF_ROPES); E.G8 = (unsigned char*)(p.ws + OFF_G8);
  pg8::gemm_phase(( __attribute__((address_space(3))) unsigned char*)(lds_ptr_t)smem, 1024, S, E);
}
struct Ffn1Sched {
  const char* U; const char* W; int nsup, vmax, grid, bid;
  DI bool next(int i, pg8::Unit& u) const {
    const int v = bid + i * grid;
    if (v >= vmax) return false;
    const int c = v >> 8, w = v & 255, local = w >> 3, sup = (c * 8 + (w & 7)) * 2 + (local >> 4);
    if (sup >= nsup) return false;
    u.pm = (sup / 11) * 8 + (local & 7); u.pn = (sup % 11) * 2 + ((local >> 3) & 1);
    return true;
  }
  DI const char* pa(const pg8::Unit& u) const { return U + (size_t)u.pm * 256 * 1024 * 2; }
  DI const char* pb(const pg8::Unit& u) const { return W + (size_t)u.pn * 256 * 1024 * 2; }
};
struct Ffn1Epi {
  bf16_t* H;
  DI void operator()(const f32x4 (&acc)[2][2][4][2], const pg8::Unit& u, int wr, int wc, int fr, int fq) const {
#pragma unroll
    for (int ai = 0; ai < 2; ++ai)
#pragma unroll
      for (int m = 0; m < 4; ++m) {
        const int row = u.pm * 256 + 128 * ai + 64 * wr + 16 * m + fr;
#pragma unroll
        for (int bj = 0; bj < 2; ++bj) {
          const f32x4 g = acc[ai][bj][m][0], up = acc[ai][bj][m][1];
          float o[4];
#pragma unroll
          for (int j = 0; j < 4; ++j) o[j] = g[j] * sigmoidf_(g[j]) * up[j];
          *(u32x2*)(H + (size_t)row * DFF + u.pn * 128 + (bj * 4 + wc) * 16 + fq * 4) = (u32x2){pk2(o[0], o[1]), pk2(o[2], o[3])};
        }
      }
  }
};
DI void phase_ffn18(const Params& p, int l, char* smem) {
  const bool last = (l == DEPTH - 1);
  Ffn1Sched S;
  S.U = (const char*)(p.ws + OFF_U); S.W = (const char*)((const bf16_t*)(p.ws + w_off(l)) + WO_WGU);
  S.nsup = (last ? 8 : 9) * 11; S.vmax = ((S.nsup + 15) >> 4) << 8; S.grid = gridDim.x; S.bid = blockIdx.x;
  Ffn1Epi E; E.H = (bf16_t*)(p.ws + OFF_H);
  pg8::gemm_phase((__attribute__((address_space(3))) unsigned char*)(lds_ptr_t)smem, 1024, S, E);
  if (!last) convert_grab(p, l + 1, 1, smem);
}

#define XB_TMO      128
#define XB_XCNT(j)  (256  + 64 * (j))
#define XB_XSUB(j)  (1280 + 64 * (j))
#define XB_XGEN(j)  (2304 + 64 * (j))
#define XB_TOP      3328
#define XB_TOPGEN   3392
#define XCD_BAR_WORDS 3456
#define XB_SPIN_CAP (1u << 20)
#define LAS __attribute__((address_space(3)))
DI unsigned xb_ld(unsigned* p) { return __hip_atomic_load(p, __ATOMIC_RELAXED, __HIP_MEMORY_SCOPE_AGENT); }
DI unsigned xb_add(unsigned* p, unsigned v) { return __hip_atomic_fetch_add(p, v, __ATOMIC_RELAXED, __HIP_MEMORY_SCOPE_AGENT); }
DI unsigned xb_xcc_id() { return (unsigned)__builtin_amdgcn_s_getreg((3 << 11) | 20) & 0xFu; }
#define XB_SPIN(cond, bar) do { unsigned _sp = 0; while (cond) { __builtin_amdgcn_s_sleep(1); \
    if ((++_sp & 255u) == 0u) { if (xb_ld(&(bar)[XB_TMO])) break; if (_sp > XB_SPIN_CAP) { atomicAdd(&(bar)[XB_TMO], 1u); break; } } } } while (0)
struct XcdBarrier { unsigned* bar; unsigned x; volatile LAS unsigned* st; };
DI XcdBarrier xcd_barrier_post(unsigned* bar, volatile LAS unsigned* st) {
  XcdBarrier b; b.bar = bar; b.x = xb_xcc_id(); b.st = st;
  if (__builtin_amdgcn_workitem_id_x() == 0) (void)xb_add(&bar[XB_XCNT(b.x)], 1u);
  return b;
}
DI void xcd_barrier_complete(unsigned* bar, unsigned x, unsigned& nloc, unsigned& nx) {
  const unsigned G = gridDim.x * gridDim.y * gridDim.z;
  unsigned sum, cnt, mine, sp = 0u;
  for (;;) {
    sum = 0u; cnt = 0u; mine = 0u;
#pragma unroll
    for (unsigned j = 0; j < 16; ++j) { const unsigned c = xb_ld(&bar[XB_XCNT(j)]); sum += c; cnt += (c > 0u) ? 1u : 0u; mine = (j == x) ? c : mine; }
    if (sum == G) break;
    __builtin_amdgcn_s_sleep(1);
    if ((++sp & 255u) == 0u) { if (xb_ld(&bar[XB_TMO])) break; if (sp > XB_SPIN_CAP) { atomicAdd(&bar[XB_TMO], 1u); break; } }
  }
  nloc = mine > 0u ? mine : 1u; nx = cnt > 0u ? cnt : 1u;
}
DI void xcd_barrier(const XcdBarrier& b) {
  asm volatile("s_waitcnt vmcnt(0)" ::: "memory");
  __syncthreads();
  if (__builtin_amdgcn_workitem_id_x() == 0) {
    unsigned* bar = b.bar;
    __builtin_amdgcn_s_waitcnt(0);
    unsigned nloc = b.st[0], nx = b.st[1];
    if (nloc == 0u) { xcd_barrier_complete(bar, b.x, nloc, nx); b.st[0] = nloc; b.st[1] = nx; }
    const unsigned old = xb_add(&bar[XB_XSUB(b.x)], 1u);
    const unsigned gen = old / nloc;
    if (old + 1u == (gen + 1u) * nloc) {
      __builtin_amdgcn_fence(__ATOMIC_RELEASE, "agent");
      asm volatile("s_waitcnt vmcnt(0)" ::: "memory");
      const unsigned og = xb_add(&bar[XB_TOP], 1u);
      const unsigned tg = og / nx;
      if (og + 1u == (tg + 1u) * nx) xb_add(&bar[XB_TOPGEN], 1u);
      else XB_SPIN(xb_ld(&bar[XB_TOPGEN]) == tg, bar);
      __builtin_amdgcn_fence(__ATOMIC_ACQUIRE, "agent");
      xb_add(&bar[XB_XGEN(b.x)], 1u);
      asm volatile("s_waitcnt vmcnt(0)" ::: "memory");
    } else {
      XB_SPIN(xb_ld(&bar[XB_XGEN(b.x)]) == gen, bar);
      __builtin_amdgcn_fence(__ATOMIC_ACQUIRE, "agent");
      asm volatile("s_waitcnt vmcnt(0)" ::: "memory");
    }
  }
  __syncthreads();
}

#define REP_MASK 0
#define REP_PRO 0
__global__ void __launch_bounds__(512) mega(Params p0) {
  extern __shared__ __attribute__((aligned(16))) char smem[];
  cg::grid_group grid = cg::this_grid();
  volatile LAS unsigned* xst = (volatile LAS unsigned*)(lds_ptr_t)(smem + 3 * GSTAGE);
  if (__builtin_amdgcn_workitem_id_x() < 4) xst[__builtin_amdgcn_workitem_id_x()] = 0u;
  __syncthreads();
  const XcdBarrier xb = xcd_barrier_post((unsigned*)(p0.ws + OFF_BAR), xst);
  for (int ph = p0.ph_begin; ph < p0.ph_end; ++ph) {
    const Params& p = p0;
    const bf16_t* Wl = (const bf16_t*)(p.ws + w_off(ph >= 2 ? (ph - 2) >> 3 : 0));
    if (ph == 0) { phase0a(p, smem); if (REP_PRO & 1) { xcd_barrier(xb); phase0a(p, smem); } }
    else if (ph == 1) { ln_pass(p, 0, T_ALL, nullptr, nullptr, nullptr, 0, 0, 0, 0); if (REP_PRO & 2) { xcd_barrier(xb); ln_pass(p, 0, T_ALL, nullptr, nullptr, nullptr, 0, 0, 0, 0); } }
    else {
      const int l = (ph - 2) >> 3, s = (ph - 2) & 7;
      const bool last = (l == DEPTH - 1);
      const int nmt = last ? 64 : 72, nrows = last ? T_LAT : T_ALL;
      for (int rep = 0; rep < 1 + ((REP_MASK >> s) & 1); ++rep) {
      if (rep) xcd_barrier(xb);
      switch (s) {
        case 0: phase_inproj8(p, l, smem); break;
        case 1: phase_mix(p, l, smem); if (!last) convert_grab(p, l + 1, 0, smem); break;
        case 2: if (last) phase_branch<4>(p, l, smem); else { phase_branch<3>(p, l, smem); convert_grab(p, l + 1, 0, smem); } break;
        case 3: if (last) phase_gemm_plain<4>((const bf16_t*)(p.ws + OFF_MOUT), 1024, Wl + WO_WO, (bf16_t*)(p.ws + OFF_Y), 64, 8, smem);
                else phase_gemm_plain<3>((const bf16_t*)(p.ws + OFF_MOUT), 1024, Wl + WO_WO, (bf16_t*)(p.ws + OFF_Y), 96, 8, smem);
                break;
        case 4: ln_pass(p, 1, nrows, (const bf16_t*)(p.ws + OFF_Y), p.ln1_g + (size_t)l * 1024, p.ln1_b + (size_t)l * 1024, l, 2, l, 3); break;
        case 5: phase_ffn18(p, l, smem); break;
        case 6: if (last) phase_gemm_plain<4>((const bf16_t*)(p.ws + OFF_H), DFF, Wl + WO_WD, (bf16_t*)(p.ws + OFF_FO), 64, 8, smem);
                else phase_gemm_plain<3>((const bf16_t*)(p.ws + OFF_H), DFF, Wl + WO_WD, (bf16_t*)(p.ws + OFF_FO), 96, 8, smem);
                break;
        default:
          ln_pass(p, last ? 2 : 1, nrows, (const bf16_t*)(p.ws + OFF_FO), p.ln2_g + (size_t)l * 1024, p.ln2_b + (size_t)l * 1024, l, 5, last ? l : l + 1, 0);
          if (!last) { convert_grab(p, l + 1, 0, smem); convert_grab(p, l + 1, 1, smem); }
          break;
      }
      }
    }
    if (ph + 1 < p0.ph_end) { if (ph == p0.ph_begin) grid.sync(); else xcd_barrier(xb); }
  }
}

extern "C" void kernel_launch(void* const* d_in, const int* in_sizes, int n_in, void* d_out, int out_size, void* d_ws, size_t ws_size, hipStream_t stream) {
  constexpr size_t kDynLds = 3 * GSTAGE + 16;
  static int grid_blocks = 0;
  if (!grid_blocks) {
    int dev = 0, cus = 0, per_cu = 0;
    (void)hipGetDevice(&dev);
    (void)hipDeviceGetAttribute(&cus, hipDeviceAttributeMultiprocessorCount, dev);
    (void)hipFuncSetAttribute((const void*)mega, hipFuncAttributeMaxDynamicSharedMemorySize, (int)kDynLds);
    (void)hipOccupancyMaxActiveBlocksPerMultiprocessor(&per_cu, mega, 512, kDynLds);
    if (per_cu > 1) per_cu = 1;
    if (per_cu < 1) per_cu = 1;
    grid_blocks = cus * per_cu;
  }
  if (ws_size < WS_NEED) { fprintf(stderr, "workspace too small: %zu < %zu\n", ws_size, (size_t)WS_NEED); return; }
  (void)hipMemsetAsync((char*)d_ws + OFF_BAR, 0, XCD_BAR_WORDS * 4 + 64, stream);
  Params p;
  memset(&p, 0, sizeof(p));
  const float** fp = (const float**)&p;
  for (int i = 0; i < 22; ++i) fp[i] = (const float*)d_in[i];
  p.out = (float*)d_out;
  p.ws = (char*)d_ws;
  for (int l = 0; l < 4; ++l) p.lam_init[l] = (float)(0.8 - 0.6 * exp(-0.3 * l));
  p.ph_begin = 0; p.ph_end = 2 + 8 * DEPTH;
  void* args[] = {&p};
  hipError_t e = hipLaunchCooperativeKernel((void*)mega, dim3(grid_blocks), dim3(512), args, kDynLds, stream);
  if (e != hipSuccess) fprintf(stderr, "cooperative launch failed: %s (grid %d)\n", hipGetErrorString(e), grid_blocks);
}
```

```cpp
#include <hip/hip_runtime.h>
#include <hip/hip_cooperative_groups.h>
#include <cstdio>
#include <cstdint>
#include <cstring>
#include <cmath>
namespace cg = cooperative_groups;

#define DI __device__ __forceinline__
typedef unsigned short bf16_t;
typedef short bf16x8 __attribute__((ext_vector_type(8)));
typedef float f32x4 __attribute__((ext_vector_type(4)));
typedef float f32x2 __attribute__((ext_vector_type(2)));
typedef float f32x16 __attribute__((ext_vector_type(16)));
typedef unsigned u32x2 __attribute__((ext_vector_type(2)));
typedef unsigned u32x4 __attribute__((ext_vector_type(4)));
typedef __bf16 bf16x2_t __attribute__((ext_vector_type(2)));

constexpr int D = 1024, NB = 8, SEQ = 2048, LC = 256, NH = 8, DEPTH = 4;
constexpr int T_LAT = NB * SEQ, T_CTX = NB * LC, T_ALL = T_LAT + T_CTX;
constexpr int NKEY = SEQ + LC;
constexpr int N_IN = 7168, DFF = 2816;
constexpr int WIN_ROWS = 7680;
constexpr int ROW_Z1 = 3072, ROW_Z2 = 3584, ROW_R = 4096, ROW_G = 4608;
constexpr float ALPHA = 1.6817928305074290f;
constexpr float LN_EPS = 1e-5f;
constexpr float QSCALE = 0.125f * 1.4426950408889634f;

constexpr size_t WO_WIN = 0;
constexpr size_t WO_WA = WO_WIN + (size_t)WIN_ROWS * 1024;
constexpr size_t WO_WF = WO_WA + 1024 * 1024;
constexpr size_t WO_WP = WO_WF + 1024 * 512;
constexpr size_t WO_WO = WO_WP + 1024 * 512;
constexpr size_t WO_WGU = WO_WO + 1024 * 1024;
constexpr size_t WO_WD = WO_WGU + (size_t)5632 * 1024;
constexpr size_t W_ELEMS = WO_WD + (size_t)1024 * DFF;

constexpr size_t al256(size_t x) { return (x + 255) & ~(size_t)255; }
constexpr size_t OFF_W = 0;
constexpr size_t OFF_ATAB = al256(OFF_W + W_ELEMS * 2);
constexpr size_t OFF_ATABC = al256(OFF_ATAB + (size_t)2048 * 4096 * 2);
constexpr size_t OFF_ROPEC = al256(OFF_ATABC + (size_t)256 * 512 * 2);
constexpr size_t OFF_ROPES = al256(OFF_ROPEC + (size_t)2048 * 32 * 4);
constexpr size_t OFF_MODV = al256(OFF_ROPES + (size_t)2048 * 32 * 4);
constexpr size_t OFF_LAMV = al256(OFF_MODV + (size_t)DEPTH * 9 * 6144 * 4);
constexpr size_t OFF_X = al256(OFF_LAMV + 256);
constexpr size_t OFF_U = al256(OFF_X + (size_t)T_ALL * 1024 * 4);
constexpr size_t OFF_KB = al256(OFF_U + (size_t)T_ALL * 1024 * 2);
constexpr size_t OFF_VT = al256(OFF_KB + (size_t)NB * NH * 2 * NKEY * 64 * 2);
constexpr size_t OFF_QB = al256(OFF_VT + (size_t)NB * NH * 128 * NKEY * 2);
constexpr size_t OFF_CQ = al256(OFF_QB + (size_t)NB * NH * 2 * SEQ * 64 * 2);
constexpr size_t OFF_ZT = al256(OFF_CQ + (size_t)NB * NH * 2 * LC * 64 * 2);
constexpr size_t OFF_ZTC = al256(OFF_ZT + (size_t)NB * 512 * 4096 * 2);
constexpr size_t OFF_R = al256(OFF_ZTC + (size_t)NB * 512 * 512 * 2);
constexpr size_t OFF_ATT = al256(OFF_R + (size_t)T_ALL * 512 * 2);
constexpr size_t OFF_FM = al256(OFF_ATT + (size_t)T_ALL * 1024 * 2);
constexpr size_t OFF_PM = al256(OFF_FM + (size_t)T_ALL * 512 * 2);
constexpr size_t OFF_BAR = al256(OFF_PM + (size_t)T_ALL * 512 * 2);
constexpr size_t OFF_CTR = OFF_BAR + 3456 * 4;
constexpr size_t OFF_W2 = al256(OFF_CTR + 64);
constexpr size_t OFF_G8 = al256(OFF_W2 + W_ELEMS * 2);
constexpr int G8_ROWS = 15360;
constexpr size_t WS_NEED = al256(OFF_G8 + (size_t)G8_ROWS * 1024);
constexpr size_t OFF_MOUT = OFF_KB;
constexpr size_t OFF_Y = OFF_VT;
constexpr size_t OFF_H = OFF_KB;
constexpr size_t OFF_FO = OFF_ATT;
static_assert((size_t)T_ALL * DFF * 2 <= OFF_CQ - OFF_KB, "H overlay too large");

struct Params {
  const float *x, *c, *ctx, *c_ctx, *w_mod, *b_mod, *w_in, *lam_qk, *subln_g, *w_att_br, *w_four_br, *w_pool_grp, *pool_scale,
      *w_pool_br, *w_out, *ln1_g, *ln1_b, *w_ffn_gate, *w_ffn_up, *w_ffn_down, *ln2_g, *ln2_b;
  float* out;
  char* ws;
  float lam_init[4];
  int ph_begin, ph_end;
};

DI size_t w_off(int l) { return (l & 1) ? OFF_W2 : OFF_W; }
DI int g_tid() { int t = __builtin_amdgcn_workitem_id_x(); asm volatile("" : "+v"(t)); return t; }
DI unsigned pk2(float a, float b) { f32x2 v = {a, b}; bf16x2_t r = __builtin_convertvector(v, bf16x2_t); return __builtin_bit_cast(unsigned, r); }
DI float bf_lo(unsigned u) { return __uint_as_float(u << 16); }
DI float bf_hi(unsigned u) { return __uint_as_float(u & 0xffff0000u); }
DI float hw_cos_rev(float r) { return __builtin_amdgcn_cosf(r); }
DI float hw_sin_rev(float r) { return __builtin_amdgcn_sinf(r); }
DI float sigmoidf_(float x) { return 1.0f / (1.0f + __expf(-x)); }
DI float xor32_sum(float v) { const auto r = __builtin_amdgcn_permlane32_swap(__float_as_uint(v), __float_as_uint(v), false, false); return __uint_as_float(r[0]) + __uint_as_float(r[1]); }
DI float xor32_max(float v) { const auto r = __builtin_amdgcn_permlane32_swap(__float_as_uint(v), __float_as_uint(v), false, false); return fmaxf(__uint_as_float(r[0]), __uint_as_float(r[1])); }
DI float dpp_add(float v, int) { return v; }
#define DPP_ADD(v, ctrl) ((v) + __uint_as_float(__builtin_amdgcn_update_dpp(0u, __float_as_uint(v), (ctrl), 0xF, 0xF, true)))
DI float wave_sum(float v) {
  v = DPP_ADD(v, 0xB1);
  v = DPP_ADD(v, 0x4E);
  v = DPP_ADD(v, 0x141);
  v = DPP_ADD(v, 0x140);
  { const auto r = __builtin_amdgcn_permlane16_swap(__float_as_uint(v), __float_as_uint(v), false, false); v = __uint_as_float(r[0]) + __uint_as_float(r[1]); }
  return xor32_sum(v);
}
#define MFMA16(a, b, c) __builtin_amdgcn_mfma_f32_16x16x32_bf16((a), (b), (c), 0, 0, 0)
#define MFMA32(a, b, c) __builtin_amdgcn_mfma_f32_32x32x16_bf16((a), (b), (c), 0, 0, 0)

constexpr int GSTAGE = 49152;
#define WAIT_VM(n) asm volatile("s_waitcnt vmcnt(" #n ")" ::: "memory")
typedef __attribute__((address_space(3))) void* lds_ptr_t;
template <bool SWAP, int MI = 4>
DI void gemm_kloop(const bf16_t* __restrict__ A, int lda, const bf16_t* __restrict__ B, int ldb, int K, f32x4 (&acc)[MI][4], char* smem, bool pre = false  ) {
  const int tid = g_tid(), lane = tid & 63, wid = __builtin_amdgcn_readfirstlane(tid >> 6), wm = wid >> 1, wn = wid & 1;
  const int lr = tid >> 3, lc = (tid & 7) ^ ((tid >> 4) & 7);
  const unsigned aoff = (unsigned)(lr * lda + lc * 8) * 2u, boff = (unsigned)(lr * ldb + lc * 8) * 2u;
  const char* Ac = (const char*)A; const char* Bc = (const char*)B;
  const int fr = lane & 15, fq = lane >> 4, sw = fr >> 1;
  const int a_base = (wm * 16 * MI + fr) * 128, b_base = 32768 + (wn * 64 + fr) * 128;
  const int nk = K >> 6;
  char* sdst = smem + tid * 16;
#define G_ISSUE(KT, ST) do { _Pragma("unroll") for (int i = 0; i < MI; ++i) \
      __builtin_amdgcn_global_load_lds((const void*)(Ac + ((size_t)(64 * i) * lda + (size_t)(KT) * 64) * 2 + aoff), (lds_ptr_t)(sdst + (ST) * GSTAGE + i * 8192), 16, 0, 0); \
    _Pragma("unroll") for (int i = 0; i < 2; ++i) \
      __builtin_amdgcn_global_load_lds((const void*)(Bc + ((size_t)(64 * i) * ldb + (size_t)(KT) * 64) * 2 + boff), (lds_ptr_t)(sdst + (ST) * GSTAGE + 32768 + i * 8192), 16, 0, 0); } while (0)
#define G_COMPUTE(ST) do { const char* st_ = smem + (ST) * GSTAGE; \
    _Pragma("unroll") for (int ks = 0; ks < 2; ++ks) { const int co = ((ks * 4 + fq) ^ sw) << 4; bf16x8 af[MI], bfr[4]; \
      _Pragma("unroll") for (int i = 0; i < 4; ++i) bfr[i] = *(const bf16x8*)(st_ + b_base + i * 2048 + co); \
      _Pragma("unroll") for (int i = 0; i < MI; ++i) af[i] = *(const bf16x8*)(st_ + a_base + i * 2048 + co); \
      _Pragma("unroll") for (int mi = 0; mi < MI; ++mi) _Pragma("unroll") for (int ni = 0; ni < 4; ++ni) { \
          if (SWAP) acc[mi][ni] = MFMA16(bfr[ni], af[mi], acc[mi][ni]); else acc[mi][ni] = MFMA16(af[mi], bfr[ni], acc[mi][ni]); } } } while (0)
  if (!pre) { G_ISSUE(0, 0); G_ISSUE(1, 1); }
  int st = 0;
  for (int t = 0; t < nk; ++t) {
    if (t == 0 || t + 1 >= nk) WAIT_VM(0);
    else if (MI == 4) WAIT_VM(6); else WAIT_VM(5);
    __builtin_amdgcn_s_barrier();
    asm volatile("" ::: "memory");
    const int st2 = (st == 0) ? 2 : st - 1;
    if (t + 2 < nk) G_ISSUE(t + 2, st2);
    __builtin_amdgcn_sched_barrier(0);
    G_COMPUTE(st);
    __builtin_amdgcn_sched_group_barrier(0x100, 6, 0);
#pragma unroll
    for (int i_ = 0; i_ < 2 * MI + 2; ++i_) { __builtin_amdgcn_sched_group_barrier(0x008, 2, 0); __builtin_amdgcn_sched_group_barrier(0x100, 1, 0); }
    __builtin_amdgcn_sched_group_barrier(0x008, 4 * MI - 4, 0);
    __builtin_amdgcn_sched_barrier(0);
    st = (st == 2) ? 0 : st + 1;
  }
  asm volatile("s_waitcnt lgkmcnt(0)" ::: "memory");
  __builtin_amdgcn_s_barrier();
  asm volatile("" ::: "memory");
#undef G_ISSUE
#undef G_COMPUTE
}
template <bool SWAP, int MI = 4>
DI void gemm_kloop_pp(const bf16_t* __restrict__ A, int lda, const bf16_t* __restrict__ B, int ldb, int K, f32x4 (&acc)[MI][4], char* smem) {
  const int tid = g_tid(), lane = tid & 63, wid = __builtin_amdgcn_readfirstlane(tid >> 6), wm = wid >> 1, wn = wid & 1, grp = wid >> 2;
  const int lr = tid >> 3, lc = (tid & 7) ^ ((tid >> 4) & 7);
  const unsigned aoff = (unsigned)(lr * lda + lc * 8) * 2u, boff = (unsigned)(lr * ldb + lc * 8) * 2u;
  const char* Ac = (const char*)A; const char* Bc = (const char*)B;
  const int fr = lane & 15, fq = lane >> 4, sw = fr >> 1;
  const int a_base = (wm * 16 * MI + fr) * 128, b_base = 32768 + (wn * 64 + fr) * 128;
  const int nk = K >> 6;
  char* sdst = smem + tid * 16;
#define P_ISSUE(KT, ST) do { _Pragma("unroll") for (int i = 0; i < MI; ++i) \
      __builtin_amdgcn_global_load_lds((const void*)(Ac + ((size_t)(64 * i) * lda + (size_t)(KT) * 64) * 2 + aoff), (lds_ptr_t)(sdst + (ST) * GSTAGE + i * 8192), 16, 0, 0); \
    _Pragma("unroll") for (int i = 0; i < 2; ++i) \
      __builtin_amdgcn_global_load_lds((const void*)(Bc + ((size_t)(64 * i) * ldb + (size_t)(KT) * 64) * 2 + boff), (lds_ptr_t)(sdst + (ST) * GSTAGE + 32768 + i * 8192), 16, 0, 0); } while (0)
  P_ISSUE(0, 0);
  P_ISSUE(1, 1);
  WAIT_VM(0);
  __builtin_amdgcn_s_barrier();
  asm volatile("" ::: "memory");
  if (grp == 1) { __builtin_amdgcn_s_barrier(); asm volatile("" ::: "memory"); }
  int st = 0;
  for (int t = 0; t < nk; ++t) {
    const int st2 = (st == 0) ? 2 : st - 1;
    if (t + 2 < nk) P_ISSUE(t + 2, st2);
    bf16x8 af[2][MI], bfr[2][4];
    const char* st_ = smem + st * GSTAGE;
#pragma unroll
    for (int ks = 0; ks < 2; ++ks) {
      const int co = ((ks * 4 + fq) ^ sw) << 4;
#pragma unroll
      for (int i = 0; i < 4; ++i) bfr[ks][i] = *(const bf16x8*)(st_ + b_base + i * 2048 + co);
#pragma unroll
      for (int i = 0; i < MI; ++i) af[ks][i] = *(const bf16x8*)(st_ + a_base + i * 2048 + co);
    }
    if (t + 2 < nk) { if (MI == 4) WAIT_VM(6); else WAIT_VM(5); } else WAIT_VM(0);
    asm volatile("s_waitcnt lgkmcnt(0)" ::: "memory");
    __builtin_amdgcn_sched_barrier(0);
    __builtin_amdgcn_s_barrier();
    asm volatile("" ::: "memory");
#pragma unroll
    for (int ks = 0; ks < 2; ++ks)
#pragma unroll
      for (int mi = 0; mi < MI; ++mi)
#pragma unroll
        for (int ni = 0; ni < 4; ++ni) {
          if (SWAP) acc[mi][ni] = MFMA16(bfr[ks][ni], af[ks][mi], acc[mi][ni]); else acc[mi][ni] = MFMA16(af[ks][mi], bfr[ks][ni], acc[mi][ni]);
        }
    __builtin_amdgcn_sched_barrier(0);
    __builtin_amdgcn_s_barrier();
    asm volatile("" ::: "memory");
    st = (st == 2) ? 0 : st + 1;
  }
  if (grp == 0) { __builtin_amdgcn_s_barrier(); asm volatile("" ::: "memory"); }
#undef P_ISSUE
}

template <int MI>
DI void gemm_prefetch(const bf16_t* __restrict__ A, int lda, const bf16_t* __restrict__ B, int ldb, char* smem) {
  const int tid = g_tid();
  const int lr = tid >> 3, lc = (tid & 7) ^ ((tid >> 4) & 7);
  const unsigned aoff = (unsigned)(lr * lda + lc * 8) * 2u, boff = (unsigned)(lr * ldb + lc * 8) * 2u;
  const char* Ac = (const char*)A; const char* Bc = (const char*)B;
  char* sdst = smem + tid * 16;
#pragma unroll
  for (int kt = 0; kt < 2; ++kt) {
#pragma unroll
    for (int i = 0; i < MI; ++i)
      __builtin_amdgcn_global_load_lds((const void*)(Ac + ((size_t)(64 * i) * lda + (size_t)kt * 64) * 2 + aoff), (lds_ptr_t)(sdst + kt * GSTAGE + i * 8192), 16, 0, 0);
#pragma unroll
    for (int i = 0; i < 2; ++i)
      __builtin_amdgcn_global_load_lds((const void*)(Bc + ((size_t)(64 * i) * ldb + (size_t)kt * 64) * 2 + boff), (lds_ptr_t)(sdst + kt * GSTAGE + 32768 + i * 8192), 16, 0, 0);
  }
}
template <int MI>
DI void zero_acc_t(f32x4 (&acc)[MI][4]) {
#pragma unroll
  for (int i = 0; i < MI; ++i)
#pragma unroll
    for (int j = 0; j < 4; ++j) acc[i][j] = (f32x4){0.f, 0.f, 0.f, 0.f};
}
DI void zero_acc(f32x4 (&acc)[4][4]) {
#pragma unroll
  for (int i = 0; i < 4; ++i)
#pragma unroll
    for (int j = 0; j < 4; ++j) acc[i][j] = (f32x4){0.f, 0.f, 0.f, 0.f};
}

template <bool SWAP>
DI void gemm_kloop_big(const bf16_t* __restrict__ A, int lda, const bf16_t* __restrict__ B, int ldb, int K, f32x4 (&acc)[8][4], char* smem, bool pre = false) {
  const int tid = g_tid(), lane = tid & 63, wid = __builtin_amdgcn_readfirstlane(tid >> 6), wm = wid >> 2, wn = wid & 3;
  const int lr = tid >> 3, lc = (tid & 7) ^ ((tid >> 4) & 7);
  const unsigned aoff = (unsigned)(lr * lda + lc * 8) * 2u, boff = (unsigned)(lr * ldb + lc * 8) * 2u;
  const char* Ac = (const char*)A; const char* Bc = (const char*)B;
  const int fr = lane & 15, fq = lane >> 4, sw = fr >> 1;
  const int a_base = (wm * 128 + fr) * 128, b_base = 32768 + (wn * 64 + fr) * 128;
  const int nk = K >> 6;
  char* sdst = smem + tid * 16;
#define GB_ISSUE(KT, ST) do { _Pragma("unroll") for (int i = 0; i < 4; ++i) { \
      __builtin_amdgcn_global_load_lds((const void*)(Ac + ((size_t)(64 * i) * lda + (size_t)(KT) * 64) * 2 + aoff), (lds_ptr_t)(sdst + (ST) * 65536 + i * 8192), 16, 0, 0); \
      __builtin_amdgcn_global_load_lds((const void*)(Bc + ((size_t)(64 * i) * ldb + (size_t)(KT) * 64) * 2 + boff), (lds_ptr_t)(sdst + (ST) * 65536 + 32768 + i * 8192), 16, 0, 0); } } while (0)
  if (!pre) GB_ISSUE(0, 0);
  for (int t = 0; t < nk; ++t) {
    WAIT_VM(0);
    __builtin_amdgcn_s_barrier();
    asm volatile("" ::: "memory");
    if (t + 1 < nk) GB_ISSUE(t + 1, (t + 1) & 1);
    __builtin_amdgcn_sched_barrier(0);
    const char* st_ = smem + (t & 1) * 65536;
#pragma unroll
    for (int ks = 0; ks < 2; ++ks) {
      const int co = ((ks * 4 + fq) ^ sw) << 4;
      bf16x8 af[8], bfr[4];
#pragma unroll
      for (int i = 0; i < 4; ++i) bfr[i] = *(const bf16x8*)(st_ + b_base + i * 2048 + co);
#pragma unroll
      for (int i = 0; i < 8; ++i) af[i] = *(const bf16x8*)(st_ + a_base + i * 2048 + co);
#pragma unroll
      for (int mi = 0; mi < 8; ++mi)
#pragma unroll
        for (int ni = 0; ni < 4; ++ni) {
          if (SWAP) acc[mi][ni] = MFMA16(bfr[ni], af[mi], acc[mi][ni]); else acc[mi][ni] = MFMA16(af[mi], bfr[ni], acc[mi][ni]);
        }
    }
    __builtin_amdgcn_sched_group_barrier(0x100, 8, 0);
#pragma unroll
    for (int i_ = 0; i_ < 16; ++i_) { __builtin_amdgcn_sched_group_barrier(0x008, 3, 0); __builtin_amdgcn_sched_group_barrier(0x100, 1, 0); }
    __builtin_amdgcn_sched_group_barrier(0x008, 16, 0);
    __builtin_amdgcn_sched_barrier(0);
  }
  asm volatile("s_waitcnt lgkmcnt(0)" ::: "memory");
  __builtin_amdgcn_s_barrier();
  asm volatile("" ::: "memory");
#undef GB_ISSUE
}

namespace pg8 {
#define PG8_LAS __attribute__((address_space(3)))
constexpr int BM = 256, BK = 64, HALF = 128, HTB = HALF * BK * 2;
DI int lds_byte(int r, int c) { const int st = (r >> 4) * 2 + (c >> 5), rr = r & 15, cc = c & 31, ob = rr * 64 + cc * 2; return st * 1024 + (ob ^ (((ob >> 9) & 1) << 5)); }
DI void stage_rc(int b, int& R, int& C) { const int st = b / 1024, sb = b % 1024, swz = sb ^ (((sb >> 9) & 1) << 5); R = (st >> 1) * 16 + swz / 64; C = (st & 1) * 32 + (swz % 64) / 2; }
struct Unit { int pm, pn; };
template <class Epi, class Sched>
DI void gemm_phase(PG8_LAS unsigned char* lds, int K, const Sched& S, const Epi& E) {
  const int tid = g_tid(), wid = __builtin_amdgcn_readfirstlane(tid >> 6), lane = tid & 63, wr = wid >> 2, wc = wid & 3, fr = lane & 15, fq = lane >> 4;
  const int nt = K / BK;
  unsigned voff[2];
#pragma unroll
  for (int i = 0; i < 2; ++i) { int R, C; stage_rc(tid * 16 + i * 8192, R, C); voff[i] = (unsigned)(R * K + C) * 2u; }
  const size_t kstep = (size_t)(BK * 2);
  const size_t hstep = (size_t)HALF * K * 2;
  const unsigned ldsw = (unsigned)wid * 1024u;
  const int aoff = lds_byte(wr * 64 + fr, fq * 8), boff = lds_byte(wc * 32 + fr, fq * 8);
#define PG8_SA(b, h) (((b) * 2 + (h)) * HTB)
#define PG8_SB(b, h) ((4 + (b) * 2 + (h)) * HTB)
#define PG8_STAGE(bufoff, gbase) do { _Pragma("unroll") for (int _i = 0; _i < 2; ++_i) \
    __builtin_amdgcn_global_load_lds((const void*)((const char*)(gbase) + voff[_i]), (PG8_LAS void*)(lds + (bufoff) + ldsw + _i * 8192), 16, 0, 0); } while (0)
#define PG8_LDA(dst, b, h) do { _Pragma("unroll") for (int m = 0; m < 4; ++m) _Pragma("unroll") for (int k = 0; k < 2; ++k) dst[m][k] = *(const PG8_LAS bf16x8*)(lds + PG8_SA(b, h) + aoff + m * 2048 + k * 1024); } while (0)
#define PG8_LDB(dst, b, h) do { _Pragma("unroll") for (int n = 0; n < 2; ++n) _Pragma("unroll") for (int k = 0; k < 2; ++k) dst[n][k] = *(const PG8_LAS bf16x8*)(lds + PG8_SB(b, h) + boff + n * 2048 + k * 1024); } while (0)
#define PG8_MMA(ai, bj, At, Bt) do { __builtin_amdgcn_s_setprio(1); _Pragma("unroll") for (int m = 0; m < 4; ++m) _Pragma("unroll") for (int n = 0; n < 2; ++n) _Pragma("unroll") for (int k = 0; k < 2; ++k) \
    acc[ai][bj][m][n] = __builtin_amdgcn_mfma_f32_16x16x32_bf16(Bt[n][k], At[m][k], acc[ai][bj][m][n], 0, 0, 0); __builtin_amdgcn_s_setprio(0); } while (0)
#define PG8_WAIT_V(n) asm volatile("s_waitcnt vmcnt(" #n ")" ::: "memory")
#define PG8_WAIT_L(n) asm volatile("s_waitcnt lgkmcnt(" #n ")" ::: "memory")
#define PG8_BAR __builtin_amdgcn_s_barrier()
#define PG8_SCHED __builtin_amdgcn_sched_barrier(0)
  Unit cur, nxt; int ui = 0;
  if (!S.next(0, cur)) return;
  f32x4 acc[2][2][4][2];
#pragma unroll
  for (int a = 0; a < 2; ++a)
#pragma unroll
    for (int b = 0; b < 2; ++b)
#pragma unroll
      for (int m = 0; m < 4; ++m)
#pragma unroll
        for (int n = 0; n < 2; ++n) acc[a][b][m][n] = (f32x4){0.f, 0.f, 0.f, 0.f};
  bf16x8 At[4][2], B0[2][2], B1[2][2];
  const char* cA = S.pa(cur); const char* cB = S.pb(cur);
  PG8_WAIT_V(0);
  PG8_STAGE(PG8_SB(0, 0), cB); PG8_STAGE(PG8_SA(0, 0), cA); PG8_STAGE(PG8_SB(0, 1), cB + hstep); PG8_STAGE(PG8_SA(0, 1), cA + hstep);
  if (wr == 1) PG8_BAR;
  PG8_WAIT_V(4); PG8_BAR;
  PG8_STAGE(PG8_SB(1, 0), cB + kstep); PG8_STAGE(PG8_SA(1, 0), cA + kstep); PG8_STAGE(PG8_SB(1, 1), cB + hstep + kstep);
  PG8_WAIT_V(6); PG8_BAR;
  for (;;) {
    const bool has_next = S.next(ui + 1, nxt);
    const char* nA = has_next ? S.pa(nxt) : cA; const char* nB = has_next ? S.pb(nxt) : cB;
    for (int t = 0; t < nt; t += 2) {
      const bool last = (t == nt - 2);
      const char* a1 = cA + (size_t)(t + 1) * kstep;
      const char* a2 = last ? nA : cA + (size_t)(t + 2) * kstep; const char* b2 = last ? nB : cB + (size_t)(t + 2) * kstep;
      const char* a3 = a2 + kstep; const char* b3 = b2 + kstep;
      PG8_LDB(B0, 0, 0); PG8_SCHED; PG8_LDA(At, 0, 0); PG8_STAGE(PG8_SA(1, 1), a1 + hstep);
      PG8_WAIT_L(8); PG8_BAR; PG8_WAIT_L(0); PG8_MMA(0, 0, At, B0); PG8_BAR; PG8_SCHED;
      PG8_LDB(B1, 0, 1); PG8_STAGE(PG8_SB(0, 0), b2);
      PG8_BAR; PG8_WAIT_L(0); PG8_MMA(0, 1, At, B1); PG8_BAR;
      PG8_LDA(At, 0, 1); PG8_STAGE(PG8_SA(0, 0), a2);
      PG8_BAR; PG8_WAIT_L(0); PG8_MMA(1, 0, At, B0); PG8_BAR; PG8_SCHED;
      PG8_STAGE(PG8_SB(0, 1), b2 + hstep);
      PG8_WAIT_V(6); PG8_BAR; PG8_MMA(1, 1, At, B1); PG8_BAR;
      PG8_LDB(B0, 1, 0); PG8_SCHED; PG8_LDA(At, 1, 0); PG8_STAGE(PG8_SA(0, 1), a2 + hstep);
      PG8_WAIT_L(8); PG8_BAR; PG8_WAIT_L(0); PG8_MMA(0, 0, At, B0); PG8_BAR; PG8_SCHED;
      PG8_LDB(B1, 1, 1); PG8_STAGE(PG8_SB(1, 0), b3);
      PG8_BAR; PG8_WAIT_L(0); PG8_MMA(0, 1, At, B1); PG8_BAR;
      PG8_LDA(At, 1, 1); PG8_STAGE(PG8_SA(1, 0), a3);
      PG8_BAR; PG8_WAIT_L(0); PG8_MMA(1, 0, At, B0); PG8_BAR; PG8_SCHED;
      PG8_STAGE(PG8_SB(1, 1), b3 + hstep);
      PG8_WAIT_V(6); PG8_BAR; PG8_MMA(1, 1, At, B1); PG8_BAR;
    }
    E(acc, cur, wr, wc, fr, fq);
    if (!has_next) break;
#pragma unroll
    for (int a = 0; a < 2; ++a)
#pragma unroll
      for (int b = 0; b < 2; ++b)
#pragma unroll
        for (int m = 0; m < 4; ++m)
#pragma unroll
          for (int n = 0; n < 2; ++n) acc[a][b][m][n] = (f32x4){0.f, 0.f, 0.f, 0.f};
    cur = nxt; cA = nA; cB = nB; ++ui;
  }
  PG8_WAIT_V(0);
  if (wr == 0) PG8_BAR;
  PG8_BAR;
#undef PG8_SA
#undef PG8_SB
#undef PG8_STAGE
#undef PG8_LDA
#undef PG8_LDB
#undef PG8_MMA
#undef PG8_WAIT_V
#undef PG8_WAIT_L
#undef PG8_BAR
#undef PG8_SCHED
}
}

DI void gemm_prefetch_big(const bf16_t* __restrict__ A, int lda, const bf16_t* __restrict__ B, int ldb, char* smem) {
  const int tid = g_tid();
  const int lr = tid >> 3, lc = (tid & 7) ^ ((tid >> 4) & 7);
  const unsigned aoff = (unsigned)(lr * lda + lc * 8) * 2u, boff = (unsigned)(lr * ldb + lc * 8) * 2u;
  const char* Ac = (const char*)A; const char* Bc = (const char*)B;
  char* sdst = smem + tid * 16;
#pragma unroll
  for (int i = 0; i < 4; ++i) {
    __builtin_amdgcn_global_load_lds((const void*)(Ac + ((size_t)(64 * i) * lda) * 2 + aoff), (lds_ptr_t)(sdst + i * 8192), 16, 0, 0);
    __builtin_amdgcn_global_load_lds((const void*)(Bc + ((size_t)(64 * i) * ldb) * 2 + boff), (lds_ptr_t)(sdst + 32768 + i * 8192), 16, 0, 0);
  }
}

DI void row_info(int r, int& b, int& pos, bool& isctx) {
  if (r < T_LAT) { b = r >> 11; pos = r & 2047; isctx = false; } else { const int q = r - T_LAT; b = q >> 8; pos = q & 255; isctx = true; }
}

constexpr int HALF_LDS = 65792;
DI void conv_tile(bool active, const float* __restrict__ src, int ld, int k0, int c0, bf16_t* __restrict__ dst, int dstld, int ilv  , int n0, char* smem) {
  float* s = (float*)smem;
  const int tid = g_tid() & 255;
  if (active) {
#pragma unroll
    for (int i = 0; i < 4; ++i) {
      const int k = (tid >> 4) + 16 * i, cc = (tid & 15) * 4;
      const f32x4 v = *(const f32x4*)(src + (size_t)(k0 + k) * ld + c0 + n0 + cc);
      s[k * 65 + cc] = v[0]; s[k * 65 + cc + 1] = v[1]; s[k * 65 + cc + 2] = v[2]; s[k * 65 + cc + 3] = v[3];
    }
  }
  __syncthreads();
  if (active) {
    const int n = tid >> 2, kq = (tid & 3) * 16;
    unsigned w[8];
#pragma unroll
    for (int j = 0; j < 8; ++j) w[j] = pk2(s[(kq + 2 * j) * 65 + n], s[(kq + 2 * j + 1) * 65 + n]);
    const int ng = n0 + n;
    size_t drow = ng;
    if (ilv) drow = (size_t)(ng >> 4) * 32 + (ng & 15) + (ilv == 2 ? 16 : 0);
    bf16_t* dp = dst + drow * dstld + k0 + kq;
    *(u32x4*)dp = (u32x4){w[0], w[1], w[2], w[3]};
    *(u32x4*)(dp + 8) = (u32x4){w[4], w[5], w[6], w[7]};
  }
  __syncthreads();
}
DI void fold_tile(bool active, const float* __restrict__ src  , int cbase, int k0, int np0  , int mode, const float* __restrict__ wgrp,
                  const float* __restrict__ pscale, bf16_t* __restrict__ dst  , char* smem) {
  float* sA = (float*)smem;
  float* sT = (float*)(smem + 33024);
  const int tid = g_tid() & 255;
  if (active) {
    for (int i = tid; i < 64 * 32; i += 256) {
      const int k = i >> 5, c4 = (i & 31) * 4;
      const f32x4 v = *(const f32x4*)(src + (size_t)(k0 + k) * N_IN + cbase + c4);
      sA[k * 129 + c4] = v[0]; sA[k * 129 + c4 + 1] = v[1]; sA[k * 129 + c4 + 2] = v[2]; sA[k * 129 + c4 + 3] = v[3];
    }
    for (int i = tid; i < 128 * 64; i += 256) {
      const int c = i >> 6, n = i & 63, np = np0 + n;
      float t;
      if (mode == 2) t = wgrp[c * 128 + np] * pscale[np];
      else { const float r = (float)((c * np) & 127) * (1.0f / 128.0f); t = (mode == 0) ? hw_cos_rev(r) : hw_sin_rev(r); }
      sT[c * 64 + n] = t;
    }
  }
  __syncthreads();
  if (active) {
    const int ty = tid >> 4, tx = tid & 15;
    float acc[4][4];
#pragma unroll
    for (int a = 0; a < 4; ++a)
#pragma unroll
      for (int b = 0; b < 4; ++b) acc[a][b] = 0.f;
    for (int c = 0; c < 128; ++c) {
      const f32x4 t4 = *(const f32x4*)(sT + c * 64 + tx * 4);
      float a4[4];
#pragma unroll
      for (int a = 0; a < 4; ++a) a4[a] = sA[(ty * 4 + a) * 129 + c];
#pragma unroll
      for (int a = 0; a < 4; ++a)
#pragma unroll
        for (int b = 0; b < 4; ++b) acc[a][b] += a4[a] * t4[b];
    }
#pragma unroll
    for (int b = 0; b < 4; ++b) {
      bf16_t* dp = dst + (size_t)(np0 + tx * 4 + b) * 1024 + k0 + ty * 4;
      *(u32x2*)dp = (u32x2){pk2(acc[0][b], acc[1][b]), pk2(acc[2][b], acc[3][b])};
    }
  }
  __syncthreads();
}

constexpr int CONV_TOTAL = 16 * 48 * 2 + 16 * 16 + 8 * 16 * 2 + 16 * 16 + 16 * 44 * 2 + 44 * 16 + 256 + 128;
DI void convert_iter(const Params& p, int l, int tb, char* smem0) {
  bf16_t* W = (bf16_t*)(p.ws + w_off(l));
  const float* win = p.w_in + (size_t)l * 1024 * N_IN;
  const int half = g_tid() >> 8;
  char* smem = smem0 + half * HALF_LDS;
  constexpr int C0 = 16 * 48, C1 = C0 + 16 * 48, C2 = C1 + 16 * 16, C3 = C2 + 8 * 16, C4 = C3 + 8 * 16, C5 = C4 + 16 * 16, C6 = C5 + 16 * 44, C7 = C6 + 16 * 44,
                C8 = C7 + 44 * 16, C9 = C8 + 256, C10 = C9 + 128;
  static_assert((C0 | C1 | C2 | C3 | C4 | C5 | C6 | C7 | C8 | C9 | C10) % 2 == 0, "segment boundaries must be even");
  const int total = C10;
  static_assert(C10 == CONV_TOTAL, "conversion tile count");
  {
    const bool active = (tb + half) < total;
    const int t = active ? tb + half : tb;
    int seg, r;
    if (t < C0) { seg = 0; r = t; } else if (t < C1) { seg = 1; r = t - C0; } else if (t < C2) { seg = 2; r = t - C1; } else if (t < C3) { seg = 3; r = t - C2; }
    else if (t < C4) { seg = 4; r = t - C3; } else if (t < C5) { seg = 5; r = t - C4; } else if (t < C6) { seg = 6; r = t - C5; } else if (t < C7) { seg = 7; r = t - C6; }
    else if (t < C8) { seg = 8; r = t - C7; } else if (t < C9) { seg = 9; r = t - C8; } else { seg = 10; r = t - C9; }
    if (seg <= 8) {
      const float* src; int ld, kt, nt, c0 = 0, dstld, ilv = 0; bf16_t* dst;
      if (seg <= 1) { kt = r & 15; nt = r >> 4; src = win; ld = N_IN; c0 = seg == 0 ? 0 : 4096; dst = W + WO_WIN + (seg == 0 ? 0 : (size_t)ROW_G * 1024); dstld = 1024; }
      else if (seg == 2) { kt = r & 15; nt = r >> 4; src = p.w_att_br + (size_t)l * 1024 * 1024; ld = 1024; dst = W + WO_WA; dstld = 1024; }
      else if (seg == 3) { kt = r & 7; nt = r >> 3; src = p.w_four_br + (size_t)l * 512 * 1024; ld = 1024; dst = W + WO_WF; dstld = 512; }
      else if (seg == 4) { kt = r & 7; nt = r >> 3; src = p.w_pool_br + (size_t)l * 512 * 1024; ld = 1024; dst = W + WO_WP; dstld = 512; }
      else if (seg == 5) { kt = r & 15; nt = r >> 4; src = p.w_out + (size_t)l * 1024 * 1024; ld = 1024; dst = W + WO_WO; dstld = 1024; }
      else if (seg == 6) { kt = r & 15; nt = r >> 4; src = p.w_ffn_gate + (size_t)l * 1024 * DFF; ld = DFF; dst = W + WO_WGU; dstld = 1024; ilv = 1; }
      else if (seg == 7) { kt = r & 15; nt = r >> 4; src = p.w_ffn_up + (size_t)l * 1024 * DFF; ld = DFF; dst = W + WO_WGU; dstld = 1024; ilv = 2; }
      else { kt = r % 44; nt = r / 44; src = p.w_ffn_down + (size_t)l * DFF * 1024; ld = 1024; dst = W + WO_WD; dstld = DFF; }
      conv_tile(active, src, ld, kt * 64, c0, dst, dstld, ilv, nt * 64, smem);
    } else if (seg == 9) {
      const int kt = r & 15, q = r >> 4; const int g = q & 3, hf = (q >> 2) & 1, mode = q >> 3;
      fold_tile(active, win, 3072 + g * 128, kt * 64, hf * 64, mode, nullptr, nullptr, W + WO_WIN + (size_t)((mode ? ROW_Z2 : ROW_Z1) + g * 128) * 1024, smem);
    } else {
      const int kt = r & 15, q = r >> 4; const int g = q & 3, hf = q >> 2;
      fold_tile(active, win, 3584 + g * 128, kt * 64, hf * 64, 2, p.w_pool_grp + ((size_t)l * 4 + g) * 128 * 128, p.pool_scale + (size_t)l * 512 + g * 128,
                W + WO_WIN + (size_t)(ROW_R + g * 128) * 1024, smem);
    }
  }
}

DI void convert_layer(const Params& p, int l, char* smem) {
  for (int tb = blockIdx.x * 2; tb < CONV_TOTAL; tb += gridDim.x * 2) convert_iter(p, l, tb, smem);
}

DI void convert_grab(const Params& p, int l, int which  , char* smem) {
  unsigned* ctr = (unsigned*)(p.ws + OFF_CTR) + l * 2 + which;
  volatile __attribute__((address_space(3))) unsigned* slot = (volatile __attribute__((address_space(3))) unsigned*)(lds_ptr_t)(smem + 3 * GSTAGE + 8);
  const int lo = which ? 2400 : 0, hi = which ? CONV_TOTAL : 2400;
  for (;;) {
    __syncthreads();
    if (__builtin_amdgcn_workitem_id_x() == 0) *slot = __hip_atomic_fetch_add(ctr, 2u, __ATOMIC_RELAXED, __HIP_MEMORY_SCOPE_AGENT);
    __syncthreads();
    const int tb = lo + (int)*slot;
    if (tb >= hi) break;
    convert_iter(p, l, tb, smem);
  }
  __syncthreads();
}

DI void phase0a(const Params& p, char* smem) {
  const int tid = g_tid();
  const int gtid = blockIdx.x * 512 + tid, gsz = gridDim.x * 512;
  {
    const int half = tid >> 8, t8 = tid & 255;
    float* ssil = (float*)smem;
    float* sred = (float*)(smem + 36864 + half * 9216);
    bool filled = false;
    float* modv = (float*)(p.ws + OFF_MODV);
    for (int tb = blockIdx.x * 2; tb < DEPTH * 96; tb += gridDim.x * 2) {
      if (!filled) {
        for (int i = tid; i < 9 * 1024; i += 512) { const float v = (i < 8192) ? p.c[i] : p.c_ctx[i - 8192]; ssil[i] = v * sigmoidf_(v); }
        filled = true;
        __syncthreads();
      }
      const int t = tb + half;
      const int l = t / 96, cgp = t % 96;
      const int col = cgp * 64 + (t8 & 63), kq = t8 >> 6;
      const float* wp = p.w_mod + ((size_t)l * 1024 + kq * 256) * 6144 + col;
      float a[9];
#pragma unroll
      for (int r = 0; r < 9; ++r) a[r] = 0.f;
#pragma unroll 4
      for (int k = 0; k < 256; ++k) {
        const float w = wp[(size_t)k * 6144];
#pragma unroll
        for (int r = 0; r < 9; ++r) a[r] += ssil[r * 1024 + kq * 256 + k] * w;
      }
#pragma unroll
      for (int r = 0; r < 9; ++r) sred[(kq * 9 + r) * 64 + (t8 & 63)] = a[r];
      __syncthreads();
      for (int i = t8; i < 9 * 64; i += 256) {
        const int r = i >> 6, cc = i & 63;
        const float v = sred[(0 * 9 + r) * 64 + cc] + sred[(1 * 9 + r) * 64 + cc] + sred[(2 * 9 + r) * 64 + cc] + sred[(3 * 9 + r) * 64 + cc];
        modv[((size_t)l * 9 + r) * 6144 + cgp * 64 + cc] = v + p.b_mod[(size_t)l * 6144 + cgp * 64 + cc];
      }
      __syncthreads();
    }
    __syncthreads();
  }
  convert_layer(p, 0, smem);
  {
    bf16_t* at = (bf16_t*)(p.ws + OFF_ATAB);
    for (int i = gtid; i < 2048 * 512; i += gsz) {
      const int k = i >> 9, c8 = (i & 511) * 8;
      unsigned w[4];
#pragma unroll
      for (int j = 0; j < 4; ++j) {
        float v[2];
#pragma unroll
        for (int e = 0; e < 2; ++e) {
          const int tp = c8 + 2 * j + e; const int tt = tp & 2047;
          const float r = (float)((k * tt) & 2047) * (1.0f / 2048.0f);
          v[e] = (tp < 2048) ? hw_cos_rev(r) : -hw_sin_rev(r);
        }
        w[j] = pk2(v[0], v[1]);
      }
      *(u32x4*)(at + (size_t)k * 4096 + c8) = (u32x4){w[0], w[1], w[2], w[3]};
    }
    bf16_t* atc = (bf16_t*)(p.ws + OFF_ATABC);
    for (int i = gtid; i < 256 * 64; i += gsz) {
      const int k = i >> 6, c8 = (i & 63) * 8;
      unsigned w[4];
#pragma unroll
      for (int j = 0; j < 4; ++j) {
        float v[2];
#pragma unroll
        for (int e = 0; e < 2; ++e) {
          const int tp = c8 + 2 * j + e; const int tt = tp & 255;
          const float r = (float)((k * tt) & 255) * (1.0f / 256.0f);
          v[e] = (tp < 256) ? hw_cos_rev(r) : -hw_sin_rev(r);
        }
        w[j] = pk2(v[0], v[1]);
      }
      *(u32x4*)(atc + (size_t)k * 512 + c8) = (u32x4){w[0], w[1], w[2], w[3]};
    }
  }
  {
    float* rc = (float*)(p.ws + OFF_ROPEC); float* rs = (float*)(p.ws + OFF_ROPES);
    for (int i = gtid; i < 2048 * 32; i += gsz) {
      const int t = i >> 5, a = i & 31, f = a & 15;
      const float pos = (float)((a < 16) ? (t >> 6) : (t & 63));
      const float inv = exp2f(-(float)f * (13.287712379549449f / 16.0f));
      float r = pos * inv * 0.15915494309189535f;
      r -= floorf(r);
      rc[i] = hw_cos_rev(r); rs[i] = hw_sin_rev(r);
    }
  }
  if (gtid < DEPTH) {
    const float* lq = p.lam_qk + (size_t)gtid * 256;
    float s1 = 0.f, s2 = 0.f;
    for (int i = 0; i < 64; ++i) { s1 += lq[i] * lq[64 + i]; s2 += lq[128 + i] * lq[192 + i]; }
    ((float*)(p.ws + OFF_LAMV))[gtid] = expf(s1) - expf(s2) + p.lam_init[gtid];
  }
}

DI void ln_pass(const Params& p, int mode, int nrows, const bf16_t* __restrict__ Yb, const float* __restrict__ lng, const float* __restrict__ lnb,
                        int modl_gate, int gate_chunk, int modl_next, int sh_chunk) {
  const int lane = g_tid() & 63, wid = g_tid() >> 6;
  float* X = (float*)(p.ws + OFF_X);
  bf16_t* U = (bf16_t*)(p.ws + OFF_U);
  const float* modv = (const float*)(p.ws + OFF_MODV);
  f32x4 xv[4], xn[4]; u32x2 yv[4], yn[4];
  const int r0 = blockIdx.x * 8 + wid, rstride = gridDim.x * 8;
  if (mode != 0 && r0 < nrows) {
#pragma unroll
    for (int i = 0; i < 4; ++i) { xv[i] = *(const f32x4*)(X + (size_t)r0 * 1024 + lane * 4 + 256 * i); yv[i] = *(const u32x2*)(Yb + (size_t)r0 * 1024 + lane * 4 + 256 * i); }
  }
  for (int r = r0; r < nrows; r += rstride) {
    int b, pos; bool isctx; row_info(r, b, pos, isctx);
    const int mr = isctx ? 8 : b;
    f32x4 v[4];
    if (mode == 0) {
      const float* src = isctx ? (p.ctx + (size_t)(r - T_LAT) * 1024) : (p.x + (size_t)r * 1024);
#pragma unroll
      for (int i = 0; i < 4; ++i) v[i] = *(const f32x4*)(src + lane * 4 + 256 * i);
#pragma unroll
      for (int i = 0; i < 4; ++i) *(f32x4*)(X + (size_t)r * 1024 + lane * 4 + 256 * i) = v[i];
    } else {
      const int rn = r + rstride;
      if (rn < nrows) {
#pragma unroll
        for (int i = 0; i < 4; ++i) { xn[i] = *(const f32x4*)(X + (size_t)rn * 1024 + lane * 4 + 256 * i); yn[i] = *(const u32x2*)(Yb + (size_t)rn * 1024 + lane * 4 + 256 * i); }
      }
      const float* gv = modv + ((size_t)modl_gate * 9 + mr) * 6144 + gate_chunk * 1024;
      float s = 0.f;
#pragma unroll
      for (int i = 0; i < 4; ++i) {
        const int col = lane * 4 + 256 * i;
        const f32x4 g = *(const f32x4*)(gv + col);
        v[i][0] = ALPHA * xv[i][0] + g[0] * bf_lo(yv[i][0]); v[i][1] = ALPHA * xv[i][1] + g[1] * bf_hi(yv[i][0]);
        v[i][2] = ALPHA * xv[i][2] + g[2] * bf_lo(yv[i][1]); v[i][3] = ALPHA * xv[i][3] + g[3] * bf_hi(yv[i][1]);
        s += (v[i][0] + v[i][1]) + (v[i][2] + v[i][3]);
      }
#pragma unroll
      for (int i = 0; i < 4; ++i) { xv[i] = xn[i]; yv[i] = yn[i]; }
      const float mu = wave_sum(s) * (1.0f / 1024.0f);
      float q = 0.f;
#pragma unroll
      for (int i = 0; i < 4; ++i) { const f32x4 d = v[i] - mu; q += (d[0] * d[0] + d[1] * d[1]) + (d[2] * d[2] + d[3] * d[3]); }
      const float rstd = rsqrtf(wave_sum(q) * (1.0f / 1024.0f) + LN_EPS);
#pragma unroll
      for (int i = 0; i < 4; ++i) {
        const int col = lane * 4 + 256 * i;
        const f32x4 g = *(const f32x4*)(lng + col), bb = *(const f32x4*)(lnb + col);
        v[i] = (v[i] - mu) * rstd * g + bb;
        if (mode == 2) *(f32x4*)(p.out + (size_t)r * 1024 + col) = v[i];
        else *(f32x4*)(X + (size_t)r * 1024 + col) = v[i];
      }
    }
    if (mode != 2) {
      float s = 0.f;
#pragma unroll
      for (int i = 0; i < 4; ++i) s += (v[i][0] + v[i][1]) + (v[i][2] + v[i][3]);
      const float mu = wave_sum(s) * (1.0f / 1024.0f);
      float q = 0.f;
#pragma unroll
      for (int i = 0; i < 4; ++i) { const f32x4 d = v[i] - mu; q += (d[0] * d[0] + d[1] * d[1]) + (d[2] * d[2] + d[3] * d[3]); }
      const float rstd = rsqrtf(wave_sum(q) * (1.0f / 1024.0f) + LN_EPS);
      const float* shv = modv + ((size_t)modl_next * 9 + mr) * 6144 + sh_chunk * 1024;
      const float* scv = shv + 1024;
#pragma unroll
      for (int i = 0; i < 4; ++i) {
        const int col = lane * 4 + 256 * i;
        const f32x4 sh = *(const f32x4*)(shv + col), sc = *(const f32x4*)(scv + col);
        const f32x4 u = (v[i] - mu) * rstd * (sc + 1.0f) + sh;
        *(u32x2*)(U + (size_t)r * 1024 + col) = (u32x2){pk2(u[0], u[1]), pk2(u[2], u[3])};
      }
    }
  }
}

DI bool tile_map(int v, int nmt, int nnt, int& mt, int& nt) {
  const int c = v >> 8, w = v & 255, xcd = w & 7, local = w >> 3;
  const int spr = nnt >> 2, nsup = (nmt >> 3) * spr, sup = c * 8 + xcd;
  if (sup >= nsup) return false;
  mt = (sup / spr) * 8 + (local & 7); nt = (sup % spr) * 4 + (local >> 3);
  return true;
}
DI int tile_vmax(int nmt, int nnt) { const int nsup = (nmt >> 3) * (nnt >> 2); return ((nsup + 7) >> 3) << 8; }

DI void phase_inproj(const Params& p, int l, char* smem) {
  const bool last = (l == DEPTH - 1);
  const bf16_t* W = (const bf16_t*)(p.ws + w_off(l)) + WO_WIN;
  const bf16_t* U = (const bf16_t*)(p.ws + OFF_U);
  bf16_t* KB = (bf16_t*)(p.ws + OFF_KB); bf16_t* VT = (bf16_t*)(p.ws + OFF_VT); bf16_t* QB = (bf16_t*)(p.ws + OFF_QB); bf16_t* CQ = (bf16_t*)(p.ws + OFF_CQ);
  bf16_t* ZT = (bf16_t*)(p.ws + OFF_ZT); bf16_t* ZTC = (bf16_t*)(p.ws + OFF_ZTC); bf16_t* R = (bf16_t*)(p.ws + OFF_R);
  const float* ropec = (const float*)(p.ws + OFF_ROPEC); const float* ropes = (const float*)(p.ws + OFF_ROPES);
  const int nsupA = last ? 72 : 81, nsup = last ? 76 : 81;
  const int vmax = ((nsup + 15) >> 4) << 8;
  auto map_tile = [&](int v, int& mt, int& nt) -> bool {
    if (v >= vmax) return false;
    const int c = v >> 8, w = v & 255, local = w >> 3, sup = (c * 8 + (w & 7)) * 2 + (local >> 4);
    if (sup >= nsup) return false;
    if (sup < nsupA) { mt = (sup / 9) * 8 + (local & 7); nt = (sup % 9) * 2 + ((local >> 3) & 1); }
    else { mt = 64 + (local & 7); nt = (sup - nsupA) * 2 + ((local >> 3) & 1); }
    return true;
  };
  int v = blockIdx.x, mt = 0, nt = 0;
  bool cur = map_tile(v, mt, nt);
  if (cur) gemm_prefetch_big(U + (size_t)mt * 256 * 1024, 1024, W + (size_t)nt * 256 * 1024, 1024, smem);
  while (cur) {
    const int m0 = mt * 256;
    int b, pos0; bool isctx; row_info(m0, b, pos0, isctx);
    f32x4 acc[8][4];
#pragma unroll
    for (int i = 0; i < 8; ++i)
#pragma unroll
      for (int j = 0; j < 4; ++j) acc[i][j] = (f32x4){0.f, 0.f, 0.f, 0.f};
    const bool swap = !((nt >= 4 && nt < 8) || (nt >= 12 && nt < 16));
    if (swap) gemm_kloop_big<true>(U + (size_t)m0 * 1024, 1024, W + (size_t)nt * 256 * 1024, 1024, 1024, acc, smem, true);
    else gemm_kloop_big<false>(U + (size_t)m0 * 1024, 1024, W + (size_t)nt * 256 * 1024, 1024, 1024, acc, smem, true);
    int v2 = v + gridDim.x, mt2 = 0, nt2 = 0;
    const bool nxt = map_tile(v2, mt2, nt2);
    if (nxt) gemm_prefetch_big(U + (size_t)mt2 * 256 * 1024, 1024, W + (size_t)nt2 * 256 * 1024, 1024, smem);
    const int tid = g_tid(), lane = tid & 63, wid = __builtin_amdgcn_readfirstlane(tid >> 6), wm = wid >> 2, wn = wid & 3;
    const int fq = lane >> 4, fr = lane & 15;
    const int ncol0 = nt * 256 + wn * 64;
    const int prow0 = pos0 + wm * 128;
    if (ncol0 < 1024 || (ncol0 >= 2048 && ncol0 < 3072)) {
      const bool isq = ncol0 >= 2048; const int h = (ncol0 >> 7) & 7, map = (ncol0 >> 6) & 1;
#pragma unroll
      for (int mi = 0; mi < 8; ++mi) {
        const int pos = prow0 + mi * 16 + fr;
        f32x4 o[4];
        if (!isctx) {
#pragma unroll
          for (int pr = 0; pr < 2; ++pr) {
            const f32x4 cs = *(const f32x4*)(ropec + pos * 32 + pr * 16 + fq * 4);
            const f32x4 sn = *(const f32x4*)(ropes + pos * 32 + pr * 16 + fq * 4);
            const f32x4 x0 = acc[mi][2 * pr], x1 = acc[mi][2 * pr + 1];
            o[2 * pr] = x0 * cs - x1 * sn;
            o[2 * pr + 1] = x1 * cs + x0 * sn;
          }
        } else {
#pragma unroll
          for (int ni = 0; ni < 4; ++ni) o[ni] = acc[mi][ni];
        }
        bf16_t* dst;
        if (!isq) dst = KB + ((size_t)((b * 8 + h) * 2 + map) * NKEY + (isctx ? SEQ + pos : pos)) * 64;
        else if (!isctx) dst = QB + ((size_t)((b * 8 + h) * 2 + map) * SEQ + pos) * 64;
        else dst = CQ + ((size_t)((b * 8 + h) * 2 + map) * LC + pos) * 64;
        const float sc = isq ? QSCALE : 1.0f;
#pragma unroll
        for (int ni = 0; ni < 4; ++ni) {
          const f32x4 vv = o[ni] * sc;
          *(u32x2*)(dst + ni * 16 + fq * 4) = (u32x2){pk2(vv[0], vv[1]), pk2(vv[2], vv[3])};
        }
      }
    } else if (ncol0 < 2048) {
      const int h = (ncol0 - 1024) >> 7, vc0 = ncol0 & 127;
#pragma unroll
      for (int mi = 0; mi < 8; ++mi) {
        const int key = (isctx ? SEQ : 0) + prow0 + mi * 16 + fq * 4;
        const int k15 = key & 15;
        const int pkey = (key & ~15) | (k15 & 3) | ((k15 & 4) << 1) | ((k15 & 8) >> 1);
#pragma unroll
        for (int ni = 0; ni < 4; ++ni) {
          const int vcol = vc0 + ni * 16 + fr;
          const f32x4 vv = acc[mi][ni];
          *(u32x2*)(VT + ((size_t)(b * 8 + h) * 128 + vcol) * NKEY + pkey) = (u32x2){pk2(vv[0], vv[1]), pk2(vv[2], vv[3])};
        }
      }
    } else if (ncol0 < 4096) {
#pragma unroll
      for (int mi = 0; mi < 8; ++mi) {
        const int pos = prow0 + mi * 16 + fq * 4;
#pragma unroll
        for (int ni = 0; ni < 4; ++ni) {
          const int zc = ncol0 - 3072 + ni * 16 + fr;
          const int np = zc & 511, second = zc >> 9;
          const f32x4 vv = acc[mi][ni];
          bf16_t* dst = isctx ? (ZTC + ((size_t)b * 512 + np) * 512 + second * 256 + pos) : (ZT + ((size_t)b * 512 + np) * 4096 + second * 2048 + pos);
          *(u32x2*)dst = (u32x2){pk2(vv[0], vv[1]), pk2(vv[2], vv[3])};
        }
      }
    } else {
#pragma unroll
      for (int mi = 0; mi < 8; ++mi) {
        const int row = m0 + wm * 128 + mi * 16 + fr;
#pragma unroll
        for (int ni = 0; ni < 4; ++ni) {
          const int col = ncol0 - 4096 + ni * 16 + fq * 4;
          const f32x4 vv = acc[mi][ni];
          *(u32x2*)(R + (size_t)row * 512 + col) = (u32x2){pk2(vv[0], vv[1]), pk2(vv[2], vv[3])};
        }
      }
    }
    v = v2; mt = mt2; nt = nt2; cur = nxt;
  }
}

DI void attn_unit(const bf16_t* __restrict__ Qb  , int nq, int q0, const bf16_t* __restrict__ Kb  ,
                  const bf16_t* __restrict__ VTb  , int key0, int ntiles  , bf16_t* __restrict__ outp  ,
                  const float* __restrict__ subg, float lam, float nscale, char* smem) {
  const int tid = g_tid(), lane = tid & 63, wid = __builtin_amdgcn_readfirstlane(tid >> 6), wq = wid & 3, map = wid >> 2;
  const int l31 = lane & 31, kh = lane >> 5;
  bf16x8 qf[4];
  {
    const bf16_t* qp = Qb + ((size_t)map * nq + q0 + wq * 32 + l31) * 64 + kh * 8;
#pragma unroll
    for (int s = 0; s < 4; ++s) qf[s] = *(const bf16x8*)(qp + s * 16);
  }
  const int srow = tid >> 3, sc = (tid & 7) ^ ((tid >> 4) & 7);
  const unsigned koff = (unsigned)((key0 + srow) * 64 + sc * 8) * 2u;
  const unsigned voff = (unsigned)(srow * NKEY + key0 + sc * 8) * 2u;
  const char* Kc = (const char*)Kb; const char* Vc = (const char*)VTb;
  char* sdst = smem + tid * 16;
#define A_ISSUE(T) do { char* d_ = sdst + ((T) & 3) * 32768; \
    __builtin_amdgcn_global_load_lds((const void*)(Kc + (size_t)(T) * 8192 + koff), (lds_ptr_t)(d_), 16, 0, 0); \
    __builtin_amdgcn_global_load_lds((const void*)(Kc + (size_t)NKEY * 128 + (size_t)(T) * 8192 + koff), (lds_ptr_t)(d_ + 8192), 16, 0, 0); \
    __builtin_amdgcn_global_load_lds((const void*)(Vc + (size_t)(T) * 128 + voff), (lds_ptr_t)(d_ + 16384), 16, 0, 0); \
    __builtin_amdgcn_global_load_lds((const void*)(Vc + (size_t)64 * NKEY * 2 + (size_t)(T) * 128 + voff), (lds_ptr_t)(d_ + 24576), 16, 0, 0); } while (0)
  f32x16 O[4];
#pragma unroll
  for (int vb = 0; vb < 4; ++vb)
#pragma unroll
    for (int i = 0; i < 16; ++i) O[vb][i] = 0.f;
  float m = 0.f, lsum = 0.f;
  const int sw = (lane >> 1) & 7;
  const int kfo = l31 * 128, cho = kh;
#define A_QK(SX, T) do { const char* st_ = smem + ((T) & 3) * 32768 + map * 8192 + kfo; \
    bf16x8 kf_[8]; \
    _Pragma("unroll") for (int s = 0; s < 4; ++s) _Pragma("unroll") for (int kb = 0; kb < 2; ++kb) \
        kf_[s * 2 + kb] = *(const bf16x8*)(st_ + kb * 4096 + (((2 * s + cho) ^ sw) << 4)); \
    _Pragma("unroll") for (int kb = 0; kb < 2; ++kb) _Pragma("unroll") for (int i = 0; i < 16; ++i) SX[kb][i] = -m; \
    __builtin_amdgcn_sched_barrier(0); \
    _Pragma("unroll") for (int s = 0; s < 4; ++s) _Pragma("unroll") for (int kb = 0; kb < 2; ++kb) \
        SX[kb] = MFMA32(kf_[s * 2 + kb], qf[s], SX[kb]); \
    __builtin_amdgcn_sched_barrier(0); } while (0)
  bf16x8 pf[4];
  auto pv = [&](int T) {
    const char* sv = smem + (T & 3) * 32768 + 16384 + kfo;
    __builtin_amdgcn_sched_barrier(0);
    bf16x8 va[4], vb_[4];
#pragma unroll
    for (int vb = 0; vb < 4; ++vb) va[vb] = *(const bf16x8*)(sv + vb * 4096 + (((0 + cho) ^ sw) << 4));
#pragma unroll
    for (int vb = 0; vb < 4; ++vb) vb_[vb] = *(const bf16x8*)(sv + vb * 4096 + (((2 + cho) ^ sw) << 4));
    __builtin_amdgcn_sched_barrier(0);
#pragma unroll
    for (int vb = 0; vb < 4; ++vb) O[vb] = MFMA32(va[vb], pf[0], O[vb]);
    __builtin_amdgcn_sched_barrier(0);
#pragma unroll
    for (int vb = 0; vb < 4; ++vb) va[vb] = *(const bf16x8*)(sv + vb * 4096 + (((4 + cho) ^ sw) << 4));
    __builtin_amdgcn_sched_barrier(0);
#pragma unroll
    for (int vb = 0; vb < 4; ++vb) O[vb] = MFMA32(vb_[vb], pf[1], O[vb]);
    __builtin_amdgcn_sched_barrier(0);
#pragma unroll
    for (int vb = 0; vb < 4; ++vb) vb_[vb] = *(const bf16x8*)(sv + vb * 4096 + (((6 + cho) ^ sw) << 4));
    __builtin_amdgcn_sched_barrier(0);
#pragma unroll
    for (int vb = 0; vb < 4; ++vb) O[vb] = MFMA32(va[vb], pf[2], O[vb]);
    __builtin_amdgcn_sched_barrier(0);
#pragma unroll
    for (int vb = 0; vb < 4; ++vb) O[vb] = MFMA32(vb_[vb], pf[3], O[vb]);
    __builtin_amdgcn_sched_barrier(0);
  };
  auto softmax = [&](f32x16 (&SC)[2], f32x16 (&SN)[2], bool has_next, bool first) {
    float mx[16];
#pragma unroll
    for (int i = 0; i < 16; ++i) mx[i] = fmaxf(SC[0][i], SC[1][i]);
#pragma unroll
    for (int w = 8; w >= 1; w >>= 1)
#pragma unroll
      for (int i = 0; i < w; ++i) mx[i] = fmaxf(mx[i], mx[i + w]);
    float tmax = xor32_max(mx[0]);
    if (first || __any(tmax > 8.0f)) {
      const float delta = first ? tmax : fmaxf(tmax, 0.f);
      const float alpha = first ? 1.0f : __builtin_amdgcn_exp2f(-delta);
      m += delta; lsum *= alpha;
#pragma unroll
      for (int vb = 0; vb < 4; ++vb) O[vb] = O[vb] * alpha;
#pragma unroll
      for (int kb = 0; kb < 2; ++kb)
#pragma unroll
        for (int i = 0; i < 16; ++i) SC[kb][i] -= delta;
      if (has_next) {
#pragma unroll
        for (int kb = 0; kb < 2; ++kb)
#pragma unroll
          for (int i = 0; i < 16; ++i) SN[kb][i] -= delta;
      }
    }
    float sm[16];
#pragma unroll
    for (int i = 0; i < 16; ++i) { const float e0 = __builtin_amdgcn_exp2f(SC[0][i]), e1 = __builtin_amdgcn_exp2f(SC[1][i]); SC[0][i] = e0; SC[1][i] = e1; sm[i] = e0 + e1; }
#pragma unroll
    for (int w = 8; w >= 1; w >>= 1)
#pragma unroll
      for (int i = 0; i < w; ++i) sm[i] += sm[i + w];
    lsum += sm[0];
#pragma unroll
    for (int g = 0; g < 4; ++g) {
      const int kb = g >> 1, s2 = g & 1;
      u32x4 w;
      w[0] = pk2(SC[kb][8 * s2 + 0], SC[kb][8 * s2 + 1]); w[1] = pk2(SC[kb][8 * s2 + 2], SC[kb][8 * s2 + 3]);
      w[2] = pk2(SC[kb][8 * s2 + 4], SC[kb][8 * s2 + 5]); w[3] = pk2(SC[kb][8 * s2 + 6], SC[kb][8 * s2 + 7]);
      pf[g] = __builtin_bit_cast(bf16x8, w);
    }
  };
  f32x16 Sa[2], Sb[2];
  if (wid >= 4) __builtin_amdgcn_s_setprio(1);
  WAIT_VM(0);
  A_ISSUE(0); A_ISSUE(1); A_ISSUE(2);
  WAIT_VM(8);
  __builtin_amdgcn_s_barrier();
  asm volatile("" ::: "memory");
  A_QK(Sa, 0);
  for (int t = 0; t < ntiles; t += 2) {
    if (t + 2 < ntiles) WAIT_VM(4); else WAIT_VM(0);
    __builtin_amdgcn_s_barrier();
    asm volatile("" ::: "memory");
    if (t + 3 < ntiles) A_ISSUE(t + 3);
    A_QK(Sb, t + 1);
    softmax(Sa, Sb, true, t == 0);
    pv(t);
    const bool nx = (t + 2 < ntiles);
    if (nx) { if (t + 3 < ntiles) WAIT_VM(4); else WAIT_VM(0); }
    __builtin_amdgcn_s_barrier();
    asm volatile("" ::: "memory");
    if (t + 4 < ntiles) A_ISSUE(t + 4);
    if (nx) A_QK(Sa, t + 2);
    softmax(Sb, Sa, nx, false);
    pv(t + 1);
  }
  __builtin_amdgcn_s_setprio(0);
  asm volatile("s_waitcnt lgkmcnt(0)" ::: "memory");
  __builtin_amdgcn_s_barrier();
  asm volatile("" ::: "memory");
#undef A_ISSUE
#undef A_QK
  const float ltot = xor32_sum(lsum);
  const float inv = 1.0f / ltot;
  float* ex = (float*)smem;
  if (map == 1) {
#pragma unroll
    for (int vb = 0; vb < 4; ++vb)
#pragma unroll
      for (int g4 = 0; g4 < 4; ++g4) {
        f32x4 v = {O[vb][4 * g4] * inv, O[vb][4 * g4 + 1] * inv, O[vb][4 * g4 + 2] * inv, O[vb][4 * g4 + 3] * inv};
        *(f32x4*)(ex + (wq * 32 + l31) * 132 + vb * 32 + 8 * g4 + 4 * kh) = v;
      }
  }
  __syncthreads();
  if (map == 0) {
    float ss = 0.f;
#pragma unroll
    for (int vb = 0; vb < 4; ++vb)
#pragma unroll
      for (int g4 = 0; g4 < 4; ++g4) {
        const f32x4 o2 = *(const f32x4*)(ex + (wq * 32 + l31) * 132 + vb * 32 + 8 * g4 + 4 * kh);
#pragma unroll
        for (int j = 0; j < 4; ++j) { const float o = O[vb][4 * g4 + j] * inv - lam * o2[j]; O[vb][4 * g4 + j] = o; ss += o * o; }
      }
    ss = xor32_sum(ss);
    const float rs = rsqrtf(ss * (1.0f / 128.0f) + LN_EPS) * nscale;
    bf16_t* op = outp + (size_t)(wq * 32 + l31) * 1024;
#pragma unroll
    for (int vb = 0; vb < 4; ++vb)
#pragma unroll
      for (int g4 = 0; g4 < 4; ++g4) {
        const int vc = vb * 32 + 8 * g4 + 4 * kh;
        const f32x4 g = *(const f32x4*)(subg + vc);
        *(u32x2*)(op + vc) = (u32x2){pk2(O[vb][4 * g4] * rs * g[0], O[vb][4 * g4 + 1] * rs * g[1]), pk2(O[vb][4 * g4 + 2] * rs * g[2], O[vb][4 * g4 + 3] * rs * g[3])};
      }
  }
  __syncthreads();
}

template <int MI>
DI void store_tile_bf16(const f32x4 (&acc)[MI][4], bf16_t* __restrict__ C, int ldc, float scale) {
  const int tid = g_tid(), lane = tid & 63, wid = __builtin_amdgcn_readfirstlane(tid >> 6), wm = wid >> 1, wn = wid & 1, fq = lane >> 4, fr = lane & 15;
#pragma unroll
  for (int mi = 0; mi < MI; ++mi)
#pragma unroll
    for (int ni = 0; ni < 4; ++ni) {
      const f32x4 v = acc[mi][ni] * scale;
      *(u32x2*)(C + (size_t)(wm * 16 * MI + mi * 16 + fr) * ldc + wn * 64 + ni * 16 + fq * 4) = (u32x2){pk2(v[0], v[1]), pk2(v[2], v[3])};
    }
}

template <int W>
DI void pool_rows(const bf16_t* __restrict__ R, bf16_t* __restrict__ PM, int m0, int g, int rhalf, int lane) {
  constexpr int LO = W / 2;
  const int col = g * 128 + (lane & 15) * 8;
#pragma unroll 2
  for (int ps = 0; ps < 8; ++ps) {
    const int row = m0 + ps * 8 + rhalf * 4 + (lane >> 4);
    int b, pos; bool isctx; row_info(row, b, pos, isctx);
    const int L = isctx ? LC : SEQ;
    const int rbase = row - pos;
    float s[8];
#pragma unroll
    for (int j = 0; j < 8; ++j) s[j] = 0.f;
    int cnt = 0;
    u32x4 self = {0u, 0u, 0u, 0u};
#pragma unroll
    for (int k = 0; k < W; ++k) {
      const int q = pos - LO + k;
      const bool ok = (q >= 0) && (q < L);
      const int qc = ok ? q : pos;
      const u32x4 v = *(const u32x4*)(R + (size_t)(rbase + qc) * 512 + col);
      const float f = ok ? 1.0f : 0.0f;
      cnt += ok ? 1 : 0;
#pragma unroll
      for (int j = 0; j < 4; ++j) { s[2 * j] += f * bf_lo(v[j]); s[2 * j + 1] += f * bf_hi(v[j]); }
      if (k == LO) self = v;
    }
    const float ic = 1.0f / (float)cnt;
    u32x4 o;
#pragma unroll
    for (int j = 0; j < 4; ++j) o[j] = pk2(s[2 * j] * ic - bf_lo(self[j]), s[2 * j + 1] * ic - bf_hi(self[j]));
    *(u32x4*)(PM + (size_t)row * 512 + col) = o;
  }
}
DI void pool_task(const bf16_t* __restrict__ R, bf16_t* __restrict__ PM, int m0) {
  const int tid = g_tid(), lane = tid & 63, wid = __builtin_amdgcn_readfirstlane(tid >> 6), g = wid & 3, rhalf = wid >> 2;
  if (g == 0) pool_rows<2>(R, PM, m0, 0, rhalf, lane);
  else if (g == 1) pool_rows<4>(R, PM, m0, 1, rhalf, lane);
  else if (g == 2) pool_rows<8>(R, PM, m0, 2, rhalf, lane);
  else pool_rows<16>(R, PM, m0, 3, rhalf, lane);
}

DI void phase_mix(const Params& p, int l, char* smem) {
  const bool last = (l == DEPTH - 1);
  const bf16_t* KB = (const bf16_t*)(p.ws + OFF_KB); const bf16_t* VT = (const bf16_t*)(p.ws + OFF_VT);
  const bf16_t* QB = (const bf16_t*)(p.ws + OFF_QB); const bf16_t* CQ = (const bf16_t*)(p.ws + OFF_CQ);
  const bf16_t* ZT = (const bf16_t*)(p.ws + OFF_ZT); const bf16_t* ZTC = (const bf16_t*)(p.ws + OFF_ZTC); const bf16_t* R = (const bf16_t*)(p.ws + OFF_R);
  bf16_t* ATT = (bf16_t*)(p.ws + OFF_ATT); bf16_t* FM = (bf16_t*)(p.ws + OFF_FM); bf16_t* PM = (bf16_t*)(p.ws + OFF_PM);
  const bf16_t* ATAB = (const bf16_t*)(p.ws + OFF_ATAB); const bf16_t* ATABC = (const bf16_t*)(p.ws + OFF_ATABC);
  const float lam = ((const float*)(p.ws + OFF_LAMV))[l];
  const float nscale = 1.0f - p.lam_init[l];
  const float* subg = p.subln_g + (size_t)l * 128;
  for (int r = blockIdx.x; r < 1024; r += gridDim.x) {
    const int c = r >> 8, w = r & 255, xcd = w & 7, local = w >> 3;
    const int bh = c * 16 + xcd * 2 + (local >> 4), qb = local & 15;
    const int b = bh >> 3, h = bh & 7;
    attn_unit(QB + (size_t)bh * 2 * SEQ * 64, SEQ, qb * 128, KB + (size_t)bh * 2 * NKEY * 64, VT + (size_t)bh * 128 * NKEY, 0, NKEY / 64,
              ATT + ((size_t)b * SEQ + qb * 128) * 1024 + h * 128, subg, lam, nscale, smem);
  }
  const int G = gridDim.x, nlo = G >> 1, nhi = G - nlo;
  if ((int)blockIdx.x < nlo) {
    for (int d = blockIdx.x; d < 128; d += nlo) {
      const int b = d & 7, local = d >> 3, mt = local & 3, nt = local >> 2;
      const bf16_t* Ab = ATAB + (size_t)mt * 256 * 4096; const bf16_t* Bb = ZT + ((size_t)b * 512 + nt * 128) * 4096;
      f32x4 accP[4][4], accQ[4][4]; zero_acc(accP); zero_acc(accQ);
      gemm_kloop_pp<true>(Ab, 4096, Bb, 4096, 2048, accP, smem);
      gemm_kloop_pp<true>(Ab + 2048, 4096, Bb + 2048, 4096, 2048, accQ, smem);
      const int tid = g_tid(), lane = tid & 63, wid = __builtin_amdgcn_readfirstlane(tid >> 6), wm = wid >> 1, wn = wid & 1, fq = lane >> 4, fr = lane & 15;
#pragma unroll
      for (int mi = 0; mi < 4; ++mi) {
        const int k = mt * 256 + wm * 64 + mi * 16 + fr;
#pragma unroll
        for (int ni = 0; ni < 4; ++ni) {
          const int col = nt * 128 + wn * 64 + ni * 16 + fq * 4;
          const f32x4 y1 = (accP[mi][ni] + accQ[mi][ni]) * (1.0f / 512.0f), y2 = (accP[mi][ni] - accQ[mi][ni]) * (1.0f / 512.0f);
          *(u32x2*)(FM + ((size_t)b * SEQ + k) * 512 + col) = (u32x2){pk2(y1[0], y1[1]), pk2(y1[2], y1[3])};
          if (k > 0) *(u32x2*)(FM + ((size_t)b * SEQ + (SEQ - k)) * 512 + col) = (u32x2){pk2(y2[0], y2[1]), pk2(y2[2], y2[3])};
        }
      }
    }
  } else {
    const int n_cattn = last ? 0 : 128, n_cdft = last ? 0 : 32, n_pool = last ? 256 : 288, n_mid = 64;
    const int n_small = n_cattn + n_cdft + n_pool + n_mid;
    for (int t = (int)blockIdx.x - nlo; t < n_small; t += nhi) {
      int r = t;
      if (r < n_cattn) {
        const int bh = r >> 1, qb = r & 1, b = bh >> 3, h = bh & 7;
        attn_unit(CQ + (size_t)bh * 2 * LC * 64, LC, qb * 128, KB + (size_t)bh * 2 * NKEY * 64, VT + (size_t)bh * 128 * NKEY, SEQ, LC / 64,
                  ATT + ((size_t)T_LAT + b * LC + qb * 128) * 1024 + h * 128, subg, lam, nscale, smem);
        continue;
      }
      r -= n_cattn;
      if (r < n_cdft) {
        const int b = r >> 2, nt = r & 3;
        f32x4 acc[4][4]; zero_acc(acc);
        gemm_kloop_pp<true>(ATABC, 512, ZTC + ((size_t)b * 512 + nt * 128) * 512, 512, 512, acc, smem);
        store_tile_bf16<4>(acc, FM + ((size_t)T_LAT + b * LC) * 512 + nt * 128, 512, 0.005524271728019903f  );
        continue;
      }
      r -= n_cdft;
      if (r < n_pool) { pool_task(R, PM, r * 64); continue; }
      r -= n_pool;
      {
        const int b = r >> 3, sub = r & 7;
        const int tid = g_tid(), lane = tid & 63, wid = __builtin_amdgcn_readfirstlane(tid >> 6);
#pragma unroll 2
        for (int i = 0; i < 8; ++i) {
          const int n = sub * 64 + wid * 8 + i;
          const bf16_t* zr = ZT + ((size_t)b * 512 + n) * 4096;
          float sacc = 0.f;
#pragma unroll
          for (int j = 0; j < 4; ++j) {
            const u32x4 v = *(const u32x4*)(zr + lane * 8 + 512 * j);
#pragma unroll
            for (int e = 0; e < 4; ++e) sacc += bf_lo(v[e]) - bf_hi(v[e]);
          }
          const float tot = wave_sum(sacc) * (1.0f / 512.0f);
          if (lane == 0) FM[((size_t)b * SEQ + 1024) * 512 + n] = (bf16_t)(pk2(tot, 0.f) & 0xffffu);
        }
      }
    }
  }
}

template <int MI>
DI void phase_branch(const Params& p, int l, char* smem) {
  const bool last = (l == DEPTH - 1);
  const bf16_t* W = (const bf16_t*)(p.ws + w_off(l));
  const bf16_t* U = (const bf16_t*)(p.ws + OFF_U);
  const bf16_t* ATT = (const bf16_t*)(p.ws + OFF_ATT); const bf16_t* FM = (const bf16_t*)(p.ws + OFF_FM); const bf16_t* PM = (const bf16_t*)(p.ws + OFF_PM);
  bf16_t* MOUT = (bf16_t*)(p.ws + OFF_MOUT);
  const int nmt = (last ? T_LAT : T_ALL) / (64 * MI), vmax = tile_vmax(nmt, 8);
  for (int v = blockIdx.x; v < vmax; v += gridDim.x) {
    int mt, nt;
    if (!tile_map(v, nmt, 8, mt, nt)) continue;
    const int m0 = mt * 64 * MI, n0 = nt * 128;
    u32x2 tot[MI][4], gpk[MI][4];
#pragma unroll
    for (int mi = 0; mi < MI; ++mi)
#pragma unroll
      for (int ni = 0; ni < 4; ++ni) tot[mi][ni] = (u32x2){0u, 0u};
#pragma unroll 1
    for (int br = 0; br < 3; ++br) {
      __builtin_amdgcn_sched_barrier(0);
      f32x4 acc[MI][4]; zero_acc_t<MI>(acc);
      const bool pre = !last && br == 0 && (m0 + 64 * MI <= G8_ROWS);
      if (!pre) {
        gemm_kloop_pp<true, MI>(U + (size_t)m0 * 1024, 1024, W + WO_WIN + (size_t)(ROW_G + br * 1024 + n0) * 1024, 1024, 1024, acc, smem);
        __builtin_amdgcn_sched_barrier(0);
#pragma unroll
        for (int mi = 0; mi < MI; ++mi)
#pragma unroll
          for (int ni = 0; ni < 4; ++ni) {
            const f32x4 a = acc[mi][ni];
            gpk[mi][ni] = (u32x2){pk2(sigmoidf_(a[0]), sigmoidf_(a[1])), pk2(sigmoidf_(a[2]), sigmoidf_(a[3]))};
          }
      } else {
        const unsigned char* G8 = (const unsigned char*)(p.ws + OFF_G8);
        const int tid_ = g_tid(), lane_ = tid_ & 63, wid_ = __builtin_amdgcn_readfirstlane(tid_ >> 6), wm_ = wid_ >> 1, wn_ = wid_ & 1, fq_ = lane_ >> 4, fr_ = lane_ & 15;
#pragma unroll
        for (int mi = 0; mi < MI; ++mi)
#pragma unroll
          for (int ni = 0; ni < 4; ++ni) {
            const unsigned g = *(const unsigned*)(G8 + (size_t)(m0 + wm_ * 16 * MI + mi * 16 + fr_) * 1024 + n0 + wn_ * 64 + ni * 16 + fq_ * 4);
            gpk[mi][ni] = (u32x2){pk2((float)(g & 255u) * (1.0f / 255.0f), (float)((g >> 8) & 255u) * (1.0f / 255.0f)),
                                  pk2((float)((g >> 16) & 255u) * (1.0f / 255.0f), (float)(g >> 24) * (1.0f / 255.0f))};
          }
      }
      __builtin_amdgcn_sched_barrier(0);
      zero_acc_t<MI>(acc);
      const int K2 = (br == 0) ? 1024 : 512;
      const bf16_t* A2 = (br == 0) ? (ATT + (size_t)m0 * 1024) : ((br == 1 ? FM : PM) + (size_t)m0 * 512);
      const bf16_t* B2 = (br == 0) ? (W + WO_WA + (size_t)n0 * 1024) : (W + (br == 1 ? WO_WF : WO_WP) + (size_t)n0 * 512);
      gemm_kloop_pp<true, MI>(A2, K2, B2, K2, K2, acc, smem);
      __builtin_amdgcn_sched_barrier(0);
#pragma unroll
      for (int mi = 0; mi < MI; ++mi)
#pragma unroll
        for (int ni = 0; ni < 4; ++ni) {
          const f32x4 a = acc[mi][ni]; const u32x2 g = gpk[mi][ni]; const u32x2 tp = tot[mi][ni];
          const float v0 = bf_lo(g[0]) * a[0] + bf_lo(tp[0]), v1 = bf_hi(g[0]) * a[1] + bf_hi(tp[0]);
          const float v2 = bf_lo(g[1]) * a[2] + bf_lo(tp[1]), v3 = bf_hi(g[1]) * a[3] + bf_hi(tp[1]);
          tot[mi][ni] = (u32x2){pk2(v0, v1), pk2(v2, v3)};
        }
    }
    const int tid = g_tid(), lane = tid & 63, wid = __builtin_amdgcn_readfirstlane(tid >> 6), wm = wid >> 1, wn = wid & 1, fq = lane >> 4, fr = lane & 15;
#pragma unroll
    for (int mi = 0; mi < MI; ++mi)
#pragma unroll
      for (int ni = 0; ni < 4; ++ni)
        *(u32x2*)(MOUT + (size_t)(m0 + wm * 16 * MI + mi * 16 + fr) * 1024 + n0 + wn * 64 + ni * 16 + fq * 4) = tot[mi][ni];
  }
}

template <int MI>
DI void phase_gemm_plain(const bf16_t* __restrict__ A, int K, const bf16_t* __restrict__ Bt, bf16_t* __restrict__ C, int nmt, int nnt, char* smem) {
  const int vmax = tile_vmax(nmt, nnt), N = nnt * 128;
  for (int v = blockIdx.x; v < vmax; v += gridDim.x) {
    int mt, nt;
    if (!tile_map(v, nmt, nnt, mt, nt)) continue;
    f32x4 acc[MI][4]; zero_acc_t<MI>(acc);
    gemm_kloop_pp<true, MI>(A + (size_t)mt * 64 * MI * K, K, Bt + (size_t)nt * 128 * K, K, K, acc, smem);
    store_tile_bf16<MI>(acc, C + (size_t)mt * 64 * MI * N + nt * 128, N, 1.0f);
  }
}
DI void phase_ffn1(const Params& p, int l, char* smem) {
  const bool last = (l == DEPTH - 1);
  const bf16_t* W = (const bf16_t*)(p.ws + w_off(l)) + WO_WGU;
  const bf16_t* U = (const bf16_t*)(p.ws + OFF_U);
  bf16_t* H = (bf16_t*)(p.ws + OFF_H);
  const int nsup = (last ? 8 : 9) * 11;
  const int vmax = ((nsup + 15) >> 4) << 8;
  auto map_tile = [&](int v, int& mt, int& nt) -> bool {
    if (v >= vmax) return false;
    const int c = v >> 8, w = v & 255, local = w >> 3, sup = (c * 8 + (w & 7)) * 2 + (local >> 4);
    if (sup >= nsup) return false;
    mt = (sup / 11) * 8 + (local & 7); nt = (sup % 11) * 2 + ((local >> 3) & 1);
    return true;
  };
  int v = blockIdx.x, mt = 0, nt = 0;
  bool cur = map_tile(v, mt, nt);
  if (cur) gemm_prefetch_big(U + (size_t)mt * 256 * 1024, 1024, W + (size_t)nt * 256 * 1024, 1024, smem);
  while (cur) {
    f32x4 acc[8][4];
#pragma unroll
    for (int i = 0; i < 8; ++i)
#pragma unroll
      for (int j = 0; j < 4; ++j) acc[i][j] = (f32x4){0.f, 0.f, 0.f, 0.f};
    gemm_kloop_big<true>(U + (size_t)mt * 256 * 1024, 1024, W + (size_t)nt * 256 * 1024, 1024, 1024, acc, smem, true);
    int v2 = v + gridDim.x, mt2 = 0, nt2 = 0;
    const bool nxt = map_tile(v2, mt2, nt2);
    if (nxt) gemm_prefetch_big(U + (size_t)mt2 * 256 * 1024, 1024, W + (size_t)nt2 * 256 * 1024, 1024, smem);
    const int tid = g_tid(), lane = tid & 63, wid = __builtin_amdgcn_readfirstlane(tid >> 6), wm = wid >> 2, wn = wid & 3, fq = lane >> 4, fr = lane & 15;
#pragma unroll
    for (int mi = 0; mi < 8; ++mi) {
      float o[8];
#pragma unroll
      for (int h2 = 0; h2 < 2; ++h2) {
        const f32x4 g = acc[mi][h2], u = acc[mi][2 + h2];
#pragma unroll
        for (int j = 0; j < 4; ++j) o[4 * h2 + j] = g[j] * sigmoidf_(g[j]) * u[j];
      }
      *(u32x4*)(H + (size_t)(mt * 256 + wm * 128 + mi * 16 + fr) * DFF + (nt * 4 + wn) * 32 + 8 * fq) = (u32x4){pk2(o[0], o[1]), pk2(o[2], o[3]), pk2(o[4], o[5]), pk2(o[6], o[7])};
    }
    v = v2; mt = mt2; nt = nt2; cur = nxt;
  }
}

struct InprojSched {
  const char* U; const char* W; int nsupA, nsup, vmax, grid, bid; bool fill;
  DI static bool transposed(int nt) { return (nt >= 4 && nt < 8) || (nt >= 12 && nt < 16); }
  DI bool next(int i, pg8::Unit& u) const {
    const int v = bid + i * grid;
    if (v >= vmax) return false;
    const int c = v >> 8, w = v & 255, local = w >> 3, sup = (c * 8 + (w & 7)) * 2 + (local >> 4);
    if (sup >= nsup) return false;
    if (sup < nsupA) { u.pm = (sup / 9) * 8 + (local & 7); u.pn = (sup % 9) * 2 + ((local >> 3) & 1); }
    else if (fill) { const int q = (sup - nsupA) * 16 + (local & 15); u.pm = q >> 2; u.pn = 18 + (q & 3); }
    else { u.pm = 64 + (local & 7); u.pn = (sup - nsupA) * 2 + ((local >> 3) & 1); }
    return true;
  }
  DI const char* pa(const pg8::Unit& u) const { return transposed(u.pn) ? W + (size_t)u.pn * 256 * 1024 * 2 : U + (size_t)u.pm * 256 * 1024 * 2; }
  DI const char* pb(const pg8::Unit& u) const { return transposed(u.pn) ? U + (size_t)u.pm * 256 * 1024 * 2 : W + (size_t)u.pn * 256 * 1024 * 2; }
};
struct InprojEpi {
  bf16_t *KB, *VT, *QB, *CQ, *ZT, *ZTC, *R; unsigned char* G8; const float *ropec, *ropes;
  DI void operator()(const f32x4 (&acc)[2][2][4][2], const pg8::Unit& u, int wr, int wc, int fr, int fq) const {
    const int mt = u.pm, nt = u.pn, m0 = mt * 256;
    int b, pos0; bool isctx; row_info(m0, b, pos0, isctx);
    if (nt < 4 || (nt >= 8 && nt < 12)) {
      const bool isq = nt >= 8; const int map = wc >> 1, axis = wc & 1;
      const float sc = isq ? QSCALE : 1.0f;
#pragma unroll
      for (int ai = 0; ai < 2; ++ai)
#pragma unroll
        for (int m = 0; m < 4; ++m) {
          const int pos = pos0 + 128 * ai + 64 * wr + 16 * m + fr;
          f32x4 cs = {1.f, 1.f, 1.f, 1.f}, sn = {0.f, 0.f, 0.f, 0.f};
          if (!isctx) { cs = *(const f32x4*)(ropec + pos * 32 + axis * 16 + fq * 4); sn = *(const f32x4*)(ropes + pos * 32 + axis * 16 + fq * 4); }
#pragma unroll
          for (int bj = 0; bj < 2; ++bj) {
            const int h = (nt * 2 + bj) & 7;
            const f32x4 x0 = acc[ai][bj][m][0], x1 = acc[ai][bj][m][1];
            const f32x4 o0 = (x0 * cs - x1 * sn) * sc, o1 = (x1 * cs + x0 * sn) * sc;
            bf16_t* dst;
            if (!isq) dst = KB + ((size_t)((b * 8 + h) * 2 + map) * NKEY + (isctx ? SEQ + pos : pos)) * 64;
            else if (!isctx) dst = QB + ((size_t)((b * 8 + h) * 2 + map) * SEQ + pos) * 64;
            else dst = CQ + ((size_t)((b * 8 + h) * 2 + map) * LC + pos) * 64;
            *(u32x2*)(dst + axis * 32 + fq * 4) = (u32x2){pk2(o0[0], o0[1]), pk2(o0[2], o0[3])};
            *(u32x2*)(dst + axis * 32 + 16 + fq * 4) = (u32x2){pk2(o1[0], o1[1]), pk2(o1[2], o1[3])};
          }
        }
    } else if (nt < 8 || (nt >= 12 && nt < 16)) {
      const bool isv = nt < 8;
#pragma unroll
      for (int ai = 0; ai < 2; ++ai)
#pragma unroll
        for (int m = 0; m < 4; ++m) {
          const int ncol = nt * 256 + 128 * ai + 64 * wr + 16 * m + fr;
#pragma unroll
          for (int bj = 0; bj < 2; ++bj)
#pragma unroll
            for (int n = 0; n < 2; ++n) {
              const int pos = pos0 + 128 * bj + 32 * wc + 16 * n + 4 * fq;
              const f32x4 vv = acc[ai][bj][m][n];
              bf16_t* dst;
              if (isv) {
                const int vg = ncol - 1024, h = vg >> 7, vcol = vg & 127;
                const int key = (isctx ? SEQ : 0) + pos, k15 = key & 15;
                const int pkey = (key & ~15) | (k15 & 3) | ((k15 & 4) << 1) | ((k15 & 8) >> 1);
                dst = VT + ((size_t)(b * 8 + h) * 128 + vcol) * NKEY + pkey;
              } else {
                const int zc = ncol - 3072, np = zc & 511, second = zc >> 9;
                dst = isctx ? (ZTC + ((size_t)b * 512 + np) * 512 + second * 256 + pos) : (ZT + ((size_t)b * 512 + np) * 4096 + second * 2048 + pos);
              }
              *(u32x2*)dst = (u32x2){pk2(vv[0], vv[1]), pk2(vv[2], vv[3])};
            }
        }
    } else if (nt >= 18) {
#pragma unroll
      for (int ai = 0; ai < 2; ++ai)
#pragma unroll
        for (int m = 0; m < 4; ++m) {
          const int row = m0 + 128 * ai + 64 * wr + 16 * m + fr;
#pragma unroll
          for (int bj = 0; bj < 2; ++bj)
#pragma unroll
            for (int n = 0; n < 2; ++n) {
              const int col = nt * 256 + 128 * bj + 32 * wc + 16 * n + 4 * fq - 4608;
              const f32x4 vv = acc[ai][bj][m][n];
              unsigned w = 0;
#pragma unroll
              for (int j = 0; j < 4; ++j) w |= (unsigned)__builtin_rintf(sigmoidf_(vv[j]) * 255.0f) << (8 * j);
              *(unsigned*)(G8 + (size_t)row * 1024 + col) = w;
            }
        }
    } else {
#pragma unroll
      for (int ai = 0; ai < 2; ++ai)
#pragma unroll
        for (int m = 0; m < 4; ++m) {
          const int row = m0 + 128 * ai + 64 * wr + 16 * m + fr;
#pragma unroll
          for (int bj = 0; bj < 2; ++bj)
#pragma unroll
            for (int n = 0; n < 2; ++n) {
              const int col = nt * 256 + 128 * bj + 32 * wc + 16 * n + 4 * fq - 4096;
              const f32x4 vv = acc[ai][bj][m][n];
              *(u32x2*)(R + (size_t)row * 512 + col) = (u32x2){pk2(vv[0], vv[1]), pk2(vv[2], vv[3])};
            }
        }
    }
  }
};
DI void phase_inproj8(const Params& p, int l, char* smem) {
  const bool last = (l == DEPTH - 1);
  InprojSched S;
  S.U = (const char*)(p.ws + OFF_U); S.W = (const char*)((const bf16_t*)(p.ws + w_off(l)) + WO_WIN);
  S.nsupA = last ? 72 : 81; S.nsup = last ? 76 : 96; S.fill = !last;
  S.vmax = ((S.nsup + 15) >> 4) << 8; S.grid = gridDim.x; S.bid = blockIdx.x;
  InprojEpi E;
  E.KB = (bf16_t*)(p.ws + OFF_KB); E.VT = (bf16_t*)(p.ws + OFF_VT); E.QB = (bf16_t*)(p.ws + OFF_QB); E.CQ = (bf16_t*)(p.ws + OFF_CQ);
  E.ZT = (bf16_t*)(p.ws + OFF_ZT); E.ZTC = (bf16_t*)(p.ws + OFF_ZTC); E.R = (bf16_t*)(p.ws + OFF_R);
  E.ropec = (const float*)(p.ws + OFF_ROPEC); E.ropes = (const float*)(p.ws + OFF_ROPES); E.G8 = (unsigned char*)(p.ws + OFF_G8);
  pg8::gemm_phase(( __attribute__((address_space(3))) unsigned char*)(lds_ptr_t)smem, 1024, S, E);
}
struct Ffn1Sched {
  const char* U; const char* W; int nsup, vmax, grid, bid;
  DI bool next(int i, pg8::Unit& u) const {
    const int v = bid + i * grid;
    if (v >= vmax) return false;
    const int c = v >> 8, w = v & 255, local = w >> 3, sup = (c * 8 + (w & 7)) * 2 + (local >> 4);
    if (sup >= nsup) return false;
    u.pm = (sup / 11) * 8 + (local & 7); u.pn = (sup % 11) * 2 + ((local >> 3) & 1);
    return true;
  }
  DI const char* pa(const pg8::Unit& u) const { return U + (size_t)u.pm * 256 * 1024 * 2; }
  DI const char* pb(const pg8::Unit& u) const { return W + (size_t)u.pn * 256 * 1024 * 2; }
};
struct Ffn1Epi {
  bf16_t* H;
  DI void operator()(const f32x4 (&acc)[2][2][4][2], const pg8::Unit& u, int wr, int wc, int fr, int fq) const {
#pragma unroll
    for (int ai = 0; ai < 2; ++ai)
#pragma unroll
      for (int m = 0; m < 4; ++m) {
        const int row = u.pm * 256 + 128 * ai + 64 * wr + 16 * m + fr;
#pragma unroll
        for (int bj = 0; bj < 2; ++bj) {
          const f32x4 g = acc[ai][bj][m][0], up = acc[ai][bj][m][1];
          float o[4];
#pragma unroll
          for (int j = 0; j < 4; ++j) o[j] = g[j] * sigmoidf_(g[j]) * up[j];
          *(u32x2*)(H + (size_t)row * DFF + u.pn * 128 + (bj * 4 + wc) * 16 + fq * 4) = (u32x2){pk2(o[0], o[1]), pk2(o[2], o[3])};
        }
      }
  }
};
DI void phase_ffn18(const Params& p, int l, char* smem) {
  const bool last = (l == DEPTH - 1);
  Ffn1Sched S;
  S.U = (const char*)(p.ws + OFF_U); S.W = (const char*)((const bf16_t*)(p.ws + w_off(l)) + WO_WGU);
  S.nsup = (last ? 8 : 9) * 11; S.vmax = ((S.nsup + 15) >> 4) << 8; S.grid = gridDim.x; S.bid = blockIdx.x;
  Ffn1Epi E; E.H = (bf16_t*)(p.ws + OFF_H);
  pg8::gemm_phase((__attribute__((address_space(3))) unsigned char*)(lds_ptr_t)smem, 1024, S, E);
  if (!last) convert_grab(p, l + 1, 1, smem);
}

#define XB_TMO      128
#define XB_XCNT(j)  (256  + 64 * (j))
#define XB_XSUB(j)  (1280 + 64 * (j))
#define XB_XGEN(j)  (2304 + 64 * (j))
#define XB_TOP      3328
#define XB_TOPGEN   3392
#define XCD_BAR_WORDS 3456
#define XB_SPIN_CAP (1u << 20)
#define LAS __attribute__((address_space(3)))
DI unsigned xb_ld(unsigned* p) { return __hip_atomic_load(p, __ATOMIC_RELAXED, __HIP_MEMORY_SCOPE_AGENT); }
DI unsigned xb_add(unsigned* p, unsigned v) { return __hip_atomic_fetch_add(p, v, __ATOMIC_RELAXED, __HIP_MEMORY_SCOPE_AGENT); }
DI unsigned xb_xcc_id() { return (unsigned)__builtin_amdgcn_s_getreg((3 << 11) | 20) & 0xFu; }
#define XB_SPIN(cond, bar) do { unsigned _sp = 0; while (cond) { __builtin_amdgcn_s_sleep(1); \
    if ((++_sp & 255u) == 0u) { if (xb_ld(&(bar)[XB_TMO])) break; if (_sp > XB_SPIN_CAP) { atomicAdd(&(bar)[XB_TMO], 1u); break; } } } } while (0)
struct XcdBarrier { unsigned* bar; unsigned x; volatile LAS unsigned* st; };
DI XcdBarrier xcd_barrier_post(unsigned* bar, volatile LAS unsigned* st) {
  XcdBarrier b; b.bar = bar; b.x = xb_xcc_id(); b.st = st;
  if (__builtin_amdgcn_workitem_id_x() == 0) (void)xb_add(&bar[XB_XCNT(b.x)], 1u);
  return b;
}
DI void xcd_barrier_complete(unsigned* bar, unsigned x, unsigned& nloc, unsigned& nx) {
  const unsigned G = gridDim.x * gridDim.y * gridDim.z;
  unsigned sum, cnt, mine, sp = 0u;
  for (;;) {
    sum = 0u; cnt = 0u; mine = 0u;
#pragma unroll
    for (unsigned j = 0; j < 16; ++j) { const unsigned c = xb_ld(&bar[XB_XCNT(j)]); sum += c; cnt += (c > 0u) ? 1u : 0u; mine = (j == x) ? c : mine; }
    if (sum == G) break;
    __builtin_amdgcn_s_sleep(1);
    if ((++sp & 255u) == 0u) { if (xb_ld(&bar[XB_TMO])) break; if (sp > XB_SPIN_CAP) { atomicAdd(&bar[XB_TMO], 1u); break; } }
  }
  nloc = mine > 0u ? mine : 1u; nx = cnt > 0u ? cnt : 1u;
}
DI void xcd_barrier(const XcdBarrier& b) {
  asm volatile("s_waitcnt vmcnt(0)" ::: "memory");
  __syncthreads();
  if (__builtin_amdgcn_workitem_id_x() == 0) {
    unsigned* bar = b.bar;
    __builtin_amdgcn_s_waitcnt(0);
    unsigned nloc = b.st[0], nx = b.st[1];
    if (nloc == 0u) { xcd_barrier_complete(bar, b.x, nloc, nx); b.st[0] = nloc; b.st[1] = nx; }
    const unsigned old = xb_add(&bar[XB_XSUB(b.x)], 1u);
    const unsigned gen = old / nloc;
    if (old + 1u == (gen + 1u) * nloc) {
      __builtin_amdgcn_fence(__ATOMIC_RELEASE, "agent");
      asm volatile("s_waitcnt vmcnt(0)" ::: "memory");
      const unsigned og = xb_add(&bar[XB_TOP], 1u);
      const unsigned tg = og / nx;
      if (og + 1u == (tg + 1u) * nx) xb_add(&bar[XB_TOPGEN], 1u);
      else XB_SPIN(xb_ld(&bar[XB_TOPGEN]) == tg, bar);
      __builtin_amdgcn_fence(__ATOMIC_ACQUIRE, "agent");
      xb_add(&bar[XB_XGEN(b.x)], 1u);
      asm volatile("s_waitcnt vmcnt(0)" ::: "memory");
    } else {
      XB_SPIN(xb_ld(&bar[XB_XGEN(b.x)]) == gen, bar);
      __builtin_amdgcn_fence(__ATOMIC_ACQUIRE, "agent");
      asm volatile("s_waitcnt vmcnt(0)" ::: "memory");
    }
  }
  __syncthreads();
}

#define REP_MASK 0
#define REP_PRO 0
__global__ void __launch_bounds__(512) mega(Params p0) {
  extern __shared__ __attribute__((aligned(16))) char smem[];
  cg::grid_group grid = cg::this_grid();
  volatile LAS unsigned* xst = (volatile LAS unsigned*)(lds_ptr_t)(smem + 3 * GSTAGE);
  if (__builtin_amdgcn_workitem_id_x() < 4) xst[__builtin_amdgcn_workitem_id_x()] = 0u;
  __syncthreads();
  const XcdBarrier xb = xcd_barrier_post((unsigned*)(p0.ws + OFF_BAR), xst);
  for (int ph = p0.ph_begin; ph < p0.ph_end; ++ph) {
    const Params& p = p0;
    const bf16_t* Wl = (const bf16_t*)(p.ws + w_off(ph >= 2 ? (ph - 2) >> 3 : 0));
    if (ph == 0) { phase0a(p, smem); if (REP_PRO & 1) { xcd_barrier(xb); phase0a(p, smem); } }
    else if (ph == 1) { ln_pass(p, 0, T_ALL, nullptr, nullptr, nullptr, 0, 0, 0, 0); if (REP_PRO & 2) { xcd_barrier(xb); ln_pass(p, 0, T_ALL, nullptr, nullptr, nullptr, 0, 0, 0, 0); } }
    else {
      const int l = (ph - 2) >> 3, s = (ph - 2) & 7;
      const bool last = (l == DEPTH - 1);
      const int nmt = last ? 64 : 72, nrows = last ? T_LAT : T_ALL;
      for (int rep = 0; rep < 1 + ((REP_MASK >> s) & 1); ++rep) {
      if (rep) xcd_barrier(xb);
      switch (s) {
        case 0: phase_inproj8(p, l, smem); break;
        case 1: phase_mix(p, l, smem); if (!last) convert_grab(p, l + 1, 0, smem); break;
        case 2: if (last) phase_branch<4>(p, l, smem); else { phase_branch<3>(p, l, smem); convert_grab(p, l + 1, 0, smem); } break;
        case 3: if (last) phase_gemm_plain<4>((const bf16_t*)(p.ws + OFF_MOUT), 1024, Wl + WO_WO, (bf16_t*)(p.ws + OFF_Y), 64, 8, smem);
                else phase_gemm_plain<3>((const bf16_t*)(p.ws + OFF_MOUT), 1024, Wl + WO_WO, (bf16_t*)(p.ws + OFF_Y), 96, 8, smem);
                break;
        case 4: ln_pass(p, 1, nrows, (const bf16_t*)(p.ws + OFF_Y), p.ln1_g + (size_t)l * 1024, p.ln1_b + (size_t)l * 1024, l, 2, l, 3); break;
        case 5: phase_ffn18(p, l, smem); break;
        case 6: if (last) phase_gemm_plain<4>((const bf16_t*)(p.ws + OFF_H), DFF, Wl + WO_WD, (bf16_t*)(p.ws + OFF_FO), 64, 8, smem);
                else phase_gemm_plain<3>((const bf16_t*)(p.ws + OFF_H), DFF, Wl + WO_WD, (bf16_t*)(p.ws + OFF_FO), 96, 8, smem);
                break;
        default:
          ln_pass(p, last ? 2 : 1, nrows, (const bf16_t*)(p.ws + OFF_FO), p.ln2_g + (size_t)l * 1024, p.ln2_b + (size_t)l * 1024, l, 5, last ? l : l + 1, 0);
          if (!last) { convert_grab(p, l + 1, 0, smem); convert_grab(p, l + 1, 1, smem); }
          break;
      }
      }
    }
    if (ph + 1 < p0.ph_end) { if (ph == p0.ph_begin) grid.sync(); else xcd_barrier(xb); }
  }
}

extern "C" void kernel_launch(void* const* d_in, const int* in_sizes, int n_in, void* d_out, int out_size, void* d_ws, size_t ws_size, hipStream_t stream) {
  constexpr size_t kDynLds = 3 * GSTAGE + 16;
  static int grid_blocks = 0;
  if (!grid_blocks) {
    int dev = 0, cus = 0, per_cu = 0;
    (void)hipGetDevice(&dev);
    (void)hipDeviceGetAttribute(&cus, hipDeviceAttributeMultiprocessorCount, dev);
    (void)hipFuncSetAttribute((const void*)mega, hipFuncAttributeMaxDynamicSharedMemorySize, (int)kDynLds);
    (void)hipOccupancyMaxActiveBlocksPerMultiprocessor(&per_cu, mega, 512, kDynLds);
    if (per_cu > 1) per_cu = 1;
    if (per_cu < 1) per_cu = 1;
    grid_blocks = cus * per_cu;
  }
  if (ws_size < WS_NEED) { fprintf(stderr, "workspace too small: %zu < %zu\n", ws_size, (size_t)WS_NEED); return; }
  (void)hipMemsetAsync((char*)d_ws + OFF_BAR, 0, XCD_BAR_WORDS * 4 + 64, stream);
  Params p;
  memset(&p, 0, sizeof(p));
  const float** fp = (const float**)&p;
  for (int i = 0; i < 22; ++i) fp[i] = (const float*)d_in[i];
  p.out = (float*)d_out;
  p.ws = (char*)d_ws;
  for (int l = 0; l < 4; ++l) p.lam_init[l] = (float)(0.8 - 0.6 * exp(-0.3 * l));
  p.ph_begin = 0; p.ph_end = 2 + 8 * DEPTH;
  void* args[] = {&p};
  hipError_t e = hipLaunchCooperativeKernel((void*)mega, dim3(grid_blocks), dim3(512), args, kDynLds, stream);
  if (e != hipSuccess) fprintf(stderr, "cooperative launch failed: %s (grid %d)\n", hipGetErrorString(e), grid_blocks);
}
```

```cpp
#include <hip/hip_runtime.h>
#include <hip/hip_cooperative_groups.h>
#include <cstdio>
#include <cstdint>
#include <cstring>
#include <cmath>
namespace cg = cooperative_groups;

#define DI __device__ __forceinline__
typedef unsigned short bf16_t;
typedef short bf16x8 __attribute__((ext_vector_type(8)));
typedef float f32x4 __attribute__((ext_vector_type(4)));
typedef float f32x2 __attribute__((ext_vector_type(2)));
typedef float f32x16 __attribute__((ext_vector_type(16)));
typedef unsigned u32x2 __attribute__((ext_vector_type(2)));
typedef unsigned u32x4 __attribute__((ext_vector_type(4)));
typedef __bf16 bf16x2_t __attribute__((ext_vector_type(2)));

constexpr int D = 1024, NB = 8, SEQ = 2048, LC = 256, NH = 8, DEPTH = 4;
constexpr int T_LAT = NB * SEQ, T_CTX = NB * LC, T_ALL = T_LAT + T_CTX;
constexpr int NKEY = SEQ + LC;
constexpr int N_IN = 7168, DFF = 2816;
constexpr int WIN_ROWS = 7680;
constexpr int ROW_Z1 = 3072, ROW_Z2 = 3584, ROW_R = 4096, ROW_G = 4608;
constexpr float ALPHA = 1.6817928305074290f;
constexpr float LN_EPS = 1e-5f;
constexpr float QSCALE = 0.125f * 1.4426950408889634f;

constexpr size_t WO_WIN = 0;
constexpr size_t WO_WA = WO_WIN + (size_t)WIN_ROWS * 1024;
constexpr size_t WO_WF = WO_WA + 1024 * 1024;
constexpr size_t WO_WP = WO_WF + 1024 * 512;
constexpr size_t WO_WO = WO_WP + 1024 * 512;
constexpr size_t WO_WGU = WO_WO + 1024 * 1024;
constexpr size_t WO_WD = WO_WGU + (size_t)5632 * 1024;
constexpr size_t W_ELEMS = WO_WD + (size_t)1024 * DFF;

constexpr size_t al256(size_t x) { return (x + 255) & ~(size_t)255; }
constexpr size_t OFF_W = 0;
constexpr size_t OFF_ATAB = al256(OFF_W + W_ELEMS * 2);
constexpr size_t OFF_ATABC = al256(OFF_ATAB + (size_t)2048 * 4096 * 2);
constexpr size_t OFF_ROPEC = al256(OFF_ATABC + (size_t)256 * 512 * 2);
constexpr size_t OFF_ROPES = al256(OFF_ROPEC + (size_t)2048 * 32 * 4);
constexpr size_t OFF_MODV = al256(OFF_ROPES + (size_t)2048 * 32 * 4);
constexpr size_t OFF_LAMV = al256(OFF_MODV + (size_t)DEPTH * 9 * 6144 * 4);
constexpr size_t OFF_X = al256(OFF_LAMV + 256);
constexpr size_t OFF_U = al256(OFF_X + (size_t)T_ALL * 1024 * 4);
constexpr size_t OFF_KB = al256(OFF_U + (size_t)T_ALL * 1024 * 2);
constexpr size_t OFF_VT = al256(OFF_KB + (size_t)NB * NH * 2 * NKEY * 64 * 2);
constexpr size_t OFF_QB = al256(OFF_VT + (size_t)NB * NH * 128 * NKEY * 2);
constexpr size_t OFF_CQ = al256(OFF_QB + (size_t)NB * NH * 2 * SEQ * 64 * 2);
constexpr size_t OFF_ZT = al256(OFF_CQ + (size_t)NB * NH * 2 * LC * 64 * 2);
constexpr size_t OFF_ZTC = al256(OFF_ZT + (size_t)NB * 512 * 4096 * 2);
constexpr size_t OFF_R = al256(OFF_ZTC + (size_t)NB * 512 * 512 * 2);
constexpr size_t OFF_ATT = al256(OFF_R + (size_t)T_ALL * 512 * 2);
constexpr size_t OFF_FM = al256(OFF_ATT + (size_t)T_ALL * 1024 * 2);
constexpr size_t OFF_PM = al256(OFF_FM + (size_t)T_ALL * 512 * 2);
constexpr size_t OFF_BAR = al256(OFF_PM + (size_t)T_ALL * 512 * 2);
constexpr size_t OFF_CTR = OFF_BAR + 3456 * 4;
constexpr size_t OFF_W2 = al256(OFF_CTR + 64);
constexpr size_t OFF_G8 = al256(OFF_W2 + W_ELEMS * 2);
constexpr int G8_ROWS = 15360;
constexpr size_t WS_NEED = al256(OFF_G8 + (size_t)G8_ROWS * 1024);
constexpr size_t OFF_MOUT = OFF_KB;
constexpr size_t OFF_Y = OFF_VT;
constexpr size_t OFF_H = OFF_KB;
constexpr size_t OFF_FO = OFF_ATT;
static_assert((size_t)T_ALL * DFF * 2 <= OFF_CQ - OFF_KB, "H overlay too large");

struct Params {
  const float *x, *c, *ctx, *c_ctx, *w_mod, *b_mod, *w_in, *lam_qk, *subln_g, *w_att_br, *w_four_br, *w_pool_grp, *pool_scale,
      *w_pool_br, *w_out, *ln1_g, *ln1_b, *w_ffn_gate, *w_ffn_up, *w_ffn_down, *ln2_g, *ln2_b;
  float* out;
  char* ws;
  float lam_init[4];
  int ph_begin, ph_end;
};

DI size_t w_off(int l) { return (l & 1) ? OFF_W2 : OFF_W; }
DI int g_tid() { int t = __builtin_amdgcn_workitem_id_x(); asm volatile("" : "+v"(t)); return t; }
DI unsigned pk2(float a, float b) { f32x2 v = {a, b}; bf16x2_t r = __builtin_convertvector(v, bf16x2_t); return __builtin_bit_cast(unsigned, r); }
DI float bf_lo(unsigned u) { return __uint_as_float(u << 16); }
DI float bf_hi(unsigned u) { return __uint_as_float(u & 0xffff0000u); }
DI float hw_cos_rev(float r) { return __builtin_amdgcn_cosf(r); }
DI float hw_sin_rev(float r) { return __builtin_amdgcn_sinf(r); }
DI float sigmoidf_(float x) { return 1.0f / (1.0f + __expf(-x)); }
DI float xor32_sum(float v) { const auto r = __builtin_amdgcn_permlane32_swap(__float_as_uint(v), __float_as_uint(v), false, false); return __uint_as_float(r[0]) + __uint_as_float(r[1]); }
DI float xor32_max(float v) { const auto r = __builtin_amdgcn_permlane32_swap(__float_as_uint(v), __float_as_uint(v), false, false); return fmaxf(__uint_as_float(r[0]), __uint_as_float(r[1])); }
DI float dpp_add(float v, int) { return v; }
#define DPP_ADD(v, ctrl) ((v) + __uint_as_float(__builtin_amdgcn_update_dpp(0u, __float_as_uint(v), (ctrl), 0xF, 0xF, true)))
DI float wave_sum(float v) {
  v = DPP_ADD(v, 0xB1);
  v = DPP_ADD(v, 0x4E);
  v = DPP_ADD(v, 0x141);
  v = DPP_ADD(v, 0x140);
  { const auto r = __builtin_amdgcn_permlane16_swap(__float_as_uint(v), __float_as_uint(v), false, false); v = __uint_as_float(r[0]) + __uint_as_float(r[1]); }
  return xor32_sum(v);
}
#define MFMA16(a, b, c) __builtin_amdgcn_mfma_f32_16x16x32_bf16((a), (b), (c), 0, 0, 0)
#define MFMA32(a, b, c) __builtin_amdgcn_mfma_f32_32x32x16_bf16((a), (b), (c), 0, 0, 0)

constexpr int GSTAGE = 49152;
#define WAIT_VM(n) asm volatile("s_waitcnt vmcnt(" #n ")" ::: "memory")
typedef __attribute__((address_space(3))) void* lds_ptr_t;
template <bool SWAP, int MI = 4>
DI void gemm_kloop(const bf16_t* __restrict__ A, int lda, const bf16_t* __restrict__ B, int ldb, int K, f32x4 (&acc)[MI][4], char* smem, bool pre = false  ) {
  const int tid = g_tid(), lane = tid & 63, wid = __builtin_amdgcn_readfirstlane(tid >> 6), wm = wid >> 1, wn = wid & 1;
  const int lr = tid >> 3, lc = (tid & 7) ^ ((tid >> 4) & 7);
  const unsigned aoff = (unsigned)(lr * lda + lc * 8) * 2u, boff = (unsigned)(lr * ldb + lc * 8) * 2u;
  const char* Ac = (const char*)A; const char* Bc = (const char*)B;
  const int fr = lane & 15, fq = lane >> 4, sw = fr >> 1;
  const int a_base = (wm * 16 * MI + fr) * 128, b_base = 32768 + (wn * 64 + fr) * 128;
  const int nk = K >> 6;
  char* sdst = smem + tid * 16;
#define G_ISSUE(KT, ST) do { _Pragma("unroll") for (int i = 0; i < MI; ++i) \
      __builtin_amdgcn_global_load_lds((const void*)(Ac + ((size_t)(64 * i) * lda + (size_t)(KT) * 64) * 2 + aoff), (lds_ptr_t)(sdst + (ST) * GSTAGE + i * 8192), 16, 0, 0); \
    _Pragma("unroll") for (int i = 0; i < 2; ++i) \
      __builtin_amdgcn_global_load_lds((const void*)(Bc + ((size_t)(64 * i) * ldb + (size_t)(KT) * 64) * 2 + boff), (lds_ptr_t)(sdst + (ST) * GSTAGE + 32768 + i * 8192), 16, 0, 0); } while (0)
#define G_COMPUTE(ST) do { const char* st_ = smem + (ST) * GSTAGE; \
    _Pragma("unroll") for (int ks = 0; ks < 2; ++ks) { const int co = ((ks * 4 + fq) ^ sw) << 4; bf16x8 af[MI], bfr[4]; \
      _Pragma("unroll") for (int i = 0; i < 4; ++i) bfr[i] = *(const bf16x8*)(st_ + b_base + i * 2048 + co); \
      _Pragma("unroll") for (int i = 0; i < MI; ++i) af[i] = *(const bf16x8*)(st_ + a_base + i * 2048 + co); \
      _Pragma("unroll") for (int mi = 0; mi < MI; ++mi) _Pragma("unroll") for (int ni = 0; ni < 4; ++ni) { \
          if (SWAP) acc[mi][ni] = MFMA16(bfr[ni], af[mi], acc[mi][ni]); else acc[mi][ni] = MFMA16(af[mi], bfr[ni], acc[mi][ni]); } } } while (0)
  if (!pre) { G_ISSUE(0, 0); G_ISSUE(1, 1); }
  int st = 0;
  for (int t = 0; t < nk; ++t) {
    if (t == 0 || t + 1 >= nk) WAIT_VM(0);
    else if (MI == 4) WAIT_VM(6); else WAIT_VM(5);
    __builtin_amdgcn_s_barrier();
    asm volatile("" ::: "memory");
    const int st2 = (st == 0) ? 2 : st - 1;
    if (t + 2 < nk) G_ISSUE(t + 2, st2);
    __builtin_amdgcn_sched_barrier(0);
    G_COMPUTE(st);
    __builtin_amdgcn_sched_group_barrier(0x100, 6, 0);
#pragma unroll
    for (int i_ = 0; i_ < 2 * MI + 2; ++i_) { __builtin_amdgcn_sched_group_barrier(0x008, 2, 0); __builtin_amdgcn_sched_group_barrier(0x100, 1, 0); }
    __builtin_amdgcn_sched_group_barrier(0x008, 4 * MI - 4, 0);
    __builtin_amdgcn_sched_barrier(0);
    st = (st == 2) ? 0 : st + 1;
  }
  asm volatile("s_waitcnt lgkmcnt(0)" ::: "memory");
  __builtin_amdgcn_s_barrier();
  asm volatile("" ::: "memory");
#undef G_ISSUE
#undef G_COMPUTE
}
template <bool SWAP, int MI = 4>
DI void gemm_kloop_pp(const bf16_t* __restrict__ A, int lda, const bf16_t* __restrict__ B, int ldb, int K, f32x4 (&acc)[MI][4], char* smem) {
  const int tid = g_tid(), lane = tid & 63, wid = __builtin_amdgcn_readfirstlane(tid >> 6), wm = wid >> 1, wn = wid & 1, grp = wid >> 2;
  const int lr = tid >> 3, lc = (tid & 7) ^ ((tid >> 4) & 7);
  const unsigned aoff = (unsigned)(lr * lda + lc * 8) * 2u, boff = (unsigned)(lr * ldb + lc * 8) * 2u;
  const char* Ac = (const char*)A; const char* Bc = (const char*)B;
  const int fr = lane & 15, fq = lane >> 4, sw = fr >> 1;
  const int a_base = (wm * 16 * MI + fr) * 128, b_base = 32768 + (wn * 64 + fr) * 128;
  const int nk = K >> 6;
  char* sdst = smem + tid * 16;
#define P_ISSUE(KT, ST) do { _Pragma("unroll") for (int i = 0; i < MI; ++i) \
      __builtin_amdgcn_global_load_lds((const void*)(Ac + ((size_t)(64 * i) * lda + (size_t)(KT) * 64) * 2 + aoff), (lds_ptr_t)(sdst + (ST) * GSTAGE + i * 8192), 16, 0, 0); \
    _Pragma("unroll") for (int i = 0; i < 2; ++i) \
      __builtin_amdgcn_global_load_lds((const void*)(Bc + ((size_t)(64 * i) * ldb + (size_t)(KT) * 64) * 2 + boff), (lds_ptr_t)(sdst + (ST) * GSTAGE + 32768 + i * 8192), 16, 0, 0); } while (0)
  P_ISSUE(0, 0);
  P_ISSUE(1, 1);
  WAIT_VM(0);
  __builtin_amdgcn_s_barrier();
  asm volatile("" ::: "memory");
  if (grp == 1) { __builtin_amdgcn_s_barrier(); asm volatile("" ::: "memory"); }
  int st = 0;
  for (int t = 0; t < nk; ++t) {
    const int st2 = (st == 0) ? 2 : st - 1;
    if (t + 2 < nk) P_ISSUE(t + 2, st2);
    bf16x8 af[2][MI], bfr[2][4];
    const char* st_ = smem + st * GSTAGE;
#pragma unroll
    for (int ks = 0; ks < 2; ++ks) {
      const int co = ((ks * 4 + fq) ^ sw) << 4;
#pragma unroll
      for (int i = 0; i < 4; ++i) bfr[ks][i] = *(const bf16x8*)(st_ + b_base + i * 2048 + co);
#pragma unroll
      for (int i = 0; i < MI; ++i) af[ks][i] = *(const bf16x8*)(st_ + a_base + i * 2048 + co);
    }
    if (t + 2 < nk) { if (MI == 4) WAIT_VM(6); else WAIT_VM(5); } else WAIT_VM(0);
    asm volatile("s_waitcnt lgkmcnt(0)" ::: "memory");
    __builtin_amdgcn_sched_barrier(0);
    __builtin_amdgcn_s_barrier();
    asm volatile("" ::: "memory");
#pragma unroll
    for (int ks = 0; ks < 2; ++ks)
#pragma unroll
      for (int mi = 0; mi < MI; ++mi)
#pragma unroll
        for (int ni = 0; ni < 4; ++ni) {
          if (SWAP) acc[mi][ni] = MFMA16(bfr[ks][ni], af[ks][mi], acc[mi][ni]); else acc[mi][ni] = MFMA16(af[ks][mi], bfr[ks][ni], acc[mi][ni]);
        }
    __builtin_amdgcn_sched_barrier(0);
    __builtin_amdgcn_s_barrier();
    asm volatile("" ::: "memory");
    st = (st == 2) ? 0 : st + 1;
  }
  if (grp == 0) { __builtin_amdgcn_s_barrier(); asm volatile("" ::: "memory"); }
#undef P_ISSUE
}

template <int MI>
DI void gemm_prefetch(const bf16_t* __restrict__ A, int lda, const bf16_t* __restrict__ B, int ldb, char* smem) {
  const int tid = g_tid();
  const int lr = tid >> 3, lc = (tid & 7) ^ ((tid >> 4) & 7);
  const unsigned aoff = (unsigned)(lr * lda + lc * 8) * 2u, boff = (unsigned)(lr * ldb + lc * 8) * 2u;
  const char* Ac = (const char*)A; const char* Bc = (const char*)B;
  char* sdst = smem + tid * 16;
#pragma unroll
  for (int kt = 0; kt < 2; ++kt) {
#pragma unroll
    for (int i = 0; i < MI; ++i)
      __builtin_amdgcn_global_load_lds((const void*)(Ac + ((size_t)(64 * i) * lda + (size_t)kt * 64) * 2 + aoff), (lds_ptr_t)(sdst + kt * GSTAGE + i * 8192), 16, 0, 0);
#pragma unroll
    for (int i = 0; i < 2; ++i)
      __builtin_amdgcn_global_load_lds((const void*)(Bc + ((size_t)(64 * i) * ldb + (size_t)kt * 64) * 2 + boff), (lds_ptr_t)(sdst + kt * GSTAGE + 32768 + i * 8192), 16, 0, 0);
  }
}
template <int MI>
DI void zero_acc_t(f32x4 (&acc)[MI][4]) {
#pragma unroll
  for (int i = 0; i < MI; ++i)
#pragma unroll
    for (int j = 0; j < 4; ++j) acc[i][j] = (f32x4){0.f, 0.f, 0.f, 0.f};
}
DI void zero_acc(f32x4 (&acc)[4][4]) {
#pragma unroll
  for (int i = 0; i < 4; ++i)
#pragma unroll
    for (int j = 0; j < 4; ++j) acc[i][j] = (f32x4){0.f, 0.f, 0.f, 0.f};
}

template <bool SWAP>
DI void gemm_kloop_big(const bf16_t* __restrict__ A, int lda, const bf16_t* __restrict__ B, int ldb, int K, f32x4 (&acc)[8][4], char* smem, bool pre = false) {
  const int tid = g_tid(), lane = tid & 63, wid = __builtin_amdgcn_readfirstlane(tid >> 6), wm = wid >> 2, wn = wid & 3;
  const int lr = tid >> 3, lc = (tid & 7) ^ ((tid >> 4) & 7);
  const unsigned aoff = (unsigned)(lr * lda + lc * 8) * 2u, boff = (unsigned)(lr * ldb + lc * 8) * 2u;
  const char* Ac = (const char*)A; const char* Bc = (const char*)B;
  const int fr = lane & 15, fq = lane >> 4, sw = fr >> 1;
  const int a_base = (wm * 128 + fr) * 128, b_base = 32768 + (wn * 64 + fr) * 128;
  const int nk = K >> 6;
  char* sdst = smem + tid * 16;
#define GB_ISSUE(KT, ST) do { _Pragma("unroll") for (int i = 0; i < 4; ++i) { \
      __builtin_amdgcn_global_load_lds((const void*)(Ac + ((size_t)(64 * i) * lda + (size_t)(KT) * 64) * 2 + aoff), (lds_ptr_t)(sdst + (ST) * 65536 + i * 8192), 16, 0, 0); \
      __builtin_amdgcn_global_load_lds((const void*)(Bc + ((size_t)(64 * i) * ldb + (size_t)(KT) * 64) * 2 + boff), (lds_ptr_t)(sdst + (ST) * 65536 + 32768 + i * 8192), 16, 0, 0); } } while (0)
  if (!pre) GB_ISSUE(0, 0);
  for (int t = 0; t < nk; ++t) {
    WAIT_VM(0);
    __builtin_amdgcn_s_barrier();
    asm volatile("" ::: "memory");
    if (t + 1 < nk) GB_ISSUE(t + 1, (t + 1) & 1);
    __builtin_amdgcn_sched_barrier(0);
    const char* st_ = smem + (t & 1) * 65536;
#pragma unroll
    for (int ks = 0; ks < 2; ++ks) {
      const int co = ((ks * 4 + fq) ^ sw) << 4;
      bf16x8 af[8], bfr[4];
#pragma unroll
      for (int i = 0; i < 4; ++i) bfr[i] = *(const bf16x8*)(st_ + b_base + i * 2048 + co);
#pragma unroll
      for (int i = 0; i < 8; ++i) af[i] = *(const bf16x8*)(st_ + a_base + i * 2048 + co);
#pragma unroll
      for (int mi = 0; mi < 8; ++mi)
#pragma unroll
        for (int ni = 0; ni < 4; ++ni) {
          if (SWAP) acc[mi][ni] = MFMA16(bfr[ni], af[mi], acc[mi][ni]); else acc[mi][ni] = MFMA16(af[mi], bfr[ni], acc[mi][ni]);
        }
    }
    __builtin_amdgcn_sched_group_barrier(0x100, 8, 0);
#pragma unroll
    for (int i_ = 0; i_ < 16; ++i_) { __builtin_amdgcn_sched_group_barrier(0x008, 3, 0); __builtin_amdgcn_sched_group_barrier(0x100, 1, 0); }
    __builtin_amdgcn_sched_group_barrier(0x008, 16, 0);
    __builtin_amdgcn_sched_barrier(0);
  }
  asm volatile("s_waitcnt lgkmcnt(0)" ::: "memory");
  __builtin_amdgcn_s_barrier();
  asm volatile("" ::: "memory");
#undef GB_ISSUE
}

namespace pg8 {
#define PG8_LAS __attribute__((address_space(3)))
constexpr int BM = 256, BK = 64, HALF = 128, HTB = HALF * BK * 2;
DI int lds_byte(int r, int c) { const int st = (r >> 4) * 2 + (c >> 5), rr = r & 15, cc = c & 31, ob = rr * 64 + cc * 2; return st * 1024 + (ob ^ (((ob >> 9) & 1) << 5)); }
DI void stage_rc(int b, int& R, int& C) { const int st = b / 1024, sb = b % 1024, swz = sb ^ (((sb >> 9) & 1) << 5); R = (st >> 1) * 16 + swz / 64; C = (st & 1) * 32 + (swz % 64) / 2; }
struct Unit { int pm, pn; };
template <class Epi, class Sched>
DI void gemm_phase(PG8_LAS unsigned char* lds, int K, const Sched& S, const Epi& E) {
  const int tid = g_tid(), wid = __builtin_amdgcn_readfirstlane(tid >> 6), lane = tid & 63, wr = wid >> 2, wc = wid & 3, fr = lane & 15, fq = lane >> 4;
  const int nt = K / BK;
  unsigned voff[2];
#pragma unroll
  for (int i = 0; i < 2; ++i) { int R, C; stage_rc(tid * 16 + i * 8192, R, C); voff[i] = (unsigned)(R * K + C) * 2u; }
  const size_t kstep = (size_t)(BK * 2);
  const size_t hstep = (size_t)HALF * K * 2;
  const unsigned ldsw = (unsigned)wid * 1024u;
  const int aoff = lds_byte(wr * 64 + fr, fq * 8), boff = lds_byte(wc * 32 + fr, fq * 8);
#define PG8_SA(b, h) (((b) * 2 + (h)) * HTB)
#define PG8_SB(b, h) ((4 + (b) * 2 + (h)) * HTB)
#define PG8_STAGE(bufoff, gbase) do { _Pragma("unroll") for (int _i = 0; _i < 2; ++_i) \
    __builtin_amdgcn_global_load_lds((const void*)((const char*)(gbase) + voff[_i]), (PG8_LAS void*)(lds + (bufoff) + ldsw + _i * 8192), 16, 0, 0); } while (0)
#define PG8_LDA(dst, b, h) do { _Pragma("unroll") for (int m = 0; m < 4; ++m) _Pragma("unroll") for (int k = 0; k < 2; ++k) dst[m][k] = *(const PG8_LAS bf16x8*)(lds + PG8_SA(b, h) + aoff + m * 2048 + k * 1024); } while (0)
#define PG8_LDB(dst, b, h) do { _Pragma("unroll") for (int n = 0; n < 2; ++n) _Pragma("unroll") for (int k = 0; k < 2; ++k) dst[n][k] = *(const PG8_LAS bf16x8*)(lds + PG8_SB(b, h) + boff + n * 2048 + k * 1024); } while (0)
#define PG8_MMA(ai, bj, At, Bt) do { __builtin_amdgcn_s_setprio(1); _Pragma("unroll") for (int m = 0; m < 4; ++m) _Pragma("unroll") for (int n = 0; n < 2; ++n) _Pragma("unroll") for (int k = 0; k < 2; ++k) \
    acc[ai][bj][m][n] = __builtin_amdgcn_mfma_f32_16x16x32_bf16(Bt[n][k], At[m][k], acc[ai][bj][m][n], 0, 0, 0); __builtin_amdgcn_s_setprio(0); } while (0)
#define PG8_WAIT_V(n) asm volatile("s_waitcnt vmcnt(" #n ")" ::: "memory")
#define PG8_WAIT_L(n) asm volatile("s_waitcnt lgkmcnt(" #n ")" ::: "memory")
#define PG8_BAR __builtin_amdgcn_s_barrier()
#define PG8_SCHED __builtin_amdgcn_sched_barrier(0)
  Unit cur, nxt; int ui = 0;
  if (!S.next(0, cur)) return;
  f32x4 acc[2][2][4][2];
#pragma unroll
  for (int a = 0; a < 2; ++a)
#pragma unroll
    for (int b = 0; b < 2; ++b)
#pragma unroll
      for (int m = 0; m < 4; ++m)
#pragma unroll
        for (int n = 0; n < 2; ++n) acc[a][b][m][n] = (f32x4){0.f, 0.f, 0.f, 0.f};
  bf16x8 At[4][2], B0[2][2], B1[2][2];
  const char* cA = S.pa(cur); const char* cB = S.pb(cur);
  PG8_WAIT_V(0);
  PG8_STAGE(PG8_SB(0, 0), cB); PG8_STAGE(PG8_SA(0, 0), cA); PG8_STAGE(PG8_SB(0, 1), cB + hstep); PG8_STAGE(PG8_SA(0, 1), cA + hstep);
  if (wr == 1) PG8_BAR;
  PG8_WAIT_V(4); PG8_BAR;
  PG8_STAGE(PG8_SB(1, 0), cB + kstep); PG8_STAGE(PG8_SA(1, 0), cA + kstep); PG8_STAGE(PG8_SB(1, 1), cB + hstep + kstep);
  PG8_WAIT_V(6); PG8_BAR;
  for (;;) {
    const bool has_next = S.next(ui + 1, nxt);
    const char* nA = has_next ? S.pa(nxt) : cA; const char* nB = has_next ? S.pb(nxt) : cB;
    for (int t = 0; t < nt; t += 2) {
      const bool last = (t == nt - 2);
      const char* a1 = cA + (size_t)(t + 1) * kstep;
      const char* a2 = last ? nA : cA + (size_t)(t + 2) * kstep; const char* b2 = last ? nB : cB + (size_t)(t + 2) * kstep;
      const char* a3 = a2 + kstep; const char* b3 = b2 + kstep;
      PG8_LDB(B0, 0, 0); PG8_SCHED; PG8_LDA(At, 0, 0); PG8_STAGE(PG8_SA(1, 1), a1 + hstep);
      PG8_WAIT_L(8); PG8_BAR; PG8_WAIT_L(0); PG8_MMA(0, 0, At, B0); PG8_BAR; PG8_SCHED;
      PG8_LDB(B1, 0, 1); PG8_STAGE(PG8_SB(0, 0), b2);
      PG8_BAR; PG8_WAIT_L(0); PG8_MMA(0, 1, At, B1); PG8_BAR;
      PG8_LDA(At, 0, 1); PG8_STAGE(PG8_SA(0, 0), a2);
      PG8_BAR; PG8_WAIT_L(0); PG8_MMA(1, 0, At, B0); PG8_BAR; PG8_SCHED;
      PG8_STAGE(PG8_SB(0, 1), b2 + hstep);
      PG8_WAIT_V(6); PG8_BAR; PG8_MMA(1, 1, At, B1); PG8_BAR;
      PG8_LDB(B0, 1, 0); PG8_SCHED; PG8_LDA(At, 1, 0); PG8_STAGE(PG8_SA(0, 1), a2 + hstep);
      PG8_WAIT_L(8); PG8_BAR; PG8_WAIT_L(0); PG8_MMA(0, 0, At, B0); PG8_BAR; PG8_SCHED;
      PG8_LDB(B1, 1, 1); PG8_STAGE(PG8_SB(1, 0), b3);
      PG8_BAR; PG8_WAIT_L(0); PG8_MMA(0, 1, At, B1); PG8_BAR;
      PG8_LDA(At, 1, 1); PG8_STAGE(PG8_SA(1, 0), a3);
      PG8_BAR; PG8_WAIT_L(0); PG8_MMA(1, 0, At, B0); PG8_BAR; PG8_SCHED;
      PG8_STAGE(PG8_SB(1, 1), b3 + hstep);
      PG8_WAIT_V(6); PG8_BAR; PG8_MMA(1, 1, At, B1); PG8_BAR;
    }
    E(acc, cur, wr, wc, fr, fq);
    if (!has_next) break;
#pragma unroll
    for (int a = 0; a < 2; ++a)
#pragma unroll
      for (int b = 0; b < 2; ++b)
#pragma unroll
        for (int m = 0; m < 4; ++m)
#pragma unroll
          for (int n = 0; n < 2; ++n) acc[a][b][m][n] = (f32x4){0.f, 0.f, 0.f, 0.f};
    cur = nxt; cA = nA; cB = nB; ++ui;
  }
  PG8_WAIT_V(0);
  if (wr == 0) PG8_BAR;
  PG8_BAR;
#undef PG8_SA
#undef PG8_SB
#undef PG8_STAGE
#undef PG8_LDA
#undef PG8_LDB
#undef PG8_MMA
#undef PG8_WAIT_V
#undef PG8_WAIT_L
#undef PG8_BAR
#undef PG8_SCHED
}
}

DI void gemm_prefetch_big(const bf16_t* __restrict__ A, int lda, const bf16_t* __restrict__ B, int ldb, char* smem) {
  const int tid = g_tid();
  const int lr = tid >> 3, lc = (tid & 7) ^ ((tid >> 4) & 7);
  const unsigned aoff = (unsigned)(lr * lda + lc * 8) * 2u, boff = (unsigned)(lr * ldb + lc * 8) * 2u;
  const char* Ac = (const char*)A; const char* Bc = (const char*)B;
  char* sdst = smem + tid * 16;
#pragma unroll
  for (int i = 0; i < 4; ++i) {
    __builtin_amdgcn_global_load_lds((const void*)(Ac + ((size_t)(64 * i) * lda) * 2 + aoff), (lds_ptr_t)(sdst + i * 8192), 16, 0, 0);
    __builtin_amdgcn_global_load_lds((const void*)(Bc + ((size_t)(64 * i) * ldb) * 2 + boff), (lds_ptr_t)(sdst + 32768 + i * 8192), 16, 0, 0);
  }
}

DI void row_info(int r, int& b, int& pos, bool& isctx) {
  if (r < T_LAT) { b = r >> 11; pos = r & 2047; isctx = false; } else { const int q = r - T_LAT; b = q >> 8; pos = q & 255; isctx = true; }
}

constexpr int HALF_LDS = 65792;
DI void conv_tile(bool active, const float* __restrict__ src, int ld, int k0, int c0, bf16_t* __restrict__ dst, int dstld, int ilv  , int n0, char* smem) {
  float* s = (float*)smem;
  const int tid = g_tid() & 255;
  if (active) {
#pragma unroll
    for (int i = 0; i < 4; ++i) {
      const int k = (tid >> 4) + 16 * i, cc = (tid & 15) * 4;
      const f32x4 v = *(const f32x4*)(src + (size_t)(k0 + k) * ld + c0 + n0 + cc);
      s[k * 65 + cc] = v[0]; s[k * 65 + cc + 1] = v[1]; s[k * 65 + cc + 2] = v[2]; s[k * 65 + cc + 3] = v[3];
    }
  }
  __syncthreads();
  if (active) {
    const int n = tid >> 2, kq = (tid & 3) * 16;
    unsigned w[8];
#pragma unroll
    for (int j = 0; j < 8; ++j) w[j] = pk2(s[(kq + 2 * j) * 65 + n], s[(kq + 2 * j + 1) * 65 + n]);
    const int ng = n0 + n;
    size_t drow = ng;
    if (ilv) drow = (size_t)(ng >> 4) * 32 + (ng & 15) + (ilv == 2 ? 16 : 0);
    bf16_t* dp = dst + drow * dstld + k0 + kq;
    *(u32x4*)dp = (u32x4){w[0], w[1], w[2], w[3]};
    *(u32x4*)(dp + 8) = (u32x4){w[4], w[5], w[6], w[7]};
  }
  __syncthreads();
}
DI void fold_tile(bool active, const float* __restrict__ src  , int cbase, int k0, int np0  , int mode, const float* __restrict__ wgrp,
                  const float* __restrict__ pscale, bf16_t* __restrict__ dst  , char* smem) {
  float* sA = (float*)smem;
  float* sT = (float*)(smem + 33024);
  const int tid = g_tid() & 255;
  if (active) {
    for (int i = tid; i < 64 * 32; i += 256) {
      const int k = i >> 5, c4 = (i & 31) * 4;
      const f32x4 v = *(const f32x4*)(src + (size_t)(k0 + k) * N_IN + cbase + c4);
      sA[k * 129 + c4] = v[0]; sA[k * 129 + c4 + 1] = v[1]; sA[k * 129 + c4 + 2] = v[2]; sA[k * 129 + c4 + 3] = v[3];
    }
    for (int i = tid; i < 128 * 64; i += 256) {
      const int c = i >> 6, n = i & 63, np = np0 + n;
      float t;
      if (mode == 2) t = wgrp[c * 128 + np] * pscale[np];
      else { const float r = (float)((c * np) & 127) * (1.0f / 128.0f); t = (mode == 0) ? hw_cos_rev(r) : hw_sin_rev(r); }
      sT[c * 64 + n] = t;
    }
  }
  __syncthreads();
  if (active) {
    const int ty = tid >> 4, tx = tid & 15;
    float acc[4][4];
#pragma unroll
    for (int a = 0; a < 4; ++a)
#pragma unroll
      for (int b = 0; b < 4; ++b) acc[a][b] = 0.f;
    for (int c = 0; c < 128; ++c) {
      const f32x4 t4 = *(const f32x4*)(sT + c * 64 + tx * 4);
      float a4[4];
#pragma unroll
      for (int a = 0; a < 4; ++a) a4[a] = sA[(ty * 4 + a) * 129 + c];
#pragma unroll
      for (int a = 0; a < 4; ++a)
#pragma unroll
        for (int b = 0; b < 4; ++b) acc[a][b] += a4[a] * t4[b];
    }
#pragma unroll
    for (int b = 0; b < 4; ++b) {
      bf16_t* dp = dst + (size_t)(np0 + tx * 4 + b) * 1024 + k0 + ty * 4;
      *(u32x2*)dp = (u32x2){pk2(acc[0][b], acc[1][b]), pk2(acc[2][b], acc[3][b])};
    }
  }
  __syncthreads();
}

constexpr int CONV_TOTAL = 16 * 48 * 2 + 16 * 16 + 8 * 16 * 2 + 16 * 16 + 16 * 44 * 2 + 44 * 16 + 256 + 128;
DI void convert_iter(const Params& p, int l, int tb, char* smem0) {
  bf16_t* W = (bf16_t*)(p.ws + w_off(l));
  const float* win = p.w_in + (size_t)l * 1024 * N_IN;
  const int half = g_tid() >> 8;
  char* smem = smem0 + half * HALF_LDS;
  constexpr int C0 = 16 * 48, C1 = C0 + 16 * 48, C2 = C1 + 16 * 16, C3 = C2 + 8 * 16, C4 = C3 + 8 * 16, C5 = C4 + 16 * 16, C6 = C5 + 16 * 44, C7 = C6 + 16 * 44,
                C8 = C7 + 44 * 16, C9 = C8 + 256, C10 = C9 + 128;
  static_assert((C0 | C1 | C2 | C3 | C4 | C5 | C6 | C7 | C8 | C9 | C10) % 2 == 0, "segment boundaries must be even");
  const int total = C10;
  static_assert(C10 == CONV_TOTAL, "conversion tile count");
  {
    const bool active = (tb + half) < total;
    const int t = active ? tb + half : tb;
    int seg, r;
    if (t < C0) { seg = 0; r = t; } else if (t < C1) { seg = 1; r = t - C0; } else if (t < C2) { seg = 2; r = t - C1; } else if (t < C3) { seg = 3; r = t - C2; }
    else if (t < C4) { seg = 4; r = t - C3; } else if (t < C5) { seg = 5; r = t - C4; } else if (t < C6) { seg = 6; r = t - C5; } else if (t < C7) { seg = 7; r = t - C6; }
    else if (t < C8) { seg = 8; r = t - C7; } else if (t < C9) { seg = 9; r = t - C8; } else { seg = 10; r = t - C9; }
    if (seg <= 8) {
      const float* src; int ld, kt, nt, c0 = 0, dstld, ilv = 0; bf16_t* dst;
      if (seg <= 1) { kt = r & 15; nt = r >> 4; src = win; ld = N_IN; c0 = seg == 0 ? 0 : 4096; dst = W + WO_WIN + (seg == 0 ? 0 : (size_t)ROW_G * 1024); dstld = 1024; }
      else if (seg == 2) { kt = r & 15; nt = r >> 4; src = p.w_att_br + (size_t)l * 1024 * 1024; ld = 1024; dst = W + WO_WA; dstld = 1024; }
      else if (seg == 3) { kt = r & 7; nt = r >> 3; src = p.w_four_br + (size_t)l * 512 * 1024; ld = 1024; dst = W + WO_WF; dstld = 512; }
      else if (seg == 4) { kt = r & 7; nt = r >> 3; src = p.w_pool_br + (size_t)l * 512 * 1024; ld = 1024; dst = W + WO_WP; dstld = 512; }
      else if (seg == 5) { kt = r & 15; nt = r >> 4; src = p.w_out + (size_t)l * 1024 * 1024; ld = 1024; dst = W + WO_WO; dstld = 1024; }
      else if (seg == 6) { kt = r & 15; nt = r >> 4; src = p.w_ffn_gate + (size_t)l * 1024 * DFF; ld = DFF; dst = W + WO_WGU; dstld = 1024; ilv = 1; }
      else if (seg == 7) { kt = r & 15; nt = r >> 4; src = p.w_ffn_up + (size_t)l * 1024 * DFF; ld = DFF; dst = W + WO_WGU; dstld = 1024; ilv = 2; }
      else { kt = r % 44; nt = r / 44; src = p.w_ffn_down + (size_t)l * DFF * 1024; ld = 1024; dst = W + WO_WD; dstld = DFF; }
      conv_tile(active, src, ld, kt * 64, c0, dst, dstld, ilv, nt * 64, smem);
    } else if (seg == 9) {
      const int kt = r & 15, q = r >> 4; const int g = q & 3, hf = (q >> 2) & 1, mode = q >> 3;
      fold_tile(active, win, 3072 + g * 128, kt * 64, hf * 64, mode, nullptr, nullptr, W + WO_WIN + (size_t)((mode ? ROW_Z2 : ROW_Z1) + g * 128) * 1024, smem);
    } else {
      const int kt = r & 15, q = r >> 4; const int g = q & 3, hf = q >> 2;
      fold_tile(active, win, 3584 + g * 128, kt * 64, hf * 64, 2, p.w_pool_grp + ((size_t)l * 4 + g) * 128 * 128, p.pool_scale + (size_t)l * 512 + g * 128,
                W + WO_WIN + (size_t)(ROW_R + g * 128) * 1024, smem);
    }
  }
}

DI void convert_layer(const Params& p, int l, char* smem) {
  for (int tb = blockIdx.x * 2; tb < CONV_TOTAL; tb += gridDim.x * 2) convert_iter(p, l, tb, smem);
}

DI void convert_grab(const Params& p, int l, int which  , char* smem) {
  unsigned* ctr = (unsigned*)(p.ws + OFF_CTR) + l * 2 + which;
  volatile __attribute__((address_space(3))) unsigned* slot = (volatile __attribute__((address_space(3))) unsigned*)(lds_ptr_t)(smem + 3 * GSTAGE + 8);
  const int lo = which ? 2400 : 0, hi = which ? CONV_TOTAL : 2400;
  for (;;) {
    __syncthreads();
    if (__builtin_amdgcn_workitem_id_x() == 0) *slot = __hip_atomic_fetch_add(ctr, 2u, __ATOMIC_RELAXED, __HIP_MEMORY_SCOPE_AGENT);
    __syncthreads();
    const int tb = lo + (int)*slot;
    if (tb >= hi) break;
    convert_iter(p, l, tb, smem);
  }
  __syncthreads();
}

DI void phase0a(const Params& p, char* smem) {
  const int tid = g_tid();
  const int gtid = blockIdx.x * 512 + tid, gsz = gridDim.x * 512;
  {
    const int half = tid >> 8, t8 = tid & 255;
    float* ssil = (float*)smem;
    float* sred = (float*)(smem + 36864 + half * 9216);
    bool filled = false;
    float* modv = (float*)(p.ws + OFF_MODV);
    for (int tb = blockIdx.x * 2; tb < DEPTH * 96; tb += gridDim.x * 2) {
      if (!filled) {
        for (int i = tid; i < 9 * 1024; i += 512) { const float v = (i < 8192) ? p.c[i] : p.c_ctx[i - 8192]; ssil[i] = v * sigmoidf_(v); }
        filled = true;
        __syncthreads();
      }
      const int t = tb + half;
      const int l = t / 96, cgp = t % 96;
      const int col = cgp * 64 + (t8 & 63), kq = t8 >> 6;
      const float* wp = p.w_mod + ((size_t)l * 1024 + kq * 256) * 6144 + col;
      float a[9];
#pragma unroll
      for (int r = 0; r < 9; ++r) a[r] = 0.f;
#pragma unroll 4
      for (int k = 0; k < 256; ++k) {
        const float w = wp[(size_t)k * 6144];
#pragma unroll
        for (int r = 0; r < 9; ++r) a[r] += ssil[r * 1024 + kq * 256 + k] * w;
      }
#pragma unroll
      for (int r = 0; r < 9; ++r) sred[(kq * 9 + r) * 64 + (t8 & 63)] = a[r];
      __syncthreads();
      for (int i = t8; i < 9 * 64; i += 256) {
        const int r = i >> 6, cc = i & 63;
        const float v = sred[(0 * 9 + r) * 64 + cc] + sred[(1 * 9 + r) * 64 + cc] + sred[(2 * 9 + r) * 64 + cc] + sred[(3 * 9 + r) * 64 + cc];
        modv[((size_t)l * 9 + r) * 6144 + cgp * 64 + cc] = v + p.b_mod[(size_t)l * 6144 + cgp * 64 + cc];
      }
      __syncthreads();
    }
    __syncthreads();
  }
  convert_layer(p, 0, smem);
  {
    bf16_t* at = (bf16_t*)(p.ws + OFF_ATAB);
    for (int i = gtid; i < 2048 * 512; i += gsz) {
      const int k = i >> 9, c8 = (i & 511) * 8;
      unsigned w[4];
#pragma unroll
      for (int j = 0; j < 4; ++j) {
        float v[2];
#pragma unroll
        for (int e = 0; e < 2; ++e) {
          const int tp = c8 + 2 * j + e; const int tt = tp & 2047;
          const float r = (float)((k * tt) & 2047) * (1.0f / 2048.0f);
          v[e] = (tp < 2048) ? hw_cos_rev(r) : -hw_sin_rev(r);
        }
        w[j] = pk2(v[0], v[1]);
      }
      *(u32x4*)(at + (size_t)k * 4096 + c8) = (u32x4){w[0], w[1], w[2], w[3]};
    }
    bf16_t* atc = (bf16_t*)(p.ws + OFF_ATABC);
    for (int i = gtid; i < 256 * 64; i += gsz) {
      const int k = i >> 6, c8 = (i & 63) * 8;
      unsigned w[4];
#pragma unroll
      for (int j = 0; j < 4; ++j) {
        float v[2];
#pragma unroll
        for (int e = 0; e < 2; ++e) {
          const int tp = c8 + 2 * j + e; const int tt = tp & 255;
          const float r = (float)((k * tt) & 255) * (1.0f / 256.0f);
          v[e] = (tp < 256) ? hw_cos_rev(r) : -hw_sin_rev(r);
        }
        w[j] = pk2(v[0], v[1]);
      }
      *(u32x4*)(atc + (size_t)k * 512 + c8) = (u32x4){w[0], w[1], w[2], w[3]};
    }
  }
  {
    float* rc = (float*)(p.ws + OFF_ROPEC); float* rs = (float*)(p.ws + OFF_ROPES);
    for (int i = gtid; i < 2048 * 32; i += gsz) {
      const int t = i >> 5, a = i & 31, f = a & 15;
      const float pos = (float)((a < 16) ? (t >> 6) : (t & 63));
      const float inv = exp2f(-(float)f * (13.287712379549449f / 16.0f));
      float r = pos * inv * 0.15915494309189535f;
      r -= floorf(r);
      rc[i] = hw_cos_rev(r); rs[i] = hw_sin_rev(r);
    }
  }
  if (gtid < DEPTH) {
    const float* lq = p.lam_qk + (size_t)gtid * 256;
    float s1 = 0.f, s2 = 0.f;
    for (int i = 0; i < 64; ++i) { s1 += lq[i] * lq[64 + i]; s2 += lq[128 + i] * lq[192 + i]; }
    ((float*)(p.ws + OFF_LAMV))[gtid] = expf(s1) - expf(s2) + p.lam_init[gtid];
  }
}

DI void ln_pass(const Params& p, int mode, int nrows, const bf16_t* __restrict__ Yb, const float* __restrict__ lng, const float* __restrict__ lnb,
                        int modl_gate, int gate_chunk, int modl_next, int sh_chunk) {
  const int lane = g_tid() & 63, wid = g_tid() >> 6;
  float* X = (float*)(p.ws + OFF_X);
  bf16_t* U = (bf16_t*)(p.ws + OFF_U);
  const float* modv = (const float*)(p.ws + OFF_MODV);
  f32x4 xv[4], xn[4]; u32x2 yv[4], yn[4];
  const int r0 = blockIdx.x * 8 + wid, rstride = gridDim.x * 8;
  if (mode != 0 && r0 < nrows) {
#pragma unroll
    for (int i = 0; i < 4; ++i) { xv[i] = *(const f32x4*)(X + (size_t)r0 * 1024 + lane * 4 + 256 * i); yv[i] = *(const u32x2*)(Yb + (size_t)r0 * 1024 + lane * 4 + 256 * i); }
  }
  for (int r = r0; r < nrows; r += rstride) {
    int b, pos; bool isctx; row_info(r, b, pos, isctx);
    const int mr = isctx ? 8 : b;
    f32x4 v[4];
    if (mode == 0) {
      const float* src = isctx ? (p.ctx + (size_t)(r - T_LAT) * 1024) : (p.x + (size_t)r * 1024);
#pragma unroll
      for (int i = 0; i < 4; ++i) v[i] = *(const f32x4*)(src + lane * 4 + 256 * i);
#pragma unroll
      for (int i = 0; i < 4; ++i) *(f32x4*)(X + (size_t)r * 1024 + lane * 4 + 256 * i) = v[i];
    } else {
      const int rn = r + rstride;
      if (rn < nrows) {
#pragma unroll
        for (int i = 0; i < 4; ++i) { xn[i] = *(const f32x4*)(X + (size_t)rn * 1024 + lane * 4 + 256 * i); yn[i] = *(const u32x2*)(Yb + (size_t)rn * 1024 + lane * 4 + 256 * i); }
      }
      const float* gv = modv + ((size_t)modl_gate * 9 + mr) * 6144 + gate_chunk * 1024;
      float s = 0.f;
#pragma unroll
      for (int i = 0; i < 4; ++i) {
        const int col = lane * 4 + 256 * i;
        const f32x4 g = *(const f32x4*)(gv + col);
        v[i][0] = ALPHA * xv[i][0] + g[0] * bf_lo(yv[i][0]); v[i][1] = ALPHA * xv[i][1] + g[1] * bf_hi(yv[i][0]);
        v[i][2] = ALPHA * xv[i][2] + g[2] * bf_lo(yv[i][1]); v[i][3] = ALPHA * xv[i][3] + g[3] * bf_hi(yv[i][1]);
        s += (v[i][0] + v[i][1]) + (v[i][2] + v[i][3]);
      }
#pragma unroll
      for (int i = 0; i < 4; ++i) { xv[i] = xn[i]; yv[i] = yn[i]; }
      const float mu = wave_sum(s) * (1.0f / 1024.0f);
      float q = 0.f;
#pragma unroll
      for (int i = 0; i < 4; ++i) { const f32x4 d = v[i] - mu; q += (d[0] * d[0] + d[1] * d[1]) + (d[2] * d[2] + d[3] * d[3]); }
      const float rstd = rsqrtf(wave_sum(q) * (1.0f / 1024.0f) + LN_EPS);
#pragma unroll
      for (int i = 0; i < 4; ++i) {
        const int col = lane * 4 + 256 * i;
        const f32x4 g = *(const f32x4*)(lng + col), bb = *(const f32x4*)(lnb + col);
        v[i] = (v[i] - mu) * rstd * g + bb;
        if (mode == 2) *(f32x4*)(p.out + (size_t)r * 1024 + col) = v[i];
        else *(f32x4*)(X + (size_t)r * 1024 + col) = v[i];
      }
    }
    if (mode != 2) {
      float s = 0.f;
#pragma unroll
      for (int i = 0; i < 4; ++i) s += (v[i][0] + v[i][1]) + (v[i][2] + v[i][3]);
      const float mu = wave_sum(s) * (1.0f / 1024.0f);
      float q = 0.f;
#pragma unroll
      for (int i = 0; i < 4; ++i) { const f32x4 d = v[i] - mu; q += (d[0] * d[0] + d[1] * d[1]) + (d[2] * d[2] + d[3] * d[3]); }
      const float rstd = rsqrtf(wave_sum(q) * (1.0f / 1024.0f) + LN_EPS);
      const float* shv = modv + ((size_t)modl_next * 9 + mr) * 6144 + sh_chunk * 1024;
      const float* scv = shv + 1024;
#pragma unroll
      for (int i = 0; i < 4; ++i) {
        const int col = lane * 4 + 256 * i;
        const f32x4 sh = *(const f32x4*)(shv + col), sc = *(const f32x4*)(scv + col);
        const f32x4 u = (v[i] - mu) * rstd * (sc + 1.0f) + sh;
        *(u32x2*)(U + (size_t)r * 1024 + col) = (u32x2){pk2(u[0], u[1]), pk2(u[2], u[3])};
      }
    }
  }
}

DI bool tile_map(int v, int nmt, int nnt, int& mt, int& nt) {
  const int c = v >> 8, w = v & 255, xcd = w & 7, local = w >> 3;
  const int spr = nnt >> 2, nsup = (nmt >> 3) * spr, sup = c * 8 + xcd;
  if (sup >= nsup) return false;
  mt = (sup / spr) * 8 + (local & 7); nt = (sup % spr) * 4 + (local >> 3);
  return true;
}
DI int tile_vmax(int nmt, int nnt) { const int nsup = (nmt >> 3) * (nnt >> 2); return ((nsup + 7) >> 3) << 8; }

DI void phase_inproj(const Params& p, int l, char* smem) {
  const bool last = (l == DEPTH - 1);
  const bf16_t* W = (const bf16_t*)(p.ws + w_off(l)) + WO_WIN;
  const bf16_t* U = (const bf16_t*)(p.ws + OFF_U);
  bf16_t* KB = (bf16_t*)(p.ws + OFF_KB); bf16_t* VT = (bf16_t*)(p.ws + OFF_VT); bf16_t* QB = (bf16_t*)(p.ws + OFF_QB); bf16_t* CQ = (bf16_t*)(p.ws + OFF_CQ);
  bf16_t* ZT = (bf16_t*)(p.ws + OFF_ZT); bf16_t* ZTC = (bf16_t*)(p.ws + OFF_ZTC); bf16_t* R = (bf16_t*)(p.ws + OFF_R);
  const float* ropec = (const float*)(p.ws + OFF_ROPEC); const float* ropes = (const float*)(p.ws + OFF_ROPES);
  const int nsupA = last ? 72 : 81, nsup = last ? 76 : 81;
  const int vmax = ((nsup + 15) >> 4) << 8;
  auto map_tile = [&](int v, int& mt, int& nt) -> bool {
    if (v >= vmax) return false;
    const int c = v >> 8, w = v & 255, local = w >> 3, sup = (c * 8 + (w & 7)) * 2 + (local >> 4);
    if (sup >= nsup) return false;
    if (sup < nsupA) { mt = (sup / 9) * 8 + (local & 7); nt = (sup % 9) * 2 + ((local >> 3) & 1); }
    else { mt = 64 + (local & 7); nt = (sup - nsupA) * 2 + ((local >> 3) & 1); }
    return true;
  };
  int v = blockIdx.x, mt = 0, nt = 0;
  bool cur = map_tile(v, mt, nt);
  if (cur) gemm_prefetch_big(U + (size_t)mt * 256 * 1024, 1024, W + (size_t)nt * 256 * 1024, 1024, smem);
  while (cur) {
    const int m0 = mt * 256;
    int b, pos0; bool isctx; row_info(m0, b, pos0, isctx);
    f32x4 acc[8][4];
#pragma unroll
    for (int i = 0; i < 8; ++i)
#pragma unroll
      for (int j = 0; j < 4; ++j) acc[i][j] = (f32x4){0.f, 0.f, 0.f, 0.f};
    const bool swap = !((nt >= 4 && nt < 8) || (nt >= 12 && nt < 16));
    if (swap) gemm_kloop_big<true>(U + (size_t)m0 * 1024, 1024, W + (size_t)nt * 256 * 1024, 1024, 1024, acc, smem, true);
    else gemm_kloop_big<false>(U + (size_t)m0 * 1024, 1024, W + (size_t)nt * 256 * 1024, 1024, 1024, acc, smem, true);
    int v2 = v + gridDim.x, mt2 = 0, nt2 = 0;
    const bool nxt = map_tile(v2, mt2, nt2);
    if (nxt) gemm_prefetch_big(U + (size_t)mt2 * 256 * 1024, 1024, W + (size_t)nt2 * 256 * 1024, 1024, smem);
    const int tid = g_tid(), lane = tid & 63, wid = __builtin_amdgcn_readfirstlane(tid >> 6), wm = wid >> 2, wn = wid & 3;
    const int fq = lane >> 4, fr = lane & 15;
    const int ncol0 = nt * 256 + wn * 64;
    const int prow0 = pos0 + wm * 128;
    if (ncol0 < 1024 || (ncol0 >= 2048 && ncol0 < 3072)) {
      const bool isq = ncol0 >= 2048; const int h = (ncol0 >> 7) & 7, map = (ncol0 >> 6) & 1;
#pragma unroll
      for (int mi = 0; mi < 8; ++mi) {
        const int pos = prow0 + mi * 16 + fr;
        f32x4 o[4];
        if (!isctx) {
#pragma unroll
          for (int pr = 0; pr < 2; ++pr) {
            const f32x4 cs = *(const f32x4*)(ropec + pos * 32 + pr * 16 + fq * 4);
            const f32x4 sn = *(const f32x4*)(ropes + pos * 32 + pr * 16 + fq * 4);
            const f32x4 x0 = acc[mi][2 * pr], x1 = acc[mi][2 * pr + 1];
            o[2 * pr] = x0 * cs - x1 * sn;
            o[2 * pr + 1] = x1 * cs + x0 * sn;
          }
        } else {
#pragma unroll
          for (int ni = 0; ni < 4; ++ni) o[ni] = acc[mi][ni];
        }
        bf16_t* dst;
        if (!isq) dst = KB + ((size_t)((b * 8 + h) * 2 + map) * NKEY + (isctx ? SEQ + pos : pos)) * 64;
        else if (!isctx) dst = QB + ((size_t)((b * 8 + h) * 2 + map) * SEQ + pos) * 64;
        else dst = CQ + ((size_t)((b * 8 + h) * 2 + map) * LC + pos) * 64;
        const float sc = isq ? QSCALE : 1.0f;
#pragma unroll
        for (int ni = 0; ni < 4; ++ni) {
          const f32x4 vv = o[ni] * sc;
          *(u32x2*)(dst + ni * 16 + fq * 4) = (u32x2){pk2(vv[0], vv[1]), pk2(vv[2], vv[3])};
        }
      }
    } else if (ncol0 < 2048) {
      const int h = (ncol0 - 1024) >> 7, vc0 = ncol0 & 127;
#pragma unroll
      for (int mi = 0; mi < 8; ++mi) {
        const int key = (isctx ? SEQ : 0) + prow0 + mi * 16 + fq * 4;
        const int k15 = key & 15;
        const int pkey = (key & ~15) | (k15 & 3) | ((k15 & 4) << 1) | ((k15 & 8) >> 1);
#pragma unroll
        for (int ni = 0; ni < 4; ++ni) {
          const int vcol = vc0 + ni * 16 + fr;
          const f32x4 vv = acc[mi][ni];
          *(u32x2*)(VT + ((size_t)(b * 8 + h) * 128 + vcol) * NKEY + pkey) = (u32x2){pk2(vv[0], vv[1]), pk2(vv[2], vv[3])};
        }
      }
    } else if (ncol0 < 4096) {
#pragma unroll
      for (int mi = 0; mi < 8; ++mi) {
        const int pos = prow0 + mi * 16 + fq * 4;
#pragma unroll
        for (int ni = 0; ni < 4; ++ni) {
          const int zc = ncol0 - 3072 + ni * 16 + fr;
          const int np = zc & 511, second = zc >> 9;
          const f32x4 vv = acc[mi][ni];
          bf16_t* dst = isctx ? (ZTC + ((size_t)b * 512 + np) * 512 + second * 256 + pos) : (ZT + ((size_t)b * 512 + np) * 4096 + second * 2048 + pos);
          *(u32x2*)dst = (u32x2){pk2(vv[0], vv[1]), pk2(vv[2], vv[3])};
        }
      }
    } else {
#pragma unroll
      for (int mi = 0; mi < 8; ++mi) {
        const int row = m0 + wm * 128 + mi * 16 + fr;
#pragma unroll
        for (int ni = 0; ni < 4; ++ni) {
          const int col = ncol0 - 4096 + ni * 16 + fq * 4;
          const f32x4 vv = acc[mi][ni];
          *(u32x2*)(R + (size_t)row * 512 + col) = (u32x2){pk2(vv[0], vv[1]), pk2(vv[2], vv[3])};
        }
      }
    }
    v = v2; mt = mt2; nt = nt2; cur = nxt;
  }
}

DI void attn_unit(const bf16_t* __restrict__ Qb  , int nq, int q0, const bf16_t* __restrict__ Kb  ,
                  const bf16_t* __restrict__ VTb  , int key0, int ntiles  , bf16_t* __restrict__ outp  ,
                  const float* __restrict__ subg, float lam, float nscale, char* smem) {
  const int tid = g_tid(), lane = tid & 63, wid = __builtin_amdgcn_readfirstlane(tid >> 6), wq = wid & 3, map = wid >> 2;
  const int l31 = lane & 31, kh = lane >> 5;
  bf16x8 qf[4];
  {
    const bf16_t* qp = Qb + ((size_t)map * nq + q0 + wq * 32 + l31) * 64 + kh * 8;
#pragma unroll
    for (int s = 0; s < 4; ++s) qf[s] = *(const bf16x8*)(qp + s * 16);
  }
  const int srow = tid >> 3, sc = (tid & 7) ^ ((tid >> 4) & 7);
  const unsigned koff = (unsigned)((key0 + srow) * 64 + sc * 8) * 2u;
  const unsigned voff = (unsigned)(srow * NKEY + key0 + sc * 8) * 2u;
  const char* Kc = (const char*)Kb; const char* Vc = (const char*)VTb;
  char* sdst = smem + tid * 16;
#define A_ISSUE(T) do { char* d_ = sdst + ((T) & 3) * 32768; \
    __builtin_amdgcn_global_load_lds((const void*)(Kc + (size_t)(T) * 8192 + koff), (lds_ptr_t)(d_), 16, 0, 0); \
    __builtin_amdgcn_global_load_lds((const void*)(Kc + (size_t)NKEY * 128 + (size_t)(T) * 8192 + koff), (lds_ptr_t)(d_ + 8192), 16, 0, 0); \
    __builtin_amdgcn_global_load_lds((const void*)(Vc + (size_t)(T) * 128 + voff), (lds_ptr_t)(d_ + 16384), 16, 0, 0); \
    __builtin_amdgcn_global_load_lds((const void*)(Vc + (size_t)64 * NKEY * 2 + (size_t)(T) * 128 + voff), (lds_ptr_t)(d_ + 24576), 16, 0, 0); } while (0)
  f32x16 O[4];
#pragma unroll
  for (int vb = 0; vb < 4; ++vb)
#pragma unroll
    for (int i = 0; i < 16; ++i) O[vb][i] = 0.f;
  float m = 0.f, lsum = 0.f;
  const int sw = (lane >> 1) & 7;
  const int kfo = l31 * 128, cho = kh;
#define A_QK(SX, T) do { const char* st_ = smem + ((T) & 3) * 32768 + map * 8192 + kfo; \
    bf16x8 kf_[8]; \
    _Pragma("unroll") for (int s = 0; s < 4; ++s) _Pragma("unroll") for (int kb = 0; kb < 2; ++kb) \
        kf_[s * 2 + kb] = *(const bf16x8*)(st_ + kb * 4096 + (((2 * s + cho) ^ sw) << 4)); \
    _Pragma("unroll") for (int kb = 0; kb < 2; ++kb) _Pragma("unroll") for (int i = 0; i < 16; ++i) SX[kb][i] = -m; \
    __builtin_amdgcn_sched_barrier(0); \
    _Pragma("unroll") for (int s = 0; s < 4; ++s) _Pragma("unroll") for (int kb = 0; kb < 2; ++kb) \
        SX[kb] = MFMA32(kf_[s * 2 + kb], qf[s], SX[kb]); \
    __builtin_amdgcn_sched_barrier(0); } while (0)
  bf16x8 pf[4];
  auto pv = [&](int T) {
    const char* sv = smem + (T & 3) * 32768 + 16384 + kfo;
    __builtin_amdgcn_sched_barrier(0);
    bf16x8 va[4], vb_[4];
#pragma unroll
    for (int vb = 0; vb < 4; ++vb) va[vb] = *(const bf16x8*)(sv + vb * 4096 + (((0 + cho) ^ sw) << 4));
#pragma unroll
    for (int vb = 0; vb < 4; ++vb) vb_[vb] = *(const bf16x8*)(sv + vb * 4096 + (((2 + cho) ^ sw) << 4));
    __builtin_amdgcn_sched_barrier(0);
#pragma unroll
    for (int vb = 0; vb < 4; ++vb) O[vb] = MFMA32(va[vb], pf[0], O[vb]);
    __builtin_amdgcn_sched_barrier(0);
#pragma unroll
    for (int vb = 0; vb < 4; ++vb) va[vb] = *(const bf16x8*)(sv + vb * 4096 + (((4 + cho) ^ sw) << 4));
    __builtin_amdgcn_sched_barrier(0);
#pragma unroll
    for (int vb = 0; vb < 4; ++vb) O[vb] = MFMA32(vb_[vb], pf[1], O[vb]);
    __builtin_amdgcn_sched_barrier(0);
#pragma unroll
    for (int vb = 0; vb < 4; ++vb) vb_[vb] = *(const bf16x8*)(sv + vb * 4096 + (((6 + cho) ^ sw) << 4));
    __builtin_amdgcn_sched_barrier(0);
#pragma unroll
    for (int vb = 0; vb < 4; ++vb) O[vb] = MFMA32(va[vb], pf[2], O[vb]);
    __builtin_amdgcn_sched_barrier(0);
#pragma unroll
    for (int vb = 0; vb < 4; ++vb) O[vb] = MFMA32(vb_[vb], pf[3], O[vb]);
    __builtin_amdgcn_sched_barrier(0);
  };
  auto softmax = [&](f32x16 (&SC)[2], f32x16 (&SN)[2], bool has_next, bool first) {
    float mx[16];
#pragma unroll
    for (int i = 0; i < 16; ++i) mx[i] = fmaxf(SC[0][i], SC[1][i]);
#pragma unroll
    for (int w = 8; w >= 1; w >>= 1)
#pragma unroll
      for (int i = 0; i < w; ++i) mx[i] = fmaxf(mx[i], mx[i + w]);
    float tmax = xor32_max(mx[0]);
    if (first || __any(tmax > 8.0f)) {
      const float delta = first ? tmax : fmaxf(tmax, 0.f);
      const float alpha = first ? 1.0f : __builtin_amdgcn_exp2f(-delta);
      m += delta; lsum *= alpha;
#pragma unroll
      for (int vb = 0; vb < 4; ++vb) O[vb] = O[vb] * alpha;
#pragma unroll
      for (int kb = 0; kb < 2; ++kb)
#pragma unroll
        for (int i = 0; i < 16; ++i) SC[kb][i] -= delta;
      if (has_next) {
#pragma unroll
        for (int kb = 0; kb < 2; ++kb)
#pragma unroll
          for (int i = 0; i < 16; ++i) SN[kb][i] -= delta;
      }
    }
    float sm[16];
#pragma unroll
    for (int i = 0; i < 16; ++i) { const float e0 = __builtin_amdgcn_exp2f(SC[0][i]), e1 = __builtin_amdgcn_exp2f(SC[1][i]); SC[0][i] = e0; SC[1][i] = e1; sm[i] = e0 + e1; }
#pragma unroll
    for (int w = 8; w >= 1; w >>= 1)
#pragma unroll
      for (int i = 0; i < w; ++i) sm[i] += sm[i + w];
    lsum += sm[0];
#pragma unroll
    for (int g = 0; g < 4; ++g) {
      const int kb = g >> 1, s2 = g & 1;
      u32x4 w;
      w[0] = pk2(SC[kb][8 * s2 + 0], SC[kb][8 * s2 + 1]); w[1] = pk2(SC[kb][8 * s2 + 2], SC[kb][8 * s2 + 3]);
      w[2] = pk2(SC[kb][8 * s2 + 4], SC[kb][8 * s2 + 5]); w[3] = pk2(SC[kb][8 * s2 + 6], SC[kb][8 * s2 + 7]);
      pf[g] = __builtin_bit_cast(bf16x8, w);
    }
  };
  f32x16 Sa[2], Sb[2];
  if (wid >= 4) __builtin_amdgcn_s_setprio(1);
  WAIT_VM(0);
  A_ISSUE(0); A_ISSUE(1); A_ISSUE(2);
  WAIT_VM(8);
  __builtin_amdgcn_s_barrier();
  asm volatile("" ::: "memory");
  A_QK(Sa, 0);
  for (int t = 0; t < ntiles; t += 2) {
    if (t + 2 < ntiles) WAIT_VM(4); else WAIT_VM(0);
    __builtin_amdgcn_s_barrier();
    asm volatile("" ::: "memory");
    if (t + 3 < ntiles) A_ISSUE(t + 3);
    A_QK(Sb, t + 1);
    softmax(Sa, Sb, true, t == 0);
    pv(t);
    const bool nx = (t + 2 < ntiles);
    if (nx) { if (t + 3 < ntiles) WAIT_VM(4); else WAIT_VM(0); }
    __builtin_amdgcn_s_barrier();
    asm volatile("" ::: "memory");
    if (t + 4 < ntiles) A_ISSUE(t + 4);
    if (nx) A_QK(Sa, t + 2);
    softmax(Sb, Sa, nx, false);
    pv(t + 1);
  }
  __builtin_amdgcn_s_setprio(0);
  asm volatile("s_waitcnt lgkmcnt(0)" ::: "memory");
  __builtin_amdgcn_s_barrier();
  asm volatile("" ::: "memory");
#undef A_ISSUE
#undef A_QK
  const float ltot = xor32_sum(lsum);
  const float inv = 1.0f / ltot;
  float* ex = (float*)smem;
  if (map == 1) {
#pragma unroll
    for (int vb = 0; vb < 4; ++vb)
#pragma unroll
      for (int g4 = 0; g4 < 4; ++g4) {
        f32x4 v = {O[vb][4 * g4] * inv, O[vb][4 * g4 + 1] * inv, O[vb][4 * g4 + 2] * inv, O[vb][4 * g4 + 3] * inv};
        *(f32x4*)(ex + (wq * 32 + l31) * 132 + vb * 32 + 8 * g4 + 4 * kh) = v;
      }
  }
  __syncthreads();
  if (map == 0) {
    float ss = 0.f;
#pragma unroll
    for (int vb = 0; vb < 4; ++vb)
#pragma unroll
      for (int g4 = 0; g4 < 4; ++g4) {
        const f32x4 o2 = *(const f32x4*)(ex + (wq * 32 + l31) * 132 + vb * 32 + 8 * g4 + 4 * kh);
#pragma unroll
        for (int j = 0; j < 4; ++j) { const float o = O[vb][4 * g4 + j] * inv - lam * o2[j]; O[vb][4 * g4 + j] = o; ss += o * o; }
      }
    ss = xor32_sum(ss);
    const float rs = rsqrtf(ss * (1.0f / 128.0f) + LN_EPS) * nscale;
    bf16_t* op = outp + (size_t)(wq * 32 + l31) * 1024;
#pragma unroll
    for (int vb = 0; vb < 4; ++vb)
#pragma unroll
      for (int g4 = 0; g4 < 4; ++g4) {
        const int vc = vb * 32 + 8 * g4 + 4 * kh;
        const f32x4 g = *(const f32x4*)(subg + vc);
        *(u32x2*)(op + vc) = (u32x2){pk2(O[vb][4 * g4] * rs * g[0], O[vb][4 * g4 + 1] * rs * g[1]), pk2(O[vb][4 * g4 + 2] * rs * g[2], O[vb][4 * g4 + 3] * rs * g[3])};
      }
  }
  __syncthreads();
}

template <int MI>
DI void store_tile_bf16(const f32x4 (&acc)[MI][4], bf16_t* __restrict__ C, int ldc, float scale) {
  const int tid = g_tid(), lane = tid & 63, wid = __builtin_amdgcn_readfirstlane(tid >> 6), wm = wid >> 1, wn = wid & 1, fq = lane >> 4, fr = lane & 15;
#pragma unroll
  for (int mi = 0; mi < MI; ++mi)
#pragma unroll
    for (int ni = 0; ni < 4; ++ni) {
      const f32x4 v = acc[mi][ni] * scale;
      *(u32x2*)(C + (size_t)(wm * 16 * MI + mi * 16 + fr) * ldc + wn * 64 + ni * 16 + fq * 4) = (u32x2){pk2(v[0], v[1]), pk2(v[2], v[3])};
    }
}

template <int W>
DI void pool_rows(const bf16_t* __restrict__ R, bf16_t* __restrict__ PM, int m0, int g, int rhalf, int lane) {
  constexpr int LO = W / 2;
  const int col = g * 128 + (lane & 15) * 8;
#pragma unroll 2
  for (int ps = 0; ps < 8; ++ps) {
    const int row = m0 + ps * 8 + rhalf * 4 + (lane >> 4);
    int b, pos; bool isctx; row_info(row, b, pos, isctx);
    const int L = isctx ? LC : SEQ;
    const int rbase = row - pos;
    float s[8];
#pragma unroll
    for (int j = 0; j < 8; ++j) s[j] = 0.f;
    int cnt = 0;
    u32x4 self = {0u, 0u, 0u, 0u};
#pragma unroll
    for (int k = 0; k < W; ++k) {
      const int q = pos - LO + k;
      const bool ok = (q >= 0) && (q < L);
      const int qc = ok ? q : pos;
      const u32x4 v = *(const u32x4*)(R + (size_t)(rbase + qc) * 512 + col);
      const float f = ok ? 1.0f : 0.0f;
      cnt += ok ? 1 : 0;
#pragma unroll
      for (int j = 0; j < 4; ++j) { s[2 * j] += f * bf_lo(v[j]); s[2 * j + 1] += f * bf_hi(v[j]); }
      if (k == LO) self = v;
    }
    const float ic = 1.0f / (float)cnt;
    u32x4 o;
#pragma unroll
    for (int j = 0; j < 4; ++j) o[j] = pk2(s[2 * j] * ic - bf_lo(self[j]), s[2 * j + 1] * ic - bf_hi(self[j]));
    *(u32x4*)(PM + (size_t)row * 512 + col) = o;
  }
}
DI void pool_task(const bf16_t* __restrict__ R, bf16_t* __restrict__ PM, int m0) {
  const int tid = g_tid(), lane = tid & 63, wid = __builtin_amdgcn_readfirstlane(tid >> 6), g = wid & 3, rhalf = wid >> 2;
  if (g == 0) pool_rows<2>(R, PM, m0, 0, rhalf, lane);
  else if (g == 1) pool_rows<4>(R, PM, m0, 1, rhalf, lane);
  else if (g == 2) pool_rows<8>(R, PM, m0, 2, rhalf, lane);
  else pool_rows<16>(R, PM, m0, 3, rhalf, lane);
}

DI void phase_mix(const Params& p, int l, char* smem) {
  const bool last = (l == DEPTH - 1);
  const bf16_t* KB = (const bf16_t*)(p.ws + OFF_KB); const bf16_t* VT = (const bf16_t*)(p.ws + OFF_VT);
  const bf16_t* QB = (const bf16_t*)(p.ws + OFF_QB); const bf16_t* CQ = (const bf16_t*)(p.ws + OFF_CQ);
  const bf16_t* ZT = (const bf16_t*)(p.ws + OFF_ZT); const bf16_t* ZTC = (const bf16_t*)(p.ws + OFF_ZTC); const bf16_t* R = (const bf16_t*)(p.ws + OFF_R);
  bf16_t* ATT = (bf16_t*)(p.ws + OFF_ATT); bf16_t* FM = (bf16_t*)(p.ws + OFF_FM); bf16_t* PM = (bf16_t*)(p.ws + OFF_PM);
  const bf16_t* ATAB = (const bf16_t*)(p.ws + OFF_ATAB); const bf16_t* ATABC = (const bf16_t*)(p.ws + OFF_ATABC);
  const float lam = ((const float*)(p.ws + OFF_LAMV))[l];
  const float nscale = 1.0f - p.lam_init[l];
  const float* subg = p.subln_g + (size_t)l * 128;
  for (int r = blockIdx.x; r < 1024; r += gridDim.x) {
    const int c = r >> 8, w = r & 255, xcd = w & 7, local = w >> 3;
    const int bh = c * 16 + xcd * 2 + (local >> 4), qb = local & 15;
    const int b = bh >> 3, h = bh & 7;
    attn_unit(QB + (size_t)bh * 2 * SEQ * 64, SEQ, qb * 128, KB + (size_t)bh * 2 * NKEY * 64, VT + (size_t)bh * 128 * NKEY, 0, NKEY / 64,
              ATT + ((size_t)b * SEQ + qb * 128) * 1024 + h * 128, subg, lam, nscale, smem);
  }
  const int G = gridDim.x, nlo = G >> 1, nhi = G - nlo;
  if ((int)blockIdx.x < nlo) {
    for (int d = blockIdx.x; d < 128; d += nlo) {
      const int b = d & 7, local = d >> 3, mt = local & 3, nt = local >> 2;
      const bf16_t* Ab = ATAB + (size_t)mt * 256 * 4096; const bf16_t* Bb = ZT + ((size_t)b * 512 + nt * 128) * 4096;
      f32x4 accP[4][4], accQ[4][4]; zero_acc(accP); zero_acc(accQ);
      gemm_kloop_pp<true>(Ab, 4096, Bb, 4096, 2048, accP, smem);
      gemm_kloop_pp<true>(Ab + 2048, 4096, Bb + 2048, 4096, 2048, accQ, smem);
      const int tid = g_tid(), lane = tid & 63, wid = __builtin_amdgcn_readfirstlane(tid >> 6), wm = wid >> 1, wn = wid & 1, fq = lane >> 4, fr = lane & 15;
#pragma unroll
      for (int mi = 0; mi < 4; ++mi) {
        const int k = mt * 256 + wm * 64 + mi * 16 + fr;
#pragma unroll
        for (int ni = 0; ni < 4; ++ni) {
          const int col = nt * 128 + wn * 64 + ni * 16 + fq * 4;
          const f32x4 y1 = (accP[mi][ni] + accQ[mi][ni]) * (1.0f / 512.0f), y2 = (accP[mi][ni] - accQ[mi][ni]) * (1.0f / 512.0f);
          *(u32x2*)(FM + ((size_t)b * SEQ + k) * 512 + col) = (u32x2){pk2(y1[0], y1[1]), pk2(y1[2], y1[3])};
          if (k > 0) *(u32x2*)(FM + ((size_t)b * SEQ + (SEQ - k)) * 512 + col) = (u32x2){pk2(y2[0], y2[1]), pk2(y2[2], y2[3])};
        }
      }
    }
  } else {
    const int n_cattn = last ? 0 : 128, n_cdft = last ? 0 : 32, n_pool = last ? 256 : 288, n_mid = 64;
    const int n_small = n_cattn + n_cdft + n_pool + n_mid;
    for (int t = (int)blockIdx.x - nlo; t < n_small; t += nhi) {
      int r = t;
      if (r < n_cattn) {
        const int bh = r >> 1, qb = r & 1, b = bh >> 3, h = bh & 7;
        attn_unit(CQ + (size_t)bh * 2 * LC * 64, LC, qb * 128, KB + (size_t)bh * 2 * NKEY * 64, VT + (size_t)bh * 128 * NKEY, SEQ, LC / 64,
                  ATT + ((size_t)T_LAT + b * LC + qb * 128) * 1024 + h * 128, subg, lam, nscale, smem);
        continue;
      }
      r -= n_cattn;
      if (r < n_cdft) {
        const int b = r >> 2, nt = r & 3;
        f32x4 acc[4][4]; zero_acc(acc);
        gemm_kloop_pp<true>(ATABC, 512, ZTC + ((size_t)b * 512 + nt * 128) * 512, 512, 512, acc, smem);
        store_tile_bf16<4>(acc, FM + ((size_t)T_LAT + b * LC) * 512 + nt * 128, 512, 0.005524271728019903f  );
        continue;
      }
      r -= n_cdft;
      if (r < n_pool) { pool_task(R, PM, r * 64); continue; }
      r -= n_pool;
      {
        const int b = r >> 3, sub = r & 7;
        const int tid = g_tid(), lane = tid & 63, wid = __builtin_amdgcn_readfirstlane(tid >> 6);
#pragma unroll 2
        for (int i = 0; i < 8; ++i) {
          const int n = sub * 64 + wid * 8 + i;
          const bf16_t* zr = ZT + ((size_t)b * 512 + n) * 4096;
          float sacc = 0.f;
#pragma unroll
          for (int j = 0; j < 4; ++j) {
            const u32x4 v = *(const u32x4*)(zr + lane * 8 + 512 * j);
#pragma unroll
            for (int e = 0; e < 4; ++e) sacc += bf_lo(v[e]) - bf_hi(v[e]);
          }
          const float tot = wave_sum(sacc) * (1.0f / 512.0f);
          if (lane == 0) FM[((size_t)b * SEQ + 1024) * 512 + n] = (bf16_t)(pk2(tot, 0.f) & 0xffffu);
        }
      }
    }
  }
}

template <int MI>
DI void phase_branch(const Params& p, int l, char* smem) {
  const bool last = (l == DEPTH - 1);
  const bf16_t* W = (const bf16_t*)(p.ws + w_off(l));
  const bf16_t* U = (const bf16_t*)(p.ws + OFF_U);
  const bf16_t* ATT = (const bf16_t*)(p.ws + OFF_ATT); const bf16_t* FM = (const bf16_t*)(p.ws + OFF_FM); const bf16_t* PM = (const bf16_t*)(p.ws + OFF_PM);
  bf16_t* MOUT = (bf16_t*)(p.ws + OFF_MOUT);
  const int nmt = (last ? T_LAT : T_ALL) / (64 * MI), vmax = tile_vmax(nmt, 8);
  for (int v = blockIdx.x; v < vmax; v += gridDim.x) {
    int mt, nt;
    if (!tile_map(v, nmt, 8, mt, nt)) continue;
    const int m0 = mt * 64 * MI, n0 = nt * 128;
    u32x2 tot[MI][4], gpk[MI][4];
#pragma unroll
    for (int mi = 0; mi < MI; ++mi)
#pragma unroll
      for (int ni = 0; ni < 4; ++ni) tot[mi][ni] = (u32x2){0u, 0u};
#pragma unroll 1
    for (int br = 0; br < 3; ++br) {
      __builtin_amdgcn_sched_barrier(0);
      f32x4 acc[MI][4]; zero_acc_t<MI>(acc);
      const bool pre = !last && br == 0 && (m0 + 64 * MI <= G8_ROWS);
      if (!pre) {
        gemm_kloop_pp<true, MI>(U + (size_t)m0 * 1024, 1024, W + WO_WIN + (size_t)(ROW_G + br * 1024 + n0) * 1024, 1024, 1024, acc, smem);
        __builtin_amdgcn_sched_barrier(0);
#pragma unroll
        for (int mi = 0; mi < MI; ++mi)
#pragma unroll
          for (int ni = 0; ni < 4; ++ni) {
            const f32x4 a = acc[mi][ni];
            gpk[mi][ni] = (u32x2){pk2(sigmoidf_(a[0]), sigmoidf_(a[1])), pk2(sigmoidf_(a[2]), sigmoidf_(a[3]))};
          }
      } else {
        const unsigned char* G8 = (const unsigned char*)(p.ws + OFF_G8);
        const int tid_ = g_tid(), lane_ = tid_ & 63, wid_ = __builtin_amdgcn_readfirstlane(tid_ >> 6), wm_ = wid_ >> 1, wn_ = wid_ & 1, fq_ = lane_ >> 4, fr_ = lane_ & 15;
#pragma unroll
        for (int mi = 0; mi < MI; ++mi)
#pragma unroll
          for (int ni = 0; ni < 4; ++ni) {
            const unsigned g = *(const unsigned*)(G8 + (size_t)(m0 + wm_ * 16 * MI + mi * 16 + fr_) * 1024 + n0 + wn_ * 64 + ni * 16 + fq_ * 4);
            gpk[mi][ni] = (u32x2){pk2((float)(g & 255u) * (1.0f / 255.0f), (float)((g >> 8) & 255u) * (1.0f / 255.0f)),
                                  pk2((float)((g >> 16) & 255u) * (1.0f / 255.0f), (float)(g >> 24) * (1.0f / 255.0f))};
          }
      }
      __builtin_amdgcn_sched_barrier(0);
      zero_acc_t<MI>(acc);
      const int K2 = (br == 0) ? 1024 : 512;
      const bf16_t* A2 = (br == 0) ? (ATT + (size_t)m0 * 1024) : ((br == 1 ? FM : PM) + (size_t)m0 * 512);
      const bf16_t* B2 = (br == 0) ? (W + WO_WA + (size_t)n0 * 1024) : (W + (br == 1 ? WO_WF : WO_WP) + (size_t)n0 * 512);
      gemm_kloop_pp<true, MI>(A2, K2, B2, K2, K2, acc, smem);
      __builtin_amdgcn_sched_barrier(0);
#pragma unroll
      for (int mi = 0; mi < MI; ++mi)
#pragma unroll
        for (int ni = 0; ni < 4; ++ni) {
          const f32x4 a = acc[mi][ni]; const u32x2 g = gpk[mi][ni]; const u32x2 tp = tot[mi][ni];
          const float v0 = bf_lo(g[0]) * a[0] + bf_lo(tp[0]), v1 = bf_hi(g[0]) * a[1] + bf_hi(tp[0]);
          const float v2 = bf_lo(g[1]) * a[2] + bf_lo(tp[1]), v3 = bf_hi(g[1]) * a[3] + bf_hi(tp[1]);
          tot[mi][ni] = (u32x2){pk2(v0, v1), pk2(v2, v3)};
        }
    }
    const int tid = g_tid(), lane = tid & 63, wid = __builtin_amdgcn_readfirstlane(tid >> 6), wm = wid >> 1, wn = wid & 1, fq = lane >> 4, fr = lane & 15;
#pragma unroll
    for (int mi = 0; mi < MI; ++mi)
#pragma unroll
      for (int ni = 0; ni < 4; ++ni)
        *(u32x2*)(MOUT + (size_t)(m0 + wm * 16 * MI + mi * 16 + fr) * 1024 + n0 + wn * 64 + ni * 16 + fq * 4) = tot[mi][ni];
  }
}

template <int MI>
DI void phase_gemm_plain(const bf16_t* __restrict__ A, int K, const bf16_t* __restrict__ Bt, bf16_t* __restrict__ C, int nmt, int nnt, char* smem) {
  const int vmax = tile_vmax(nmt, nnt), N = nnt * 128;
  for (int v = blockIdx.x; v < vmax; v += gridDim.x) {
    int mt, nt;
    if (!tile_map(v, nmt, nnt, mt, nt)) continue;
    f32x4 acc[MI][4]; zero_acc_t<MI>(acc);
    gemm_kloop_pp<true, MI>(A + (size_t)mt * 64 * MI * K, K, Bt + (size_t)nt * 128 * K, K, K, acc, smem);
    store_tile_bf16<MI>(acc, C + (size_t)mt * 64 * MI * N + nt * 128, N, 1.0f);
  }
}
DI void phase_ffn1(const Params& p, int l, char* smem) {
  const bool last = (l == DEPTH - 1);
  const bf16_t* W = (const bf16_t*)(p.ws + w_off(l)) + WO_WGU;
  const bf16_t* U = (const bf16_t*)(p.ws + OFF_U);
  bf16_t* H = (bf16_t*)(p.ws + OFF_H);
  const int nsup = (last ? 8 : 9) * 11;
  const int vmax = ((nsup + 15) >> 4) << 8;
  auto map_tile = [&](int v, int& mt, int& nt) -> bool {
    if (v >= vmax) return false;
    const int c = v >> 8, w = v & 255, local = w >> 3, sup = (c * 8 + (w & 7)) * 2 + (local >> 4);
    if (sup >= nsup) return false;
    mt = (sup / 11) * 8 + (local & 7); nt = (sup % 11) * 2 + ((local >> 3) & 1);
    return true;
  };
  int v = blockIdx.x, mt = 0, nt = 0;
  bool cur = map_tile(v, mt, nt);
  if (cur) gemm_prefetch_big(U + (size_t)mt * 256 * 1024, 1024, W + (size_t)nt * 256 * 1024, 1024, smem);
  while (cur) {
    f32x4 acc[8][4];
#pragma unroll
    for (int i = 0; i < 8; ++i)
#pragma unroll
      for (int j = 0; j < 4; ++j) acc[i][j] = (f32x4){0.f, 0.f, 0.f, 0.f};
    gemm_kloop_big<true>(U + (size_t)mt * 256 * 1024, 1024, W + (size_t)nt * 256 * 1024, 1024, 1024, acc, smem, true);
    int v2 = v + gridDim.x, mt2 = 0, nt2 = 0;
    const bool nxt = map_tile(v2, mt2, nt2);
    if (nxt) gemm_prefetch_big(U + (size_t)mt2 * 256 * 1024, 1024, W + (size_t)nt2 * 256 * 1024, 1024, smem);
    const int tid = g_tid(), lane = tid & 63, wid = __builtin_amdgcn_readfirstlane(tid >> 6), wm = wid >> 2, wn = wid & 3, fq = lane >> 4, fr = lane & 15;
#pragma unroll
    for (int mi = 0; mi < 8; ++mi) {
      float o[8];
#pragma unroll
      for (int h2 = 0; h2 < 2; ++h2) {
        const f32x4 g = acc[mi][h2], u = acc[mi][2 + h2];
#pragma unroll
        for (int j = 0; j < 4; ++j) o[4 * h2 + j] = g[j] * sigmoidf_(g[j]) * u[j];
      }
      *(u32x4*)(H + (size_t)(mt * 256 + wm * 128 + mi * 16 + fr) * DFF + (nt * 4 + wn) * 32 + 8 * fq) = (u32x4){pk2(o[0], o[1]), pk2(o[2], o[3]), pk2(o[4], o[5]), pk2(o[6], o[7])};
    }
    v = v2; mt = mt2; nt = nt2; cur = nxt;
  }
}

struct InprojSched {
  const char* U; const char* W; int nsupA, nsup, vmax, grid, bid; bool fill;
  DI static bool transposed(int nt) { return (nt >= 4 && nt < 8) || (nt >= 12 && nt < 16); }
  DI bool next(int i, pg8::Unit& u) const {
    const int v = bid + i * grid;
    if (v >= vmax) return false;
    const int c = v >> 8, w = v & 255, local = w >> 3, sup = (c * 8 + (w & 7)) * 2 + (local >> 4);
    if (sup >= nsup) return false;
    if (sup < nsupA) { u.pm = (sup / 9) * 8 + (local & 7); u.pn = (sup % 9) * 2 + ((local >> 3) & 1); }
    else if (fill) { const int q = (sup - nsupA) * 16 + (local & 15); u.pm = q >> 2; u.pn = 18 + (q & 3); }
    else { u.pm = 64 + (local & 7); u.pn = (sup - nsupA) * 2 + ((local >> 3) & 1); }
    return true;
  }
  DI const char* pa(const pg8::Unit& u) const { return transposed(u.pn) ? W + (size_t)u.pn * 256 * 1024 * 2 : U + (size_t)u.pm * 256 * 1024 * 2; }
  DI const char* pb(const pg8::Unit& u) const { return transposed(u.pn) ? U + (size_t)u.pm * 256 * 1024 * 2 : W + (size_t)u.pn * 256 * 1024 * 2; }
};
struct InprojEpi {
  bf16_t *KB, *VT, *QB, *CQ, *ZT, *ZTC, *R; unsigned char* G8; const float *ropec, *ropes;
  DI void operator()(const f32x4 (&acc)[2][2][4][2], const pg8::Unit& u, int wr, int wc, int fr, int fq) const {
    const int mt = u.pm, nt = u.pn, m0 = mt * 256;
    int b, pos0; bool isctx; row_info(m0, b, pos0, isctx);
    if (nt < 4 || (nt >= 8 && nt < 12)) {
      const bool isq = nt >= 8; const int map = wc >> 1, axis = wc & 1;
      const float sc = isq ? QSCALE : 1.0f;
#pragma unroll
      for (int ai = 0; ai < 2; ++ai)
#pragma unroll
        for (int m = 0; m < 4; ++m) {
          const int pos = pos0 + 128 * ai + 64 * wr + 16 * m + fr;
          f32x4 cs = {1.f, 1.f, 1.f, 1.f}, sn = {0.f, 0.f, 0.f, 0.f};
          if (!isctx) { cs = *(const f32x4*)(ropec + pos * 32 + axis * 16 + fq * 4); sn = *(const f32x4*)(ropes + pos * 32 + axis * 16 + fq * 4); }
#pragma unroll
          for (int bj = 0; bj < 2; ++bj) {
            const int h = (nt * 2 + bj) & 7;
            const f32x4 x0 = acc[ai][bj][m][0], x1 = acc[ai][bj][m][1];
            const f32x4 o0 = (x0 * cs - x1 * sn) * sc, o1 = (x1 * cs + x0 * sn) * sc;
            bf16_t* dst;
            if (!isq) dst = KB + ((size_t)((b * 8 + h) * 2 + map) * NKEY + (isctx ? SEQ + pos : pos)) * 64;
            else if (!isctx) dst = QB + ((size_t)((b * 8 + h) * 2 + map) * SEQ + pos) * 64;
            else dst = CQ + ((size_t)((b * 8 + h) * 2 + map) * LC + pos) * 64;
            *(u32x2*)(dst + axis * 32 + fq * 4) = (u32x2){pk2(o0[0], o0[1]), pk2(o0[2], o0[3])};
            *(u32x2*)(dst + axis * 32 + 16 + fq * 4) = (u32x2){pk2(o1[0], o1[1]), pk2(o1[2], o1[3])};
          }
        }
    } else if (nt < 8 || (nt >= 12 && nt < 16)) {
      const bool isv = nt < 8;
#pragma unroll
      for (int ai = 0; ai < 2; ++ai)
#pragma unroll
        for (int m = 0; m < 4; ++m) {
          const int ncol = nt * 256 + 128 * ai + 64 * wr + 16 * m + fr;
#pragma unroll
          for (int bj = 0; bj < 2; ++bj)
#pragma unroll
            for (int n = 0; n < 2; ++n) {
              const int pos = pos0 + 128 * bj + 32 * wc + 16 * n + 4 * fq;
              const f32x4 vv = acc[ai][bj][m][n];
              bf16_t* dst;
              if (isv) {
                const int vg = ncol - 1024, h = vg >> 7, vcol = vg & 127;
                const int key = (isctx ? SEQ : 0) + pos, k15 = key & 15;
                const int pkey = (key & ~15) | (k15 & 3) | ((k15 & 4) << 1) | ((k15 & 8) >> 1);
                dst = VT + ((size_t)(b * 8 + h) * 128 + vcol) * NKEY + pkey;
              } else {
                const int zc = ncol - 3072, np = zc & 511, second = zc >> 9;
                dst = isctx ? (ZTC + ((size_t)b * 512 + np) * 512 + second * 256 + pos) : (ZT + ((size_t)b * 512 + np) * 4096 + second * 2048 + pos);
              }
              *(u32x2*)dst = (u32x2){pk2(vv[0], vv[1]), pk2(vv[2], vv[3])};
            }
        }
    } else if (nt >= 18) {
#pragma unroll
      for (int ai = 0; ai < 2; ++ai)
#pragma unroll
        for (int m = 0; m < 4; ++m) {
          const int row = m0 + 128 * ai + 64 * wr + 16 * m + fr;
#pragma unroll
          for (int bj = 0; bj < 2; ++bj)
#pragma unroll
            for (int n = 0; n < 2; ++n) {
              const int col = nt * 256 + 128 * bj + 32 * wc + 16 * n + 4 * fq - 4608;
              const f32x4 vv = acc[ai][bj][m][n];
              unsigned w = 0;
#pragma unroll
              for (int j = 0; j < 4; ++j) w |= (unsigned)__builtin_rintf(sigmoidf_(vv[j]) * 255.0f) << (8 * j);
              *(unsigned*)(G8 + (size_t)row * 1024 + col) = w;
            }
        }
    } else {
#pragma unroll
      for (int ai = 0; ai < 2; ++ai)
#pragma unroll
        for (int m = 0; m < 4; ++m) {
          const int row = m0 + 128 * ai + 64 * wr + 16 * m + fr;
#pragma unroll
          for (int bj = 0; bj < 2; ++bj)
#pragma unroll
            for (int n = 0; n < 2; ++n) {
              const int col = nt * 256 + 128 * bj + 32 * wc + 16 * n + 4 * fq - 4096;
              const f32x4 vv = acc[ai][bj][m][n];
              *(u32x2*)(R + (size_t)row * 512 + col) = (u32x2){pk2(vv[0], vv[1]), pk2(vv[2], vv[3])};
            }
        }
    }
  }
};
DI void phase_inproj8(const Params& p, int l, char* smem) {
  const bool last = (l == DEPTH - 1);
  InprojSched S;
  S.U = (const char*)(p.ws + OFF_U); S.W = (const char*)((const bf16_t*)(p.ws + w_off(l)) + WO_WIN);
  S.nsupA = last ? 72 : 81; S.nsup = last ? 76 : 96; S.fill = !last;
  S.vmax = ((S.nsup + 15) >> 4) << 8; S.grid = gridDim.x; S.bid = blockIdx.x;
  InprojEpi E;
  E.KB = (bf16_t*)(p.ws + OFF_KB); E.VT = (bf16_t*)(p.ws + OFF_VT); E.QB = (bf16_t*)(p.ws + OFF_QB); E.CQ = (bf16_t*)(p.ws + OFF_CQ);
  E.ZT = (bf16_t*)(p.ws + OFF_ZT); E.ZTC = (bf16_t*)(p.ws + OFF_ZTC); E.R = (bf16_t*)(p.ws + OFF_R);
  E.ropec = (const float*)(p.ws + OFF_ROPEC); E.ropes = (const float*)(p.ws + OFF_ROPES); E.G8 = (unsigned char*)(p.ws + OFF_G8);
  pg8::gemm_phase(( __attribute__((address_space(3))) unsigned char*)(lds_ptr_t)smem, 1024, S, E);
}
struct Ffn1Sched {
  const char* U; const char* W; int nsup, vmax, grid, bid;
  DI bool next(int i, pg8::Unit& u) const {
    const int v = bid + i * grid;
    if (v >= vmax) return false;
    const int c = v >> 8, w = v & 255, local = w >> 3, sup = (c * 8 + (w & 7)) * 2 + (local >> 4);
    if (sup >= nsup) return false;
    u.pm = (sup / 11) * 8 + (local & 7); u.pn = (sup % 11) * 2 + ((local >> 3) & 1);
    return true;
  }
  DI const char* pa(const pg8::Unit& u) const { return U + (size_t)u.pm * 256 * 1024 * 2; }
  DI const char* pb(const pg8::Unit& u) const { return W + (size_t)u.pn * 256 * 1024 * 2; }
};
struct Ffn1Epi {
  bf16_t* H;
  DI void operator()(const f32x4 (&acc)[2][2][4][2], const pg8::Unit& u, int wr, int wc, int fr, int fq) const {
#pragma unroll
    for (int ai = 0; ai < 2; ++ai)
#pragma unroll
      for (int m = 0; m < 4; ++m) {
        const int row = u.pm * 256 + 128 * ai + 64 * wr + 16 * m + fr;
#pragma unroll
        for (int bj = 0; bj < 2; ++bj) {
          const f32x4 g = acc[ai][bj][m][0], up = acc[ai][bj][m][1];
          float o[4];
#pragma unroll
          for (int j = 0; j < 4; ++j) o[j] = g[j] * sigmoidf_(g[j]) * up[j];
          *(u32x2*)(H + (size_t)row * DFF + u.pn * 128 + (bj * 4 + wc) * 16 + fq * 4) = (u32x2){pk2(o[0], o[1]), pk2(o[2], o[3])};
        }
      }
  }
};
DI void phase_ffn18(const Params& p, int l, char* smem) {
  const bool last = (l == DEPTH - 1);
  Ffn1Sched S;
  S.U = (const char*)(p.ws + OFF_U); S.W = (const char*)((const bf16_t*)(p.ws + w_off(l)) + WO_WGU);
  S.nsup = (last ? 8 : 9) * 11; S.vmax = ((S.nsup + 15) >> 4) << 8; S.grid = gridDim.x; S.bid = blockIdx.x;
  Ffn1Epi E; E.H = (bf16_t*)(p.ws + OFF_H);
  pg8::gemm_phase((__attribute__((address_space(3))) unsigned char*)(lds_ptr_t)smem, 1024, S, E);
  if (!last) convert_grab(p, l + 1, 1, smem);
}

#define XB_TMO      128
#define XB_XCNT(j)  (256  + 64 * (j))
#define XB_XSUB(j)  (1280 + 64 * (j))
#define XB_XGEN(j)  (2304 + 64 * (j))
#define XB_TOP      3328
#define XB_TOPGEN   3392
#define XCD_BAR_WORDS 3456
#define XB_SPIN_CAP (1u << 20)
#define LAS __attribute__((address_space(3)))
DI unsigned xb_ld(unsigned* p) { return __hip_atomic_load(p, __ATOMIC_RELAXED, __HIP_MEMORY_SCOPE_AGENT); }
DI unsigned xb_add(unsigned* p, unsigned v) { return __hip_atomic_fetch_add(p, v, __ATOMIC_RELAXED, __HIP_MEMORY_SCOPE_AGENT); }
DI unsigned xb_xcc_id() { return (unsigned)__builtin_amdgcn_s_getreg((3 << 11) | 20) & 0xFu; }
#define XB_SPIN(cond, bar) do { unsigned _sp = 0; while (cond) { __builtin_amdgcn_s_sleep(1); \
    if ((++_sp & 255u) == 0u) { if (xb_ld(&(bar)[XB_TMO])) break; if (_sp > XB_SPIN_CAP) { atomicAdd(&(bar)[XB_TMO], 1u); break; } } } } while (0)
struct XcdBarrier { unsigned* bar; unsigned x; volatile LAS unsigned* st; };
DI XcdBarrier xcd_barrier_post(unsigned* bar, volatile LAS unsigned* st) {
  XcdBarrier b; b.bar = bar; b.x = xb_xcc_id(); b.st = st;
  if (__builtin_amdgcn_workitem_id_x() == 0) (void)xb_add(&bar[XB_XCNT(b.x)], 1u);
  return b;
}
DI void xcd_barrier_complete(unsigned* bar, unsigned x, unsigned& nloc, unsigned& nx) {
  const unsigned G = gridDim.x * gridDim.y * gridDim.z;
  unsigned sum, cnt, mine, sp = 0u;
  for (;;) {
    sum = 0u; cnt = 0u; mine = 0u;
#pragma unroll
    for (unsigned j = 0; j < 16; ++j) { const unsigned c = xb_ld(&bar[XB_XCNT(j)]); sum += c; cnt += (c > 0u) ? 1u : 0u; mine = (j == x) ? c : mine; }
    if (sum == G) break;
    __builtin_amdgcn_s_sleep(1);
    if ((++sp & 255u) == 0u) { if (xb_ld(&bar[XB_TMO])) break; if (sp > XB_SPIN_CAP) { atomicAdd(&bar[XB_TMO], 1u); break; } }
  }
  nloc = mine > 0u ? mine : 1u; nx = cnt > 0u ? cnt : 1u;
}
DI void xcd_barrier(const XcdBarrier& b) {
  asm volatile("s_waitcnt vmcnt(0)" ::: "memory");
  __syncthreads();
  if (__builtin_amdgcn_workitem_id_x() == 0) {
    unsigned* bar = b.bar;
    __builtin_amdgcn_s_waitcnt(0);
    unsigned nloc = b.st[0], nx = b.st[1];
    if (nloc == 0u) { xcd_barrier_complete(bar, b.x, nloc, nx); b.st[0] = nloc; b.st[1] = nx; }
    const unsigned old = xb_add(&bar[XB_XSUB(b.x)], 1u);
    const unsigned gen = old / nloc;
    if (old + 1u == (gen + 1u) * nloc) {
      __builtin_amdgcn_fence(__ATOMIC_RELEASE, "agent");
      asm volatile("s_waitcnt vmcnt(0)" ::: "memory");
      const unsigned og = xb_add(&bar[XB_TOP], 1u);
      const unsigned tg = og / nx;
      if (og + 1u == (tg + 1u) * nx) xb_add(&bar[XB_TOPGEN], 1u);
      else XB_SPIN(xb_ld(&bar[XB_TOPGEN]) == tg, bar);
      __builtin_amdgcn_fence(__ATOMIC_ACQUIRE, "agent");
      xb_add(&bar[XB_XGEN(b.x)], 1u);
      asm volatile("s_waitcnt vmcnt(0)" ::: "memory");
    } else {
      XB_SPIN(xb_ld(&bar[XB_XGEN(b.x)]) == gen, bar);
      __builtin_amdgcn_fence(__ATOMIC_ACQUIRE, "agent");
      asm volatile("s_waitcnt vmcnt(0)" ::: "memory");
    }
  }
  __syncthreads();
}

#define REP_MASK 0
#define REP_PRO 0
__global__ void __launch_bounds__(512) mega(Params p0) {
  extern __shared__ __attribute__((aligned(16))) char smem[];
  cg::grid_group grid = cg::this_grid();
  volatile LAS unsigned* xst = (volatile LAS unsigned*)(lds_ptr_t)(smem + 3 * GSTAGE);
  if (__builtin_amdgcn_workitem_id_x() < 4) xst[__builtin_amdgcn_workitem_id_x()] = 0u;
  __syncthreads();
  const XcdBarrier xb = xcd_barrier_post((unsigned*)(p0.ws + OFF_BAR), xst);
  for (int ph = p0.ph_begin; ph < p0.ph_end; ++ph) {
    const Params& p = p0;
    const bf16_t* Wl = (const bf16_t*)(p.ws + w_off(ph >= 2 ? (ph - 2) >> 3 : 0));
    if (ph == 0) { phase0a(p, smem); if (REP_PRO & 1) { xcd_barrier(xb); phase0a(p, smem); } }
    else if (ph == 1) { ln_pass(p, 0, T_ALL, nullptr, nullptr, nullptr, 0, 0, 0, 0); if (REP_PRO & 2) { xcd_barrier(xb); ln_pass(p, 0, T_ALL, nullptr, nullptr, nullptr, 0, 0, 0, 0); } }
    else {
      const int l = (ph - 2) >> 3, s = (ph - 2) & 7;
      const bool last = (l == DEPTH - 1);
      const int nmt = last ? 64 : 72, nrows = last ? T_LAT : T_ALL;
      for (int rep = 0; rep < 1 + ((REP_MASK >> s) & 1); ++rep) {
      if (rep) xcd_barrier(xb);
      switch (s) {
        case 0: phase_inproj8(p, l, smem); break;
        case 1: phase_mix(p, l, smem); if (!last) convert_grab(p, l + 1, 0, smem); break;
        case 2: if (last) phase_branch<4>(p, l, smem); else { phase_branch<3>(p, l, smem); convert_grab(p, l + 1, 0, smem); } break;
        case 3: if (last) phase_gemm_plain<4>((const bf16_t*)(p.ws + OFF_MOUT), 1024, Wl + WO_WO, (bf16_t*)(p.ws + OFF_Y), 64, 8, smem);
                else phase_gemm_plain<3>((const bf16_t*)(p.ws + OFF_MOUT), 1024, Wl + WO_WO, (bf16_t*)(p.ws + OFF_Y), 96, 8, smem);
                break;
        case 4: ln_pass(p, 1, nrows, (const bf16_t*)(p.ws + OFF_Y), p.ln1_g + (size_t)l * 1024, p.ln1_b + (size_t)l * 1024, l, 2, l, 3); break;
        case 5: phase_ffn18(p, l, smem); break;
        case 6: if (last) phase_gemm_plain<4>((const bf16_t*)(p.ws + OFF_H), DFF, Wl + WO_WD, (bf16_t*)(p.ws + OFF_FO), 64, 8, smem);
                else phase_gemm_plain<3>((const bf16_t*)(p.ws + OFF_H), DFF, Wl + WO_WD, (bf16_t*)(p.ws + OFF_FO), 96, 8, smem);
                break;
        default:
          ln_pass(p, last ? 2 : 1, nrows, (const bf16_t*)(p.ws + OFF_FO), p.ln2_g + (size_t)l * 1024, p.ln2_b + (size_t)l * 1024, l, 5, last ? l : l + 1, 0);
          if (!last) { convert_grab(p, l + 1, 0, smem); convert_grab(p, l + 1, 1, smem); }
          break;
      }
      }
    }
    if (ph + 1 < p0.ph_end) { if (p0.ph_begin < 0) grid.sync(); xcd_barrier(xb); }
  }
}

extern "C" void kernel_launch(void* const* d_in, const int* in_sizes, int n_in, void* d_out, int out_size, void* d_ws, size_t ws_size, hipStream_t stream) {
  constexpr size_t kDynLds = 3 * GSTAGE + 16;
  static int grid_blocks = 0;
  if (!grid_blocks) {
    int dev = 0, cus = 0, per_cu = 0;
    (void)hipGetDevice(&dev);
    (void)hipDeviceGetAttribute(&cus, hipDeviceAttributeMultiprocessorCount, dev);
    (void)hipFuncSetAttribute((const void*)mega, hipFuncAttributeMaxDynamicSharedMemorySize, (int)kDynLds);
    (void)hipOccupancyMaxActiveBlocksPerMultiprocessor(&per_cu, mega, 512, kDynLds);
    if (per_cu > 1) per_cu = 1;
    if (per_cu < 1) per_cu = 1;
    grid_blocks = cus * per_cu;
  }
  if (ws_size < WS_NEED) { fprintf(stderr, "workspace too small: %zu < %zu\n", ws_size, (size_t)WS_NEED); return; }
  (void)hipMemsetAsync((char*)d_ws + OFF_BAR, 0, XCD_BAR_WORDS * 4 + 64, stream);
  Params p;
  memset(&p, 0, sizeof(p));
  const float** fp = (const float**)&p;
  for (int i = 0; i < 22; ++i) fp[i] = (const float*)d_in[i];
  p.out = (float*)d_out;
  p.ws = (char*)d_ws;
  for (int l = 0; l < 4; ++l) p.lam_init[l] = (float)(0.8 - 0.6 * exp(-0.3 * l));
  p.ph_begin = 0; p.ph_end = 2 + 8 * DEPTH;
  void* args[] = {&p};
  hipError_t e = hipLaunchCooperativeKernel((void*)mega, dim3(grid_blocks), dim3(512), args, kDynLds, stream);
  if (e != hipSuccess) fprintf(stderr, "cooperative launch failed: %s (grid %d)\n", hipGetErrorString(e), grid_blocks);
}
```

```cpp
#include <hip/hip_runtime.h>
#include <hip/hip_cooperative_groups.h>
#include <cstdio>
#include <cstdint>
#include <cstring>
#include <cmath>
namespace cg = cooperative_groups;

#define DI __device__ __forceinline__
typedef unsigned short bf16_t;
typedef short bf16x8 __attribute__((ext_vector_type(8)));
typedef float f32x4 __attribute__((ext_vector_type(4)));
typedef float f32x2 __attribute__((ext_vector_type(2)));
typedef float f32x16 __attribute__((ext_vector_type(16)));
typedef unsigned u32x2 __attribute__((ext_vector_type(2)));
typedef unsigned u32x4 __attribute__((ext_vector_type(4)));
typedef __bf16 bf16x2_t __attribute__((ext_vector_type(2)));

constexpr int D = 1024, NB = 8, SEQ = 2048, LC = 256, NH = 8, DEPTH = 4;
constexpr int T_LAT = NB * SEQ, T_CTX = NB * LC, T_ALL = T_LAT + T_CTX;
constexpr int NKEY = SEQ + LC;
constexpr int N_IN = 7168, DFF = 2816;
constexpr int WIN_ROWS = 7680;
constexpr int ROW_Z1 = 3072, ROW_Z2 = 3584, ROW_R = 4096, ROW_G = 4608;
constexpr float ALPHA = 1.6817928305074290f;
constexpr float LN_EPS = 1e-5f;
constexpr float QSCALE = 0.125f * 1.4426950408889634f;

constexpr size_t WO_WIN = 0;
constexpr size_t WO_WA = WO_WIN + (size_t)WIN_ROWS * 1024;
constexpr size_t WO_WF = WO_WA + 1024 * 1024;
constexpr size_t WO_WP = WO_WF + 1024 * 512;
constexpr size_t WO_WO = WO_WP + 1024 * 512;
constexpr size_t WO_WGU = WO_WO + 1024 * 1024;
constexpr size_t WO_WD = WO_WGU + (size_t)5632 * 1024;
constexpr size_t W_ELEMS = WO_WD + (size_t)1024 * DFF;

constexpr size_t al256(size_t x) { return (x + 255) & ~(size_t)255; }
constexpr size_t OFF_W = 0;
constexpr size_t OFF_ATAB = al256(OFF_W + W_ELEMS * 2);
constexpr size_t OFF_ATABC = al256(OFF_ATAB + (size_t)2048 * 4096 * 2);
constexpr size_t OFF_ROPEC = al256(OFF_ATABC + (size_t)256 * 512 * 2);
constexpr size_t OFF_ROPES = al256(OFF_ROPEC + (size_t)2048 * 32 * 4);
constexpr size_t OFF_MODV = al256(OFF_ROPES + (size_t)2048 * 32 * 4);
constexpr size_t OFF_LAMV = al256(OFF_MODV + (size_t)DEPTH * 9 * 6144 * 4);
constexpr size_t OFF_X = al256(OFF_LAMV + 256);
constexpr size_t OFF_U = al256(OFF_X + (size_t)T_ALL * 1024 * 4);
constexpr size_t OFF_KB = al256(OFF_U + (size_t)T_ALL * 1024 * 2);
constexpr size_t OFF_VT = al256(OFF_KB + (size_t)NB * NH * 2 * NKEY * 64 * 2);
constexpr size_t OFF_QB = al256(OFF_VT + (size_t)NB * NH * 128 * NKEY * 2);
constexpr size_t OFF_CQ = al256(OFF_QB + (size_t)NB * NH * 2 * SEQ * 64 * 2);
constexpr size_t OFF_ZT = al256(OFF_CQ + (size_t)NB * NH * 2 * LC * 64 * 2);
constexpr size_t OFF_ZTC = al256(OFF_ZT + (size_t)NB * 512 * 4096 * 2);
constexpr size_t OFF_R = al256(OFF_ZTC + (size_t)NB * 512 * 512 * 2);
constexpr size_t OFF_ATT = al256(OFF_R + (size_t)T_ALL * 512 * 2);
constexpr size_t OFF_FM = al256(OFF_ATT + (size_t)T_ALL * 1024 * 2);
constexpr size_t OFF_PM = al256(OFF_FM + (size_t)T_ALL * 512 * 2);
constexpr size_t OFF_BAR = al256(OFF_PM + (size_t)T_ALL * 512 * 2);
constexpr size_t OFF_CTR = OFF_BAR + 3456 * 4;
constexpr size_t OFF_W2 = al256(OFF_CTR + 64);
constexpr size_t OFF_G8 = al256(OFF_W2 + W_ELEMS * 2);
constexpr int G8_ROWS = 15360;
constexpr size_t WS_NEED = al256(OFF_G8 + (size_t)G8_ROWS * 1024);
constexpr size_t OFF_MOUT = OFF_KB;
constexpr size_t OFF_Y = OFF_VT;
constexpr size_t OFF_H = OFF_KB;
constexpr size_t OFF_FO = OFF_ATT;
static_assert((size_t)T_ALL * DFF * 2 <= OFF_CQ - OFF_KB, "H overlay too large");

struct Params {
  const float *x, *c, *ctx, *c_ctx, *w_mod, *b_mod, *w_in, *lam_qk, *subln_g, *w_att_br, *w_four_br, *w_pool_grp, *pool_scale,
      *w_pool_br, *w_out, *ln1_g, *ln1_b, *w_ffn_gate, *w_ffn_up, *w_ffn_down, *ln2_g, *ln2_b;
  float* out;
  char* ws;
  float lam_init[4];
  int ph_begin, ph_end;
};

DI size_t w_off(int l) { return (l & 1) ? OFF_W2 : OFF_W; }
DI int g_tid() { int t = __builtin_amdgcn_workitem_id_x(); asm volatile("" : "+v"(t)); return t; }
DI unsigned pk2(float a, float b) { f32x2 v = {a, b}; bf16x2_t r = __builtin_convertvector(v, bf16x2_t); return __builtin_bit_cast(unsigned, r); }
DI float bf_lo(unsigned u) { return __uint_as_float(u << 16); }
DI float bf_hi(unsigned u) { return __uint_as_float(u & 0xffff0000u); }
DI float hw_cos_rev(float r) { return __builtin_amdgcn_cosf(r); }
DI float hw_sin_rev(float r) { return __builtin_amdgcn_sinf(r); }
DI float sigmoidf_(float x) { return 1.0f / (1.0f + __expf(-x)); }
DI float xor32_sum(float v) { const auto r = __builtin_amdgcn_permlane32_swap(__float_as_uint(v), __float_as_uint(v), false, false); return __uint_as_float(r[0]) + __uint_as_float(r[1]); }
DI float xor32_max(float v) { const auto r = __builtin_amdgcn_permlane32_swap(__float_as_uint(v), __float_as_uint(v), false, false); return fmaxf(__uint_as_float(r[0]), __uint_as_float(r[1])); }
DI float dpp_add(float v, int) { return v; }
#define DPP_ADD(v, ctrl) ((v) + __uint_as_float(__builtin_amdgcn_update_dpp(0u, __float_as_uint(v), (ctrl), 0xF, 0xF, true)))
DI float wave_sum(float v) {
  v = DPP_ADD(v, 0xB1);
  v = DPP_ADD(v, 0x4E);
  v = DPP_ADD(v, 0x141);
  v = DPP_ADD(v, 0x140);
  { const auto r = __builtin_amdgcn_permlane16_swap(__float_as_uint(v), __float_as_uint(v), false, false); v = __uint_as_float(r[0]) + __uint_as_float(r[1]); }
  return xor32_sum(v);
}
#define MFMA16(a, b, c) __builtin_amdgcn_mfma_f32_16x16x32_bf16((a), (b), (c), 0, 0, 0)
#define MFMA32(a, b, c) __builtin_amdgcn_mfma_f32_32x32x16_bf16((a), (b), (c), 0, 0, 0)

constexpr int GSTAGE = 49152;
#define WAIT_VM(n) asm volatile("s_waitcnt vmcnt(" #n ")" ::: "memory")
typedef __attribute__((address_space(3))) void* lds_ptr_t;
template <bool SWAP, int MI = 4>
DI void gemm_kloop(const bf16_t* __restrict__ A, int lda, const bf16_t* __restrict__ B, int ldb, int K, f32x4 (&acc)[MI][4], char* smem, bool pre = false  ) {
  const int tid = g_tid(), lane = tid & 63, wid = __builtin_amdgcn_readfirstlane(tid >> 6), wm = wid >> 1, wn = wid & 1;
  const int lr = tid >> 3, lc = (tid & 7) ^ ((tid >> 4) & 7);
  const unsigned aoff = (unsigned)(lr * lda + lc * 8) * 2u, boff = (unsigned)(lr * ldb + lc * 8) * 2u;
  const char* Ac = (const char*)A; const char* Bc = (const char*)B;
  const int fr = lane & 15, fq = lane >> 4, sw = fr >> 1;
  const int a_base = (wm * 16 * MI + fr) * 128, b_base = 32768 + (wn * 64 + fr) * 128;
  const int nk = K >> 6;
  char* sdst = smem + tid * 16;
#define G_ISSUE(KT, ST) do { _Pragma("unroll") for (int i = 0; i < MI; ++i) \
      __builtin_amdgcn_global_load_lds((const void*)(Ac + ((size_t)(64 * i) * lda + (size_t)(KT) * 64) * 2 + aoff), (lds_ptr_t)(sdst + (ST) * GSTAGE + i * 8192), 16, 0, 0); \
    _Pragma("unroll") for (int i = 0; i < 2; ++i) \
      __builtin_amdgcn_global_load_lds((const void*)(Bc + ((size_t)(64 * i) * ldb + (size_t)(KT) * 64) * 2 + boff), (lds_ptr_t)(sdst + (ST) * GSTAGE + 32768 + i * 8192), 16, 0, 0); } while (0)
#define G_COMPUTE(ST) do { const char* st_ = smem + (ST) * GSTAGE; \
    _Pragma("unroll") for (int ks = 0; ks < 2; ++ks) { const int co = ((ks * 4 + fq) ^ sw) << 4; bf16x8 af[MI], bfr[4]; \
      _Pragma("unroll") for (int i = 0; i < 4; ++i) bfr[i] = *(const bf16x8*)(st_ + b_base + i * 2048 + co); \
      _Pragma("unroll") for (int i = 0; i < MI; ++i) af[i] = *(const bf16x8*)(st_ + a_base + i * 2048 + co); \
      _Pragma("unroll") for (int mi = 0; mi < MI; ++mi) _Pragma("unroll") for (int ni = 0; ni < 4; ++ni) { \
          if (SWAP) acc[mi][ni] = MFMA16(bfr[ni], af[mi], acc[mi][ni]); else acc[mi][ni] = MFMA16(af[mi], bfr[ni], acc[mi][ni]); } } } while (0)
  if (!pre) { G_ISSUE(0, 0); G_ISSUE(1, 1); }
  int st = 0;
  for (int t = 0; t < nk; ++t) {
    if (t == 0 || t + 1 >= nk) WAIT_VM(0);
    else if (MI == 4) WAIT_VM(6); else WAIT_VM(5);
    __builtin_amdgcn_s_barrier();
    asm volatile("" ::: "memory");
    const int st2 = (st == 0) ? 2 : st - 1;
    if (t + 2 < nk) G_ISSUE(t + 2, st2);
    __builtin_amdgcn_sched_barrier(0);
    G_COMPUTE(st);
    __builtin_amdgcn_sched_group_barrier(0x100, 6, 0);
#pragma unroll
    for (int i_ = 0; i_ < 2 * MI + 2; ++i_) { __builtin_amdgcn_sched_group_barrier(0x008, 2, 0); __builtin_amdgcn_sched_group_barrier(0x100, 1, 0); }
    __builtin_amdgcn_sched_group_barrier(0x008, 4 * MI - 4, 0);
    __builtin_amdgcn_sched_barrier(0);
    st = (st == 2) ? 0 : st + 1;
  }
  asm volatile("s_waitcnt lgkmcnt(0)" ::: "memory");
  __builtin_amdgcn_s_barrier();
  asm volatile("" ::: "memory");
#undef G_ISSUE
#undef G_COMPUTE
}
template <bool SWAP, int MI = 4>
DI void gemm_kloop_pp(const bf16_t* __restrict__ A, int lda, const bf16_t* __restrict__ B, int ldb, int K, f32x4 (&acc)[MI][4], char* smem) {
  const int tid = g_tid(), lane = tid & 63, wid = __builtin_amdgcn_readfirstlane(tid >> 6), wm = wid >> 1, wn = wid & 1, grp = wid >> 2;
  const int lr = tid >> 3, lc = (tid & 7) ^ ((tid >> 4) & 7);
  const unsigned aoff = (unsigned)(lr * lda + lc * 8) * 2u, boff = (unsigned)(lr * ldb + lc * 8) * 2u;
  const char* Ac = (const char*)A; const char* Bc = (const char*)B;
  const int fr = lane & 15, fq = lane >> 4, sw = fr >> 1;
  const int a_base = (wm * 16 * MI + fr) * 128, b_base = 32768 + (wn * 64 + fr) * 128;
  const int nk = K >> 6;
  char* sdst = smem + tid * 16;
#define P_ISSUE(KT, ST) do { _Pragma("unroll") for (int i = 0; i < MI; ++i) \
      __builtin_amdgcn_global_load_lds((const void*)(Ac + ((size_t)(64 * i) * lda + (size_t)(KT) * 64) * 2 + aoff), (lds_ptr_t)(sdst + (ST) * GSTAGE + i * 8192), 16, 0, 0); \
    _Pragma("unroll") for (int i = 0; i < 2; ++i) \
      __builtin_amdgcn_global_load_lds((const void*)(Bc + ((size_t)(64 * i) * ldb + (size_t)(KT) * 64) * 2 + boff), (lds_ptr_t)(sdst + (ST) * GSTAGE + 32768 + i * 8192), 16, 0, 0); } while (0)
  P_ISSUE(0, 0);
  P_ISSUE(1, 1);
  WAIT_VM(0);
  __builtin_amdgcn_s_barrier();
  asm volatile("" ::: "memory");
  if (grp == 1) { __builtin_amdgcn_s_barrier(); asm volatile("" ::: "memory"); }
  int st = 0;
  for (int t = 0; t < nk; ++t) {
    const int st2 = (st == 0) ? 2 : st - 1;
    if (t + 2 < nk) P_ISSUE(t + 2, st2);
    bf16x8 af[2][MI], bfr[2][4];
    const char* st_ = smem + st * GSTAGE;
#pragma unroll
    for (int ks = 0; ks < 2; ++ks) {
      const int co = ((ks * 4 + fq) ^ sw) << 4;
#pragma unroll
      for (int i = 0; i < 4; ++i) bfr[ks][i] = *(const bf16x8*)(st_ + b_base + i * 2048 + co);
#pragma unroll
      for (int i = 0; i < MI; ++i) af[ks][i] = *(const bf16x8*)(st_ + a_base + i * 2048 + co);
    }
    if (t + 2 < nk) { if (MI == 4) WAIT_VM(6); else WAIT_VM(5); } else WAIT_VM(0);
    asm volatile("s_waitcnt lgkmcnt(0)" ::: "memory");
    __builtin_amdgcn_sched_barrier(0);
    __builtin_amdgcn_s_barrier();
    asm volatile("" ::: "memory");
#pragma unroll
    for (int ks = 0; ks < 2; ++ks)
#pragma unroll
      for (int mi = 0; mi < MI; ++mi)
#pragma unroll
        for (int ni = 0; ni < 4; ++ni) {
          if (SWAP) acc[mi][ni] = MFMA16(bfr[ks][ni], af[ks][mi], acc[mi][ni]); else acc[mi][ni] = MFMA16(af[ks][mi], bfr[ks][ni], acc[mi][ni]);
        }
    __builtin_amdgcn_sched_barrier(0);
    __builtin_amdgcn_s_barrier();
    asm volatile("" ::: "memory");
    st = (st == 2) ? 0 : st + 1;
  }
  if (grp == 0) { __builtin_amdgcn_s_barrier(); asm volatile("" ::: "memory"); }
#undef P_ISSUE
}

template <int MI>
DI void gemm_prefetch(const bf16_t* __restrict__ A, int lda, const bf16_t* __restrict__ B, int ldb, char* smem) {
  const int tid = g_tid();
  const int lr = tid >> 3, lc = (tid & 7) ^ ((tid >> 4) & 7);
  const unsigned aoff = (unsigned)(lr * lda + lc * 8) * 2u, boff = (unsigned)(lr * ldb + lc * 8) * 2u;
  const char* Ac = (const char*)A; const char* Bc = (const char*)B;
  char* sdst = smem + tid * 16;
#pragma unroll
  for (int kt = 0; kt < 2; ++kt) {
#pragma unroll
    for (int i = 0; i < MI; ++i)
      __builtin_amdgcn_global_load_lds((const void*)(Ac + ((size_t)(64 * i) * lda + (size_t)kt * 64) * 2 + aoff), (lds_ptr_t)(sdst + kt * GSTAGE + i * 8192), 16, 0, 0);
#pragma unroll
    for (int i = 0; i < 2; ++i)
      __builtin_amdgcn_global_load_lds((const void*)(Bc + ((size_t)(64 * i) * ldb + (size_t)kt * 64) * 2 + boff), (lds_ptr_t)(sdst + kt * GSTAGE + 32768 + i * 8192), 16, 0, 0);
  }
}
template <int MI>
DI void zero_acc_t(f32x4 (&acc)[MI][4]) {
#pragma unroll
  for (int i = 0; i < MI; ++i)
#pragma unroll
    for (int j = 0; j < 4; ++j) acc[i][j] = (f32x4){0.f, 0.f, 0.f, 0.f};
}
DI void zero_acc(f32x4 (&acc)[4][4]) {
#pragma unroll
  for (int i = 0; i < 4; ++i)
#pragma unroll
    for (int j = 0; j < 4; ++j) acc[i][j] = (f32x4){0.f, 0.f, 0.f, 0.f};
}

template <bool SWAP>
DI void gemm_kloop_big(const bf16_t* __restrict__ A, int lda, const bf16_t* __restrict__ B, int ldb, int K, f32x4 (&acc)[8][4], char* smem, bool pre = false) {
  const int tid = g_tid(), lane = tid & 63, wid = __builtin_amdgcn_readfirstlane(tid >> 6), wm = wid >> 2, wn = wid & 3;
  const int lr = tid >> 3, lc = (tid & 7) ^ ((tid >> 4) & 7);
  const unsigned aoff = (unsigned)(lr * lda + lc * 8) * 2u, boff = (unsigned)(lr * ldb + lc * 8) * 2u;
  const char* Ac = (const char*)A; const char* Bc = (const char*)B;
  const int fr = lane & 15, fq = lane >> 4, sw = fr >> 1;
  const int a_base = (wm * 128 + fr) * 128, b_base = 32768 + (wn * 64 + fr) * 128;
  const int nk = K >> 6;
  char* sdst = smem + tid * 16;
#define GB_ISSUE(KT, ST) do { _Pragma("unroll") for (int i = 0; i < 4; ++i) { \
      __builtin_amdgcn_global_load_lds((const void*)(Ac + ((size_t)(64 * i) * lda + (size_t)(KT) * 64) * 2 + aoff), (lds_ptr_t)(sdst + (ST) * 65536 + i * 8192), 16, 0, 0); \
      __builtin_amdgcn_global_load_lds((const void*)(Bc + ((size_t)(64 * i) * ldb + (size_t)(KT) * 64) * 2 + boff), (lds_ptr_t)(sdst + (ST) * 65536 + 32768 + i * 8192), 16, 0, 0); } } while (0)
  if (!pre) GB_ISSUE(0, 0);
  for (int t = 0; t < nk; ++t) {
    WAIT_VM(0);
    __builtin_amdgcn_s_barrier();
    asm volatile("" ::: "memory");
    if (t + 1 < nk) GB_ISSUE(t + 1, (t + 1) & 1);
    __builtin_amdgcn_sched_barrier(0);
    const char* st_ = smem + (t & 1) * 65536;
#pragma unroll
    for (int ks = 0; ks < 2; ++ks) {
      const int co = ((ks * 4 + fq) ^ sw) << 4;
      bf16x8 af[8], bfr[4];
#pragma unroll
      for (int i = 0; i < 4; ++i) bfr[i] = *(const bf16x8*)(st_ + b_base + i * 2048 + co);
#pragma unroll
      for (int i = 0; i < 8; ++i) af[i] = *(const bf16x8*)(st_ + a_base + i * 2048 + co);
#pragma unroll
      for (int mi = 0; mi < 8; ++mi)
#pragma unroll
        for (int ni = 0; ni < 4; ++ni) {
          if (SWAP) acc[mi][ni] = MFMA16(bfr[ni], af[mi], acc[mi][ni]); else acc[mi][ni] = MFMA16(af[mi], bfr[ni], acc[mi][ni]);
        }
    }
    __builtin_amdgcn_sched_group_barrier(0x100, 8, 0);
#pragma unroll
    for (int i_ = 0; i_ < 16; ++i_) { __builtin_amdgcn_sched_group_barrier(0x008, 3, 0); __builtin_amdgcn_sched_group_barrier(0x100, 1, 0); }
    __builtin_amdgcn_sched_group_barrier(0x008, 16, 0);
    __builtin_amdgcn_sched_barrier(0);
  }
  asm volatile("s_waitcnt lgkmcnt(0)" ::: "memory");
  __builtin_amdgcn_s_barrier();
  asm volatile("" ::: "memory");
#undef GB_ISSUE
}

namespace pg8 {
#define PG8_LAS __attribute__((address_space(3)))
constexpr int BM = 256, BK = 64, HALF = 128, HTB = HALF * BK * 2;
DI int lds_byte(int r, int c) { const int st = (r >> 4) * 2 + (c >> 5), rr = r & 15, cc = c & 31, ob = rr * 64 + cc * 2; return st * 1024 + (ob ^ (((ob >> 9) & 1) << 5)); }
DI void stage_rc(int b, int& R, int& C) { const int st = b / 1024, sb = b % 1024, swz = sb ^ (((sb >> 9) & 1) << 5); R = (st >> 1) * 16 + swz / 64; C = (st & 1) * 32 + (swz % 64) / 2; }
struct Unit { int pm, pn; };
template <class Epi, class Sched>
DI void gemm_phase(PG8_LAS unsigned char* lds, int K, const Sched& S, const Epi& E) {
  const int tid = g_tid(), wid = __builtin_amdgcn_readfirstlane(tid >> 6), lane = tid & 63, wr = wid >> 2, wc = wid & 3, fr = lane & 15, fq = lane >> 4;
  const int nt = K / BK;
  unsigned voff[2];
#pragma unroll
  for (int i = 0; i < 2; ++i) { int R, C; stage_rc(tid * 16 + i * 8192, R, C); voff[i] = (unsigned)(R * K + C) * 2u; }
  const size_t kstep = (size_t)(BK * 2);
  const size_t hstep = (size_t)HALF * K * 2;
  const unsigned ldsw = (unsigned)wid * 1024u;
  const int aoff = lds_byte(wr * 64 + fr, fq * 8), boff = lds_byte(wc * 32 + fr, fq * 8);
#define PG8_SA(b, h) (((b) * 2 + (h)) * HTB)
#define PG8_SB(b, h) ((4 + (b) * 2 + (h)) * HTB)
#define PG8_STAGE(bufoff, gbase) do { _Pragma("unroll") for (int _i = 0; _i < 2; ++_i) \
    __builtin_amdgcn_global_load_lds((const void*)((const char*)(gbase) + voff[_i]), (PG8_LAS void*)(lds + (bufoff) + ldsw + _i * 8192), 16, 0, 0); } while (0)
#define PG8_LDA(dst, b, h) do { _Pragma("unroll") for (int m = 0; m < 4; ++m) _Pragma("unroll") for (int k = 0; k < 2; ++k) dst[m][k] = *(const PG8_LAS bf16x8*)(lds + PG8_SA(b, h) + aoff + m * 2048 + k * 1024); } while (0)
#define PG8_LDB(dst, b, h) do { _Pragma("unroll") for (int n = 0; n < 2; ++n) _Pragma("unroll") for (int k = 0; k < 2; ++k) dst[n][k] = *(const PG8_LAS bf16x8*)(lds + PG8_SB(b, h) + boff + n * 2048 + k * 1024); } while (0)
#define PG8_MMA(ai, bj, At, Bt) do { __builtin_amdgcn_s_setprio(1); _Pragma("unroll") for (int m = 0; m < 4; ++m) _Pragma("unroll") for (int n = 0; n < 2; ++n) _Pragma("unroll") for (int k = 0; k < 2; ++k) \
    acc[ai][bj][m][n] = __builtin_amdgcn_mfma_f32_16x16x32_bf16(Bt[n][k], At[m][k], acc[ai][bj][m][n], 0, 0, 0); __builtin_amdgcn_s_setprio(0); } while (0)
#define PG8_WAIT_V(n) asm volatile("s_waitcnt vmcnt(" #n ")" ::: "memory")
#define PG8_WAIT_L(n) asm volatile("s_waitcnt lgkmcnt(" #n ")" ::: "memory")
#define PG8_BAR __builtin_amdgcn_s_barrier()
#define PG8_SCHED __builtin_amdgcn_sched_barrier(0)
  Unit cur, nxt; int ui = 0;
  if (!S.next(0, cur)) return;
  f32x4 acc[2][2][4][2];
#pragma unroll
  for (int a = 0; a < 2; ++a)
#pragma unroll
    for (int b = 0; b < 2; ++b)
#pragma unroll
      for (int m = 0; m < 4; ++m)
#pragma unroll
        for (int n = 0; n < 2; ++n) acc[a][b][m][n] = (f32x4){0.f, 0.f, 0.f, 0.f};
  bf16x8 At[4][2], B0[2][2], B1[2][2];
  const char* cA = S.pa(cur); const char* cB = S.pb(cur);
  PG8_WAIT_V(0);
  PG8_STAGE(PG8_SB(0, 0), cB); PG8_STAGE(PG8_SA(0, 0), cA); PG8_STAGE(PG8_SB(0, 1), cB + hstep); PG8_STAGE(PG8_SA(0, 1), cA + hstep);
  if (wr == 1) PG8_BAR;
  PG8_WAIT_V(4); PG8_BAR;
  PG8_STAGE(PG8_SB(1, 0), cB + kstep); PG8_STAGE(PG8_SA(1, 0), cA + kstep); PG8_STAGE(PG8_SB(1, 1), cB + hstep + kstep);
  PG8_WAIT_V(6); PG8_BAR;
  for (;;) {
    const bool has_next = S.next(ui + 1, nxt);
    const char* nA = has_next ? S.pa(nxt) : cA; const char* nB = has_next ? S.pb(nxt) : cB;
    for (int t = 0; t < nt; t += 2) {
      const bool last = (t == nt - 2);
      const char* a1 = cA + (size_t)(t + 1) * kstep;
      const char* a2 = last ? nA : cA + (size_t)(t + 2) * kstep; const char* b2 = last ? nB : cB + (size_t)(t + 2) * kstep;
      const char* a3 = a2 + kstep; const char* b3 = b2 + kstep;
      PG8_LDB(B0, 0, 0); PG8_SCHED; PG8_LDA(At, 0, 0); PG8_STAGE(PG8_SA(1, 1), a1 + hstep);
      PG8_WAIT_L(8); PG8_BAR; PG8_WAIT_L(0); PG8_MMA(0, 0, At, B0); PG8_BAR; PG8_SCHED;
      PG8_LDB(B1, 0, 1); PG8_STAGE(PG8_SB(0, 0), b2);
      PG8_BAR; PG8_WAIT_L(0); PG8_MMA(0, 1, At, B1); PG8_BAR;
      PG8_LDA(At, 0, 1); PG8_STAGE(PG8_SA(0, 0), a2);
      PG8_BAR; PG8_WAIT_L(0); PG8_MMA(1, 0, At, B0); PG8_BAR; PG8_SCHED;
      PG8_STAGE(PG8_SB(0, 1), b2 + hstep);
      PG8_WAIT_V(6); PG8_BAR; PG8_MMA(1, 1, At, B1); PG8_BAR;
      PG8_LDB(B0, 1, 0); PG8_SCHED; PG8_LDA(At, 1, 0); PG8_STAGE(PG8_SA(0, 1), a2 + hstep);
      PG8_WAIT_L(8); PG8_BAR; PG8_WAIT_L(0); PG8_MMA(0, 0, At, B0); PG8_BAR; PG8_SCHED;
      PG8_LDB(B1, 1, 1); PG8_STAGE(PG8_SB(1, 0), b3);
      PG8_BAR; PG8_WAIT_L(0); PG8_MMA(0, 1, At, B1); PG8_BAR;
      PG8_LDA(At, 1, 1); PG8_STAGE(PG8_SA(1, 0), a3);
      PG8_BAR; PG8_WAIT_L(0); PG8_MMA(1, 0, At, B0); PG8_BAR; PG8_SCHED;
      PG8_STAGE(PG8_SB(1, 1), b3 + hstep);
      PG8_WAIT_V(6); PG8_BAR; PG8_MMA(1, 1, At, B1); PG8_BAR;
    }
    E(acc, cur, wr, wc, fr, fq);
    if (!has_next) break;
#pragma unroll
    for (int a = 0; a < 2; ++a)
#pragma unroll
      for (int b = 0; b < 2; ++b)
#pragma unroll
        for (int m = 0; m < 4; ++m)
#pragma unroll
          for (int n = 0; n < 2; ++n) acc[a][b][m][n] = (f32x4){0.f, 0.f, 0.f, 0.f};
    cur = nxt; cA = nA; cB = nB; ++ui;
  }
  PG8_WAIT_V(0);
  if (wr == 0) PG8_BAR;
  PG8_BAR;
#undef PG8_SA
#undef PG8_SB
#undef PG8_STAGE
#undef PG8_LDA
#undef PG8_LDB
#undef PG8_MMA
#undef PG8_WAIT_V
#undef PG8_WAIT_L
#undef PG8_BAR
#undef PG8_SCHED
}
}

DI void gemm_prefetch_big(const bf16_t* __restrict__ A, int lda, const bf16_t* __restrict__ B, int ldb, char* smem) {
  const int tid = g_tid();
  const int lr = tid >> 3, lc = (tid & 7) ^ ((tid >> 4) & 7);
  const unsigned aoff = (unsigned)(lr * lda + lc * 8) * 2u, boff = (unsigned)(lr * ldb + lc * 8) * 2u;
  const char* Ac = (const char*)A; const char* Bc = (const char*)B;
  char* sdst = smem + tid * 16;
#pragma unroll
  for (int i = 0; i < 4; ++i) {
    __builtin_amdgcn_global_load_lds((const void*)(Ac + ((size_t)(64 * i) * lda) * 2 + aoff), (lds_ptr_t)(sdst + i * 8192), 16, 0, 0);
    __builtin_amdgcn_global_load_lds((const void*)(Bc + ((size_t)(64 * i) * ldb) * 2 + boff), (lds_ptr_t)(sdst + 32768 + i * 8192), 16, 0, 0);
  }
}

DI void row_info(int r, int& b, int& pos, bool& isctx) {
  if (r < T_LAT) { b = r >> 11; pos = r & 2047; isctx = false; } else { const int q = r - T_LAT; b = q >> 8; pos = q & 255; isctx = true; }
}

constexpr int HALF_LDS = 65792;
DI void conv_tile(bool active, const float* __restrict__ src, int ld, int k0, int c0, bf16_t* __restrict__ dst, int dstld, int ilv  , int n0, char* smem) {
  float* s = (float*)smem;
  const int tid = g_tid() & 255;
  if (active) {
#pragma unroll
    for (int i = 0; i < 4; ++i) {
      const int k = (tid >> 4) + 16 * i, cc = (tid & 15) * 4;
      const f32x4 v = *(const f32x4*)(src + (size_t)(k0 + k) * ld + c0 + n0 + cc);
      s[k * 65 + cc] = v[0]; s[k * 65 + cc + 1] = v[1]; s[k * 65 + cc + 2] = v[2]; s[k * 65 + cc + 3] = v[3];
    }
  }
  __syncthreads();
  if (active) {
    const int n = tid >> 2, kq = (tid & 3) * 16;
    unsigned w[8];
#pragma unroll
    for (int j = 0; j < 8; ++j) w[j] = pk2(s[(kq + 2 * j) * 65 + n], s[(kq + 2 * j + 1) * 65 + n]);
    const int ng = n0 + n;
    size_t drow = ng;
    if (ilv) drow = (size_t)(ng >> 4) * 32 + (ng & 15) + (ilv == 2 ? 16 : 0);
    bf16_t* dp = dst + drow * dstld + k0 + kq;
    *(u32x4*)dp = (u32x4){w[0], w[1], w[2], w[3]};
    *(u32x4*)(dp + 8) = (u32x4){w[4], w[5], w[6], w[7]};
  }
  __syncthreads();
}
DI void fold_tile(bool active, const float* __restrict__ src  , int cbase, int k0, int np0  , int mode, const float* __restrict__ wgrp,
                  const float* __restrict__ pscale, bf16_t* __restrict__ dst  , char* smem) {
  float* sA = (float*)smem;
  float* sT = (float*)(smem + 33024);
  const int tid = g_tid() & 255;
  if (active) {
    for (int i = tid; i < 64 * 32; i += 256) {
      const int k = i >> 5, c4 = (i & 31) * 4;
      const f32x4 v = *(const f32x4*)(src + (size_t)(k0 + k) * N_IN + cbase + c4);
      sA[k * 129 + c4] = v[0]; sA[k * 129 + c4 + 1] = v[1]; sA[k * 129 + c4 + 2] = v[2]; sA[k * 129 + c4 + 3] = v[3];
    }
    for (int i = tid; i < 128 * 64; i += 256) {
      const int c = i >> 6, n = i & 63, np = np0 + n;
      float t;
      if (mode == 2) t = wgrp[c * 128 + np] * pscale[np];
      else { const float r = (float)((c * np) & 127) * (1.0f / 128.0f); t = (mode == 0) ? hw_cos_rev(r) : hw_sin_rev(r); }
      sT[c * 64 + n] = t;
    }
  }
  __syncthreads();
  if (active) {
    const int ty = tid >> 4, tx = tid & 15;
    float acc[4][4];
#pragma unroll
    for (int a = 0; a < 4; ++a)
#pragma unroll
      for (int b = 0; b < 4; ++b) acc[a][b] = 0.f;
    for (int c = 0; c < 128; ++c) {
      const f32x4 t4 = *(const f32x4*)(sT + c * 64 + tx * 4);
      float a4[4];
#pragma unroll
      for (int a = 0; a < 4; ++a) a4[a] = sA[(ty * 4 + a) * 129 + c];
#pragma unroll
      for (int a = 0; a < 4; ++a)
#pragma unroll
        for (int b = 0; b < 4; ++b) acc[a][b] += a4[a] * t4[b];
    }
#pragma unroll
    for (int b = 0; b < 4; ++b) {
      bf16_t* dp = dst + (size_t)(np0 + tx * 4 + b) * 1024 + k0 + ty * 4;
      *(u32x2*)dp = (u32x2){pk2(acc[0][b], acc[1][b]), pk2(acc[2][b], acc[3][b])};
    }
  }
  __syncthreads();
}

constexpr int CONV_TOTAL = 16 * 48 * 2 + 16 * 16 + 8 * 16 * 2 + 16 * 16 + 16 * 44 * 2 + 44 * 16 + 256 + 128;
DI void convert_iter(const Params& p, int l, int tb, char* smem0) {
  bf16_t* W = (bf16_t*)(p.ws + w_off(l));
  const float* win = p.w_in + (size_t)l * 1024 * N_IN;
  const int half = g_tid() >> 8;
  char* smem = smem0 + half * HALF_LDS;
  constexpr int C0 = 16 * 48, C1 = C0 + 16 * 48, C2 = C1 + 16 * 16, C3 = C2 + 8 * 16, C4 = C3 + 8 * 16, C5 = C4 + 16 * 16, C6 = C5 + 16 * 44, C7 = C6 + 16 * 44,
                C8 = C7 + 44 * 16, C9 = C8 + 256, C10 = C9 + 128;
  static_assert((C0 | C1 | C2 | C3 | C4 | C5 | C6 | C7 | C8 | C9 | C10) % 2 == 0, "segment boundaries must be even");
  const int total = C10;
  static_assert(C10 == CONV_TOTAL, "conversion tile count");
  {
    const bool active = (tb + half) < total;
    const int t = active ? tb + half : tb;
    int seg, r;
    if (t < C0) { seg = 0; r = t; } else if (t < C1) { seg = 1; r = t - C0; } else if (t < C2) { seg = 2; r = t - C1; } else if (t < C3) { seg = 3; r = t - C2; }
    else if (t < C4) { seg = 4; r = t - C3; } else if (t < C5) { seg = 5; r = t - C4; } else if (t < C6) { seg = 6; r = t - C5; } else if (t < C7) { seg = 7; r = t - C6; }
    else if (t < C8) { seg = 8; r = t - C7; } else if (t < C9) { seg = 9; r = t - C8; } else { seg = 10; r = t - C9; }
    if (seg <= 8) {
      const float* src; int ld, kt, nt, c0 = 0, dstld, ilv = 0; bf16_t* dst;
      if (seg <= 1) { kt = r & 15; nt = r >> 4; src = win; ld = N_IN; c0 = seg == 0 ? 0 : 4096; dst = W + WO_WIN + (seg == 0 ? 0 : (size_t)ROW_G * 1024); dstld = 1024; }
      else if (seg == 2) { kt = r & 15; nt = r >> 4; src = p.w_att_br + (size_t)l * 1024 * 1024; ld = 1024; dst = W + WO_WA; dstld = 1024; }
      else if (seg == 3) { kt = r & 7; nt = r >> 3; src = p.w_four_br + (size_t)l * 512 * 1024; ld = 1024; dst = W + WO_WF; dstld = 512; }
      else if (seg == 4) { kt = r & 7; nt = r >> 3; src = p.w_pool_br + (size_t)l * 512 * 1024; ld = 1024; dst = W + WO_WP; dstld = 512; }
      else if (seg == 5) { kt = r & 15; nt = r >> 4; src = p.w_out + (size_t)l * 1024 * 1024; ld = 1024; dst = W + WO_WO; dstld = 1024; }
      else if (seg == 6) { kt = r & 15; nt = r >> 4; src = p.w_ffn_gate + (size_t)l * 1024 * DFF; ld = DFF; dst = W + WO_WGU; dstld = 1024; ilv = 1; }
      else if (seg == 7) { kt = r & 15; nt = r >> 4; src = p.w_ffn_up + (size_t)l * 1024 * DFF; ld = DFF; dst = W + WO_WGU; dstld = 1024; ilv = 2; }
      else { kt = r % 44; nt = r / 44; src = p.w_ffn_down + (size_t)l * DFF * 1024; ld = 1024; dst = W + WO_WD; dstld = DFF; }
      conv_tile(active, src, ld, kt * 64, c0, dst, dstld, ilv, nt * 64, smem);
    } else if (seg == 9) {
      const int kt = r & 15, q = r >> 4; const int g = q & 3, hf = (q >> 2) & 1, mode = q >> 3;
      fold_tile(active, win, 3072 + g * 128, kt * 64, hf * 64, mode, nullptr, nullptr, W + WO_WIN + (size_t)((mode ? ROW_Z2 : ROW_Z1) + g * 128) * 1024, smem);
    } else {
      const int kt = r & 15, q = r >> 4; const int g = q & 3, hf = q >> 2;
      fold_tile(active, win, 3584 + g * 128, kt * 64, hf * 64, 2, p.w_pool_grp + ((size_t)l * 4 + g) * 128 * 128, p.pool_scale + (size_t)l * 512 + g * 128,
                W + WO_WIN + (size_t)(ROW_R + g * 128) * 1024, smem);
    }
  }
}

DI void convert_layer(const Params& p, int l, char* smem) {
  for (int tb = blockIdx.x * 2; tb < CONV_TOTAL; tb += gridDim.x * 2) convert_iter(p, l, tb, smem);
}

DI void convert_grab(const Params& p, int l, int which  , char* smem) {
  unsigned* ctr = (unsigned*)(p.ws + OFF_CTR) + l * 2 + which;
  volatile __attribute__((address_space(3))) unsigned* slot = (volatile __attribute__((address_space(3))) unsigned*)(lds_ptr_t)(smem + 3 * GSTAGE + 8);
  const int lo = which ? 2400 : 0, hi = which ? CONV_TOTAL : 2400;
  for (;;) {
    __syncthreads();
    if (__builtin_amdgcn_workitem_id_x() == 0) *slot = __hip_atomic_fetch_add(ctr, 2u, __ATOMIC_RELAXED, __HIP_MEMORY_SCOPE_AGENT);
    __syncthreads();
    const int tb = lo + (int)*slot;
    if (tb >= hi) break;
    convert_iter(p, l, tb, smem);
  }
  __syncthreads();
}

DI void phase0a(const Params& p, char* smem) {
  const int tid = g_tid();
  const int gtid = blockIdx.x * 512 + tid, gsz = gridDim.x * 512;
  {
    const int half = tid >> 8, t8 = tid & 255;
    float* ssil = (float*)smem;
    float* sred = (float*)(smem + 36864 + half * 9216);
    bool filled = false;
    float* modv = (float*)(p.ws + OFF_MODV);
    for (int tb = blockIdx.x * 2; tb < DEPTH * 96; tb += gridDim.x * 2) {
      if (!filled) {
        for (int i = tid; i < 9 * 1024; i += 512) { const float v = (i < 8192) ? p.c[i] : p.c_ctx[i - 8192]; ssil[i] = v * sigmoidf_(v); }
        filled = true;
        __syncthreads();
      }
      const int t = tb + half;
      const int l = t / 96, cgp = t % 96;
      const int col = cgp * 64 + (t8 & 63), kq = t8 >> 6;
      const float* wp = p.w_mod + ((size_t)l * 1024 + kq * 256) * 6144 + col;
      float a[9];
#pragma unroll
      for (int r = 0; r < 9; ++r) a[r] = 0.f;
#pragma unroll 4
      for (int k = 0; k < 256; ++k) {
        const float w = wp[(size_t)k * 6144];
#pragma unroll
        for (int r = 0; r < 9; ++r) a[r] += ssil[r * 1024 + kq * 256 + k] * w;
      }
#pragma unroll
      for (int r = 0; r < 9; ++r) sred[(kq * 9 + r) * 64 + (t8 & 63)] = a[r];
      __syncthreads();
      for (int i = t8; i < 9 * 64; i += 256) {
        const int r = i >> 6, cc = i & 63;
        const float v = sred[(0 * 9 + r) * 64 + cc] + sred[(1 * 9 + r) * 64 + cc] + sred[(2 * 9 + r) * 64 + cc] + sred[(3 * 9 + r) * 64 + cc];
        modv[((size_t)l * 9 + r) * 6144 + cgp * 64 + cc] = v + p.b_mod[(size_t)l * 6144 + cgp * 64 + cc];
      }
      __syncthreads();
    }
    __syncthreads();
  }
  convert_layer(p, 0, smem);
  {
    bf16_t* at = (bf16_t*)(p.ws + OFF_ATAB);
    for (int i = gtid; i < 2048 * 512; i += gsz) {
      const int k = i >> 9, c8 = (i & 511) * 8;
      unsigned w[4];
#pragma unroll
      for (int j = 0; j < 4; ++j) {
        float v[2];
#pragma unroll
        for (int e = 0; e < 2; ++e) {
          const int tp = c8 + 2 * j + e; const int tt = tp & 2047;
          const float r = (float)((k * tt) & 2047) * (1.0f / 2048.0f);
          v[e] = (tp < 2048) ? hw_cos_rev(r) : -hw_sin_rev(r);
        }
        w[j] = pk2(v[0], v[1]);
      }
      *(u32x4*)(at + (size_t)k * 4096 + c8) = (u32x4){w[0], w[1], w[2], w[3]};
    }
    bf16_t* atc = (bf16_t*)(p.ws + OFF_ATABC);
    for (int i = gtid; i < 256 * 64; i += gsz) {
      const int k = i >> 6, c8 = (i & 63) * 8;
      unsigned w[4];
#pragma unroll
      for (int j = 0; j < 4; ++j) {
        float v[2];
#pragma unroll
        for (int e = 0; e < 2; ++e) {
          const int tp = c8 + 2 * j + e; const int tt = tp & 255;
          const float r = (float)((k * tt) & 255) * (1.0f / 256.0f);
          v[e] = (tp < 256) ? hw_cos_rev(r) : -hw_sin_rev(r);
        }
        w[j] = pk2(v[0], v[1]);
      }
      *(u32x4*)(atc + (size_t)k * 512 + c8) = (u32x4){w[0], w[1], w[2], w[3]};
    }
  }
  {
    float* rc = (float*)(p.ws + OFF_ROPEC); float* rs = (float*)(p.ws + OFF_ROPES);
    for (int i = gtid; i < 2048 * 32; i += gsz) {
      const int t = i >> 5, a = i & 31, f = a & 15;
      const float pos = (float)((a < 16) ? (t >> 6) : (t & 63));
      const float inv = exp2f(-(float)f * (13.287712379549449f / 16.0f));
      float r = pos * inv * 0.15915494309189535f;
      r -= floorf(r);
      rc[i] = hw_cos_rev(r); rs[i] = hw_sin_rev(r);
    }
  }
  if (gtid < DEPTH) {
    const float* lq = p.lam_qk + (size_t)gtid * 256;
    float s1 = 0.f, s2 = 0.f;
    for (int i = 0; i < 64; ++i) { s1 += lq[i] * lq[64 + i]; s2 += lq[128 + i] * lq[192 + i]; }
    ((float*)(p.ws + OFF_LAMV))[gtid] = expf(s1) - expf(s2) + p.lam_init[gtid];
  }
}

DI void ln_pass(const Params& p, int mode, int nrows, const bf16_t* __restrict__ Yb, const float* __restrict__ lng, const float* __restrict__ lnb,
                        int modl_gate, int gate_chunk, int modl_next, int sh_chunk) {
  const int lane = g_tid() & 63, wid = g_tid() >> 6;
  float* X = (float*)(p.ws + OFF_X);
  bf16_t* U = (bf16_t*)(p.ws + OFF_U);
  const float* modv = (const float*)(p.ws + OFF_MODV);
  f32x4 xv[4], xn[4]; u32x2 yv[4], yn[4];
  const int r0 = blockIdx.x * 8 + wid, rstride = gridDim.x * 8;
  if (mode != 0 && r0 < nrows) {
#pragma unroll
    for (int i = 0; i < 4; ++i) { xv[i] = *(const f32x4*)(X + (size_t)r0 * 1024 + lane * 4 + 256 * i); yv[i] = *(const u32x2*)(Yb + (size_t)r0 * 1024 + lane * 4 + 256 * i); }
  }
  for (int r = r0; r < nrows; r += rstride) {
    int b, pos; bool isctx; row_info(r, b, pos, isctx);
    const int mr = isctx ? 8 : b;
    f32x4 v[4];
    if (mode == 0) {
      const float* src = isctx ? (p.ctx + (size_t)(r - T_LAT) * 1024) : (p.x + (size_t)r * 1024);
#pragma unroll
      for (int i = 0; i < 4; ++i) v[i] = *(const f32x4*)(src + lane * 4 + 256 * i);
#pragma unroll
      for (int i = 0; i < 4; ++i) *(f32x4*)(X + (size_t)r * 1024 + lane * 4 + 256 * i) = v[i];
    } else {
      const int rn = r + rstride;
      if (rn < nrows) {
#pragma unroll
        for (int i = 0; i < 4; ++i) { xn[i] = *(const f32x4*)(X + (size_t)rn * 1024 + lane * 4 + 256 * i); yn[i] = *(const u32x2*)(Yb + (size_t)rn * 1024 + lane * 4 + 256 * i); }
      }
      const float* gv = modv + ((size_t)modl_gate * 9 + mr) * 6144 + gate_chunk * 1024;
      float s = 0.f;
#pragma unroll
      for (int i = 0; i < 4; ++i) {
        const int col = lane * 4 + 256 * i;
        const f32x4 g = *(const f32x4*)(gv + col);
        v[i][0] = ALPHA * xv[i][0] + g[0] * bf_lo(yv[i][0]); v[i][1] = ALPHA * xv[i][1] + g[1] * bf_hi(yv[i][0]);
        v[i][2] = ALPHA * xv[i][2] + g[2] * bf_lo(yv[i][1]); v[i][3] = ALPHA * xv[i][3] + g[3] * bf_hi(yv[i][1]);
        s += (v[i][0] + v[i][1]) + (v[i][2] + v[i][3]);
      }
#pragma unroll
      for (int i = 0; i < 4; ++i) { xv[i] = xn[i]; yv[i] = yn[i]; }
      const float mu = wave_sum(s) * (1.0f / 1024.0f);
      float q = 0.f;
#pragma unroll
      for (int i = 0; i < 4; ++i) { const f32x4 d = v[i] - mu; q += (d[0] * d[0] + d[1] * d[1]) + (d[2] * d[2] + d[3] * d[3]); }
      const float rstd = rsqrtf(wave_sum(q) * (1.0f / 1024.0f) + LN_EPS);
#pragma unroll
      for (int i = 0; i < 4; ++i) {
        const int col = lane * 4 + 256 * i;
        const f32x4 g = *(const f32x4*)(lng + col), bb = *(const f32x4*)(lnb + col);
        v[i] = (v[i] - mu) * rstd * g + bb;
        if (mode == 2) *(f32x4*)(p.out + (size_t)r * 1024 + col) = v[i];
        else *(f32x4*)(X + (size_t)r * 1024 + col) = v[i];
      }
    }
    if (mode != 2) {
      float s = 0.f;
#pragma unroll
      for (int i = 0; i < 4; ++i) s += (v[i][0] + v[i][1]) + (v[i][2] + v[i][3]);
      const float mu = wave_sum(s) * (1.0f / 1024.0f);
      float q = 0.f;
#pragma unroll
      for (int i = 0; i < 4; ++i) { const f32x4 d = v[i] - mu; q += (d[0] * d[0] + d[1] * d[1]) + (d[2] * d[2] + d[3] * d[3]); }
      const float rstd = rsqrtf(wave_sum(q) * (1.0f / 1024.0f) + LN_EPS);
      const float* shv = modv + ((size_t)modl_next * 9 + mr) * 6144 + sh_chunk * 1024;
      const float* scv = shv + 1024;
#pragma unroll
      for (int i = 0; i < 4; ++i) {
        const int col = lane * 4 + 256 * i;
        const f32x4 sh = *(const f32x4*)(shv + col), sc = *(const f32x4*)(scv + col);
        const f32x4 u = (v[i] - mu) * rstd * (sc + 1.0f) + sh;
        *(u32x2*)(U + (size_t)r * 1024 + col) = (u32x2){pk2(u[0], u[1]), pk2(u[2], u[3])};
      }
    }
  }
}

DI bool tile_map(int v, int nmt, int nnt, int& mt, int& nt) {
  const int c = v >> 8, w = v & 255, xcd = w & 7, local = w >> 3;
  const int spr = nnt >> 2, nsup = (nmt >> 3) * spr, sup = c * 8 + xcd;
  if (sup >= nsup) return false;
  mt = (sup / spr) * 8 + (local & 7); nt = (sup % spr) * 4 + (local >> 3);
  return true;
}
DI int tile_vmax(int nmt, int nnt) { const int nsup = (nmt >> 3) * (nnt >> 2); return ((nsup + 7) >> 3) << 8; }

DI void phase_inproj(const Params& p, int l, char* smem) {
  const bool last = (l == DEPTH - 1);
  const bf16_t* W = (const bf16_t*)(p.ws + w_off(l)) + WO_WIN;
  const bf16_t* U = (const bf16_t*)(p.ws + OFF_U);
  bf16_t* KB = (bf16_t*)(p.ws + OFF_KB); bf16_t* VT = (bf16_t*)(p.ws + OFF_VT); bf16_t* QB = (bf16_t*)(p.ws + OFF_QB); bf16_t* CQ = (bf16_t*)(p.ws + OFF_CQ);
  bf16_t* ZT = (bf16_t*)(p.ws + OFF_ZT); bf16_t* ZTC = (bf16_t*)(p.ws + OFF_ZTC); bf16_t* R = (bf16_t*)(p.ws + OFF_R);
  const float* ropec = (const float*)(p.ws + OFF_ROPEC); const float* ropes = (const float*)(p.ws + OFF_ROPES);
  const int nsupA = last ? 72 : 81, nsup = last ? 76 : 81;
  const int vmax = ((nsup + 15) >> 4) << 8;
  auto map_tile = [&](int v, int& mt, int& nt) -> bool {
    if (v >= vmax) return false;
    const int c = v >> 8, w = v & 255, local = w >> 3, sup = (c * 8 + (w & 7)) * 2 + (local >> 4);
    if (sup >= nsup) return false;
    if (sup < nsupA) { mt = (sup / 9) * 8 + (local & 7); nt = (sup % 9) * 2 + ((local >> 3) & 1); }
    else { mt = 64 + (local & 7); nt = (sup - nsupA) * 2 + ((local >> 3) & 1); }
    return true;
  };
  int v = blockIdx.x, mt = 0, nt = 0;
  bool cur = map_tile(v, mt, nt);
  if (cur) gemm_prefetch_big(U + (size_t)mt * 256 * 1024, 1024, W + (size_t)nt * 256 * 1024, 1024, smem);
  while (cur) {
    const int m0 = mt * 256;
    int b, pos0; bool isctx; row_info(m0, b, pos0, isctx);
    f32x4 acc[8][4];
#pragma unroll
    for (int i = 0; i < 8; ++i)
#pragma unroll
      for (int j = 0; j < 4; ++j) acc[i][j] = (f32x4){0.f, 0.f, 0.f, 0.f};
    const bool swap = !((nt >= 4 && nt < 8) || (nt >= 12 && nt < 16));
    if (swap) gemm_kloop_big<true>(U + (size_t)m0 * 1024, 1024, W + (size_t)nt * 256 * 1024, 1024, 1024, acc, smem, true);
    else gemm_kloop_big<false>(U + (size_t)m0 * 1024, 1024, W + (size_t)nt * 256 * 1024, 1024, 1024, acc, smem, true);
    int v2 = v + gridDim.x, mt2 = 0, nt2 = 0;
    const bool nxt = map_tile(v2, mt2, nt2);
    if (nxt) gemm_prefetch_big(U + (size_t)mt2 * 256 * 1024, 1024, W + (size_t)nt2 * 256 * 1024, 1024, smem);
    const int tid = g_tid(), lane = tid & 63, wid = __builtin_amdgcn_readfirstlane(tid >> 6), wm = wid >> 2, wn = wid & 3;
    const int fq = lane >> 4, fr = lane & 15;
    const int ncol0 = nt * 256 + wn * 64;
    const int prow0 = pos0 + wm * 128;
    if (ncol0 < 1024 || (ncol0 >= 2048 && ncol0 < 3072)) {
      const bool isq = ncol0 >= 2048; const int h = (ncol0 >> 7) & 7, map = (ncol0 >> 6) & 1;
#pragma unroll
      for (int mi = 0; mi < 8; ++mi) {
        const int pos = prow0 + mi * 16 + fr;
        f32x4 o[4];
        if (!isctx) {
#pragma unroll
          for (int pr = 0; pr < 2; ++pr) {
            const f32x4 cs = *(const f32x4*)(ropec + pos * 32 + pr * 16 + fq * 4);
            const f32x4 sn = *(const f32x4*)(ropes + pos * 32 + pr * 16 + fq * 4);
            const f32x4 x0 = acc[mi][2 * pr], x1 = acc[mi][2 * pr + 1];
            o[2 * pr] = x0 * cs - x1 * sn;
            o[2 * pr + 1] = x1 * cs + x0 * sn;
          }
        } else {
#pragma unroll
          for (int ni = 0; ni < 4; ++ni) o[ni] = acc[mi][ni];
        }
        bf16_t* dst;
        if (!isq) dst = KB + ((size_t)((b * 8 + h) * 2 + map) * NKEY + (isctx ? SEQ + pos : pos)) * 64;
        else if (!isctx) dst = QB + ((size_t)((b * 8 + h) * 2 + map) * SEQ + pos) * 64;
        else dst = CQ + ((size_t)((b * 8 + h) * 2 + map) * LC + pos) * 64;
        const float sc = isq ? QSCALE : 1.0f;
#pragma unroll
        for (int ni = 0; ni < 4; ++ni) {
          const f32x4 vv = o[ni] * sc;
          *(u32x2*)(dst + ni * 16 + fq * 4) = (u32x2){pk2(vv[0], vv[1]), pk2(vv[2], vv[3])};
        }
      }
    } else if (ncol0 < 2048) {
      const int h = (ncol0 - 1024) >> 7, vc0 = ncol0 & 127;
#pragma unroll
      for (int mi = 0; mi < 8; ++mi) {
        const int key = (isctx ? SEQ : 0) + prow0 + mi * 16 + fq * 4;
        const int k15 = key & 15;
        const int pkey = (key & ~15) | (k15 & 3) | ((k15 & 4) << 1) | ((k15 & 8) >> 1);
#pragma unroll
        for (int ni = 0; ni < 4; ++ni) {
          const int vcol = vc0 + ni * 16 + fr;
          const f32x4 vv = acc[mi][ni];
          *(u32x2*)(VT + ((size_t)(b * 8 + h) * 128 + vcol) * NKEY + pkey) = (u32x2){pk2(vv[0], vv[1]), pk2(vv[2], vv[3])};
        }
      }
    } else if (ncol0 < 4096) {
#pragma unroll
      for (int mi = 0; mi < 8; ++mi) {
        const int pos = prow0 + mi * 16 + fq * 4;
#pragma unroll
        for (int ni = 0; ni < 4; ++ni) {
          const int zc = ncol0 - 3072 + ni * 16 + fr;
          const int np = zc & 511, second = zc >> 9;
          const f32x4 vv = acc[mi][ni];
          bf16_t* dst = isctx ? (ZTC + ((size_t)b * 512 + np) * 512 + second * 256 + pos) : (ZT + ((size_t)b * 512 + np) * 4096 + second * 2048 + pos);
          *(u32x2*)dst = (u32x2){pk2(vv[0], vv[1]), pk2(vv[2], vv[3])};
        }
      }
    } else {
#pragma unroll
      for (int mi = 0; mi < 8; ++mi) {
        const int row = m0 + wm * 128 + mi * 16 + fr;
#pragma unroll
        for (int ni = 0; ni < 4; ++ni) {
          const int col = ncol0 - 4096 + ni * 16 + fq * 4;
          const f32x4 vv = acc[mi][ni];
          *(u32x2*)(R + (size_t)row * 512 + col) = (u32x2){pk2(vv[0], vv[1]), pk2(vv[2], vv[3])};
        }
      }
    }
    v = v2; mt = mt2; nt = nt2; cur = nxt;
  }
}

DI void attn_unit(const bf16_t* __restrict__ Qb  , int nq, int q0, const bf16_t* __restrict__ Kb  ,
                  const bf16_t* __restrict__ VTb  , int key0, int ntiles  , bf16_t* __restrict__ outp  ,
                  const float* __restrict__ subg, float lam, float nscale, char* smem) {
  const int tid = g_tid(), lane = tid & 63, wid = __builtin_amdgcn_readfirstlane(tid >> 6), wq = wid & 3, map = wid >> 2;
  const int l31 = lane & 31, kh = lane >> 5;
  bf16x8 qf[4];
  {
    const bf16_t* qp = Qb + ((size_t)map * nq + q0 + wq * 32 + l31) * 64 + kh * 8;
#pragma unroll
    for (int s = 0; s < 4; ++s) qf[s] = *(const bf16x8*)(qp + s * 16);
  }
  const int srow = tid >> 3, sc = (tid & 7) ^ ((tid >> 4) & 7);
  const unsigned koff = (unsigned)((key0 + srow) * 64 + sc * 8) * 2u;
  const unsigned voff = (unsigned)(srow * NKEY + key0 + sc * 8) * 2u;
  const char* Kc = (const char*)Kb; const char* Vc = (const char*)VTb;
  char* sdst = smem + tid * 16;
#define A_ISSUE(T) do { char* d_ = sdst + ((T) & 3) * 32768; \
    __builtin_amdgcn_global_load_lds((const void*)(Kc + (size_t)(T) * 8192 + koff), (lds_ptr_t)(d_), 16, 0, 0); \
    __builtin_amdgcn_global_load_lds((const void*)(Kc + (size_t)NKEY * 128 + (size_t)(T) * 8192 + koff), (lds_ptr_t)(d_ + 8192), 16, 0, 0); \
    __builtin_amdgcn_global_load_lds((const void*)(Vc + (size_t)(T) * 128 + voff), (lds_ptr_t)(d_ + 16384), 16, 0, 0); \
    __builtin_amdgcn_global_load_lds((const void*)(Vc + (size_t)64 * NKEY * 2 + (size_t)(T) * 128 + voff), (lds_ptr_t)(d_ + 24576), 16, 0, 0); } while (0)
  f32x16 O[4];
#pragma unroll
  for (int vb = 0; vb < 4; ++vb)
#pragma unroll
    for (int i = 0; i < 16; ++i) O[vb][i] = 0.f;
  float m = 0.f, lsum = 0.f;
  const int sw = (lane >> 1) & 7;
  const int kfo = l31 * 128, cho = kh;
#define A_QK(SX, T) do { const char* st_ = smem + ((T) & 3) * 32768 + map * 8192 + kfo; \
    bf16x8 kf_[8]; \
    _Pragma("unroll") for (int s = 0; s < 4; ++s) _Pragma("unroll") for (int kb = 0; kb < 2; ++kb) \
        kf_[s * 2 + kb] = *(const bf16x8*)(st_ + kb * 4096 + (((2 * s + cho) ^ sw) << 4)); \
    _Pragma("unroll") for (int kb = 0; kb < 2; ++kb) _Pragma("unroll") for (int i = 0; i < 16; ++i) SX[kb][i] = -m; \
    __builtin_amdgcn_sched_barrier(0); \
    _Pragma("unroll") for (int s = 0; s < 4; ++s) _Pragma("unroll") for (int kb = 0; kb < 2; ++kb) \
        SX[kb] = MFMA32(kf_[s * 2 + kb], qf[s], SX[kb]); \
    __builtin_amdgcn_sched_barrier(0); } while (0)
  bf16x8 pf[4];
  auto pv = [&](int T) {
    const char* sv = smem + (T & 3) * 32768 + 16384 + kfo;
    __builtin_amdgcn_sched_barrier(0);
    bf16x8 va[4], vb_[4];
#pragma unroll
    for (int vb = 0; vb < 4; ++vb) va[vb] = *(const bf16x8*)(sv + vb * 4096 + (((0 + cho) ^ sw) << 4));
#pragma unroll
    for (int vb = 0; vb < 4; ++vb) vb_[vb] = *(const bf16x8*)(sv + vb * 4096 + (((2 + cho) ^ sw) << 4));
    __builtin_amdgcn_sched_barrier(0);
#pragma unroll
    for (int vb = 0; vb < 4; ++vb) O[vb] = MFMA32(va[vb], pf[0], O[vb]);
    __builtin_amdgcn_sched_barrier(0);
#pragma unroll
    for (int vb = 0; vb < 4; ++vb) va[vb] = *(const bf16x8*)(sv + vb * 4096 + (((4 + cho) ^ sw) << 4));
    __builtin_amdgcn_sched_barrier(0);
#pragma unroll
    for (int vb = 0; vb < 4; ++vb) O[vb] = MFMA32(vb_[vb], pf[1], O[vb]);
    __builtin_amdgcn_sched_barrier(0);
#pragma unroll
    for (int vb = 0; vb < 4; ++vb) vb_[vb] = *(const bf16x8*)(sv + vb * 4096 + (((6 + cho) ^ sw) << 4));
    __builtin_amdgcn_sched_barrier(0);
#pragma unroll
    for (int vb = 0; vb < 4; ++vb) O[vb] = MFMA32(va[vb], pf[2], O[vb]);
    __builtin_amdgcn_sched_barrier(0);
#pragma unroll
    for (int vb = 0; vb < 4; ++vb) O[vb] = MFMA32(vb_[vb], pf[3], O[vb]);
    __builtin_amdgcn_sched_barrier(0);
  };
  auto softmax = [&](f32x16 (&SC)[2], f32x16 (&SN)[2], bool has_next, bool first) {
    float mx[16];
#pragma unroll
    for (int i = 0; i < 16; ++i) mx[i] = fmaxf(SC[0][i], SC[1][i]);
#pragma unroll
    for (int w = 8; w >= 1; w >>= 1)
#pragma unroll
      for (int i = 0; i < w; ++i) mx[i] = fmaxf(mx[i], mx[i + w]);
    float tmax = xor32_max(mx[0]);
    if (first || __any(tmax > 8.0f)) {
      const float delta = first ? tmax : fmaxf(tmax, 0.f);
      const float alpha = first ? 1.0f : __builtin_amdgcn_exp2f(-delta);
      m += delta; lsum *= alpha;
#pragma unroll
      for (int vb = 0; vb < 4; ++vb) O[vb] = O[vb] * alpha;
#pragma unroll
      for (int kb = 0; kb < 2; ++kb)
#pragma unroll
        for (int i = 0; i < 16; ++i) SC[kb][i] -= delta;
      if (has_next) {
#pragma unroll
        for (int kb = 0; kb < 2; ++kb)
#pragma unroll
          for (int i = 0; i < 16; ++i) SN[kb][i] -= delta;
      }
    }
    float sm[16];
#pragma unroll
    for (int i = 0; i < 16; ++i) { const float e0 = __builtin_amdgcn_exp2f(SC[0][i]), e1 = __builtin_amdgcn_exp2f(SC[1][i]); SC[0][i] = e0; SC[1][i] = e1; sm[i] = e0 + e1; }
#pragma unroll
    for (int w = 8; w >= 1; w >>= 1)
#pragma unroll
      for (int i = 0; i < w; ++i) sm[i] += sm[i + w];
    lsum += sm[0];
#pragma unroll
    for (int g = 0; g < 4; ++g) {
      const int kb = g >> 1, s2 = g & 1;
      u32x4 w;
      w[0] = pk2(SC[kb][8 * s2 + 0], SC[kb][8 * s2 + 1]); w[1] = pk2(SC[kb][8 * s2 + 2], SC[kb][8 * s2 + 3]);
      w[2] = pk2(SC[kb][8 * s2 + 4], SC[kb][8 * s2 + 5]); w[3] = pk2(SC[kb][8 * s2 + 6], SC[kb][8 * s2 + 7]);
      pf[g] = __builtin_bit_cast(bf16x8, w);
    }
  };
  f32x16 Sa[2], Sb[2];
  if (wid >= 4) __builtin_amdgcn_s_setprio(1);
  WAIT_VM(0);
  A_ISSUE(0); A_ISSUE(1); A_ISSUE(2);
  WAIT_VM(8);
  __builtin_amdgcn_s_barrier();
  asm volatile("" ::: "memory");
  A_QK(Sa, 0);
  for (int t = 0; t < ntiles; t += 2) {
    if (t + 2 < ntiles) WAIT_VM(4); else WAIT_VM(0);
    __builtin_amdgcn_s_barrier();
    asm volatile("" ::: "memory");
    if (t + 3 < ntiles) A_ISSUE(t + 3);
    A_QK(Sb, t + 1);
    softmax(Sa, Sb, true, t == 0);
    pv(t);
    const bool nx = (t + 2 < ntiles);
    if (nx) { if (t + 3 < ntiles) WAIT_VM(4); else WAIT_VM(0); }
    __builtin_amdgcn_s_barrier();
    asm volatile("" ::: "memory");
    if (t + 4 < ntiles) A_ISSUE(t + 4);
    if (nx) A_QK(Sa, t + 2);
    softmax(Sb, Sa, nx, false);
    pv(t + 1);
  }
  __builtin_amdgcn_s_setprio(0);
  asm volatile("s_waitcnt lgkmcnt(0)" ::: "memory");
  __builtin_amdgcn_s_barrier();
  asm volatile("" ::: "memory");
#undef A_ISSUE
#undef A_QK
  const float ltot = xor32_sum(lsum);
  const float inv = 1.0f / ltot;
  float* ex = (float*)smem;
  if (map == 1) {
#pragma unroll
    for (int vb = 0; vb < 4; ++vb)
#pragma unroll
      for (int g4 = 0; g4 < 4; ++g4) {
        f32x4 v = {O[vb][4 * g4] * inv, O[vb][4 * g4 + 1] * inv, O[vb][4 * g4 + 2] * inv, O[vb][4 * g4 + 3] * inv};
        *(f32x4*)(ex + (wq * 32 + l31) * 132 + vb * 32 + 8 * g4 + 4 * kh) = v;
      }
  }
  __syncthreads();
  if (map == 0) {
    float ss = 0.f;
#pragma unroll
    for (int vb = 0; vb < 4; ++vb)
#pragma unroll
      for (int g4 = 0; g4 < 4; ++g4) {
        const f32x4 o2 = *(const f32x4*)(ex + (wq * 32 + l31) * 132 + vb * 32 + 8 * g4 + 4 * kh);
#pragma unroll
        for (int j = 0; j < 4; ++j) { const float o = O[vb][4 * g4 + j] * inv - lam * o2[j]; O[vb][4 * g4 + j] = o; ss += o * o; }
      }
    ss = xor32_sum(ss);
    const float rs = rsqrtf(ss * (1.0f / 128.0f) + LN_EPS) * nscale;
    bf16_t* op = outp + (size_t)(wq * 32 + l31) * 1024;
#pragma unroll
    for (int vb = 0; vb < 4; ++vb)
#pragma unroll
      for (int g4 = 0; g4 < 4; ++g4) {
        const int vc = vb * 32 + 8 * g4 + 4 * kh;
        const f32x4 g = *(const f32x4*)(subg + vc);
        *(u32x2*)(op + vc) = (u32x2){pk2(O[vb][4 * g4] * rs * g[0], O[vb][4 * g4 + 1] * rs * g[1]), pk2(O[vb][4 * g4 + 2] * rs * g[2], O[vb][4 * g4 + 3] * rs * g[3])};
      }
  }
  __syncthreads();
}

template <int MI>
DI void store_tile_bf16(const f32x4 (&acc)[MI][4], bf16_t* __restrict__ C, int ldc, float scale) {
  const int tid = g_tid(), lane = tid & 63, wid = __builtin_amdgcn_readfirstlane(tid >> 6), wm = wid >> 1, wn = wid & 1, fq = lane >> 4, fr = lane & 15;
#pragma unroll
  for (int mi = 0; mi < MI; ++mi)
#pragma unroll
    for (int ni = 0; ni < 4; ++ni) {
      const f32x4 v = acc[mi][ni] * scale;
      *(u32x2*)(C + (size_t)(wm * 16 * MI + mi * 16 + fr) * ldc + wn * 64 + ni * 16 + fq * 4) = (u32x2){pk2(v[0], v[1]), pk2(v[2], v[3])};
    }
}

template <int W>
DI void pool_rows(const bf16_t* __restrict__ R, bf16_t* __restrict__ PM, int m0, int g, int rhalf, int lane) {
  constexpr int LO = W / 2;
  const int col = g * 128 + (lane & 15) * 8;
#pragma unroll 2
  for (int ps = 0; ps < 8; ++ps) {
    const int row = m0 + ps * 8 + rhalf * 4 + (lane >> 4);
    int b, pos; bool isctx; row_info(row, b, pos, isctx);
    const int L = isctx ? LC : SEQ;
    const int rbase = row - pos;
    float s[8];
#pragma unroll
    for (int j = 0; j < 8; ++j) s[j] = 0.f;
    int cnt = 0;
    u32x4 self = {0u, 0u, 0u, 0u};
#pragma unroll
    for (int k = 0; k < W; ++k) {
      const int q = pos - LO + k;
      const bool ok = (q >= 0) && (q < L);
      const int qc = ok ? q : pos;
      const u32x4 v = *(const u32x4*)(R + (size_t)(rbase + qc) * 512 + col);
      const float f = ok ? 1.0f : 0.0f;
      cnt += ok ? 1 : 0;
#pragma unroll
      for (int j = 0; j < 4; ++j) { s[2 * j] += f * bf_lo(v[j]); s[2 * j + 1] += f * bf_hi(v[j]); }
      if (k == LO) self = v;
    }
    const float ic = 1.0f / (float)cnt;
    u32x4 o;
#pragma unroll
    for (int j = 0; j < 4; ++j) o[j] = pk2(s[2 * j] * ic - bf_lo(self[j]), s[2 * j + 1] * ic - bf_hi(self[j]));
    *(u32x4*)(PM + (size_t)row * 512 + col) = o;
  }
}
DI void pool_task(const bf16_t* __restrict__ R, bf16_t* __restrict__ PM, int m0) {
  const int tid = g_tid(), lane = tid & 63, wid = __builtin_amdgcn_readfirstlane(tid >> 6), g = wid & 3, rhalf = wid >> 2;
  if (g == 0) pool_rows<2>(R, PM, m0, 0, rhalf, lane);
  else if (g == 1) pool_rows<4>(R, PM, m0, 1, rhalf, lane);
  else if (g == 2) pool_rows<8>(R, PM, m0, 2, rhalf, lane);
  else pool_rows<16>(R, PM, m0, 3, rhalf, lane);
}

DI void phase_mix(const Params& p, int l, char* smem) {
  const bool last = (l == DEPTH - 1);
  const bf16_t* KB = (const bf16_t*)(p.ws + OFF_KB); const bf16_t* VT = (const bf16_t*)(p.ws + OFF_VT);
  const bf16_t* QB = (const bf16_t*)(p.ws + OFF_QB); const bf16_t* CQ = (const bf16_t*)(p.ws + OFF_CQ);
  const bf16_t* ZT = (const bf16_t*)(p.ws + OFF_ZT); const bf16_t* ZTC = (const bf16_t*)(p.ws + OFF_ZTC); const bf16_t* R = (const bf16_t*)(p.ws + OFF_R);
  bf16_t* ATT = (bf16_t*)(p.ws + OFF_ATT); bf16_t* FM = (bf16_t*)(p.ws + OFF_FM); bf16_t* PM = (bf16_t*)(p.ws + OFF_PM);
  const bf16_t* ATAB = (const bf16_t*)(p.ws + OFF_ATAB); const bf16_t* ATABC = (const bf16_t*)(p.ws + OFF_ATABC);
  const float lam = ((const float*)(p.ws + OFF_LAMV))[l];
  const float nscale = 1.0f - p.lam_init[l];
  const float* subg = p.subln_g + (size_t)l * 128;
  for (int r = blockIdx.x; r < 1024; r += gridDim.x) {
    const int c = r >> 8, w = r & 255, xcd = w & 7, local = w >> 3;
    const int bh = c * 16 + xcd * 2 + (local >> 4), qb = local & 15;
    const int b = bh >> 3, h = bh & 7;
    attn_unit(QB + (size_t)bh * 2 * SEQ * 64, SEQ, qb * 128, KB + (size_t)bh * 2 * NKEY * 64, VT + (size_t)bh * 128 * NKEY, 0, NKEY / 64,
              ATT + ((size_t)b * SEQ + qb * 128) * 1024 + h * 128, subg, lam, nscale, smem);
  }
  const int G = gridDim.x, nlo = G >> 1, nhi = G - nlo;
  if ((int)blockIdx.x < nlo) {
    for (int d = blockIdx.x; d < 128; d += nlo) {
      const int b = d & 7, local = d >> 3, mt = local & 3, nt = local >> 2;
      const bf16_t* Ab = ATAB + (size_t)mt * 256 * 4096; const bf16_t* Bb = ZT + ((size_t)b * 512 + nt * 128) * 4096;
      f32x4 accP[4][4], accQ[4][4]; zero_acc(accP); zero_acc(accQ);
      gemm_kloop_pp<true>(Ab, 4096, Bb, 4096, 2048, accP, smem);
      gemm_kloop_pp<true>(Ab + 2048, 4096, Bb + 2048, 4096, 2048, accQ, smem);
      const int tid = g_tid(), lane = tid & 63, wid = __builtin_amdgcn_readfirstlane(tid >> 6), wm = wid >> 1, wn = wid & 1, fq = lane >> 4, fr = lane & 15;
#pragma unroll
      for (int mi = 0; mi < 4; ++mi) {
        const int k = mt * 256 + wm * 64 + mi * 16 + fr;
#pragma unroll
        for (int ni = 0; ni < 4; ++ni) {
          const int col = nt * 128 + wn * 64 + ni * 16 + fq * 4;
          const f32x4 y1 = (accP[mi][ni] + accQ[mi][ni]) * (1.0f / 512.0f), y2 = (accP[mi][ni] - accQ[mi][ni]) * (1.0f / 512.0f);
          *(u32x2*)(FM + ((size_t)b * SEQ + k) * 512 + col) = (u32x2){pk2(y1[0], y1[1]), pk2(y1[2], y1[3])};
          if (k > 0) *(u32x2*)(FM + ((size_t)b * SEQ + (SEQ - k)) * 512 + col) = (u32x2){pk2(y2[0], y2[1]), pk2(y2[2], y2[3])};
        }
      }
    }
  } else {
    const int n_cattn = last ? 0 : 128, n_cdft = last ? 0 : 32, n_pool = last ? 256 : 288, n_mid = 64;
    const int n_small = n_cattn + n_cdft + n_pool + n_mid;
    for (int t = (int)blockIdx.x - nlo; t < n_small; t += nhi) {
      int r = t;
      if (r < n_cattn) {
        const int bh = r >> 1, qb = r & 1, b = bh >> 3, h = bh & 7;
        attn_unit(CQ + (size_t)bh * 2 * LC * 64, LC, qb * 128, KB + (size_t)bh * 2 * NKEY * 64, VT + (size_t)bh * 128 * NKEY, SEQ, LC / 64,
                  ATT + ((size_t)T_LAT + b * LC + qb * 128) * 1024 + h * 128, subg, lam, nscale, smem);
        continue;
      }
      r -= n_cattn;
      if (r < n_cdft) {
        const int b = r >> 2, nt = r & 3;
        f32x4 acc[4][4]; zero_acc(acc);
        gemm_kloop_pp<true>(ATABC, 512, ZTC + ((size_t)b * 512 + nt * 128) * 512, 512, 512, acc, smem);
        store_tile_bf16<4>(acc, FM + ((size_t)T_LAT + b * LC) * 512 + nt * 128, 512, 0.005524271728019903f  );
        continue;
      }
      r -= n_cdft;
      if (r < n_pool) { pool_task(R, PM, r * 64); continue; }
      r -= n_pool;
      {
        const int b = r >> 3, sub = r & 7;
        const int tid = g_tid(), lane = tid & 63, wid = __builtin_amdgcn_readfirstlane(tid >> 6);
#pragma unroll 2
        for (int i = 0; i < 8; ++i) {
          const int n = sub * 64 + wid * 8 + i;
          const bf16_t* zr = ZT + ((size_t)b * 512 + n) * 4096;
          float sacc = 0.f;
#pragma unroll
          for (int j = 0; j < 4; ++j) {
            const u32x4 v = *(const u32x4*)(zr + lane * 8 + 512 * j);
#pragma unroll
            for (int e = 0; e < 4; ++e) sacc += bf_lo(v[e]) - bf_hi(v[e]);
          }
          const float tot = wave_sum(sacc) * (1.0f / 512.0f);
          if (lane == 0) FM[((size_t)b * SEQ + 1024) * 512 + n] = (bf16_t)(pk2(tot, 0.f) & 0xffffu);
        }
      }
    }
  }
}

template <int MI>
DI void phase_branch(const Params& p, int l, char* smem) {
  const bool last = (l == DEPTH - 1);
  const bf16_t* W = (const bf16_t*)(p.ws + w_off(l));
  const bf16_t* U = (const bf16_t*)(p.ws + OFF_U);
  const bf16_t* ATT = (const bf16_t*)(p.ws + OFF_ATT); const bf16_t* FM = (const bf16_t*)(p.ws + OFF_FM); const bf16_t* PM = (const bf16_t*)(p.ws + OFF_PM);
  bf16_t* MOUT = (bf16_t*)(p.ws + OFF_MOUT);
  const int nmt = (last ? T_LAT : T_ALL) / (64 * MI), vmax = tile_vmax(nmt, 8);
  for (int v = blockIdx.x; v < vmax; v += gridDim.x) {
    int mt, nt;
    if (!tile_map(v, nmt, 8, mt, nt)) continue;
    const int m0 = mt * 64 * MI, n0 = nt * 128;
    u32x2 tot[MI][4], gpk[MI][4];
#pragma unroll
    for (int mi = 0; mi < MI; ++mi)
#pragma unroll
      for (int ni = 0; ni < 4; ++ni) tot[mi][ni] = (u32x2){0u, 0u};
#pragma unroll 1
    for (int br = 0; br < 3; ++br) {
      __builtin_amdgcn_sched_barrier(0);
      f32x4 acc[MI][4]; zero_acc_t<MI>(acc);
      const bool pre = !last && br == 0 && (m0 + 64 * MI <= G8_ROWS);
      if (!pre) {
        gemm_kloop_pp<true, MI>(U + (size_t)m0 * 1024, 1024, W + WO_WIN + (size_t)(ROW_G + br * 1024 + n0) * 1024, 1024, 1024, acc, smem);
        __builtin_amdgcn_sched_barrier(0);
#pragma unroll
        for (int mi = 0; mi < MI; ++mi)
#pragma unroll
          for (int ni = 0; ni < 4; ++ni) {
            const f32x4 a = acc[mi][ni];
            gpk[mi][ni] = (u32x2){pk2(sigmoidf_(a[0]), sigmoidf_(a[1])), pk2(sigmoidf_(a[2]), sigmoidf_(a[3]))};
          }
      } else {
        const unsigned char* G8 = (const unsigned char*)(p.ws + OFF_G8);
        const int tid_ = g_tid(), lane_ = tid_ & 63, wid_ = __builtin_amdgcn_readfirstlane(tid_ >> 6), wm_ = wid_ >> 1, wn_ = wid_ & 1, fq_ = lane_ >> 4, fr_ = lane_ & 15;
#pragma unroll
        for (int mi = 0; mi < MI; ++mi)
#pragma unroll
          for (int ni = 0; ni < 4; ++ni) {
            const unsigned g = *(const unsigned*)(G8 + (size_t)(m0 + wm_ * 16 * MI + mi * 16 + fr_) * 1024 + n0 + wn_ * 64 + ni * 16 + fq_ * 4);
            gpk[mi][ni] = (u32x2){pk2((float)(g & 255u) * (1.0f / 255.0f), (float)((g >> 8) & 255u) * (1.0f / 255.0f)),
                                  pk2((float)((g >> 16) & 255u) * (1.0f / 255.0f), (float)(g >> 24) * (1.0f / 255.0f))};
          }
      }
      __builtin_amdgcn_sched_barrier(0);
      zero_acc_t<MI>(acc);
      const int K2 = (br == 0) ? 1024 : 512;
      const bf16_t* A2 = (br == 0) ? (ATT + (size_t)m0 * 1024) : ((br == 1 ? FM : PM) + (size_t)m0 * 512);
      const bf16_t* B2 = (br == 0) ? (W + WO_WA + (size_t)n0 * 1024) : (W + (br == 1 ? WO_WF : WO_WP) + (size_t)n0 * 512);
      gemm_kloop_pp<true, MI>(A2, K2, B2, K2, K2, acc, smem);
      __builtin_amdgcn_sched_barrier(0);
#pragma unroll
      for (int mi = 0; mi < MI; ++mi)
#pragma unroll
        for (int ni = 0; ni < 4; ++ni) {
          const f32x4 a = acc[mi][ni]; const u32x2 g = gpk[mi][ni]; const u32x2 tp = tot[mi][ni];
          const float v0 = bf_lo(g[0]) * a[0] + bf_lo(tp[0]), v1 = bf_hi(g[0]) * a[1] + bf_hi(tp[0]);
          const float v2 = bf_lo(g[1]) * a[2] + bf_lo(tp[1]), v3 = bf_hi(g[1]) * a[3] + bf_hi(tp[1]);
          tot[mi][ni] = (u32x2){pk2(v0, v1), pk2(v2, v3)};
        }
    }
    const int tid = g_tid(), lane = tid & 63, wid = __builtin_amdgcn_readfirstlane(tid >> 6), wm = wid >> 1, wn = wid & 1, fq = lane >> 4, fr = lane & 15;
#pragma unroll
    for (int mi = 0; mi < MI; ++mi)
#pragma unroll
      for (int ni = 0; ni < 4; ++ni)
        *(u32x2*)(MOUT + (size_t)(m0 + wm * 16 * MI + mi * 16 + fr) * 1024 + n0 + wn * 64 + ni * 16 + fq * 4) = tot[mi][ni];
  }
}

template <int MI>
DI void phase_gemm_plain(const bf16_t* __restrict__ A, int K, const bf16_t* __restrict__ Bt, bf16_t* __restrict__ C, int nmt, int nnt, char* smem) {
  const int vmax = tile_vmax(nmt, nnt), N = nnt * 128;
  for (int v = blockIdx.x; v < vmax; v += gridDim.x) {
    int mt, nt;
    if (!tile_map(v, nmt, nnt, mt, nt)) continue;
    f32x4 acc[MI][4]; zero_acc_t<MI>(acc);
    gemm_kloop_pp<true, MI>(A + (size_t)mt * 64 * MI * K, K, Bt + (size_t)nt * 128 * K, K, K, acc, smem);
    store_tile_bf16<MI>(acc, C + (size_t)mt * 64 * MI * N + nt * 128, N, 1.0f);
  }
}
DI void phase_ffn1(const Params& p, int l, char* smem) {
  const bool last = (l == DEPTH - 1);
  const bf16_t* W = (const bf16_t*)(p.ws + w_off(l)) + WO_WGU;
  const bf16_t* U = (const bf16_t*)(p.ws + OFF_U);
  bf16_t* H = (bf16_t*)(p.ws + OFF_H);
  const int nsup = (last ? 8 : 9) * 11;
  const int vmax = ((nsup + 15) >> 4) << 8;
  auto map_tile = [&](int v, int& mt, int& nt) -> bool {
    if (v >= vmax) return false;
    const int c = v >> 8, w = v & 255, local = w >> 3, sup = (c * 8 + (w & 7)) * 2 + (local >> 4);
    if (sup >= nsup) return false;
    mt = (sup / 11) * 8 + (local & 7); nt = (sup % 11) * 2 + ((local >> 3) & 1);
    return true;
  };
  int v = blockIdx.x, mt = 0, nt = 0;
  bool cur = map_tile(v, mt, nt);
  if (cur) gemm_prefetch_big(U + (size_t)mt * 256 * 1024, 1024, W + (size_t)nt * 256 * 1024, 1024, smem);
  while (cur) {
    f32x4 acc[8][4];
#pragma unroll
    for (int i = 0; i < 8; ++i)
#pragma unroll
      for (int j = 0; j < 4; ++j) acc[i][j] = (f32x4){0.f, 0.f, 0.f, 0.f};
    gemm_kloop_big<true>(U + (size_t)mt * 256 * 1024, 1024, W + (size_t)nt * 256 * 1024, 1024, 1024, acc, smem, true);
    int v2 = v + gridDim.x, mt2 = 0, nt2 = 0;
    const bool nxt = map_tile(v2, mt2, nt2);
    if (nxt) gemm_prefetch_big(U + (size_t)mt2 * 256 * 1024, 1024, W + (size_t)nt2 * 256 * 1024, 1024, smem);
    const int tid = g_tid(), lane = tid & 63, wid = __builtin_amdgcn_readfirstlane(tid >> 6), wm = wid >> 2, wn = wid & 3, fq = lane >> 4, fr = lane & 15;
#pragma unroll
    for (int mi = 0; mi < 8; ++mi) {
      float o[8];
#pragma unroll
      for (int h2 = 0; h2 < 2; ++h2) {
        const f32x4 g = acc[mi][h2], u = acc[mi][2 + h2];
#pragma unroll
        for (int j = 0; j < 4; ++j) o[4 * h2 + j] = g[j] * sigmoidf_(g[j]) * u[j];
      }
      *(u32x4*)(H + (size_t)(mt * 256 + wm * 128 + mi * 16 + fr) * DFF + (nt * 4 + wn) * 32 + 8 * fq) = (u32x4){pk2(o[0], o[1]), pk2(o[2], o[3]), pk2(o[4], o[5]), pk2(o[6], o[7])};
    }
    v = v2; mt = mt2; nt = nt2; cur = nxt;
  }
}

struct InprojSched {
  const char* U; const char* W; int nsupA, nsup, vmax, grid, bid; bool fill;
  DI static bool transposed(int nt) { return (nt >= 4 && nt < 8) || (nt >= 12 && nt < 16); }
  DI bool next(int i, pg8::Unit& u) const {
    const int v = bid + i * grid;
    if (v >= vmax) return false;
    const int c = v >> 8, w = v & 255, local = w >> 3, sup = (c * 8 + (w & 7)) * 2 + (local >> 4);
    if (sup >= nsup) return false;
    if (sup < nsupA) { u.pm = (sup / 9) * 8 + (local & 7); u.pn = (sup % 9) * 2 + ((local >> 3) & 1); }
    else if (fill) { const int q = (sup - nsupA) * 16 + (local & 15); u.pm = q >> 2; u.pn = 18 + (q & 3); }
    else { u.pm = 64 + (local & 7); u.pn = (sup - nsupA) * 2 + ((local >> 3) & 1); }
    return true;
  }
  DI const char* pa(const pg8::Unit& u) const { return transposed(u.pn) ? W + (size_t)u.pn * 256 * 1024 * 2 : U + (size_t)u.pm * 256 * 1024 * 2; }
  DI const char* pb(const pg8::Unit& u) const { return transposed(u.pn) ? U + (size_t)u.pm * 256 * 1024 * 2 : W + (size_t)u.pn * 256 * 1024 * 2; }
};
struct InprojEpi {
  bf16_t *KB, *VT, *QB, *CQ, *ZT, *ZTC, *R; unsigned char* G8; const float *ropec, *ropes;
  DI void operator()(const f32x4 (&acc)[2][2][4][2], const pg8::Unit& u, int wr, int wc, int fr, int fq) const {
    const int mt = u.pm, nt = u.pn, m0 = mt * 256;
    int b, pos0; bool isctx; row_info(m0, b, pos0, isctx);
    if (nt < 4 || (nt >= 8 && nt < 12)) {
      const bool isq = nt >= 8; const int map = wc >> 1, axis = wc & 1;
      const float sc = isq ? QSCALE : 1.0f;
#pragma unroll
      for (int ai = 0; ai < 2; ++ai)
#pragma unroll
        for (int m = 0; m < 4; ++m) {
          const int pos = pos0 + 128 * ai + 64 * wr + 16 * m + fr;
          f32x4 cs = {1.f, 1.f, 1.f, 1.f}, sn = {0.f, 0.f, 0.f, 0.f};
          if (!isctx) { cs = *(const f32x4*)(ropec + pos * 32 + axis * 16 + fq * 4); sn = *(const f32x4*)(ropes + pos * 32 + axis * 16 + fq * 4); }
#pragma unroll
          for (int bj = 0; bj < 2; ++bj) {
            const int h = (nt * 2 + bj) & 7;
            const f32x4 x0 = acc[ai][bj][m][0], x1 = acc[ai][bj][m][1];
            const f32x4 o0 = (x0 * cs - x1 * sn) * sc, o1 = (x1 * cs + x0 * sn) * sc;
            bf16_t* dst;
            if (!isq) dst = KB + ((size_t)((b * 8 + h) * 2 + map) * NKEY + (isctx ? SEQ + pos : pos)) * 64;
            else if (!isctx) dst = QB + ((size_t)((b * 8 + h) * 2 + map) * SEQ + pos) * 64;
            else dst = CQ + ((size_t)((b * 8 + h) * 2 + map) * LC + pos) * 64;
            *(u32x2*)(dst + axis * 32 + fq * 4) = (u32x2){pk2(o0[0], o0[1]), pk2(o0[2], o0[3])};
            *(u32x2*)(dst + axis * 32 + 16 + fq * 4) = (u32x2){pk2(o1[0], o1[1]), pk2(o1[2], o1[3])};
          }
        }
    } else if (nt < 8 || (nt >= 12 && nt < 16)) {
      const bool isv = nt < 8;
#pragma unroll
      for (int ai = 0; ai < 2; ++ai)
#pragma unroll
        for (int m = 0; m < 4; ++m) {
          const int ncol = nt * 256 + 128 * ai + 64 * wr + 16 * m + fr;
#pragma unroll
          for (int bj = 0; bj < 2; ++bj)
#pragma unroll
            for (int n = 0; n < 2; ++n) {
              const int pos = pos0 + 128 * bj + 32 * wc + 16 * n + 4 * fq;
              const f32x4 vv = acc[ai][bj][m][n];
              bf16_t* dst;
              if (isv) {
                const int vg = ncol - 1024, h = vg >> 7, vcol = vg & 127;
                const int key = (isctx ? SEQ : 0) + pos, k15 = key & 15;
                const int pkey = (key & ~15) | (k15 & 3) | ((k15 & 4) << 1) | ((k15 & 8) >> 1);
                dst = VT + ((size_t)(b * 8 + h) * 128 + vcol) * NKEY + pkey;
              } else {
                const int zc = ncol - 3072, np = zc & 511, second = zc >> 9;
                dst = isctx ? (ZTC + ((size_t)b * 512 + np) * 512 + second * 256 + pos) : (ZT + ((size_t)b * 512 + np) * 4096 + second * 2048 + pos);
              }
              *(u32x2*)dst = (u32x2){pk2(vv[0], vv[1]), pk2(vv[2], vv[3])};
            }
        }
    } else if (nt >= 18) {
#pragma unroll
      for (int ai = 0; ai < 2; ++ai)
#pragma unroll
        for (int m = 0; m < 4; ++m) {
          const int row = m0 + 128 * ai + 64 * wr + 16 * m + fr;
#pragma unroll
          for (int bj = 0; bj < 2; ++bj)
#pragma unroll
            for (int n = 0; n < 2; ++n) {
              const int col = nt * 256 + 128 * bj + 32 * wc + 16 * n + 4 * fq - 4608;
              const f32x4 vv = acc[ai][bj][m][n];
              unsigned w = 0;
#pragma unroll
              for (int j = 0; j < 4; ++j) w |= (unsigned)__builtin_rintf(sigmoidf_(vv[j]) * 255.0f) << (8 * j);
              *(unsigned*)(G8 + (size_t)row * 1024 + col) = w;
            }
        }
    } else {
#pragma unroll
      for (int ai = 0; ai < 2; ++ai)
#pragma unroll
        for (int m = 0; m < 4; ++m) {
          const int row = m0 + 128 * ai + 64 * wr + 16 * m + fr;
#pragma unroll
          for (int bj = 0; bj < 2; ++bj)
#pragma unroll
            for (int n = 0; n < 2; ++n) {
              const int col = nt * 256 + 128 * bj + 32 * wc + 16 * n + 4 * fq - 4096;
              const f32x4 vv = acc[ai][bj][m][n];
              *(u32x2*)(R + (size_t)row * 512 + col) = (u32x2){pk2(vv[0], vv[1]), pk2(vv[2], vv[3])};
            }
        }
    }
  }
};
DI void phase_inproj8(const Params& p, int l, char* smem) {
  const bool last = (l == DEPTH - 1);
  InprojSched S;
  S.U = (const char*)(p.ws + OFF_U); S.W = (const char*)((const bf16_t*)(p.ws + w_off(l)) + WO_WIN);
  S.nsupA = last ? 72 : 81; S.nsup = last ? 76 : 96; S.fill = !last;
  S.vmax = ((S.nsup + 15) >> 4) << 8; S.grid = gridDim.x; S.bid = blockIdx.x;
  InprojEpi E;
  E.KB = (bf16_t*)(p.ws + OFF_KB); E.VT = (bf16_t*)(p.ws + OFF_VT); E.QB = (bf16_t*)(p.ws + OFF_QB); E.CQ = (bf16_t*)(p.ws + OFF_CQ);
  E.ZT = (bf16_t*)(p.ws + OFF_ZT); E.ZTC = (bf16_t*)(p.ws + OFF_ZTC); E.R = (bf16_t*)(p.ws + OFF_R);
  E.ropec = (const float*)(p.ws + OFF_ROPEC); E.ropes = (const float*)(p.ws + OFF_ROPES); E.G8 = (unsigned char*)(p.ws + OFF_G8);
  pg8::gemm_phase(( __attribute__((address_space(3))) unsigned char*)(lds_ptr_t)smem, 1024, S, E);
}
struct Ffn1Sched {
  const char* U; const char* W; int nsup, vmax, grid, bid;
  DI bool next(int i, pg8::Unit& u) const {
    const int v = bid + i * grid;
    if (v >= vmax) return false;
    const int c = v >> 8, w = v & 255, local = w >> 3, sup = (c * 8 + (w & 7)) * 2 + (local >> 4);
    if (sup >= nsup) return false;
    u.pm = (sup / 11) * 8 + (local & 7); u.pn = (sup % 11) * 2 + ((local >> 3) & 1);
    return true;
  }
  DI const char* pa(const pg8::Unit& u) const { return U + (size_t)u.pm * 256 * 1024 * 2; }
  DI const char* pb(const pg8::Unit& u) const { return W + (size_t)u.pn * 256 * 1024 * 2; }
};
struct Ffn1Epi {
  bf16_t* H;
  DI void operator()(const f32x4 (&acc)[2][2][4][2], const pg8::Unit& u, int wr, int wc, int fr, int fq) const {
#pragma unroll
    for (int ai = 0; ai < 2; ++ai)
#pragma unroll
      for (int m = 0; m < 4; ++m) {
        const int row = u.pm * 256 + 128 * ai + 64 * wr + 16 * m + fr;
#pragma unroll
        for (int bj = 0; bj < 2; ++bj) {
          const f32x4 g = acc[ai][bj][m][0], up = acc[ai][bj][m][1];
          float o[4];
#pragma unroll
          for (int j = 0; j < 4; ++j) o[j] = g[j] * sigmoidf_(g[j]) * up[j];
          *(u32x2*)(H + (size_t)row * DFF + u.pn * 128 + (bj * 4 + wc) * 16 + fq * 4) = (u32x2){pk2(o[0], o[1]), pk2(o[2], o[3])};
        }
      }
  }
};
DI void phase_ffn18(const Params& p, int l, char* smem) {
  const bool last = (l == DEPTH - 1);
  Ffn1Sched S;
  S.U = (const char*)(p.ws + OFF_U); S.W = (const char*)((const bf16_t*)(p.ws + w_off(l)) + WO_WGU);
  S.nsup = (last ? 8 : 9) * 11; S.vmax = ((S.nsup + 15) >> 4) << 8; S.grid = gridDim.x; S.bid = blockIdx.x;
  Ffn1Epi E; E.H = (bf16_t*)(p.ws + OFF_H);
  pg8::gemm_phase((__attribute__((address_space(3))) unsigned char*)(lds_ptr_t)smem, 1024, S, E);
  if (!last) convert_grab(p, l + 1, 1, smem);
}

struct Plain8Sched {
  const char* A; const char* B; int K, grid, bid;
  DI bool next(int i, pg8::Unit& u) const {
    const int v = bid + i * grid;
    if (v >= 256) return false;
    const int xcd = v & 7, local = v >> 3;
    u.pm = xcd * 8 + (local & 7); u.pn = local >> 3;
    return true;
  }
  DI const char* pa(const pg8::Unit& u) const { return A + (size_t)u.pm * 256 * K * 2; }
  DI const char* pb(const pg8::Unit& u) const { return B + (size_t)u.pn * 256 * K * 2; }
};
struct Plain8Epi {
  bf16_t* C;
  DI void operator()(const f32x4 (&acc)[2][2][4][2], const pg8::Unit& u, int wr, int wc, int fr, int fq) const {
#pragma unroll
    for (int ai = 0; ai < 2; ++ai)
#pragma unroll
      for (int m = 0; m < 4; ++m) {
        const int row = u.pm * 256 + 128 * ai + 64 * wr + 16 * m + fr;
#pragma unroll
        for (int bj = 0; bj < 2; ++bj)
#pragma unroll
          for (int n = 0; n < 2; ++n) {
            const f32x4 v = acc[ai][bj][m][n];
            *(u32x2*)(C + (size_t)row * 1024 + u.pn * 256 + 128 * bj + 32 * wc + 16 * n + 4 * fq) = (u32x2){pk2(v[0], v[1]), pk2(v[2], v[3])};
          }
      }
  }
};
DI void phase_plain8(const bf16_t* A, int K, const bf16_t* Bt, bf16_t* C, char* smem) {
  Plain8Sched S; S.A = (const char*)A; S.B = (const char*)Bt; S.K = K; S.grid = gridDim.x; S.bid = blockIdx.x;
  Plain8Epi E; E.C = C;
  pg8::gemm_phase((__attribute__((address_space(3))) unsigned char*)(lds_ptr_t)smem, K, S, E);
}

#define XB_TMO      128
#define XB_XCNT(j)  (256  + 64 * (j))
#define XB_XSUB(j)  (1280 + 64 * (j))
#define XB_XGEN(j)  (2304 + 64 * (j))
#define XB_TOP      3328
#define XB_TOPGEN   3392
#define XCD_BAR_WORDS 3456
#define XB_SPIN_CAP (1u << 20)
#define LAS __attribute__((address_space(3)))
DI unsigned xb_ld(unsigned* p) { return __hip_atomic_load(p, __ATOMIC_RELAXED, __HIP_MEMORY_SCOPE_AGENT); }
DI unsigned xb_add(unsigned* p, unsigned v) { return __hip_atomic_fetch_add(p, v, __ATOMIC_RELAXED, __HIP_MEMORY_SCOPE_AGENT); }
DI unsigned xb_xcc_id() { return (unsigned)__builtin_amdgcn_s_getreg((3 << 11) | 20) & 0xFu; }
#define XB_SPIN(cond, bar) do { unsigned _sp = 0; while (cond) { __builtin_amdgcn_s_sleep(1); \
    if ((++_sp & 255u) == 0u) { if (xb_ld(&(bar)[XB_TMO])) break; if (_sp > XB_SPIN_CAP) { atomicAdd(&(bar)[XB_TMO], 1u); break; } } } } while (0)
struct XcdBarrier { unsigned* bar; unsigned x; volatile LAS unsigned* st; };
DI XcdBarrier xcd_barrier_post(unsigned* bar, volatile LAS unsigned* st) {
  XcdBarrier b; b.bar = bar; b.x = xb_xcc_id(); b.st = st;
  if (__builtin_amdgcn_workitem_id_x() == 0) (void)xb_add(&bar[XB_XCNT(b.x)], 1u);
  return b;
}
DI void xcd_barrier_complete(unsigned* bar, unsigned x, unsigned& nloc, unsigned& nx) {
  const unsigned G = gridDim.x * gridDim.y * gridDim.z;
  unsigned sum, cnt, mine, sp = 0u;
  for (;;) {
    sum = 0u; cnt = 0u; mine = 0u;
#pragma unroll
    for (unsigned j = 0; j < 16; ++j) { const unsigned c = xb_ld(&bar[XB_XCNT(j)]); sum += c; cnt += (c > 0u) ? 1u : 0u; mine = (j == x) ? c : mine; }
    if (sum == G) break;
    __builtin_amdgcn_s_sleep(1);
    if ((++sp & 255u) == 0u) { if (xb_ld(&bar[XB_TMO])) break; if (sp > XB_SPIN_CAP) { atomicAdd(&bar[XB_TMO], 1u); break; } }
  }
  nloc = mine > 0u ? mine : 1u; nx = cnt > 0u ? cnt : 1u;
}
DI void xcd_barrier(const XcdBarrier& b) {
  asm volatile("s_waitcnt vmcnt(0)" ::: "memory");
  __syncthreads();
  if (__builtin_amdgcn_workitem_id_x() == 0) {
    unsigned* bar = b.bar;
    __builtin_amdgcn_s_waitcnt(0);
    unsigned nloc = b.st[0], nx = b.st[1];
    if (nloc == 0u) { xcd_barrier_complete(bar, b.x, nloc, nx); b.st[0] = nloc; b.st[1] = nx; }
    const unsigned old = xb_add(&bar[XB_XSUB(b.x)], 1u);
    const unsigned gen = old / nloc;
    if (old + 1u == (gen + 1u) * nloc) {
      __builtin_amdgcn_fence(__ATOMIC_RELEASE, "agent");
      asm volatile("s_waitcnt vmcnt(0)" ::: "memory");
      const unsigned og = xb_add(&bar[XB_TOP], 1u);
      const unsigned tg = og / nx;
      if (og + 1u == (tg + 1u) * nx) xb_add(&bar[XB_TOPGEN], 1u);
      else XB_SPIN(xb_ld(&bar[XB_TOPGEN]) == tg, bar);
      __builtin_amdgcn_fence(__ATOMIC_ACQUIRE, "agent");
      xb_add(&bar[XB_XGEN(b.x)], 1u);
      asm volatile("s_waitcnt vmcnt(0)" ::: "memory");
    } else {
      XB_SPIN(xb_ld(&bar[XB_XGEN(b.x)]) == gen, bar);
      __builtin_amdgcn_fence(__ATOMIC_ACQUIRE, "agent");
      asm volatile("s_waitcnt vmcnt(0)" ::: "memory");
    }
  }
  __syncthreads();
}

#define REP_MASK 0
#define REP_PRO 0
__global__ void __launch_bounds__(512) mega(Params p0) {
  extern __shared__ __attribute__((aligned(16))) char smem[];
  cg::grid_group grid = cg::this_grid();
  volatile LAS unsigned* xst = (volatile LAS unsigned*)(lds_ptr_t)(smem + 3 * GSTAGE);
  if (__builtin_amdgcn_workitem_id_x() < 4) xst[__builtin_amdgcn_workitem_id_x()] = 0u;
  __syncthreads();
  const XcdBarrier xb = xcd_barrier_post((unsigned*)(p0.ws + OFF_BAR), xst);
  for (int ph = p0.ph_begin; ph < p0.ph_end; ++ph) {
    const Params& p = p0;
    const bf16_t* Wl = (const bf16_t*)(p.ws + w_off(ph >= 2 ? (ph - 2) >> 3 : 0));
    if (ph == 0) { phase0a(p, smem); if (REP_PRO & 1) { xcd_barrier(xb); phase0a(p, smem); } }
    else if (ph == 1) { ln_pass(p, 0, T_ALL, nullptr, nullptr, nullptr, 0, 0, 0, 0); if (REP_PRO & 2) { xcd_barrier(xb); ln_pass(p, 0, T_ALL, nullptr, nullptr, nullptr, 0, 0, 0, 0); } }
    else {
      const int l = (ph - 2) >> 3, s = (ph - 2) & 7;
      const bool last = (l == DEPTH - 1);
      const int nmt = last ? 64 : 72, nrows = last ? T_LAT : T_ALL;
      for (int rep = 0; rep < 1 + ((REP_MASK >> s) & 1); ++rep) {
      if (rep) xcd_barrier(xb);
      switch (s) {
        case 0: phase_inproj8(p, l, smem); break;
        case 1: phase_mix(p, l, smem); if (!last) convert_grab(p, l + 1, 0, smem); break;
        case 2: if (last) phase_branch<4>(p, l, smem); else { phase_branch<3>(p, l, smem); convert_grab(p, l + 1, 0, smem); } break;
        case 3: if (last) phase_plain8((const bf16_t*)(p.ws + OFF_MOUT), 1024, Wl + WO_WO, (bf16_t*)(p.ws + OFF_Y), smem);
                else phase_gemm_plain<3>((const bf16_t*)(p.ws + OFF_MOUT), 1024, Wl + WO_WO, (bf16_t*)(p.ws + OFF_Y), 96, 8, smem);
                break;
        case 4: ln_pass(p, 1, nrows, (const bf16_t*)(p.ws + OFF_Y), p.ln1_g + (size_t)l * 1024, p.ln1_b + (size_t)l * 1024, l, 2, l, 3); break;
        case 5: phase_ffn18(p, l, smem); break;
        case 6: if (last) phase_plain8((const bf16_t*)(p.ws + OFF_H), DFF, Wl + WO_WD, (bf16_t*)(p.ws + OFF_FO), smem);
                else phase_gemm_plain<3>((const bf16_t*)(p.ws + OFF_H), DFF, Wl + WO_WD, (bf16_t*)(p.ws + OFF_FO), 96, 8, smem);
                break;
        default:
          ln_pass(p, last ? 2 : 1, nrows, (const bf16_t*)(p.ws + OFF_FO), p.ln2_g + (size_t)l * 1024, p.ln2_b + (size_t)l * 1024, l, 5, last ? l : l + 1, 0);
          if (!last) { convert_grab(p, l + 1, 0, smem); convert_grab(p, l + 1, 1, smem); }
          break;
      }
      }
    }
    if (ph + 1 < p0.ph_end) { if (p0.ph_begin < 0) grid.sync(); xcd_barrier(xb); }
  }
}

extern "C" void kernel_launch(void* const* d_in, const int* in_sizes, int n_in, void* d_out, int out_size, void* d_ws, size_t ws_size, hipStream_t stream) {
  constexpr size_t kDynLds = 3 * GSTAGE + 16;
  static int grid_blocks = 0;
  if (!grid_blocks) {
    int dev = 0, cus = 0, per_cu = 0;
    (void)hipGetDevice(&dev);
    (void)hipDeviceGetAttribute(&cus, hipDeviceAttributeMultiprocessorCount, dev);
    (void)hipFuncSetAttribute((const void*)mega, hipFuncAttributeMaxDynamicSharedMemorySize, (int)kDynLds);
    (void)hipOccupancyMaxActiveBlocksPerMultiprocessor(&per_cu, mega, 512, kDynLds);
    if (per_cu > 1) per_cu = 1;
    if (per_cu < 1) per_cu = 1;
    grid_blocks = cus * per_cu;
  }
  if (ws_size < WS_NEED) { fprintf(stderr, "workspace too small: %zu < %zu\n", ws_size, (size_t)WS_NEED); return; }
  (void)hipMemsetAsync((char*)d_ws + OFF_BAR, 0, XCD_BAR_WORDS * 4 + 64, stream);
  Params p;
  memset(&p, 0, sizeof(p));
  const float** fp = (const float**)&p;
  for (int i = 0; i < 22; ++i) fp[i] = (const float*)d_in[i];
  p.out = (float*)d_out;
  p.ws = (char*)d_ws;
  for (int l = 0; l < 4; ++l) p.lam_init[l] = (float)(0.8 - 0.6 * exp(-0.3 * l));
  p.ph_begin = 0; p.ph_end = 2 + 8 * DEPTH;
  void* args[] = {&p};
  hipError_t e = hipLaunchCooperativeKernel((void*)mega, dim3(grid_blocks), dim3(512), args, kDynLds, stream);
  if (e != hipSuccess) fprintf(stderr, "cooperative launch failed: %s (grid %d)\n", hipGetErrorString(e), grid_blocks);
}
```

```cpp
#include <hip/hip_runtime.h>
#include <hip/hip_cooperative_groups.h>
#include <cstdio>
#include <cstdint>
#include <cstring>
#include <cmath>
namespace cg = cooperative_groups;

#define DI __device__ __forceinline__
typedef unsigned short bf16_t;
typedef short bf16x8 __attribute__((ext_vector_type(8)));
typedef float f32x4 __attribute__((ext_vector_type(4)));
typedef float f32x2 __attribute__((ext_vector_type(2)));
typedef float f32x16 __attribute__((ext_vector_type(16)));
typedef unsigned u32x2 __attribute__((ext_vector_type(2)));
typedef unsigned u32x4 __attribute__((ext_vector_type(4)));
typedef __bf16 bf16x2_t __attribute__((ext_vector_type(2)));

constexpr int D = 1024, NB = 8, SEQ = 2048, LC = 256, NH = 8, DEPTH = 4;
constexpr int T_LAT = NB * SEQ, T_CTX = NB * LC, T_ALL = T_LAT + T_CTX;
constexpr int NKEY = SEQ + LC;
constexpr int N_IN = 7168, DFF = 2816;
constexpr int WIN_ROWS = 7680;
constexpr int ROW_Z1 = 3072, ROW_Z2 = 3584, ROW_R = 4096, ROW_G = 4608;
constexpr float ALPHA = 1.6817928305074290f;
constexpr float LN_EPS = 1e-5f;
constexpr float QSCALE = 0.125f * 1.4426950408889634f;

constexpr size_t WO_WIN = 0;
constexpr size_t WO_WA = WO_WIN + (size_t)WIN_ROWS * 1024;
constexpr size_t WO_WF = WO_WA + 1024 * 1024;
constexpr size_t WO_WP = WO_WF + 1024 * 512;
constexpr size_t WO_WO = WO_WP + 1024 * 512;
constexpr size_t WO_WGU = WO_WO + 1024 * 1024;
constexpr size_t WO_WD = WO_WGU + (size_t)5632 * 1024;
constexpr size_t W_ELEMS = WO_WD + (size_t)1024 * DFF;

constexpr size_t al256(size_t x) { return (x + 255) & ~(size_t)255; }
constexpr size_t OFF_W = 0;
constexpr size_t OFF_ATAB = al256(OFF_W + W_ELEMS * 2);
constexpr size_t OFF_ATABC = al256(OFF_ATAB + (size_t)2048 * 4096 * 2);
constexpr size_t OFF_ROPEC = al256(OFF_ATABC + (size_t)256 * 512 * 2);
constexpr size_t OFF_ROPES = al256(OFF_ROPEC + (size_t)2048 * 32 * 4);
constexpr size_t OFF_MODV = al256(OFF_ROPES + (size_t)2048 * 32 * 4);
constexpr size_t OFF_LAMV = al256(OFF_MODV + (size_t)DEPTH * 9 * 6144 * 4);
constexpr size_t OFF_X = al256(OFF_LAMV + 256);
constexpr size_t OFF_U = al256(OFF_X + (size_t)T_ALL * 1024 * 4);
constexpr size_t OFF_KB = al256(OFF_U + (size_t)T_ALL * 1024 * 2);
constexpr size_t OFF_VT = al256(OFF_KB + (size_t)NB * NH * 2 * NKEY * 64 * 2);
constexpr size_t OFF_QB = al256(OFF_VT + (size_t)NB * NH * 128 * NKEY * 2);
constexpr size_t OFF_CQ = al256(OFF_QB + (size_t)NB * NH * 2 * SEQ * 64 * 2);
constexpr size_t OFF_ZT = al256(OFF_CQ + (size_t)NB * NH * 2 * LC * 64 * 2);
constexpr size_t OFF_ZTC = al256(OFF_ZT + (size_t)NB * 512 * 4096 * 2);
constexpr size_t OFF_R = al256(OFF_ZTC + (size_t)NB * 512 * 512 * 2);
constexpr size_t OFF_ATT = al256(OFF_R + (size_t)T_ALL * 512 * 2);
constexpr size_t OFF_FM = al256(OFF_ATT + (size_t)T_ALL * 1024 * 2);
constexpr size_t OFF_PM = al256(OFF_FM + (size_t)T_ALL * 512 * 2);
constexpr size_t OFF_BAR = al256(OFF_PM + (size_t)T_ALL * 512 * 2);
constexpr size_t OFF_CTR = OFF_BAR + 3456 * 4;
constexpr size_t OFF_W2 = al256(OFF_CTR + 64);
constexpr size_t OFF_G8 = al256(OFF_W2 + W_ELEMS * 2);
constexpr int G8_ROWS = 15360;
constexpr size_t WS_NEED = al256(OFF_G8 + (size_t)G8_ROWS * 1024);
constexpr size_t OFF_MOUT = OFF_KB;
constexpr size_t OFF_Y = OFF_VT;
constexpr size_t OFF_H = OFF_KB;
constexpr size_t OFF_FO = OFF_ATT;
static_assert((size_t)T_ALL * DFF * 2 <= OFF_CQ - OFF_KB, "H overlay too large");

struct Params {
  const float *x, *c, *ctx, *c_ctx, *w_mod, *b_mod, *w_in, *lam_qk, *subln_g, *w_att_br, *w_four_br, *w_pool_grp, *pool_scale,
      *w_pool_br, *w_out, *ln1_g, *ln1_b, *w_ffn_gate, *w_ffn_up, *w_ffn_down, *ln2_g, *ln2_b;
  float* out;
  char* ws;
  float lam_init[4];
  int ph_begin, ph_end;
};

DI size_t w_off(int l) { return (l & 1) ? OFF_W2 : OFF_W; }
DI int g_tid() { int t = __builtin_amdgcn_workitem_id_x(); asm volatile("" : "+v"(t)); return t; }
DI unsigned pk2(float a, float b) { f32x2 v = {a, b}; bf16x2_t r = __builtin_convertvector(v, bf16x2_t); return __builtin_bit_cast(unsigned, r); }
DI float bf_lo(unsigned u) { return __uint_as_float(u << 16); }
DI float bf_hi(unsigned u) { return __uint_as_float(u & 0xffff0000u); }
DI float hw_cos_rev(float r) { return __builtin_amdgcn_cosf(r); }
DI float hw_sin_rev(float r) { return __builtin_amdgcn_sinf(r); }
DI float sigmoidf_(float x) { return __builtin_amdgcn_rcpf(1.0f + __expf(-x)); }
DI float xor32_sum(float v) { const auto r = __builtin_amdgcn_permlane32_swap(__float_as_uint(v), __float_as_uint(v), false, false); return __uint_as_float(r[0]) + __uint_as_float(r[1]); }
DI float xor32_max(float v) { const auto r = __builtin_amdgcn_permlane32_swap(__float_as_uint(v), __float_as_uint(v), false, false); return fmaxf(__uint_as_float(r[0]), __uint_as_float(r[1])); }
DI float dpp_add(float v, int) { return v; }
#define DPP_ADD(v, ctrl) ((v) + __uint_as_float(__builtin_amdgcn_update_dpp(0u, __float_as_uint(v), (ctrl), 0xF, 0xF, true)))
DI float wave_sum(float v) {
  v = DPP_ADD(v, 0xB1);
  v = DPP_ADD(v, 0x4E);
  v = DPP_ADD(v, 0x141);
  v = DPP_ADD(v, 0x140);
  { const auto r = __builtin_amdgcn_permlane16_swap(__float_as_uint(v), __float_as_uint(v), false, false); v = __uint_as_float(r[0]) + __uint_as_float(r[1]); }
  return xor32_sum(v);
}
#define MFMA16(a, b, c) __builtin_amdgcn_mfma_f32_16x16x32_bf16((a), (b), (c), 0, 0, 0)
#define MFMA32(a, b, c) __builtin_amdgcn_mfma_f32_32x32x16_bf16((a), (b), (c), 0, 0, 0)

constexpr int GSTAGE = 49152;
#define WAIT_VM(n) asm volatile("s_waitcnt vmcnt(" #n ")" ::: "memory")
typedef __attribute__((address_space(3))) void* lds_ptr_t;
template <bool SWAP, int MI = 4>
DI void gemm_kloop(const bf16_t* __restrict__ A, int lda, const bf16_t* __restrict__ B, int ldb, int K, f32x4 (&acc)[MI][4], char* smem, bool pre = false  ) {
  const int tid = g_tid(), lane = tid & 63, wid = __builtin_amdgcn_readfirstlane(tid >> 6), wm = wid >> 1, wn = wid & 1;
  const int lr = tid >> 3, lc = (tid & 7) ^ ((tid >> 4) & 7);
  const unsigned aoff = (unsigned)(lr * lda + lc * 8) * 2u, boff = (unsigned)(lr * ldb + lc * 8) * 2u;
  const char* Ac = (const char*)A; const char* Bc = (const char*)B;
  const int fr = lane & 15, fq = lane >> 4, sw = fr >> 1;
  const int a_base = (wm * 16 * MI + fr) * 128, b_base = 32768 + (wn * 64 + fr) * 128;
  const int nk = K >> 6;
  char* sdst = smem + tid * 16;
#define G_ISSUE(KT, ST) do { _Pragma("unroll") for (int i = 0; i < MI; ++i) \
      __builtin_amdgcn_global_load_lds((const void*)(Ac + ((size_t)(64 * i) * lda + (size_t)(KT) * 64) * 2 + aoff), (lds_ptr_t)(sdst + (ST) * GSTAGE + i * 8192), 16, 0, 0); \
    _Pragma("unroll") for (int i = 0; i < 2; ++i) \
      __builtin_amdgcn_global_load_lds((const void*)(Bc + ((size_t)(64 * i) * ldb + (size_t)(KT) * 64) * 2 + boff), (lds_ptr_t)(sdst + (ST) * GSTAGE + 32768 + i * 8192), 16, 0, 0); } while (0)
#define G_COMPUTE(ST) do { const char* st_ = smem + (ST) * GSTAGE; \
    _Pragma("unroll") for (int ks = 0; ks < 2; ++ks) { const int co = ((ks * 4 + fq) ^ sw) << 4; bf16x8 af[MI], bfr[4]; \
      _Pragma("unroll") for (int i = 0; i < 4; ++i) bfr[i] = *(const bf16x8*)(st_ + b_base + i * 2048 + co); \
      _Pragma("unroll") for (int i = 0; i < MI; ++i) af[i] = *(const bf16x8*)(st_ + a_base + i * 2048 + co); \
      _Pragma("unroll") for (int mi = 0; mi < MI; ++mi) _Pragma("unroll") for (int ni = 0; ni < 4; ++ni) { \
          if (SWAP) acc[mi][ni] = MFMA16(bfr[ni], af[mi], acc[mi][ni]); else acc[mi][ni] = MFMA16(af[mi], bfr[ni], acc[mi][ni]); } } } while (0)
  if (!pre) { G_ISSUE(0, 0); G_ISSUE(1, 1); }
  int st = 0;
  for (int t = 0; t < nk; ++t) {
    if (t == 0 || t + 1 >= nk) WAIT_VM(0);
    else if (MI == 4) WAIT_VM(6); else WAIT_VM(5);
    __builtin_amdgcn_s_barrier();
    asm volatile("" ::: "memory");
    const int st2 = (st == 0) ? 2 : st - 1;
    if (t + 2 < nk) G_ISSUE(t + 2, st2);
    __builtin_amdgcn_sched_barrier(0);
    G_COMPUTE(st);
    __builtin_amdgcn_sched_group_barrier(0x100, 6, 0);
#pragma unroll
    for (int i_ = 0; i_ < 2 * MI + 2; ++i_) { __builtin_amdgcn_sched_group_barrier(0x008, 2, 0); __builtin_amdgcn_sched_group_barrier(0x100, 1, 0); }
    __builtin_amdgcn_sched_group_barrier(0x008, 4 * MI - 4, 0);
    __builtin_amdgcn_sched_barrier(0);
    st = (st == 2) ? 0 : st + 1;
  }
  asm volatile("s_waitcnt lgkmcnt(0)" ::: "memory");
  __builtin_amdgcn_s_barrier();
  asm volatile("" ::: "memory");
#undef G_ISSUE
#undef G_COMPUTE
}
template <bool SWAP, int MI = 4>
DI void gemm_kloop_pp(const bf16_t* __restrict__ A, int lda, const bf16_t* __restrict__ B, int ldb, int K, f32x4 (&acc)[MI][4], char* smem) {
  const int tid = g_tid(), lane = tid & 63, wid = __builtin_amdgcn_readfirstlane(tid >> 6), wm = wid >> 1, wn = wid & 1, grp = wid >> 2;
  const int lr = tid >> 3, lc = (tid & 7) ^ ((tid >> 4) & 7);
  const unsigned aoff = (unsigned)(lr * lda + lc * 8) * 2u, boff = (unsigned)(lr * ldb + lc * 8) * 2u;
  const char* Ac = (const char*)A; const char* Bc = (const char*)B;
  const int fr = lane & 15, fq = lane >> 4, sw = fr >> 1;
  const int a_base = (wm * 16 * MI + fr) * 128, b_base = 32768 + (wn * 64 + fr) * 128;
  const int nk = K >> 6;
  char* sdst = smem + tid * 16;
#define P_ISSUE(KT, ST) do { _Pragma("unroll") for (int i = 0; i < MI; ++i) \
      __builtin_amdgcn_global_load_lds((const void*)(Ac + ((size_t)(64 * i) * lda + (size_t)(KT) * 64) * 2 + aoff), (lds_ptr_t)(sdst + (ST) * GSTAGE + i * 8192), 16, 0, 0); \
    _Pragma("unroll") for (int i = 0; i < 2; ++i) \
      __builtin_amdgcn_global_load_lds((const void*)(Bc + ((size_t)(64 * i) * ldb + (size_t)(KT) * 64) * 2 + boff), (lds_ptr_t)(sdst + (ST) * GSTAGE + 32768 + i * 8192), 16, 0, 0); } while (0)
  P_ISSUE(0, 0);
  P_ISSUE(1, 1);
  WAIT_VM(0);
  __builtin_amdgcn_s_barrier();
  asm volatile("" ::: "memory");
  if (grp == 1) { __builtin_amdgcn_s_barrier(); asm volatile("" ::: "memory"); }
  int st = 0;
  for (int t = 0; t < nk; ++t) {
    const int st2 = (st == 0) ? 2 : st - 1;
    if (t + 2 < nk) P_ISSUE(t + 2, st2);
    bf16x8 af[2][MI], bfr[2][4];
    const char* st_ = smem + st * GSTAGE;
#pragma unroll
    for (int ks = 0; ks < 2; ++ks) {
      const int co = ((ks * 4 + fq) ^ sw) << 4;
#pragma unroll
      for (int i = 0; i < 4; ++i) bfr[ks][i] = *(const bf16x8*)(st_ + b_base + i * 2048 + co);
#pragma unroll
      for (int i = 0; i < MI; ++i) af[ks][i] = *(const bf16x8*)(st_ + a_base + i * 2048 + co);
    }
    if (t + 2 < nk) { if (MI == 4) WAIT_VM(6); else WAIT_VM(5); } else WAIT_VM(0);
    asm volatile("s_waitcnt lgkmcnt(0)" ::: "memory");
    __builtin_amdgcn_sched_barrier(0);
    __builtin_amdgcn_s_barrier();
    asm volatile("" ::: "memory");
#pragma unroll
    for (int ks = 0; ks < 2; ++ks)
#pragma unroll
      for (int mi = 0; mi < MI; ++mi)
#pragma unroll
        for (int ni = 0; ni < 4; ++ni) {
          if (SWAP) acc[mi][ni] = MFMA16(bfr[ks][ni], af[ks][mi], acc[mi][ni]); else acc[mi][ni] = MFMA16(af[ks][mi], bfr[ks][ni], acc[mi][ni]);
        }
    __builtin_amdgcn_sched_barrier(0);
    __builtin_amdgcn_s_barrier();
    asm volatile("" ::: "memory");
    st = (st == 2) ? 0 : st + 1;
  }
  if (grp == 0) { __builtin_amdgcn_s_barrier(); asm volatile("" ::: "memory"); }
#undef P_ISSUE
}

template <int MI>
DI void gemm_prefetch(const bf16_t* __restrict__ A, int lda, const bf16_t* __restrict__ B, int ldb, char* smem) {
  const int tid = g_tid();
  const int lr = tid >> 3, lc = (tid & 7) ^ ((tid >> 4) & 7);
  const unsigned aoff = (unsigned)(lr * lda + lc * 8) * 2u, boff = (unsigned)(lr * ldb + lc * 8) * 2u;
  const char* Ac = (const char*)A; const char* Bc = (const char*)B;
  char* sdst = smem + tid * 16;
#pragma unroll
  for (int kt = 0; kt < 2; ++kt) {
#pragma unroll
    for (int i = 0; i < MI; ++i)
      __builtin_amdgcn_global_load_lds((const void*)(Ac + ((size_t)(64 * i) * lda + (size_t)kt * 64) * 2 + aoff), (lds_ptr_t)(sdst + kt * GSTAGE + i * 8192), 16, 0, 0);
#pragma unroll
    for (int i = 0; i < 2; ++i)
      __builtin_amdgcn_global_load_lds((const void*)(Bc + ((size_t)(64 * i) * ldb + (size_t)kt * 64) * 2 + boff), (lds_ptr_t)(sdst + kt * GSTAGE + 32768 + i * 8192), 16, 0, 0);
  }
}
template <int MI>
DI void zero_acc_t(f32x4 (&acc)[MI][4]) {
#pragma unroll
  for (int i = 0; i < MI; ++i)
#pragma unroll
    for (int j = 0; j < 4; ++j) acc[i][j] = (f32x4){0.f, 0.f, 0.f, 0.f};
}
DI void zero_acc(f32x4 (&acc)[4][4]) {
#pragma unroll
  for (int i = 0; i < 4; ++i)
#pragma unroll
    for (int j = 0; j < 4; ++j) acc[i][j] = (f32x4){0.f, 0.f, 0.f, 0.f};
}

template <bool SWAP>
DI void gemm_kloop_big(const bf16_t* __restrict__ A, int lda, const bf16_t* __restrict__ B, int ldb, int K, f32x4 (&acc)[8][4], char* smem, bool pre = false) {
  const int tid = g_tid(), lane = tid & 63, wid = __builtin_amdgcn_readfirstlane(tid >> 6), wm = wid >> 2, wn = wid & 3;
  const int lr = tid >> 3, lc = (tid & 7) ^ ((tid >> 4) & 7);
  const unsigned aoff = (unsigned)(lr * lda + lc * 8) * 2u, boff = (unsigned)(lr * ldb + lc * 8) * 2u;
  const char* Ac = (const char*)A; const char* Bc = (const char*)B;
  const int fr = lane & 15, fq = lane >> 4, sw = fr >> 1;
  const int a_base = (wm * 128 + fr) * 128, b_base = 32768 + (wn * 64 + fr) * 128;
  const int nk = K >> 6;
  char* sdst = smem + tid * 16;
#define GB_ISSUE(KT, ST) do { _Pragma("unroll") for (int i = 0; i < 4; ++i) { \
      __builtin_amdgcn_global_load_lds((const void*)(Ac + ((size_t)(64 * i) * lda + (size_t)(KT) * 64) * 2 + aoff), (lds_ptr_t)(sdst + (ST) * 65536 + i * 8192), 16, 0, 0); \
      __builtin_amdgcn_global_load_lds((const void*)(Bc + ((size_t)(64 * i) * ldb + (size_t)(KT) * 64) * 2 + boff), (lds_ptr_t)(sdst + (ST) * 65536 + 32768 + i * 8192), 16, 0, 0); } } while (0)
  if (!pre) GB_ISSUE(0, 0);
  for (int t = 0; t < nk; ++t) {
    WAIT_VM(0);
    __builtin_amdgcn_s_barrier();
    asm volatile("" ::: "memory");
    if (t + 1 < nk) GB_ISSUE(t + 1, (t + 1) & 1);
    __builtin_amdgcn_sched_barrier(0);
    const char* st_ = smem + (t & 1) * 65536;
#pragma unroll
    for (int ks = 0; ks < 2; ++ks) {
      const int co = ((ks * 4 + fq) ^ sw) << 4;
      bf16x8 af[8], bfr[4];
#pragma unroll
      for (int i = 0; i < 4; ++i) bfr[i] = *(const bf16x8*)(st_ + b_base + i * 2048 + co);
#pragma unroll
      for (int i = 0; i < 8; ++i) af[i] = *(const bf16x8*)(st_ + a_base + i * 2048 + co);
#pragma unroll
      for (int mi = 0; mi < 8; ++mi)
#pragma unroll
        for (int ni = 0; ni < 4; ++ni) {
          if (SWAP) acc[mi][ni] = MFMA16(bfr[ni], af[mi], acc[mi][ni]); else acc[mi][ni] = MFMA16(af[mi], bfr[ni], acc[mi][ni]);
        }
    }
    __builtin_amdgcn_sched_group_barrier(0x100, 8, 0);
#pragma unroll
    for (int i_ = 0; i_ < 16; ++i_) { __builtin_amdgcn_sched_group_barrier(0x008, 3, 0); __builtin_amdgcn_sched_group_barrier(0x100, 1, 0); }
    __builtin_amdgcn_sched_group_barrier(0x008, 16, 0);
    __builtin_amdgcn_sched_barrier(0);
  }
  asm volatile("s_waitcnt lgkmcnt(0)" ::: "memory");
  __builtin_amdgcn_s_barrier();
  asm volatile("" ::: "memory");
#undef GB_ISSUE
}

namespace pg8 {
#define PG8_LAS __attribute__((address_space(3)))
constexpr int BM = 256, BK = 64, HALF = 128, HTB = HALF * BK * 2;
DI int lds_byte(int r, int c) { const int st = (r >> 4) * 2 + (c >> 5), rr = r & 15, cc = c & 31, ob = rr * 64 + cc * 2; return st * 1024 + (ob ^ (((ob >> 9) & 1) << 5)); }
DI void stage_rc(int b, int& R, int& C) { const int st = b / 1024, sb = b % 1024, swz = sb ^ (((sb >> 9) & 1) << 5); R = (st >> 1) * 16 + swz / 64; C = (st & 1) * 32 + (swz % 64) / 2; }
struct Unit { int pm, pn; };
template <class Epi, class Sched>
DI void gemm_phase(PG8_LAS unsigned char* lds, int K, const Sched& S, const Epi& E) {
  const int tid = g_tid(), wid = __builtin_amdgcn_readfirstlane(tid >> 6), lane = tid & 63, wr = wid >> 2, wc = wid & 3, fr = lane & 15, fq = lane >> 4;
  const int nt = K / BK;
  unsigned voff[2];
#pragma unroll
  for (int i = 0; i < 2; ++i) { int R, C; stage_rc(tid * 16 + i * 8192, R, C); voff[i] = (unsigned)(R * K + C) * 2u; }
  const size_t kstep = (size_t)(BK * 2);
  const size_t hstep = (size_t)HALF * K * 2;
  const unsigned ldsw = (unsigned)wid * 1024u;
  const int aoff = lds_byte(wr * 64 + fr, fq * 8), boff = lds_byte(wc * 32 + fr, fq * 8);
#define PG8_SA(b, h) (((b) * 2 + (h)) * HTB)
#define PG8_SB(b, h) ((4 + (b) * 2 + (h)) * HTB)
#define PG8_STAGE(bufoff, gbase) do { _Pragma("unroll") for (int _i = 0; _i < 2; ++_i) \
    __builtin_amdgcn_global_load_lds((const void*)((const char*)(gbase) + voff[_i]), (PG8_LAS void*)(lds + (bufoff) + ldsw + _i * 8192), 16, 0, 0); } while (0)
#define PG8_LDA(dst, b, h) do { _Pragma("unroll") for (int m = 0; m < 4; ++m) _Pragma("unroll") for (int k = 0; k < 2; ++k) dst[m][k] = *(const PG8_LAS bf16x8*)(lds + PG8_SA(b, h) + aoff + m * 2048 + k * 1024); } while (0)
#define PG8_LDB(dst, b, h) do { _Pragma("unroll") for (int n = 0; n < 2; ++n) _Pragma("unroll") for (int k = 0; k < 2; ++k) dst[n][k] = *(const PG8_LAS bf16x8*)(lds + PG8_SB(b, h) + boff + n * 2048 + k * 1024); } while (0)
#define PG8_MMA(ai, bj, At, Bt) do { __builtin_amdgcn_s_setprio(1); _Pragma("unroll") for (int m = 0; m < 4; ++m) _Pragma("unroll") for (int n = 0; n < 2; ++n) _Pragma("unroll") for (int k = 0; k < 2; ++k) \
    acc[ai][bj][m][n] = __builtin_amdgcn_mfma_f32_16x16x32_bf16(Bt[n][k], At[m][k], acc[ai][bj][m][n], 0, 0, 0); __builtin_amdgcn_s_setprio(0); } while (0)
#define PG8_WAIT_V(n) asm volatile("s_waitcnt vmcnt(" #n ")" ::: "memory")
#define PG8_WAIT_L(n) asm volatile("s_waitcnt lgkmcnt(" #n ")" ::: "memory")
#define PG8_BAR __builtin_amdgcn_s_barrier()
#define PG8_SCHED __builtin_amdgcn_sched_barrier(0)
  Unit cur, nxt; int ui = 0;
  if (!S.next(0, cur)) return;
  f32x4 acc[2][2][4][2];
#pragma unroll
  for (int a = 0; a < 2; ++a)
#pragma unroll
    for (int b = 0; b < 2; ++b)
#pragma unroll
      for (int m = 0; m < 4; ++m)
#pragma unroll
        for (int n = 0; n < 2; ++n) acc[a][b][m][n] = (f32x4){0.f, 0.f, 0.f, 0.f};
  bf16x8 At[4][2], B0[2][2], B1[2][2];
  const char* cA = S.pa(cur); const char* cB = S.pb(cur);
  PG8_WAIT_V(0);
  PG8_STAGE(PG8_SB(0, 0), cB); PG8_STAGE(PG8_SA(0, 0), cA); PG8_STAGE(PG8_SB(0, 1), cB + hstep); PG8_STAGE(PG8_SA(0, 1), cA + hstep);
  if (wr == 1) PG8_BAR;
  PG8_WAIT_V(4); PG8_BAR;
  PG8_STAGE(PG8_SB(1, 0), cB + kstep); PG8_STAGE(PG8_SA(1, 0), cA + kstep); PG8_STAGE(PG8_SB(1, 1), cB + hstep + kstep);
  PG8_WAIT_V(6); PG8_BAR;
  for (;;) {
    const bool has_next = S.next(ui + 1, nxt);
    const char* nA = has_next ? S.pa(nxt) : cA; const char* nB = has_next ? S.pb(nxt) : cB;
    for (int t = 0; t < nt; t += 2) {
      const bool last = (t == nt - 2);
      const char* a1 = cA + (size_t)(t + 1) * kstep;
      const char* a2 = last ? nA : cA + (size_t)(t + 2) * kstep; const char* b2 = last ? nB : cB + (size_t)(t + 2) * kstep;
      const char* a3 = a2 + kstep; const char* b3 = b2 + kstep;
      PG8_LDB(B0, 0, 0); PG8_SCHED; PG8_LDA(At, 0, 0); PG8_STAGE(PG8_SA(1, 1), a1 + hstep);
      PG8_WAIT_L(8); PG8_BAR; PG8_WAIT_L(0); PG8_MMA(0, 0, At, B0); PG8_BAR; PG8_SCHED;
      PG8_LDB(B1, 0, 1); PG8_STAGE(PG8_SB(0, 0), b2);
      PG8_BAR; PG8_WAIT_L(0); PG8_MMA(0, 1, At, B1); PG8_BAR;
      PG8_LDA(At, 0, 1); PG8_STAGE(PG8_SA(0, 0), a2);
      PG8_BAR; PG8_WAIT_L(0); PG8_MMA(1, 0, At, B0); PG8_BAR; PG8_SCHED;
      PG8_STAGE(PG8_SB(0, 1), b2 + hstep);
      PG8_WAIT_V(6); PG8_BAR; PG8_MMA(1, 1, At, B1); PG8_BAR;
      PG8_LDB(B0, 1, 0); PG8_SCHED; PG8_LDA(At, 1, 0); PG8_STAGE(PG8_SA(0, 1), a2 + hstep);
      PG8_WAIT_L(8); PG8_BAR; PG8_WAIT_L(0); PG8_MMA(0, 0, At, B0); PG8_BAR; PG8_SCHED;
      PG8_LDB(B1, 1, 1); PG8_STAGE(PG8_SB(1, 0), b3);
      PG8_BAR; PG8_WAIT_L(0); PG8_MMA(0, 1, At, B1); PG8_BAR;
      PG8_LDA(At, 1, 1); PG8_STAGE(PG8_SA(1, 0), a3);
      PG8_BAR; PG8_WAIT_L(0); PG8_MMA(1, 0, At, B0); PG8_BAR; PG8_SCHED;
      PG8_STAGE(PG8_SB(1, 1), b3 + hstep);
      PG8_WAIT_V(6); PG8_BAR; PG8_MMA(1, 1, At, B1); PG8_BAR;
    }
    E(acc, cur, wr, wc, fr, fq);
    if (!has_next) break;
#pragma unroll
    for (int a = 0; a < 2; ++a)
#pragma unroll
      for (int b = 0; b < 2; ++b)
#pragma unroll
        for (int m = 0; m < 4; ++m)
#pragma unroll
          for (int n = 0; n < 2; ++n) acc[a][b][m][n] = (f32x4){0.f, 0.f, 0.f, 0.f};
    cur = nxt; cA = nA; cB = nB; ++ui;
  }
  PG8_WAIT_V(0);
  if (wr == 0) PG8_BAR;
  PG8_BAR;
#undef PG8_SA
#undef PG8_SB
#undef PG8_STAGE
#undef PG8_LDA
#undef PG8_LDB
#undef PG8_MMA
#undef PG8_WAIT_V
#undef PG8_WAIT_L
#undef PG8_BAR
#undef PG8_SCHED
}
}

DI void gemm_prefetch_big(const bf16_t* __restrict__ A, int lda, const bf16_t* __restrict__ B, int ldb, char* smem) {
  const int tid = g_tid();
  const int lr = tid >> 3, lc = (tid & 7) ^ ((tid >> 4) & 7);
  const unsigned aoff = (unsigned)(lr * lda + lc * 8) * 2u, boff = (unsigned)(lr * ldb + lc * 8) * 2u;
  const char* Ac = (const char*)A; const char* Bc = (const char*)B;
  char* sdst = smem + tid * 16;
#pragma unroll
  for (int i = 0; i < 4; ++i) {
    __builtin_amdgcn_global_load_lds((const void*)(Ac + ((size_t)(64 * i) * lda) * 2 + aoff), (lds_ptr_t)(sdst + i * 8192), 16, 0, 0);
    __builtin_amdgcn_global_load_lds((const void*)(Bc + ((size_t)(64 * i) * ldb) * 2 + boff), (lds_ptr_t)(sdst + 32768 + i * 8192), 16, 0, 0);
  }
}

DI void row_info(int r, int& b, int& pos, bool& isctx) {
  if (r < T_LAT) { b = r >> 11; pos = r & 2047; isctx = false; } else { const int q = r - T_LAT; b = q >> 8; pos = q & 255; isctx = true; }
}

constexpr int HALF_LDS = 65792;
DI void conv_tile(bool active, const float* __restrict__ src, int ld, int k0, int c0, bf16_t* __restrict__ dst, int dstld, int ilv  , int n0, char* smem) {
  float* s = (float*)smem;
  const int tid = g_tid() & 255;
  if (active) {
#pragma unroll
    for (int i = 0; i < 4; ++i) {
      const int k = (tid >> 4) + 16 * i, cc = (tid & 15) * 4;
      const f32x4 v = *(const f32x4*)(src + (size_t)(k0 + k) * ld + c0 + n0 + cc);
      s[k * 65 + cc] = v[0]; s[k * 65 + cc + 1] = v[1]; s[k * 65 + cc + 2] = v[2]; s[k * 65 + cc + 3] = v[3];
    }
  }
  __syncthreads();
  if (active) {
    const int n = tid >> 2, kq = (tid & 3) * 16;
    unsigned w[8];
#pragma unroll
    for (int j = 0; j < 8; ++j) w[j] = pk2(s[(kq + 2 * j) * 65 + n], s[(kq + 2 * j + 1) * 65 + n]);
    const int ng = n0 + n;
    size_t drow = ng;
    if (ilv) drow = (size_t)(ng >> 4) * 32 + (ng & 15) + (ilv == 2 ? 16 : 0);
    bf16_t* dp = dst + drow * dstld + k0 + kq;
    *(u32x4*)dp = (u32x4){w[0], w[1], w[2], w[3]};
    *(u32x4*)(dp + 8) = (u32x4){w[4], w[5], w[6], w[7]};
  }
  __syncthreads();
}
DI void fold_tile(bool active, const float* __restrict__ src  , int cbase, int k0, int np0  , int mode, const float* __restrict__ wgrp,
                  const float* __restrict__ pscale, bf16_t* __restrict__ dst  , char* smem) {
  float* sA = (float*)smem;
  float* sT = (float*)(smem + 33024);
  const int tid = g_tid() & 255;
  if (active) {
    for (int i = tid; i < 64 * 32; i += 256) {
      const int k = i >> 5, c4 = (i & 31) * 4;
      const f32x4 v = *(const f32x4*)(src + (size_t)(k0 + k) * N_IN + cbase + c4);
      sA[k * 129 + c4] = v[0]; sA[k * 129 + c4 + 1] = v[1]; sA[k * 129 + c4 + 2] = v[2]; sA[k * 129 + c4 + 3] = v[3];
    }
    for (int i = tid; i < 128 * 64; i += 256) {
      const int c = i >> 6, n = i & 63, np = np0 + n;
      float t;
      if (mode == 2) t = wgrp[c * 128 + np] * pscale[np];
      else { const float r = (float)((c * np) & 127) * (1.0f / 128.0f); t = (mode == 0) ? hw_cos_rev(r) : hw_sin_rev(r); }
      sT[c * 64 + n] = t;
    }
  }
  __syncthreads();
  if (active) {
    const int ty = tid >> 4, tx = tid & 15;
    float acc[4][4];
#pragma unroll
    for (int a = 0; a < 4; ++a)
#pragma unroll
      for (int b = 0; b < 4; ++b) acc[a][b] = 0.f;
    for (int c = 0; c < 128; ++c) {
      const f32x4 t4 = *(const f32x4*)(sT + c * 64 + tx * 4);
      float a4[4];
#pragma unroll
      for (int a = 0; a < 4; ++a) a4[a] = sA[(ty * 4 + a) * 129 + c];
#pragma unroll
      for (int a = 0; a < 4; ++a)
#pragma unroll
        for (int b = 0; b < 4; ++b) acc[a][b] += a4[a] * t4[b];
    }
#pragma unroll
    for (int b = 0; b < 4; ++b) {
      bf16_t* dp = dst + (size_t)(np0 + tx * 4 + b) * 1024 + k0 + ty * 4;
      *(u32x2*)dp = (u32x2){pk2(acc[0][b], acc[1][b]), pk2(acc[2][b], acc[3][b])};
    }
  }
  __syncthreads();
}

constexpr int CONV_TOTAL = 16 * 48 * 2 + 16 * 16 + 8 * 16 * 2 + 16 * 16 + 16 * 44 * 2 + 44 * 16 + 256 + 128;
DI void convert_iter(const Params& p, int l, int tb, char* smem0) {
  bf16_t* W = (bf16_t*)(p.ws + w_off(l));
  const float* win = p.w_in + (size_t)l * 1024 * N_IN;
  const int half = g_tid() >> 8;
  char* smem = smem0 + half * HALF_LDS;
  constexpr int C0 = 16 * 48, C1 = C0 + 16 * 48, C2 = C1 + 16 * 16, C3 = C2 + 8 * 16, C4 = C3 + 8 * 16, C5 = C4 + 16 * 16, C6 = C5 + 16 * 44, C7 = C6 + 16 * 44,
                C8 = C7 + 44 * 16, C9 = C8 + 256, C10 = C9 + 128;
  static_assert((C0 | C1 | C2 | C3 | C4 | C5 | C6 | C7 | C8 | C9 | C10) % 2 == 0, "segment boundaries must be even");
  const int total = C10;
  static_assert(C10 == CONV_TOTAL, "conversion tile count");
  {
    const bool active = (tb + half) < total;
    const int t = active ? tb + half : tb;
    int seg, r;
    if (t < C0) { seg = 0; r = t; } else if (t < C1) { seg = 1; r = t - C0; } else if (t < C2) { seg = 2; r = t - C1; } else if (t < C3) { seg = 3; r = t - C2; }
    else if (t < C4) { seg = 4; r = t - C3; } else if (t < C5) { seg = 5; r = t - C4; } else if (t < C6) { seg = 6; r = t - C5; } else if (t < C7) { seg = 7; r = t - C6; }
    else if (t < C8) { seg = 8; r = t - C7; } else if (t < C9) { seg = 9; r = t - C8; } else { seg = 10; r = t - C9; }
    if (seg <= 8) {
      const float* src; int ld, kt, nt, c0 = 0, dstld, ilv = 0; bf16_t* dst;
      if (seg <= 1) { kt = r & 15; nt = r >> 4; src = win; ld = N_IN; c0 = seg == 0 ? 0 : 4096; dst = W + WO_WIN + (seg == 0 ? 0 : (size_t)ROW_G * 1024); dstld = 1024; }
      else if (seg == 2) { kt = r & 15; nt = r >> 4; src = p.w_att_br + (size_t)l * 1024 * 1024; ld = 1024; dst = W + WO_WA; dstld = 1024; }
      else if (seg == 3) { kt = r & 7; nt = r >> 3; src = p.w_four_br + (size_t)l * 512 * 1024; ld = 1024; dst = W + WO_WF; dstld = 512; }
      else if (seg == 4) { kt = r & 7; nt = r >> 3; src = p.w_pool_br + (size_t)l * 512 * 1024; ld = 1024; dst = W + WO_WP; dstld = 512; }
      else if (seg == 5) { kt = r & 15; nt = r >> 4; src = p.w_out + (size_t)l * 1024 * 1024; ld = 1024; dst = W + WO_WO; dstld = 1024; }
      else if (seg == 6) { kt = r & 15; nt = r >> 4; src = p.w_ffn_gate + (size_t)l * 1024 * DFF; ld = DFF; dst = W + WO_WGU; dstld = 1024; ilv = 1; }
      else if (seg == 7) { kt = r & 15; nt = r >> 4; src = p.w_ffn_up + (size_t)l * 1024 * DFF; ld = DFF; dst = W + WO_WGU; dstld = 1024; ilv = 2; }
      else { kt = r % 44; nt = r / 44; src = p.w_ffn_down + (size_t)l * DFF * 1024; ld = 1024; dst = W + WO_WD; dstld = DFF; }
      conv_tile(active, src, ld, kt * 64, c0, dst, dstld, ilv, nt * 64, smem);
    } else if (seg == 9) {
      const int kt = r & 15, q = r >> 4; const int g = q & 3, hf = (q >> 2) & 1, mode = q >> 3;
      fold_tile(active, win, 3072 + g * 128, kt * 64, hf * 64, mode, nullptr, nullptr, W + WO_WIN + (size_t)((mode ? ROW_Z2 : ROW_Z1) + g * 128) * 1024, smem);
    } else {
      const int kt = r & 15, q = r >> 4; const int g = q & 3, hf = q >> 2;
      fold_tile(active, win, 3584 + g * 128, kt * 64, hf * 64, 2, p.w_pool_grp + ((size_t)l * 4 + g) * 128 * 128, p.pool_scale + (size_t)l * 512 + g * 128,
                W + WO_WIN + (size_t)(ROW_R + g * 128) * 1024, smem);
    }
  }
}

DI void convert_layer(const Params& p, int l, char* smem) {
  for (int tb = blockIdx.x * 2; tb < CONV_TOTAL; tb += gridDim.x * 2) convert_iter(p, l, tb, smem);
}

DI void convert_grab(const Params& p, int l, int which  , char* smem) {
  unsigned* ctr = (unsigned*)(p.ws + OFF_CTR) + l * 2 + which;
  volatile __attribute__((address_space(3))) unsigned* slot = (volatile __attribute__((address_space(3))) unsigned*)(lds_ptr_t)(smem + 3 * GSTAGE + 8);
  const int lo = which ? 2400 : 0, hi = which ? CONV_TOTAL : 2400;
  for (;;) {
    __syncthreads();
    if (__builtin_amdgcn_workitem_id_x() == 0) *slot = __hip_atomic_fetch_add(ctr, 2u, __ATOMIC_RELAXED, __HIP_MEMORY_SCOPE_AGENT);
    __syncthreads();
    const int tb = lo + (int)*slot;
    if (tb >= hi) break;
    convert_iter(p, l, tb, smem);
  }
  __syncthreads();
}

DI void phase0a(const Params& p, char* smem) {
  const int tid = g_tid();
  const int gtid = blockIdx.x * 512 + tid, gsz = gridDim.x * 512;
  {
    const int half = tid >> 8, t8 = tid & 255;
    float* ssil = (float*)smem;
    float* sred = (float*)(smem + 36864 + half * 9216);
    bool filled = false;
    float* modv = (float*)(p.ws + OFF_MODV);
    for (int tb = blockIdx.x * 2; tb < DEPTH * 96; tb += gridDim.x * 2) {
      if (!filled) {
        for (int i = tid; i < 9 * 1024; i += 512) { const float v = (i < 8192) ? p.c[i] : p.c_ctx[i - 8192]; ssil[i] = v * sigmoidf_(v); }
        filled = true;
        __syncthreads();
      }
      const int t = tb + half;
      const int l = t / 96, cgp = t % 96;
      const int col = cgp * 64 + (t8 & 63), kq = t8 >> 6;
      const float* wp = p.w_mod + ((size_t)l * 1024 + kq * 256) * 6144 + col;
      float a[9];
#pragma unroll
      for (int r = 0; r < 9; ++r) a[r] = 0.f;
#pragma unroll 4
      for (int k = 0; k < 256; ++k) {
        const float w = wp[(size_t)k * 6144];
#pragma unroll
        for (int r = 0; r < 9; ++r) a[r] += ssil[r * 1024 + kq * 256 + k] * w;
      }
#pragma unroll
      for (int r = 0; r < 9; ++r) sred[(kq * 9 + r) * 64 + (t8 & 63)] = a[r];
      __syncthreads();
      for (int i = t8; i < 9 * 64; i += 256) {
        const int r = i >> 6, cc = i & 63;
        const float v = sred[(0 * 9 + r) * 64 + cc] + sred[(1 * 9 + r) * 64 + cc] + sred[(2 * 9 + r) * 64 + cc] + sred[(3 * 9 + r) * 64 + cc];
        modv[((size_t)l * 9 + r) * 6144 + cgp * 64 + cc] = v + p.b_mod[(size_t)l * 6144 + cgp * 64 + cc];
      }
      __syncthreads();
    }
    __syncthreads();
  }
  convert_layer(p, 0, smem);
  {
    bf16_t* at = (bf16_t*)(p.ws + OFF_ATAB);
    for (int i = gtid; i < 2048 * 512; i += gsz) {
      const int k = i >> 9, c8 = (i & 511) * 8;
      unsigned w[4];
#pragma unroll
      for (int j = 0; j < 4; ++j) {
        float v[2];
#pragma unroll
        for (int e = 0; e < 2; ++e) {
          const int tp = c8 + 2 * j + e; const int tt = tp & 2047;
          const float r = (float)((k * tt) & 2047) * (1.0f / 2048.0f);
          v[e] = (tp < 2048) ? hw_cos_rev(r) : -hw_sin_rev(r);
        }
        w[j] = pk2(v[0], v[1]);
      }
      *(u32x4*)(at + (size_t)k * 4096 + c8) = (u32x4){w[0], w[1], w[2], w[3]};
    }
    bf16_t* atc = (bf16_t*)(p.ws + OFF_ATABC);
    for (int i = gtid; i < 256 * 64; i += gsz) {
      const int k = i >> 6, c8 = (i & 63) * 8;
      unsigned w[4];
#pragma unroll
      for (int j = 0; j < 4; ++j) {
        float v[2];
#pragma unroll
        for (int e = 0; e < 2; ++e) {
          const int tp = c8 + 2 * j + e; const int tt = tp & 255;
          const float r = (float)((k * tt) & 255) * (1.0f / 256.0f);
          v[e] = (tp < 256) ? hw_cos_rev(r) : -hw_sin_rev(r);
        }
        w[j] = pk2(v[0], v[1]);
      }
      *(u32x4*)(atc + (size_t)k * 512 + c8) = (u32x4){w[0], w[1], w[2], w[3]};
    }
  }
  {
    float* rc = (float*)(p.ws + OFF_ROPEC); float* rs = (float*)(p.ws + OFF_ROPES);
    for (int i = gtid; i < 2048 * 32; i += gsz) {
      const int t = i >> 5, a = i & 31, f = a & 15;
      const float pos = (float)((a < 16) ? (t >> 6) : (t & 63));
      const float inv = exp2f(-(float)f * (13.287712379549449f / 16.0f));
      float r = pos * inv * 0.15915494309189535f;
      r -= floorf(r);
      rc[i] = hw_cos_rev(r); rs[i] = hw_sin_rev(r);
    }
  }
  if (gtid < DEPTH) {
    const float* lq = p.lam_qk + (size_t)gtid * 256;
    float s1 = 0.f, s2 = 0.f;
    for (int i = 0; i < 64; ++i) { s1 += lq[i] * lq[64 + i]; s2 += lq[128 + i] * lq[192 + i]; }
    ((float*)(p.ws + OFF_LAMV))[gtid] = expf(s1) - expf(s2) + p.lam_init[gtid];
  }
}

DI void ln_pass(const Params& p, int mode, int nrows, const bf16_t* __restrict__ Yb, const float* __restrict__ lng, const float* __restrict__ lnb,
                        int modl_gate, int gate_chunk, int modl_next, int sh_chunk) {
  const int lane = g_tid() & 63, wid = g_tid() >> 6;
  float* X = (float*)(p.ws + OFF_X);
  bf16_t* U = (bf16_t*)(p.ws + OFF_U);
  const float* modv = (const float*)(p.ws + OFF_MODV);
  f32x4 xv[4], xn[4]; u32x2 yv[4], yn[4];
  const int r0 = blockIdx.x * 8 + wid, rstride = gridDim.x * 8;
  if (mode != 0 && r0 < nrows) {
#pragma unroll
    for (int i = 0; i < 4; ++i) { xv[i] = *(const f32x4*)(X + (size_t)r0 * 1024 + lane * 4 + 256 * i); yv[i] = *(const u32x2*)(Yb + (size_t)r0 * 1024 + lane * 4 + 256 * i); }
  }
  for (int r = r0; r < nrows; r += rstride) {
    int b, pos; bool isctx; row_info(r, b, pos, isctx);
    const int mr = isctx ? 8 : b;
    f32x4 v[4];
    if (mode == 0) {
      const float* src = isctx ? (p.ctx + (size_t)(r - T_LAT) * 1024) : (p.x + (size_t)r * 1024);
#pragma unroll
      for (int i = 0; i < 4; ++i) v[i] = *(const f32x4*)(src + lane * 4 + 256 * i);
#pragma unroll
      for (int i = 0; i < 4; ++i) *(f32x4*)(X + (size_t)r * 1024 + lane * 4 + 256 * i) = v[i];
    } else {
      const int rn = r + rstride;
      if (rn < nrows) {
#pragma unroll
        for (int i = 0; i < 4; ++i) { xn[i] = *(const f32x4*)(X + (size_t)rn * 1024 + lane * 4 + 256 * i); yn[i] = *(const u32x2*)(Yb + (size_t)rn * 1024 + lane * 4 + 256 * i); }
      }
      const float* gv = modv + ((size_t)modl_gate * 9 + mr) * 6144 + gate_chunk * 1024;
      float s = 0.f;
#pragma unroll
      for (int i = 0; i < 4; ++i) {
        const int col = lane * 4 + 256 * i;
        const f32x4 g = *(const f32x4*)(gv + col);
        v[i][0] = ALPHA * xv[i][0] + g[0] * bf_lo(yv[i][0]); v[i][1] = ALPHA * xv[i][1] + g[1] * bf_hi(yv[i][0]);
        v[i][2] = ALPHA * xv[i][2] + g[2] * bf_lo(yv[i][1]); v[i][3] = ALPHA * xv[i][3] + g[3] * bf_hi(yv[i][1]);
        s += (v[i][0] + v[i][1]) + (v[i][2] + v[i][3]);
      }
#pragma unroll
      for (int i = 0; i < 4; ++i) { xv[i] = xn[i]; yv[i] = yn[i]; }
      const float mu = wave_sum(s) * (1.0f / 1024.0f);
      float q = 0.f;
#pragma unroll
      for (int i = 0; i < 4; ++i) { const f32x4 d = v[i] - mu; q += (d[0] * d[0] + d[1] * d[1]) + (d[2] * d[2] + d[3] * d[3]); }
      const float rstd = rsqrtf(wave_sum(q) * (1.0f / 1024.0f) + LN_EPS);
#pragma unroll
      for (int i = 0; i < 4; ++i) {
        const int col = lane * 4 + 256 * i;
        const f32x4 g = *(const f32x4*)(lng + col), bb = *(const f32x4*)(lnb + col);
        v[i] = (v[i] - mu) * rstd * g + bb;
        if (mode == 2) *(f32x4*)(p.out + (size_t)r * 1024 + col) = v[i];
        else *(f32x4*)(X + (size_t)r * 1024 + col) = v[i];
      }
    }
    if (mode != 2) {
      float s = 0.f;
#pragma unroll
      for (int i = 0; i < 4; ++i) s += (v[i][0] + v[i][1]) + (v[i][2] + v[i][3]);
      const float mu = wave_sum(s) * (1.0f / 1024.0f);
      float q = 0.f;
#pragma unroll
      for (int i = 0; i < 4; ++i) { const f32x4 d = v[i] - mu; q += (d[0] * d[0] + d[1] * d[1]) + (d[2] * d[2] + d[3] * d[3]); }
      const float rstd = rsqrtf(wave_sum(q) * (1.0f / 1024.0f) + LN_EPS);
      const float* shv = modv + ((size_t)modl_next * 9 + mr) * 6144 + sh_chunk * 1024;
      const float* scv = shv + 1024;
#pragma unroll
      for (int i = 0; i < 4; ++i) {
        const int col = lane * 4 + 256 * i;
        const f32x4 sh = *(const f32x4*)(shv + col), sc = *(const f32x4*)(scv + col);
        const f32x4 u = (v[i] - mu) * rstd * (sc + 1.0f) + sh;
        *(u32x2*)(U + (size_t)r * 1024 + col) = (u32x2){pk2(u[0], u[1]), pk2(u[2], u[3])};
      }
    }
  }
}

DI bool tile_map(int v, int nmt, int nnt, int& mt, int& nt) {
  const int c = v >> 8, w = v & 255, xcd = w & 7, local = w >> 3;
  const int spr = nnt >> 2, nsup = (nmt >> 3) * spr, sup = c * 8 + xcd;
  if (sup >= nsup) return false;
  mt = (sup / spr) * 8 + (local & 7); nt = (sup % spr) * 4 + (local >> 3);
  return true;
}
DI int tile_vmax(int nmt, int nnt) { const int nsup = (nmt >> 3) * (nnt >> 2); return ((nsup + 7) >> 3) << 8; }

DI void phase_inproj(const Params& p, int l, char* smem) {
  const bool last = (l == DEPTH - 1);
  const bf16_t* W = (const bf16_t*)(p.ws + w_off(l)) + WO_WIN;
  const bf16_t* U = (const bf16_t*)(p.ws + OFF_U);
  bf16_t* KB = (bf16_t*)(p.ws + OFF_KB); bf16_t* VT = (bf16_t*)(p.ws + OFF_VT); bf16_t* QB = (bf16_t*)(p.ws + OFF_QB); bf16_t* CQ = (bf16_t*)(p.ws + OFF_CQ);
  bf16_t* ZT = (bf16_t*)(p.ws + OFF_ZT); bf16_t* ZTC = (bf16_t*)(p.ws + OFF_ZTC); bf16_t* R = (bf16_t*)(p.ws + OFF_R);
  const float* ropec = (const float*)(p.ws + OFF_ROPEC); const float* ropes = (const float*)(p.ws + OFF_ROPES);
  const int nsupA = last ? 72 : 81, nsup = last ? 76 : 81;
  const int vmax = ((nsup + 15) >> 4) << 8;
  auto map_tile = [&](int v, int& mt, int& nt) -> bool {
    if (v >= vmax) return false;
    const int c = v >> 8, w = v & 255, local = w >> 3, sup = (c * 8 + (w & 7)) * 2 + (local >> 4);
    if (sup >= nsup) return false;
    if (sup < nsupA) { mt = (sup / 9) * 8 + (local & 7); nt = (sup % 9) * 2 + ((local >> 3) & 1); }
    else { mt = 64 + (local & 7); nt = (sup - nsupA) * 2 + ((local >> 3) & 1); }
    return true;
  };
  int v = blockIdx.x, mt = 0, nt = 0;
  bool cur = map_tile(v, mt, nt);
  if (cur) gemm_prefetch_big(U + (size_t)mt * 256 * 1024, 1024, W + (size_t)nt * 256 * 1024, 1024, smem);
  while (cur) {
    const int m0 = mt * 256;
    int b, pos0; bool isctx; row_info(m0, b, pos0, isctx);
    f32x4 acc[8][4];
#pragma unroll
    for (int i = 0; i < 8; ++i)
#pragma unroll
      for (int j = 0; j < 4; ++j) acc[i][j] = (f32x4){0.f, 0.f, 0.f, 0.f};
    const bool swap = !((nt >= 4 && nt < 8) || (nt >= 12 && nt < 16));
    if (swap) gemm_kloop_big<true>(U + (size_t)m0 * 1024, 1024, W + (size_t)nt * 256 * 1024, 1024, 1024, acc, smem, true);
    else gemm_kloop_big<false>(U + (size_t)m0 * 1024, 1024, W + (size_t)nt * 256 * 1024, 1024, 1024, acc, smem, true);
    int v2 = v + gridDim.x, mt2 = 0, nt2 = 0;
    const bool nxt = map_tile(v2, mt2, nt2);
    if (nxt) gemm_prefetch_big(U + (size_t)mt2 * 256 * 1024, 1024, W + (size_t)nt2 * 256 * 1024, 1024, smem);
    const int tid = g_tid(), lane = tid & 63, wid = __builtin_amdgcn_readfirstlane(tid >> 6), wm = wid >> 2, wn = wid & 3;
    const int fq = lane >> 4, fr = lane & 15;
    const int ncol0 = nt * 256 + wn * 64;
    const int prow0 = pos0 + wm * 128;
    if (ncol0 < 1024 || (ncol0 >= 2048 && ncol0 < 3072)) {
      const bool isq = ncol0 >= 2048; const int h = (ncol0 >> 7) & 7, map = (ncol0 >> 6) & 1;
#pragma unroll
      for (int mi = 0; mi < 8; ++mi) {
        const int pos = prow0 + mi * 16 + fr;
        f32x4 o[4];
        if (!isctx) {
#pragma unroll
          for (int pr = 0; pr < 2; ++pr) {
            const f32x4 cs = *(const f32x4*)(ropec + pos * 32 + pr * 16 + fq * 4);
            const f32x4 sn = *(const f32x4*)(ropes + pos * 32 + pr * 16 + fq * 4);
            const f32x4 x0 = acc[mi][2 * pr], x1 = acc[mi][2 * pr + 1];
            o[2 * pr] = x0 * cs - x1 * sn;
            o[2 * pr + 1] = x1 * cs + x0 * sn;
          }
        } else {
#pragma unroll
          for (int ni = 0; ni < 4; ++ni) o[ni] = acc[mi][ni];
        }
        bf16_t* dst;
        if (!isq) dst = KB + ((size_t)((b * 8 + h) * 2 + map) * NKEY + (isctx ? SEQ + pos : pos)) * 64;
        else if (!isctx) dst = QB + ((size_t)((b * 8 + h) * 2 + map) * SEQ + pos) * 64;
        else dst = CQ + ((size_t)((b * 8 + h) * 2 + map) * LC + pos) * 64;
        const float sc = isq ? QSCALE : 1.0f;
#pragma unroll
        for (int ni = 0; ni < 4; ++ni) {
          const f32x4 vv = o[ni] * sc;
          *(u32x2*)(dst + ni * 16 + fq * 4) = (u32x2){pk2(vv[0], vv[1]), pk2(vv[2], vv[3])};
        }
      }
    } else if (ncol0 < 2048) {
      const int h = (ncol0 - 1024) >> 7, vc0 = ncol0 & 127;
#pragma unroll
      for (int mi = 0; mi < 8; ++mi) {
        const int key = (isctx ? SEQ : 0) + prow0 + mi * 16 + fq * 4;
        const int k15 = key & 15;
        const int pkey = (key & ~15) | (k15 & 3) | ((k15 & 4) << 1) | ((k15 & 8) >> 1);
#pragma unroll
        for (int ni = 0; ni < 4; ++ni) {
          const int vcol = vc0 + ni * 16 + fr;
          const f32x4 vv = acc[mi][ni];
          *(u32x2*)(VT + ((size_t)(b * 8 + h) * 128 + vcol) * NKEY + pkey) = (u32x2){pk2(vv[0], vv[1]), pk2(vv[2], vv[3])};
        }
      }
    } else if (ncol0 < 4096) {
#pragma unroll
      for (int mi = 0; mi < 8; ++mi) {
        const int pos = prow0 + mi * 16 + fq * 4;
#pragma unroll
        for (int ni = 0; ni < 4; ++ni) {
          const int zc = ncol0 - 3072 + ni * 16 + fr;
          const int np = zc & 511, second = zc >> 9;
          const f32x4 vv = acc[mi][ni];
          bf16_t* dst = isctx ? (ZTC + ((size_t)b * 512 + np) * 512 + second * 256 + pos) : (ZT + ((size_t)b * 512 + np) * 4096 + second * 2048 + pos);
          *(u32x2*)dst = (u32x2){pk2(vv[0], vv[1]), pk2(vv[2], vv[3])};
        }
      }
    } else {
#pragma unroll
      for (int mi = 0; mi < 8; ++mi) {
        const int row = m0 + wm * 128 + mi * 16 + fr;
#pragma unroll
        for (int ni = 0; ni < 4; ++ni) {
          const int col = ncol0 - 4096 + ni * 16 + fq * 4;
          const f32x4 vv = acc[mi][ni];
          *(u32x2*)(R + (size_t)row * 512 + col) = (u32x2){pk2(vv[0], vv[1]), pk2(vv[2], vv[3])};
        }
      }
    }
    v = v2; mt = mt2; nt = nt2; cur = nxt;
  }
}

DI void attn_unit(const bf16_t* __restrict__ Qb  , int nq, int q0, const bf16_t* __restrict__ Kb  ,
                  const bf16_t* __restrict__ VTb  , int key0, int ntiles  , bf16_t* __restrict__ outp  ,
                  const float* __restrict__ subg, float lam, float nscale, char* smem) {
  const int tid = g_tid(), lane = tid & 63, wid = __builtin_amdgcn_readfirstlane(tid >> 6), wq = wid & 3, map = wid >> 2;
  const int l31 = lane & 31, kh = lane >> 5;
  bf16x8 qf[4];
  {
    const bf16_t* qp = Qb + ((size_t)map * nq + q0 + wq * 32 + l31) * 64 + kh * 8;
#pragma unroll
    for (int s = 0; s < 4; ++s) qf[s] = *(const bf16x8*)(qp + s * 16);
  }
  const int srow = tid >> 3, sc = (tid & 7) ^ ((tid >> 4) & 7);
  const unsigned koff = (unsigned)((key0 + srow) * 64 + sc * 8) * 2u;
  const unsigned voff = (unsigned)(srow * NKEY + key0 + sc * 8) * 2u;
  const char* Kc = (const char*)Kb; const char* Vc = (const char*)VTb;
  char* sdst = smem + tid * 16;
#define A_ISSUE(T) do { char* d_ = sdst + ((T) & 3) * 32768; \
    __builtin_amdgcn_global_load_lds((const void*)(Kc + (size_t)(T) * 8192 + koff), (lds_ptr_t)(d_), 16, 0, 0); \
    __builtin_amdgcn_global_load_lds((const void*)(Kc + (size_t)NKEY * 128 + (size_t)(T) * 8192 + koff), (lds_ptr_t)(d_ + 8192), 16, 0, 0); \
    __builtin_amdgcn_global_load_lds((const void*)(Vc + (size_t)(T) * 128 + voff), (lds_ptr_t)(d_ + 16384), 16, 0, 0); \
    __builtin_amdgcn_global_load_lds((const void*)(Vc + (size_t)64 * NKEY * 2 + (size_t)(T) * 128 + voff), (lds_ptr_t)(d_ + 24576), 16, 0, 0); } while (0)
  f32x16 O[4];
#pragma unroll
  for (int vb = 0; vb < 4; ++vb)
#pragma unroll
    for (int i = 0; i < 16; ++i) O[vb][i] = 0.f;
  float m = 0.f, lsum = 0.f;
  const int sw = (lane >> 1) & 7;
  const int kfo = l31 * 128, cho = kh;
#define A_QK(SX, T) do { const char* st_ = smem + ((T) & 3) * 32768 + map * 8192 + kfo; \
    bf16x8 kf_[8]; \
    _Pragma("unroll") for (int s = 0; s < 4; ++s) _Pragma("unroll") for (int kb = 0; kb < 2; ++kb) \
        kf_[s * 2 + kb] = *(const bf16x8*)(st_ + kb * 4096 + (((2 * s + cho) ^ sw) << 4)); \
    _Pragma("unroll") for (int kb = 0; kb < 2; ++kb) _Pragma("unroll") for (int i = 0; i < 16; ++i) SX[kb][i] = -m; \
    __builtin_amdgcn_sched_barrier(0); \
    _Pragma("unroll") for (int s = 0; s < 4; ++s) _Pragma("unroll") for (int kb = 0; kb < 2; ++kb) \
        SX[kb] = MFMA32(kf_[s * 2 + kb], qf[s], SX[kb]); \
    __builtin_amdgcn_sched_barrier(0); } while (0)
  bf16x8 pf[4];
  auto pv = [&](int T) {
    const char* sv = smem + (T & 3) * 32768 + 16384 + kfo;
    __builtin_amdgcn_sched_barrier(0);
    bf16x8 va[4], vb_[4];
#pragma unroll
    for (int vb = 0; vb < 4; ++vb) va[vb] = *(const bf16x8*)(sv + vb * 4096 + (((0 + cho) ^ sw) << 4));
#pragma unroll
    for (int vb = 0; vb < 4; ++vb) vb_[vb] = *(const bf16x8*)(sv + vb * 4096 + (((2 + cho) ^ sw) << 4));
    __builtin_amdgcn_sched_barrier(0);
#pragma unroll
    for (int vb = 0; vb < 4; ++vb) O[vb] = MFMA32(va[vb], pf[0], O[vb]);
    __builtin_amdgcn_sched_barrier(0);
#pragma unroll
    for (int vb = 0; vb < 4; ++vb) va[vb] = *(const bf16x8*)(sv + vb * 4096 + (((4 + cho) ^ sw) << 4));
    __builtin_amdgcn_sched_barrier(0);
#pragma unroll
    for (int vb = 0; vb < 4; ++vb) O[vb] = MFMA32(vb_[vb], pf[1], O[vb]);
    __builtin_amdgcn_sched_barrier(0);
#pragma unroll
    for (int vb = 0; vb < 4; ++vb) vb_[vb] = *(const bf16x8*)(sv + vb * 4096 + (((6 + cho) ^ sw) << 4));
    __builtin_amdgcn_sched_barrier(0);
#pragma unroll
    for (int vb = 0; vb < 4; ++vb) O[vb] = MFMA32(va[vb], pf[2], O[vb]);
    __builtin_amdgcn_sched_barrier(0);
#pragma unroll
    for (int vb = 0; vb < 4; ++vb) O[vb] = MFMA32(vb_[vb], pf[3], O[vb]);
    __builtin_amdgcn_sched_barrier(0);
  };
  auto softmax = [&](f32x16 (&SC)[2], f32x16 (&SN)[2], bool has_next, bool first) {
    float mx[16];
#pragma unroll
    for (int i = 0; i < 16; ++i) mx[i] = fmaxf(SC[0][i], SC[1][i]);
#pragma unroll
    for (int w = 8; w >= 1; w >>= 1)
#pragma unroll
      for (int i = 0; i < w; ++i) mx[i] = fmaxf(mx[i], mx[i + w]);
    float tmax = xor32_max(mx[0]);
    if (first || __any(tmax > 8.0f)) {
      const float delta = first ? tmax : fmaxf(tmax, 0.f);
      const float alpha = first ? 1.0f : __builtin_amdgcn_exp2f(-delta);
      m += delta; lsum *= alpha;
#pragma unroll
      for (int vb = 0; vb < 4; ++vb) O[vb] = O[vb] * alpha;
#pragma unroll
      for (int kb = 0; kb < 2; ++kb)
#pragma unroll
        for (int i = 0; i < 16; ++i) SC[kb][i] -= delta;
      if (has_next) {
#pragma unroll
        for (int kb = 0; kb < 2; ++kb)
#pragma unroll
          for (int i = 0; i < 16; ++i) SN[kb][i] -= delta;
      }
    }
    float sm[16];
#pragma unroll
    for (int i = 0; i < 16; ++i) { const float e0 = __builtin_amdgcn_exp2f(SC[0][i]), e1 = __builtin_amdgcn_exp2f(SC[1][i]); SC[0][i] = e0; SC[1][i] = e1; sm[i] = e0 + e1; }
#pragma unroll
    for (int w = 8; w >= 1; w >>= 1)
#pragma unroll
      for (int i = 0; i < w; ++i) sm[i] += sm[i + w];
    lsum += sm[0];
#pragma unroll
    for (int g = 0; g < 4; ++g) {
      const int kb = g >> 1, s2 = g & 1;
      u32x4 w;
      w[0] = pk2(SC[kb][8 * s2 + 0], SC[kb][8 * s2 + 1]); w[1] = pk2(SC[kb][8 * s2 + 2], SC[kb][8 * s2 + 3]);
      w[2] = pk2(SC[kb][8 * s2 + 4], SC[kb][8 * s2 + 5]); w[3] = pk2(SC[kb][8 * s2 + 6], SC[kb][8 * s2 + 7]);
      pf[g] = __builtin_bit_cast(bf16x8, w);
    }
  };
  f32x16 Sa[2], Sb[2];
  if (wid >= 4) __builtin_amdgcn_s_setprio(1);
  WAIT_VM(0);
  A_ISSUE(0); A_ISSUE(1); A_ISSUE(2);
  WAIT_VM(8);
  __builtin_amdgcn_s_barrier();
  asm volatile("" ::: "memory");
  A_QK(Sa, 0);
  for (int t = 0; t < ntiles; t += 2) {
    if (t + 2 < ntiles) WAIT_VM(4); else WAIT_VM(0);
    __builtin_amdgcn_s_barrier();
    asm volatile("" ::: "memory");
    if (t + 3 < ntiles) A_ISSUE(t + 3);
    A_QK(Sb, t + 1);
    softmax(Sa, Sb, true, t == 0);
    pv(t);
    const bool nx = (t + 2 < ntiles);
    if (nx) { if (t + 3 < ntiles) WAIT_VM(4); else WAIT_VM(0); }
    __builtin_amdgcn_s_barrier();
    asm volatile("" ::: "memory");
    if (t + 4 < ntiles) A_ISSUE(t + 4);
    if (nx) A_QK(Sa, t + 2);
    softmax(Sb, Sa, nx, false);
    pv(t + 1);
  }
  __builtin_amdgcn_s_setprio(0);
  asm volatile("s_waitcnt lgkmcnt(0)" ::: "memory");
  __builtin_amdgcn_s_barrier();
  asm volatile("" ::: "memory");
#undef A_ISSUE
#undef A_QK
  const float ltot = xor32_sum(lsum);
  const float inv = 1.0f / ltot;
  float* ex = (float*)smem;
  if (map == 1) {
#pragma unroll
    for (int vb = 0; vb < 4; ++vb)
#pragma unroll
      for (int g4 = 0; g4 < 4; ++g4) {
        f32x4 v = {O[vb][4 * g4] * inv, O[vb][4 * g4 + 1] * inv, O[vb][4 * g4 + 2] * inv, O[vb][4 * g4 + 3] * inv};
        *(f32x4*)(ex + (wq * 32 + l31) * 132 + vb * 32 + 8 * g4 + 4 * kh) = v;
      }
  }
  __syncthreads();
  if (map == 0) {
    float ss = 0.f;
#pragma unroll
    for (int vb = 0; vb < 4; ++vb)
#pragma unroll
      for (int g4 = 0; g4 < 4; ++g4) {
        const f32x4 o2 = *(const f32x4*)(ex + (wq * 32 + l31) * 132 + vb * 32 + 8 * g4 + 4 * kh);
#pragma unroll
        for (int j = 0; j < 4; ++j) { const float o = O[vb][4 * g4 + j] * inv - lam * o2[j]; O[vb][4 * g4 + j] = o; ss += o * o; }
      }
    ss = xor32_sum(ss);
    const float rs = rsqrtf(ss * (1.0f / 128.0f) + LN_EPS) * nscale;
    bf16_t* op = outp + (size_t)(wq * 32 + l31) * 1024;
#pragma unroll
    for (int vb = 0; vb < 4; ++vb)
#pragma unroll
      for (int g4 = 0; g4 < 4; ++g4) {
        const int vc = vb * 32 + 8 * g4 + 4 * kh;
        const f32x4 g = *(const f32x4*)(subg + vc);
        *(u32x2*)(op + vc) = (u32x2){pk2(O[vb][4 * g4] * rs * g[0], O[vb][4 * g4 + 1] * rs * g[1]), pk2(O[vb][4 * g4 + 2] * rs * g[2], O[vb][4 * g4 + 3] * rs * g[3])};
      }
  }
  __syncthreads();
}

template <int MI>
DI void store_tile_bf16(const f32x4 (&acc)[MI][4], bf16_t* __restrict__ C, int ldc, float scale) {
  const int tid = g_tid(), lane = tid & 63, wid = __builtin_amdgcn_readfirstlane(tid >> 6), wm = wid >> 1, wn = wid & 1, fq = lane >> 4, fr = lane & 15;
#pragma unroll
  for (int mi = 0; mi < MI; ++mi)
#pragma unroll
    for (int ni = 0; ni < 4; ++ni) {
      const f32x4 v = acc[mi][ni] * scale;
      *(u32x2*)(C + (size_t)(wm * 16 * MI + mi * 16 + fr) * ldc + wn * 64 + ni * 16 + fq * 4) = (u32x2){pk2(v[0], v[1]), pk2(v[2], v[3])};
    }
}

template <int W>
DI void pool_rows(const bf16_t* __restrict__ R, bf16_t* __restrict__ PM, int m0, int g, int rhalf, int lane) {
  constexpr int LO = W / 2;
  const int col = g * 128 + (lane & 15) * 8;
#pragma unroll 2
  for (int ps = 0; ps < 8; ++ps) {
    const int row = m0 + ps * 8 + rhalf * 4 + (lane >> 4);
    int b, pos; bool isctx; row_info(row, b, pos, isctx);
    const int L = isctx ? LC : SEQ;
    const int rbase = row - pos;
    float s[8];
#pragma unroll
    for (int j = 0; j < 8; ++j) s[j] = 0.f;
    int cnt = 0;
    u32x4 self = {0u, 0u, 0u, 0u};
#pragma unroll
    for (int k = 0; k < W; ++k) {
      const int q = pos - LO + k;
      const bool ok = (q >= 0) && (q < L);
      const int qc = ok ? q : pos;
      const u32x4 v = *(const u32x4*)(R + (size_t)(rbase + qc) * 512 + col);
      const float f = ok ? 1.0f : 0.0f;
      cnt += ok ? 1 : 0;
#pragma unroll
      for (int j = 0; j < 4; ++j) { s[2 * j] += f * bf_lo(v[j]); s[2 * j + 1] += f * bf_hi(v[j]); }
      if (k == LO) self = v;
    }
    const float ic = 1.0f / (float)cnt;
    u32x4 o;
#pragma unroll
    for (int j = 0; j < 4; ++j) o[j] = pk2(s[2 * j] * ic - bf_lo(self[j]), s[2 * j + 1] * ic - bf_hi(self[j]));
    *(u32x4*)(PM + (size_t)row * 512 + col) = o;
  }
}
DI void pool_task(const bf16_t* __restrict__ R, bf16_t* __restrict__ PM, int m0) {
  const int tid = g_tid(), lane = tid & 63, wid = __builtin_amdgcn_readfirstlane(tid >> 6), g = wid & 3, rhalf = wid >> 2;
  if (g == 0) pool_rows<2>(R, PM, m0, 0, rhalf, lane);
  else if (g == 1) pool_rows<4>(R, PM, m0, 1, rhalf, lane);
  else if (g == 2) pool_rows<8>(R, PM, m0, 2, rhalf, lane);
  else pool_rows<16>(R, PM, m0, 3, rhalf, lane);
}

DI void phase_mix(const Params& p, int l, char* smem) {
  const bool last = (l == DEPTH - 1);
  const bf16_t* KB = (const bf16_t*)(p.ws + OFF_KB); const bf16_t* VT = (const bf16_t*)(p.ws + OFF_VT);
  const bf16_t* QB = (const bf16_t*)(p.ws + OFF_QB); const bf16_t* CQ = (const bf16_t*)(p.ws + OFF_CQ);
  const bf16_t* ZT = (const bf16_t*)(p.ws + OFF_ZT); const bf16_t* ZTC = (const bf16_t*)(p.ws + OFF_ZTC); const bf16_t* R = (const bf16_t*)(p.ws + OFF_R);
  bf16_t* ATT = (bf16_t*)(p.ws + OFF_ATT); bf16_t* FM = (bf16_t*)(p.ws + OFF_FM); bf16_t* PM = (bf16_t*)(p.ws + OFF_PM);
  const bf16_t* ATAB = (const bf16_t*)(p.ws + OFF_ATAB); const bf16_t* ATABC = (const bf16_t*)(p.ws + OFF_ATABC);
  const float lam = ((const float*)(p.ws + OFF_LAMV))[l];
  const float nscale = 1.0f - p.lam_init[l];
  const float* subg = p.subln_g + (size_t)l * 128;
  for (int r = blockIdx.x; r < 1024; r += gridDim.x) {
    const int c = r >> 8, w = r & 255, xcd = w & 7, local = w >> 3;
    const int bh = c * 16 + xcd * 2 + (local >> 4), qb = local & 15;
    const int b = bh >> 3, h = bh & 7;
    attn_unit(QB + (size_t)bh * 2 * SEQ * 64, SEQ, qb * 128, KB + (size_t)bh * 2 * NKEY * 64, VT + (size_t)bh * 128 * NKEY, 0, NKEY / 64,
              ATT + ((size_t)b * SEQ + qb * 128) * 1024 + h * 128, subg, lam, nscale, smem);
  }
  const int G = gridDim.x, nlo = G >> 1, nhi = G - nlo;
  if ((int)blockIdx.x < nlo) {
    for (int d = blockIdx.x; d < 128; d += nlo) {
      const int b = d & 7, local = d >> 3, mt = local & 3, nt = local >> 2;
      const bf16_t* Ab = ATAB + (size_t)mt * 256 * 4096; const bf16_t* Bb = ZT + ((size_t)b * 512 + nt * 128) * 4096;
      f32x4 accP[4][4], accQ[4][4]; zero_acc(accP); zero_acc(accQ);
      gemm_kloop_pp<true>(Ab, 4096, Bb, 4096, 2048, accP, smem);
      gemm_kloop_pp<true>(Ab + 2048, 4096, Bb + 2048, 4096, 2048, accQ, smem);
      const int tid = g_tid(), lane = tid & 63, wid = __builtin_amdgcn_readfirstlane(tid >> 6), wm = wid >> 1, wn = wid & 1, fq = lane >> 4, fr = lane & 15;
#pragma unroll
      for (int mi = 0; mi < 4; ++mi) {
        const int k = mt * 256 + wm * 64 + mi * 16 + fr;
#pragma unroll
        for (int ni = 0; ni < 4; ++ni) {
          const int col = nt * 128 + wn * 64 + ni * 16 + fq * 4;
          const f32x4 y1 = (accP[mi][ni] + accQ[mi][ni]) * (1.0f / 512.0f), y2 = (accP[mi][ni] - accQ[mi][ni]) * (1.0f / 512.0f);
          *(u32x2*)(FM + ((size_t)b * SEQ + k) * 512 + col) = (u32x2){pk2(y1[0], y1[1]), pk2(y1[2], y1[3])};
          if (k > 0) *(u32x2*)(FM + ((size_t)b * SEQ + (SEQ - k)) * 512 + col) = (u32x2){pk2(y2[0], y2[1]), pk2(y2[2], y2[3])};
        }
      }
    }
  } else {
    const int n_cattn = last ? 0 : 128, n_cdft = last ? 0 : 32, n_pool = last ? 256 : 288, n_mid = 64;
    const int n_small = n_cattn + n_cdft + n_pool + n_mid;
    for (int t = (int)blockIdx.x - nlo; t < n_small; t += nhi) {
      int r = t;
      if (r < n_cattn) {
        const int bh = r >> 1, qb = r & 1, b = bh >> 3, h = bh & 7;
        attn_unit(CQ + (size_t)bh * 2 * LC * 64, LC, qb * 128, KB + (size_t)bh * 2 * NKEY * 64, VT + (size_t)bh * 128 * NKEY, SEQ, LC / 64,
                  ATT + ((size_t)T_LAT + b * LC + qb * 128) * 1024 + h * 128, subg, lam, nscale, smem);
        continue;
      }
      r -= n_cattn;
      if (r < n_cdft) {
        const int b = r >> 2, nt = r & 3;
        f32x4 acc[4][4]; zero_acc(acc);
        gemm_kloop_pp<true>(ATABC, 512, ZTC + ((size_t)b * 512 + nt * 128) * 512, 512, 512, acc, smem);
        store_tile_bf16<4>(acc, FM + ((size_t)T_LAT + b * LC) * 512 + nt * 128, 512, 0.005524271728019903f  );
        continue;
      }
      r -= n_cdft;
      if (r < n_pool) { pool_task(R, PM, r * 64); continue; }
      r -= n_pool;
      {
        const int b = r >> 3, sub = r & 7;
        const int tid = g_tid(), lane = tid & 63, wid = __builtin_amdgcn_readfirstlane(tid >> 6);
#pragma unroll 2
        for (int i = 0; i < 8; ++i) {
          const int n = sub * 64 + wid * 8 + i;
          const bf16_t* zr = ZT + ((size_t)b * 512 + n) * 4096;
          float sacc = 0.f;
#pragma unroll
          for (int j = 0; j < 4; ++j) {
            const u32x4 v = *(const u32x4*)(zr + lane * 8 + 512 * j);
#pragma unroll
            for (int e = 0; e < 4; ++e) sacc += bf_lo(v[e]) - bf_hi(v[e]);
          }
          const float tot = wave_sum(sacc) * (1.0f / 512.0f);
          if (lane == 0) FM[((size_t)b * SEQ + 1024) * 512 + n] = (bf16_t)(pk2(tot, 0.f) & 0xffffu);
        }
      }
    }
  }
}

template <int MI>
DI void phase_branch(const Params& p, int l, char* smem) {
  const bool last = (l == DEPTH - 1);
  const bf16_t* W = (const bf16_t*)(p.ws + w_off(l));
  const bf16_t* U = (const bf16_t*)(p.ws + OFF_U);
  const bf16_t* ATT = (const bf16_t*)(p.ws + OFF_ATT); const bf16_t* FM = (const bf16_t*)(p.ws + OFF_FM); const bf16_t* PM = (const bf16_t*)(p.ws + OFF_PM);
  bf16_t* MOUT = (bf16_t*)(p.ws + OFF_MOUT);
  const int nmt = (last ? T_LAT : T_ALL) / (64 * MI), vmax = tile_vmax(nmt, 8);
  for (int v = blockIdx.x; v < vmax; v += gridDim.x) {
    int mt, nt;
    if (!tile_map(v, nmt, 8, mt, nt)) continue;
    const int m0 = mt * 64 * MI, n0 = nt * 128;
    u32x2 tot[MI][4], gpk[MI][4];
#pragma unroll
    for (int mi = 0; mi < MI; ++mi)
#pragma unroll
      for (int ni = 0; ni < 4; ++ni) tot[mi][ni] = (u32x2){0u, 0u};
#pragma unroll 1
    for (int br = 0; br < 3; ++br) {
      __builtin_amdgcn_sched_barrier(0);
      f32x4 acc[MI][4]; zero_acc_t<MI>(acc);
      const bool pre = !last && br == 0 && (m0 + 64 * MI <= G8_ROWS);
      if (!pre) {
        gemm_kloop_pp<true, MI>(U + (size_t)m0 * 1024, 1024, W + WO_WIN + (size_t)(ROW_G + br * 1024 + n0) * 1024, 1024, 1024, acc, smem);
        __builtin_amdgcn_sched_barrier(0);
#pragma unroll
        for (int mi = 0; mi < MI; ++mi)
#pragma unroll
          for (int ni = 0; ni < 4; ++ni) {
            const f32x4 a = acc[mi][ni];
            gpk[mi][ni] = (u32x2){pk2(sigmoidf_(a[0]), sigmoidf_(a[1])), pk2(sigmoidf_(a[2]), sigmoidf_(a[3]))};
          }
      } else {
        const unsigned char* G8 = (const unsigned char*)(p.ws + OFF_G8);
        const int tid_ = g_tid(), lane_ = tid_ & 63, wid_ = __builtin_amdgcn_readfirstlane(tid_ >> 6), wm_ = wid_ >> 1, wn_ = wid_ & 1, fq_ = lane_ >> 4, fr_ = lane_ & 15;
#pragma unroll
        for (int mi = 0; mi < MI; ++mi)
#pragma unroll
          for (int ni = 0; ni < 4; ++ni) {
            const unsigned g = *(const unsigned*)(G8 + (size_t)(m0 + wm_ * 16 * MI + mi * 16 + fr_) * 1024 + n0 + wn_ * 64 + ni * 16 + fq_ * 4);
            gpk[mi][ni] = (u32x2){pk2((float)(g & 255u) * (1.0f / 255.0f), (float)((g >> 8) & 255u) * (1.0f / 255.0f)),
                                  pk2((float)((g >> 16) & 255u) * (1.0f / 255.0f), (float)(g >> 24) * (1.0f / 255.0f))};
          }
      }
      __builtin_amdgcn_sched_barrier(0);
      zero_acc_t<MI>(acc);
      const int K2 = (br == 0) ? 1024 : 512;
      const bf16_t* A2 = (br == 0) ? (ATT + (size_t)m0 * 1024) : ((br == 1 ? FM : PM) + (size_t)m0 * 512);
      const bf16_t* B2 = (br == 0) ? (W + WO_WA + (size_t)n0 * 1024) : (W + (br == 1 ? WO_WF : WO_WP) + (size_t)n0 * 512);
      gemm_kloop_pp<true, MI>(A2, K2, B2, K2, K2, acc, smem);
      __builtin_amdgcn_sched_barrier(0);
#pragma unroll
      for (int mi = 0; mi < MI; ++mi)
#pragma unroll
        for (int ni = 0; ni < 4; ++ni) {
          const f32x4 a = acc[mi][ni]; const u32x2 g = gpk[mi][ni]; const u32x2 tp = tot[mi][ni];
          const float v0 = bf_lo(g[0]) * a[0] + bf_lo(tp[0]), v1 = bf_hi(g[0]) * a[1] + bf_hi(tp[0]);
          const float v2 = bf_lo(g[1]) * a[2] + bf_lo(tp[1]), v3 = bf_hi(g[1]) * a[3] + bf_hi(tp[1]);
          tot[mi][ni] = (u32x2){pk2(v0, v1), pk2(v2, v3)};
        }
    }
    const int tid = g_tid(), lane = tid & 63, wid = __builtin_amdgcn_readfirstlane(tid >> 6), wm = wid >> 1, wn = wid & 1, fq = lane >> 4, fr = lane & 15;
#pragma unroll
    for (int mi = 0; mi < MI; ++mi)
#pragma unroll
      for (int ni = 0; ni < 4; ++ni)
        *(u32x2*)(MOUT + (size_t)(m0 + wm * 16 * MI + mi * 16 + fr) * 1024 + n0 + wn * 64 + ni * 16 + fq * 4) = tot[mi][ni];
  }
}

template <int MI>
DI void phase_gemm_plain(const bf16_t* __restrict__ A, int K, const bf16_t* __restrict__ Bt, bf16_t* __restrict__ C, int nmt, int nnt, char* smem) {
  const int vmax = tile_vmax(nmt, nnt), N = nnt * 128;
  for (int v = blockIdx.x; v < vmax; v += gridDim.x) {
    int mt, nt;
    if (!tile_map(v, nmt, nnt, mt, nt)) continue;
    f32x4 acc[MI][4]; zero_acc_t<MI>(acc);
    gemm_kloop_pp<true, MI>(A + (size_t)mt * 64 * MI * K, K, Bt + (size_t)nt * 128 * K, K, K, acc, smem);
    store_tile_bf16<MI>(acc, C + (size_t)mt * 64 * MI * N + nt * 128, N, 1.0f);
  }
}
DI void phase_ffn1(const Params& p, int l, char* smem) {
  const bool last = (l == DEPTH - 1);
  const bf16_t* W = (const bf16_t*)(p.ws + w_off(l)) + WO_WGU;
  const bf16_t* U = (const bf16_t*)(p.ws + OFF_U);
  bf16_t* H = (bf16_t*)(p.ws + OFF_H);
  const int nsup = (last ? 8 : 9) * 11;
  const int vmax = ((nsup + 15) >> 4) << 8;
  auto map_tile = [&](int v, int& mt, int& nt) -> bool {
    if (v >= vmax) return false;
    const int c = v >> 8, w = v & 255, local = w >> 3, sup = (c * 8 + (w & 7)) * 2 + (local >> 4);
    if (sup >= nsup) return false;
    mt = (sup / 11) * 8 + (local & 7); nt = (sup % 11) * 2 + ((local >> 3) & 1);
    return true;
  };
  int v = blockIdx.x, mt = 0, nt = 0;
  bool cur = map_tile(v, mt, nt);
  if (cur) gemm_prefetch_big(U + (size_t)mt * 256 * 1024, 1024, W + (size_t)nt * 256 * 1024, 1024, smem);
  while (cur) {
    f32x4 acc[8][4];
#pragma unroll
    for (int i = 0; i < 8; ++i)
#pragma unroll
      for (int j = 0; j < 4; ++j) acc[i][j] = (f32x4){0.f, 0.f, 0.f, 0.f};
    gemm_kloop_big<true>(U + (size_t)mt * 256 * 1024, 1024, W + (size_t)nt * 256 * 1024, 1024, 1024, acc, smem, true);
    int v2 = v + gridDim.x, mt2 = 0, nt2 = 0;
    const bool nxt = map_tile(v2, mt2, nt2);
    if (nxt) gemm_prefetch_big(U + (size_t)mt2 * 256 * 1024, 1024, W + (size_t)nt2 * 256 * 1024, 1024, smem);
    const int tid = g_tid(), lane = tid & 63, wid = __builtin_amdgcn_readfirstlane(tid >> 6), wm = wid >> 2, wn = wid & 3, fq = lane >> 4, fr = lane & 15;
#pragma unroll
    for (int mi = 0; mi < 8; ++mi) {
      float o[8];
#pragma unroll
      for (int h2 = 0; h2 < 2; ++h2) {
        const f32x4 g = acc[mi][h2], u = acc[mi][2 + h2];
#pragma unroll
        for (int j = 0; j < 4; ++j) o[4 * h2 + j] = g[j] * sigmoidf_(g[j]) * u[j];
      }
      *(u32x4*)(H + (size_t)(mt * 256 + wm * 128 + mi * 16 + fr) * DFF + (nt * 4 + wn) * 32 + 8 * fq) = (u32x4){pk2(o[0], o[1]), pk2(o[2], o[3]), pk2(o[4], o[5]), pk2(o[6], o[7])};
    }
    v = v2; mt = mt2; nt = nt2; cur = nxt;
  }
}

struct InprojSched {
  const char* U; const char* W; int nsupA, nsup, vmax, grid, bid; bool fill;
  DI static bool transposed(int nt) { return (nt >= 4 && nt < 8) || (nt >= 12 && nt < 16); }
  DI bool next(int i, pg8::Unit& u) const {
    const int v = bid + i * grid;
    if (v >= vmax) return false;
    const int c = v >> 8, w = v & 255, local = w >> 3, sup = (c * 8 + (w & 7)) * 2 + (local >> 4);
    if (sup >= nsup) return false;
    if (sup < nsupA) { u.pm = (sup / 9) * 8 + (local & 7); u.pn = (sup % 9) * 2 + ((local >> 3) & 1); }
    else if (fill) { const int q = (sup - nsupA) * 16 + (local & 15); u.pm = q >> 2; u.pn = 18 + (q & 3); }
    else { u.pm = 64 + (local & 7); u.pn = (sup - nsupA) * 2 + ((local >> 3) & 1); }
    return true;
  }
  DI const char* pa(const pg8::Unit& u) const { return transposed(u.pn) ? W + (size_t)u.pn * 256 * 1024 * 2 : U + (size_t)u.pm * 256 * 1024 * 2; }
  DI const char* pb(const pg8::Unit& u) const { return transposed(u.pn) ? U + (size_t)u.pm * 256 * 1024 * 2 : W + (size_t)u.pn * 256 * 1024 * 2; }
};
struct InprojEpi {
  bf16_t *KB, *VT, *QB, *CQ, *ZT, *ZTC, *R; unsigned char* G8; const float *ropec, *ropes;
  DI void operator()(const f32x4 (&acc)[2][2][4][2], const pg8::Unit& u, int wr, int wc, int fr, int fq) const {
    const int mt = u.pm, nt = u.pn, m0 = mt * 256;
    int b, pos0; bool isctx; row_info(m0, b, pos0, isctx);
    if (nt < 4 || (nt >= 8 && nt < 12)) {
      const bool isq = nt >= 8; const int map = wc >> 1, axis = wc & 1;
      const float sc = isq ? QSCALE : 1.0f;
#pragma unroll
      for (int ai = 0; ai < 2; ++ai)
#pragma unroll
        for (int m = 0; m < 4; ++m) {
          const int pos = pos0 + 128 * ai + 64 * wr + 16 * m + fr;
          f32x4 cs = {1.f, 1.f, 1.f, 1.f}, sn = {0.f, 0.f, 0.f, 0.f};
          if (!isctx) { cs = *(const f32x4*)(ropec + pos * 32 + axis * 16 + fq * 4); sn = *(const f32x4*)(ropes + pos * 32 + axis * 16 + fq * 4); }
#pragma unroll
          for (int bj = 0; bj < 2; ++bj) {
            const int h = (nt * 2 + bj) & 7;
            const f32x4 x0 = acc[ai][bj][m][0], x1 = acc[ai][bj][m][1];
            const f32x4 o0 = (x0 * cs - x1 * sn) * sc, o1 = (x1 * cs + x0 * sn) * sc;
            bf16_t* dst;
            if (!isq) dst = KB + ((size_t)((b * 8 + h) * 2 + map) * NKEY + (isctx ? SEQ + pos : pos)) * 64;
            else if (!isctx) dst = QB + ((size_t)((b * 8 + h) * 2 + map) * SEQ + pos) * 64;
            else dst = CQ + ((size_t)((b * 8 + h) * 2 + map) * LC + pos) * 64;
            *(u32x2*)(dst + axis * 32 + fq * 4) = (u32x2){pk2(o0[0], o0[1]), pk2(o0[2], o0[3])};
            *(u32x2*)(dst + axis * 32 + 16 + fq * 4) = (u32x2){pk2(o1[0], o1[1]), pk2(o1[2], o1[3])};
          }
        }
    } else if (nt < 8 || (nt >= 12 && nt < 16)) {
      const bool isv = nt < 8;
#pragma unroll
      for (int ai = 0; ai < 2; ++ai)
#pragma unroll
        for (int m = 0; m < 4; ++m) {
          const int ncol = nt * 256 + 128 * ai + 64 * wr + 16 * m + fr;
#pragma unroll
          for (int bj = 0; bj < 2; ++bj)
#pragma unroll
            for (int n = 0; n < 2; ++n) {
              const int pos = pos0 + 128 * bj + 32 * wc + 16 * n + 4 * fq;
              const f32x4 vv = acc[ai][bj][m][n];
              bf16_t* dst;
              if (isv) {
                const int vg = ncol - 1024, h = vg >> 7, vcol = vg & 127;
                const int key = (isctx ? SEQ : 0) + pos, k15 = key & 15;
                const int pkey = (key & ~15) | (k15 & 3) | ((k15 & 4) << 1) | ((k15 & 8) >> 1);
                dst = VT + ((size_t)(b * 8 + h) * 128 + vcol) * NKEY + pkey;
              } else {
                const int zc = ncol - 3072, np = zc & 511, second = zc >> 9;
                dst = isctx ? (ZTC + ((size_t)b * 512 + np) * 512 + second * 256 + pos) : (ZT + ((size_t)b * 512 + np) * 4096 + second * 2048 + pos);
              }
              *(u32x2*)dst = (u32x2){pk2(vv[0], vv[1]), pk2(vv[2], vv[3])};
            }
        }
    } else if (nt >= 18) {
#pragma unroll
      for (int ai = 0; ai < 2; ++ai)
#pragma unroll
        for (int m = 0; m < 4; ++m) {
          const int row = m0 + 128 * ai + 64 * wr + 16 * m + fr;
#pragma unroll
          for (int bj = 0; bj < 2; ++bj)
#pragma unroll
            for (int n = 0; n < 2; ++n) {
              const int col = nt * 256 + 128 * bj + 32 * wc + 16 * n + 4 * fq - 4608;
              const f32x4 vv = acc[ai][bj][m][n];
              unsigned w = 0;
#pragma unroll
              for (int j = 0; j < 4; ++j) w |= (unsigned)__builtin_rintf(sigmoidf_(vv[j]) * 255.0f) << (8 * j);
              *(unsigned*)(G8 + (size_t)row * 1024 + col) = w;
            }
        }
    } else {
#pragma unroll
      for (int ai = 0; ai < 2; ++ai)
#pragma unroll
        for (int m = 0; m < 4; ++m) {
          const int row = m0 + 128 * ai + 64 * wr + 16 * m + fr;
#pragma unroll
          for (int bj = 0; bj < 2; ++bj)
#pragma unroll
            for (int n = 0; n < 2; ++n) {
              const int col = nt * 256 + 128 * bj + 32 * wc + 16 * n + 4 * fq - 4096;
              const f32x4 vv = acc[ai][bj][m][n];
              *(u32x2*)(R + (size_t)row * 512 + col) = (u32x2){pk2(vv[0], vv[1]), pk2(vv[2], vv[3])};
            }
        }
    }
  }
};
DI void phase_inproj8(const Params& p, int l, char* smem) {
  const bool last = (l == DEPTH - 1);
  InprojSched S;
  S.U = (const char*)(p.ws + OFF_U); S.W = (const char*)((const bf16_t*)(p.ws + w_off(l)) + WO_WIN);
  S.nsupA = last ? 72 : 81; S.nsup = last ? 76 : 96; S.fill = !last;
  S.vmax = ((S.nsup + 15) >> 4) << 8; S.grid = gridDim.x; S.bid = blockIdx.x;
  InprojEpi E;
  E.KB = (bf16_t*)(p.ws + OFF_KB); E.VT = (bf16_t*)(p.ws + OFF_VT); E.QB = (bf16_t*)(p.ws + OFF_QB); E.CQ = (bf16_t*)(p.ws + OFF_CQ);
  E.ZT = (bf16_t*)(p.ws + OFF_ZT); E.ZTC = (bf16_t*)(p.ws + OFF_ZTC); E.R = (bf16_t*)(p.ws + OFF_R);
  E.ropec = (const float*)(p.ws + OFF_ROPEC); E.ropes = (const float*)(p.ws + OFF_ROPES); E.G8 = (unsigned char*)(p.ws + OFF_G8);
  pg8::gemm_phase(( __attribute__((address_space(3))) unsigned char*)(lds_ptr_t)smem, 1024, S, E);
}
struct Ffn1Sched {
  const char* U; const char* W; int nsup, vmax, grid, bid;
  DI bool next(int i, pg8::Unit& u) const {
    const int v = bid + i * grid;
    if (v >= vmax) return false;
    const int c = v >> 8, w = v & 255, local = w >> 3, sup = (c * 8 + (w & 7)) * 2 + (local >> 4);
    if (sup >= nsup) return false;
    u.pm = (sup / 11) * 8 + (local & 7); u.pn = (sup % 11) * 2 + ((local >> 3) & 1);
    return true;
  }
  DI const char* pa(const pg8::Unit& u) const { return U + (size_t)u.pm * 256 * 1024 * 2; }
  DI const char* pb(const pg8::Unit& u) const { return W + (size_t)u.pn * 256 * 1024 * 2; }
};
struct Ffn1Epi {
  bf16_t* H;
  DI void operator()(const f32x4 (&acc)[2][2][4][2], const pg8::Unit& u, int wr, int wc, int fr, int fq) const {
#pragma unroll
    for (int ai = 0; ai < 2; ++ai)
#pragma unroll
      for (int m = 0; m < 4; ++m) {
        const int row = u.pm * 256 + 128 * ai + 64 * wr + 16 * m + fr;
#pragma unroll
        for (int bj = 0; bj < 2; ++bj) {
          const f32x4 g = acc[ai][bj][m][0], up = acc[ai][bj][m][1];
          float o[4];
#pragma unroll
          for (int j = 0; j < 4; ++j) o[j] = g[j] * sigmoidf_(g[j]) * up[j];
          *(u32x2*)(H + (size_t)row * DFF + u.pn * 128 + (bj * 4 + wc) * 16 + fq * 4) = (u32x2){pk2(o[0], o[1]), pk2(o[2], o[3])};
        }
      }
  }
};
DI void phase_ffn18(const Params& p, int l, char* smem) {
  const bool last = (l == DEPTH - 1);
  Ffn1Sched S;
  S.U = (const char*)(p.ws + OFF_U); S.W = (const char*)((const bf16_t*)(p.ws + w_off(l)) + WO_WGU);
  S.nsup = (last ? 8 : 9) * 11; S.vmax = ((S.nsup + 15) >> 4) << 8; S.grid = gridDim.x; S.bid = blockIdx.x;
  Ffn1Epi E; E.H = (bf16_t*)(p.ws + OFF_H);
  pg8::gemm_phase((__attribute__((address_space(3))) unsigned char*)(lds_ptr_t)smem, 1024, S, E);
  if (!last) convert_grab(p, l + 1, 1, smem);
}

struct Plain8Sched {
  const char* A; const char* B; int K, grid, bid;
  DI bool next(int i, pg8::Unit& u) const {
    const int v = bid + i * grid;
    if (v >= 256) return false;
    const int xcd = v & 7, local = v >> 3;
    u.pm = xcd * 8 + (local & 7); u.pn = local >> 3;
    return true;
  }
  DI const char* pa(const pg8::Unit& u) const { return A + (size_t)u.pm * 256 * K * 2; }
  DI const char* pb(const pg8::Unit& u) const { return B + (size_t)u.pn * 256 * K * 2; }
};
struct Plain8Epi {
  bf16_t* C;
  DI void operator()(const f32x4 (&acc)[2][2][4][2], const pg8::Unit& u, int wr, int wc, int fr, int fq) const {
#pragma unroll
    for (int ai = 0; ai < 2; ++ai)
#pragma unroll
      for (int m = 0; m < 4; ++m) {
        const int row = u.pm * 256 + 128 * ai + 64 * wr + 16 * m + fr;
#pragma unroll
        for (int bj = 0; bj < 2; ++bj)
#pragma unroll
          for (int n = 0; n < 2; ++n) {
            const f32x4 v = acc[ai][bj][m][n];
            *(u32x2*)(C + (size_t)row * 1024 + u.pn * 256 + 128 * bj + 32 * wc + 16 * n + 4 * fq) = (u32x2){pk2(v[0], v[1]), pk2(v[2], v[3])};
          }
      }
  }
};
DI void phase_plain8(const bf16_t* A, int K, const bf16_t* Bt, bf16_t* C, char* smem) {
  Plain8Sched S; S.A = (const char*)A; S.B = (const char*)Bt; S.K = K; S.grid = gridDim.x; S.bid = blockIdx.x;
  Plain8Epi E; E.C = C;
  pg8::gemm_phase((__attribute__((address_space(3))) unsigned char*)(lds_ptr_t)smem, K, S, E);
}

#define XB_TMO      128
#define XB_XCNT(j)  (256  + 64 * (j))
#define XB_XSUB(j)  (1280 + 64 * (j))
#define XB_XGEN(j)  (2304 + 64 * (j))
#define XB_TOP      3328
#define XB_TOPGEN   3392
#define XCD_BAR_WORDS 3456
#define XB_SPIN_CAP (1u << 20)
#define LAS __attribute__((address_space(3)))
DI unsigned xb_ld(unsigned* p) { return __hip_atomic_load(p, __ATOMIC_RELAXED, __HIP_MEMORY_SCOPE_AGENT); }
DI unsigned xb_add(unsigned* p, unsigned v) { return __hip_atomic_fetch_add(p, v, __ATOMIC_RELAXED, __HIP_MEMORY_SCOPE_AGENT); }
DI unsigned xb_xcc_id() { return (unsigned)__builtin_amdgcn_s_getreg((3 << 11) | 20) & 0xFu; }
#define XB_SPIN(cond, bar) do { unsigned _sp = 0; while (cond) { __builtin_amdgcn_s_sleep(1); \
    if ((++_sp & 255u) == 0u) { if (xb_ld(&(bar)[XB_TMO])) break; if (_sp > XB_SPIN_CAP) { atomicAdd(&(bar)[XB_TMO], 1u); break; } } } } while (0)
struct XcdBarrier { unsigned* bar; unsigned x; volatile LAS unsigned* st; };
DI XcdBarrier xcd_barrier_post(unsigned* bar, volatile LAS unsigned* st) {
  XcdBarrier b; b.bar = bar; b.x = xb_xcc_id(); b.st = st;
  if (__builtin_amdgcn_workitem_id_x() == 0) (void)xb_add(&bar[XB_XCNT(b.x)], 1u);
  return b;
}
DI void xcd_barrier_complete(unsigned* bar, unsigned x, unsigned& nloc, unsigned& nx) {
  const unsigned G = gridDim.x * gridDim.y * gridDim.z;
  unsigned sum, cnt, mine, sp = 0u;
  for (;;) {
    sum = 0u; cnt = 0u; mine = 0u;
#pragma unroll
    for (unsigned j = 0; j < 16; ++j) { const unsigned c = xb_ld(&bar[XB_XCNT(j)]); sum += c; cnt += (c > 0u) ? 1u : 0u; mine = (j == x) ? c : mine; }
    if (sum == G) break;
    __builtin_amdgcn_s_sleep(1);
    if ((++sp & 255u) == 0u) { if (xb_ld(&bar[XB_TMO])) break; if (sp > XB_SPIN_CAP) { atomicAdd(&bar[XB_TMO], 1u); break; } }
  }
  nloc = mine > 0u ? mine : 1u; nx = cnt > 0u ? cnt : 1u;
}
DI void xcd_barrier(const XcdBarrier& b) {
  asm volatile("s_waitcnt vmcnt(0)" ::: "memory");
  __syncthreads();
  if (__builtin_amdgcn_workitem_id_x() == 0) {
    unsigned* bar = b.bar;
    __builtin_amdgcn_s_waitcnt(0);
    unsigned nloc = b.st[0], nx = b.st[1];
    if (nloc == 0u) { xcd_barrier_complete(bar, b.x, nloc, nx); b.st[0] = nloc; b.st[1] = nx; }
    const unsigned old = xb_add(&bar[XB_XSUB(b.x)], 1u);
    const unsigned gen = old / nloc;
    if (old + 1u == (gen + 1u) * nloc) {
      __builtin_amdgcn_fence(__ATOMIC_RELEASE, "agent");
      asm volatile("s_waitcnt vmcnt(0)" ::: "memory");
      const unsigned og = xb_add(&bar[XB_TOP], 1u);
      const unsigned tg = og / nx;
      if (og + 1u == (tg + 1u) * nx) xb_add(&bar[XB_TOPGEN], 1u);
      else XB_SPIN(xb_ld(&bar[XB_TOPGEN]) == tg, bar);
      __builtin_amdgcn_fence(__ATOMIC_ACQUIRE, "agent");
      xb_add(&bar[XB_XGEN(b.x)], 1u);
      asm volatile("s_waitcnt vmcnt(0)" ::: "memory");
    } else {
      XB_SPIN(xb_ld(&bar[XB_XGEN(b.x)]) == gen, bar);
      __builtin_amdgcn_fence(__ATOMIC_ACQUIRE, "agent");
      asm volatile("s_waitcnt vmcnt(0)" ::: "memory");
    }
  }
  __syncthreads();
}

#define REP_MASK 0
#define REP_PRO 0
__global__ void __launch_bounds__(512) mega(Params p0) {
  extern __shared__ __attribute__((aligned(16))) char smem[];
  cg::grid_group grid = cg::this_grid();
  volatile LAS unsigned* xst = (volatile LAS unsigned*)(lds_ptr_t)(smem + 3 * GSTAGE);
  if (__builtin_amdgcn_workitem_id_x() < 4) xst[__builtin_amdgcn_workitem_id_x()] = 0u;
  __syncthreads();
  const XcdBarrier xb = xcd_barrier_post((unsigned*)(p0.ws + OFF_BAR), xst);
  for (int ph = p0.ph_begin; ph < p0.ph_end; ++ph) {
    const Params& p = p0;
    const bf16_t* Wl = (const bf16_t*)(p.ws + w_off(ph >= 2 ? (ph - 2) >> 3 : 0));
    if (ph == 0) { phase0a(p, smem); if (REP_PRO & 1) { xcd_barrier(xb); phase0a(p, smem); } }
    else if (ph == 1) { ln_pass(p, 0, T_ALL, nullptr, nullptr, nullptr, 0, 0, 0, 0); if (REP_PRO & 2) { xcd_barrier(xb); ln_pass(p, 0, T_ALL, nullptr, nullptr, nullptr, 0, 0, 0, 0); } }
    else {
      const int l = (ph - 2) >> 3, s = (ph - 2) & 7;
      const bool last = (l == DEPTH - 1);
      const int nmt = last ? 64 : 72, nrows = last ? T_LAT : T_ALL;
      for (int rep = 0; rep < 1 + ((REP_MASK >> s) & 1); ++rep) {
      if (rep) xcd_barrier(xb);
      switch (s) {
        case 0: phase_inproj8(p, l, smem); break;
        case 1: phase_mix(p, l, smem); if (!last) convert_grab(p, l + 1, 0, smem); break;
        case 2: if (last) phase_branch<4>(p, l, smem); else { phase_branch<3>(p, l, smem); convert_grab(p, l + 1, 0, smem); } break;
        case 3: if (last) phase_plain8((const bf16_t*)(p.ws + OFF_MOUT), 1024, Wl + WO_WO, (bf16_t*)(p.ws + OFF_Y), smem);
                else phase_gemm_plain<3>((const bf16_t*)(p.ws + OFF_MOUT), 1024, Wl + WO_WO, (bf16_t*)(p.ws + OFF_Y), 96, 8, smem);
                break;
        case 4: ln_pass(p, 1, nrows, (const bf16_t*)(p.ws + OFF_Y), p.ln1_g + (size_t)l * 1024, p.ln1_b + (size_t)l * 1024, l, 2, l, 3); break;
        case 5: phase_ffn18(p, l, smem); break;
        case 6: if (last) phase_plain8((const bf16_t*)(p.ws + OFF_H), DFF, Wl + WO_WD, (bf16_t*)(p.ws + OFF_FO), smem);
                else phase_gemm_plain<3>((const bf16_t*)(p.ws + OFF_H), DFF, Wl + WO_WD, (bf16_t*)(p.ws + OFF_FO), 96, 8, smem);
                break;
        default:
          ln_pass(p, last ? 2 : 1, nrows, (const bf16_t*)(p.ws + OFF_FO), p.ln2_g + (size_t)l * 1024, p.ln2_b + (size_t)l * 1024, l, 5, last ? l : l + 1, 0);
          if (!last) { convert_grab(p, l + 1, 0, smem); convert_grab(p, l + 1, 1, smem); }
          break;
      }
      }
    }
    if (ph + 1 < p0.ph_end) { if (p0.ph_begin < 0) grid.sync(); xcd_barrier(xb); }
  }
}

extern "C" void kernel_launch(void* const* d_in, const int* in_sizes, int n_in, void* d_out, int out_size, void* d_ws, size_t ws_size, hipStream_t stream) {
  constexpr size_t kDynLds = 3 * GSTAGE + 16;
  static int grid_blocks = 0;
  if (!grid_blocks) {
    int dev = 0, cus = 0, per_cu = 0;
    (void)hipGetDevice(&dev);
    (void)hipDeviceGetAttribute(&cus, hipDeviceAttributeMultiprocessorCount, dev);
    (void)hipFuncSetAttribute((const void*)mega, hipFuncAttributeMaxDynamicSharedMemorySize, (int)kDynLds);
    (void)hipOccupancyMaxActiveBlocksPerMultiprocessor(&per_cu, mega, 512, kDynLds);
    if (per_cu > 1) per_cu = 1;
    if (per_cu < 1) per_cu = 1;
    grid_blocks = cus * per_cu;
  }
  if (ws_size < WS_NEED) { fprintf(stderr, "workspace too small: %zu < %zu\n", ws_size, (size_t)WS_NEED); return; }
  (void)hipMemsetAsync((char*)d_ws + OFF_BAR, 0, XCD_BAR_WORDS * 4 + 64, stream);
  Params p;
  memset(&p, 0, sizeof(p));
  const float** fp = (const float**)&p;
  for (int i = 0; i < 22; ++i) fp[i] = (const float*)d_in[i];
  p.out = (float*)d_out;
  p.ws = (char*)d_ws;
  for (int l = 0; l < 4; ++l) p.lam_init[l] = (float)(0.8 - 0.6 * exp(-0.3 * l));
  p.ph_begin = 0; p.ph_end = 2 + 8 * DEPTH;
  void* args[] = {&p};
  hipError_t e = hipLaunchCooperativeKernel((void*)mega, dim3(grid_blocks), dim3(512), args, kDynLds, stream);
  if (e != hipSuccess) fprintf(stderr, "cooperative launch failed: %s (grid %d)\n", hipGetErrorString(e), grid_blocks);
}
```
